# Optimizing an MI355X kernel written in HIP

```python
import math
import jax, jax.numpy as jnp
from jax import lax
import numpy as np

D_MODEL = 1024
BATCH = 4
SEQ = 8192
DEPTH = 2

EPS = 1e-6
SC_WIDTH = 1024
SC_CONV_WIDTH = 3
SSM_D_INNER = 1024
SSM_HEADDIM = 64
SSM_HEADS = SSM_D_INNER // SSM_HEADDIM
SSM_GROUPS = 4
SSM_HPG = SSM_HEADS // SSM_GROUPS
SSM_STATE = 128
SSM_CONV_WIDTH = 4
SSM_CHUNK = 128
SSM_CONV_DIM = SSM_D_INNER + 2 * SSM_GROUPS * SSM_STATE
GLA_HEADS = 4
GLA_KEY_DIM = D_MODEL // 2
GLA_VAL_DIM = D_MODEL
GLA_HEAD_K = GLA_KEY_DIM // GLA_HEADS
GLA_HEAD_V = GLA_VAL_DIM // GLA_HEADS
GLA_GATE_RANK = 16
GLA_GATE_NORMALIZER = 16.0
GLA_CHUNK = 64
N_BRANCHES = 3
D_FF = 4 * D_MODEL

SPLIT_SIZES = (
    SC_WIDTH, SC_WIDTH, SC_WIDTH,
    SSM_D_INNER, SSM_CONV_DIM, SSM_HEADS,
    GLA_KEY_DIM, GLA_KEY_DIM, GLA_VAL_DIM, GLA_VAL_DIM, GLA_GATE_RANK,
    N_BRANCHES * D_MODEL,
)
IN_WIDTH = 12320

kernel_name = "hybrid_conv_ssd_gla_block"


def split_cols(u, sizes):
    outs, start = [], 0
    for s in sizes:
        outs.append(u[..., start:start + s])
        start += s
    return outs


def rms_norm(x, w):
    xf = x.astype(jnp.float32)
    y = xf * lax.rsqrt(jnp.mean(xf * xf, axis=-1, keepdims=True) + EPS)
    return (y * w.astype(jnp.float32)).astype(x.dtype)


def causal_dwconv(u, w):
    K = w.shape[0]
    s = u.shape[1]
    up = jnp.pad(u, ((0, 0), (K - 1, 0), (0, 0)))
    y = up[:, 0:s, :] * w[0]
    for k in range(1, K):
        y = y + up[:, k:k + s, :] * w[k]
    return y


def short_conv_mixer(a_x, a_b, a_c, conv_w, w_out):
    u = causal_dwconv(a_c * a_x, conv_w)
    return (a_b * u) @ w_out


def mamba2_ssd(z, xbc, dt_raw, conv_w, conv_b, dt_bias, a_log, d_skip, norm_w, w_out):
    b, s, _ = z.shape
    f32 = jnp.float32
    G, R, P, N, Q = SSM_GROUPS, SSM_HPG, SSM_HEADDIM, SSM_STATE, SSM_CHUNK
    nc = s // Q
    xbc = jax.nn.silu(causal_dwconv(xbc, conv_w) + conv_b)
    xs, bm, cm = split_cols(xbc, (SSM_D_INNER, G * N, G * N))
    dt = jax.nn.softplus((dt_raw + dt_bias).astype(f32))
    a = -jnp.exp(a_log.astype(f32)).reshape(G, R)
    xh = xs.astype(f32).reshape(b, nc, Q, G, R, P)
    bm = bm.astype(f32).reshape(b, nc, Q, G, N)
    cm = cm.astype(f32).reshape(b, nc, Q, G, N)
    dt_c = dt.reshape(b, nc, Q, G, R)
    a_cum = jnp.cumsum(dt_c * a, axis=2)
    xdt = xh * dt_c[..., None]
    causal = jnp.tril(jnp.ones((Q, Q), dtype=bool))[None, None, :, :, None, None]
    seg = a_cum[:, :, :, None] - a_cum[:, :, None]
    decay_ls = jnp.where(causal, jnp.exp(jnp.where(causal, seg, 0.0)), 0.0)
    cb = jnp.einsum("bclgn,bcsgn->bclsg", cm, bm)
    y_diag = jnp.einsum("bclsg,bclsgr,bcsgrp->bclgrp", cb, decay_ls, xdt)
    decay_to_end = jnp.exp(a_cum[:, :, -1:] - a_cum)
    states = jnp.einsum("bclgn,bclgr,bclgrp->bcgrpn", bm, decay_to_end, xdt)
    chunk_decay = jnp.exp(a_cum[:, :, -1])

    def step(carry, inp):
        st, dec = inp
        return dec[..., None, None] * carry + st, carry

    init = jnp.zeros((b, G, R, P, N), f32)
    _, prev = lax.scan(step, init, (jnp.moveaxis(states, 1, 0), jnp.moveaxis(chunk_decay, 1, 0)))
    prev = jnp.moveaxis(prev, 0, 1)
    y_off = jnp.einsum("bclgn,bcgrpn,bclgr->bclgrp", cm, prev, jnp.exp(a_cum))
    y = y_diag + y_off + xh * d_skip.astype(f32).reshape(G, R)[:, :, None]
    y = y.reshape(b, s, SSM_D_INNER) * jax.nn.silu(z.astype(f32))
    yg = y.reshape(b, s, G, SSM_D_INNER // G)
    yg = yg * lax.rsqrt(jnp.mean(yg * yg, axis=-1, keepdims=True) + EPS)
    y = yg.reshape(b, s, SSM_D_INNER) * norm_w.astype(f32)
    return y.astype(z.dtype) @ w_out


def gla_mixer(q, k, v, g, gk_low, w_gk2, b_gk, norm_w, w_out):
    b, s, _ = q.shape
    f32 = jnp.float32
    H, DK, DV, T = GLA_HEADS, GLA_HEAD_K, GLA_HEAD_V, GLA_CHUNK
    nc = s // T
    gk = jax.nn.log_sigmoid((gk_low @ w_gk2 + b_gk).astype(f32)) / GLA_GATE_NORMALIZER
    qh = q.astype(f32).reshape(b, nc, T, H, DK) * (DK ** -0.5)
    kh = k.astype(f32).reshape(b, nc, T, H, DK)
    vh = v.astype(f32).reshape(b, nc, T, H, DV)
    gcum = jnp.cumsum(gk.reshape(b, nc, T, H, DK), axis=2)
    q_in = qh * jnp.exp(gcum)
    k_in = kh * jnp.exp(-gcum)
    causal = jnp.tril(jnp.ones((T, T), dtype=bool))[None, None, None]
    scores = jnp.where(causal, jnp.einsum("bclhd,bcshd->bchls", q_in, k_in), 0.0)
    o_intra = jnp.einsum("bchls,bcshv->bclhv", scores, vh)
    g_last = gcum[:, :, -1]
    k_end = kh * jnp.exp(g_last[:, :, None] - gcum)
    chunk_kv = jnp.einsum("bclhd,bclhv->bchdv", k_end, vh)
    chunk_decay = jnp.exp(g_last)

    def step(carry, inp):
        kv, dec = inp
        return dec[..., None] * carry + kv, carry

    init = jnp.zeros((b, H, DK, DV), f32)
    _, prev = lax.scan(step, init, (jnp.moveaxis(chunk_kv, 1, 0), jnp.moveaxis(chunk_decay, 1, 0)))
    prev = jnp.moveaxis(prev, 0, 1)
    o_inter = jnp.einsum("bclhd,bchdv->bclhv", q_in, prev)
    o = (o_intra + o_inter).reshape(b, s, H, DV)
    o = o * lax.rsqrt(jnp.mean(o * o, axis=-1, keepdims=True) + EPS) * norm_w.astype(f32)
    o = o * jax.nn.silu(g.astype(f32).reshape(b, s, H, DV))
    return o.reshape(b, s, GLA_VAL_DIM).astype(q.dtype) @ w_out


def setup_inputs(seed: int = 0) -> dict:
    key = jax.random.key(seed)
    ks = jax.random.split(key, 24)
    f32 = jnp.float32

    def nrm(k, shape, scale):
        return jax.random.normal(k, shape, f32) * scale

    dt0 = jnp.exp(jax.random.uniform(ks[7], (DEPTH, SSM_HEADS), f32, math.log(1e-3), math.log(1e-1)))
    return {
        "x": nrm(ks[0], (BATCH, SEQ, D_MODEL), 1.0),
        "norm_mix_w": 1.0 + nrm(ks[1], (DEPTH, D_MODEL), 0.02),
        "w_in": nrm(ks[2], (DEPTH, D_MODEL, IN_WIDTH), D_MODEL ** -0.5),
        "conv_a_w": nrm(ks[3], (DEPTH, SC_CONV_WIDTH, SC_WIDTH), SC_CONV_WIDTH ** -0.5),
        "w_out_a": nrm(ks[4], (DEPTH, SC_WIDTH, D_MODEL), SC_WIDTH ** -0.5),
        "ssm_conv_w": nrm(ks[5], (DEPTH, SSM_CONV_WIDTH, SSM_CONV_DIM), SSM_CONV_WIDTH ** -0.5),
        "ssm_conv_b": nrm(ks[6], (DEPTH, SSM_CONV_DIM), 0.02),
        "ssm_dt_bias": dt0 + jnp.log(-jnp.expm1(-dt0)),
        "ssm_a_log": jnp.log(jax.random.uniform(ks[8], (DEPTH, SSM_HEADS), f32, 1.0, 16.0)),
        "ssm_d": 1.0 + nrm(ks[9], (DEPTH, SSM_HEADS), 0.1),
        "ssm_norm_w": 1.0 + nrm(ks[10], (DEPTH, SSM_D_INNER), 0.02),
        "w_out_ssm": nrm(ks[11], (DEPTH, SSM_D_INNER, D_MODEL), SSM_D_INNER ** -0.5),
        "gla_w_gk2": nrm(ks[12], (DEPTH, GLA_GATE_RANK, GLA_KEY_DIM), GLA_GATE_RANK ** -0.5),
        "gla_b_gk": nrm(ks[13], (DEPTH, GLA_KEY_DIM), 0.1),
        "gla_norm_w": 1.0 + nrm(ks[14], (DEPTH, GLA_HEAD_V), 0.02),
        "w_out_gla": nrm(ks[15], (DEPTH, GLA_VAL_DIM, D_MODEL), GLA_VAL_DIM ** -0.5),
        "w_o": nrm(ks[16], (DEPTH, D_MODEL, D_MODEL), D_MODEL ** -0.5),
        "norm_mlp_w": 1.0 + nrm(ks[17], (DEPTH, D_MODEL), 0.02),
        "w_mlp_up": nrm(ks[18], (DEPTH, D_MODEL, D_FF), D_MODEL ** -0.5),
        "w_mlp_down": nrm(ks[19], (DEPTH, D_FF, D_MODEL), D_FF ** -0.5),
        "norm_f_w": 1.0 + nrm(ks[20], (D_MODEL,), 0.02),
    }


def reference(x, norm_mix_w, w_in, conv_a_w, w_out_a, ssm_conv_w, ssm_conv_b, ssm_dt_bias,
              ssm_a_log, ssm_d, ssm_norm_w, w_out_ssm, gla_w_gk2, gla_b_gk, gla_norm_w,
              w_out_gla, w_o, norm_mlp_w, w_mlp_up, w_mlp_down, norm_f_w):
    b, s, _ = x.shape
    for i in range(DEPTH):
        h = rms_norm(x, norm_mix_w[i])
        u = h @ w_in[i]
        (a_x, a_b, a_c, z, xbc, dt_raw, q, k, v, g, gk_low, gates) = split_cols(u, SPLIT_SIZES)
        y_a = short_conv_mixer(a_x, a_b, a_c, conv_a_w[i], w_out_a[i])
        y_b = mamba2_ssd(z, xbc, dt_raw, ssm_conv_w[i], ssm_conv_b[i], ssm_dt_bias[i],
                         ssm_a_log[i], ssm_d[i], ssm_norm_w[i], w_out_ssm[i])
        y_c = gla_mixer(q, k, v, g, gk_low, gla_w_gk2[i], gla_b_gk[i], gla_norm_w[i], w_out_gla[i])
        gt = jax.nn.sigmoid(gates.astype(jnp.float32)).reshape(b, s, N_BRANCHES, D_MODEL)
        merged = (gt[:, :, 0] * y_a.astype(jnp.float32) + gt[:, :, 1] * y_b.astype(jnp.float32)
                  + gt[:, :, 2] * y_c.astype(jnp.float32))
        x = x + merged.astype(x.dtype) @ w_o[i]
        h = rms_norm(x, norm_mlp_w[i])
        x = x + jnp.square(jax.nn.relu(h @ w_mlp_up[i])) @ w_mlp_down[i]
    return rms_norm(x, norm_f_w)
```

```cpp
#include <hip/hip_runtime.h>
#include <hip/hip_cooperative_groups.h>
#include <cstdio>
namespace cg = cooperative_groups;

#define LAS __attribute__((address_space(3)))
#define DEV __device__ __forceinline__
typedef unsigned short bf16_t;
typedef short bf16x8 __attribute__((ext_vector_type(8)));
typedef float f32x4 __attribute__((ext_vector_type(4)));
typedef float f32x2 __attribute__((ext_vector_type(2)));
typedef unsigned u32x4 __attribute__((ext_vector_type(4)));
typedef unsigned u32x2 __attribute__((ext_vector_type(2)));

constexpr int T_ALL = 32768, HT = 16384, DM = 1024, SEQ = 8192, INW = 12320, DFF = 4096;
constexpr int NTHR = 512, NWAVES = 8;
constexpr int LDS_BYTES = 136 * 1024;
constexpr float EPS = 1e-6f;

constexpr size_t WS_WIN = 1048576;
constexpr size_t WS_WOA = WS_WIN + (size_t)INW * 1024 * 2 + 1048576;
constexpr size_t WS_WOS = WS_WOA + 2097152;
constexpr size_t WS_WOG = WS_WOS + 2097152;
constexpr size_t WS_WO = WS_WOG + 2097152;
constexpr size_t WS_WUP = WS_WO + 2097152;
constexpr size_t WS_WDN = WS_WUP + 8388608;
constexpr size_t WS_HB = WS_WDN + 8388608;
constexpr size_t WS_MERGED = WS_HB + (size_t)HT * 1024 * 2;
constexpr size_t WS_G = WS_MERGED + (size_t)HT * 1024 * 4;
constexpr size_t WS_YIN = WS_G + (size_t)HT * 1024 * 2;
constexpr size_t WS_DTGK = WS_YIN + (size_t)HT * 1024 * 2;
constexpr size_t WS_R = WS_DTGK + (size_t)HT * 32 * 4;
constexpr size_t RA_UA = WS_R;
constexpr size_t RB_Z = WS_R;
constexpr size_t RB_XST = RB_Z + 33554432;
constexpr size_t RB_BC = RB_XST + 33554432;
constexpr size_t RB_XSTC = RB_BC + 33554432;
constexpr size_t RB_BCC = RB_XSTC + 33554432;
constexpr size_t RB_BTC = RB_BCC + 33554432;
constexpr size_t RB_DT = RB_BTC + 16777216;
constexpr size_t RB_ACUM = RB_DT + 1048576;
constexpr size_t RB_ST = RB_ACUM + 1048576;
constexpr size_t RB_END = RB_ST + 67108864;
constexpr size_t RC_QK = WS_R;
constexpr size_t RC_KT = RC_QK + 33554432;
constexpr size_t RC_VT = RC_KT + 16777216;
constexpr size_t RC_GS = RC_VT + 33554432;
constexpr size_t RC_DEC = RC_GS + 33554432;
constexpr size_t RC_ST = RC_DEC + 524288;
constexpr size_t RC_END = RC_ST + 134217728;
constexpr size_t R_HID_END = WS_R + (size_t)T_ALL * DFF * 2;
constexpr size_t WS_END = (RB_END > RC_END ? (RB_END > R_HID_END ? RB_END : R_HID_END) : (RC_END > R_HID_END ? RC_END : R_HID_END));

constexpr size_t WS_MSUM = (WS_END + 255) & ~(size_t)255;
constexpr size_t WS_BAR = WS_MSUM + (size_t)HT * 1024 * 2;
constexpr size_t WS_DEC = WS_BAR + 16384;
constexpr size_t WS_TOTAL = WS_DEC + 524288;
struct Params { const float* in[21]; float* out; unsigned char* ws; };

DEV unsigned f2bf(float f) { unsigned u = __float_as_uint(f); return (u + 0x7fffu + ((u >> 16) & 1u)) >> 16; }
DEV unsigned pk2(float lo, float hi) { return f2bf(lo) | (f2bf(hi) << 16); }
DEV float bf_lo(unsigned w) { return __uint_as_float(w << 16); }
DEV float bf_hi(unsigned w) { return __uint_as_float(w & 0xffff0000u); }
DEV float bf1(bf16_t h) { return __uint_as_float(((unsigned)h) << 16); }
DEV void unpack8(const u32x4 w, float (&f)[8]) {
    f[0] = bf_lo(w.x); f[1] = bf_hi(w.x); f[2] = bf_lo(w.y); f[3] = bf_hi(w.y);
    f[4] = bf_lo(w.z); f[5] = bf_hi(w.z); f[6] = bf_lo(w.w); f[7] = bf_hi(w.w);
}
DEV u32x4 pack8(const float (&f)[8]) { u32x4 w; w.x = pk2(f[0], f[1]); w.y = pk2(f[2], f[3]); w.z = pk2(f[4], f[5]); w.w = pk2(f[6], f[7]); return w; }
DEV float sigmoidf_(float x) { return __builtin_amdgcn_rcpf(1.0f + __expf(-x)); }
DEV float siluf_(float x) { return x * sigmoidf_(x); }
DEV float softplusf_(float x) { return x > 20.f ? x : log1pf(__expf(x)); }
DEV float logsigf_(float x) { return fminf(x, 0.f) - log1pf(__expf(-fabsf(x))); }
DEV float wave_sum(float v) {
#pragma unroll
    for (int o = 1; o < 64; o <<= 1) v += __shfl_xor(v, o);
    return v;
}
DEV f32x4 mma(bf16x8 x, bf16x8 y, f32x4 acc) { return __builtin_amdgcn_mfma_f32_16x16x32_bf16(x, y, acc, 0, 0, 0); }
DEV bf16x8 ldsfrag(const LAS unsigned char* p) { return *(const LAS bf16x8*)p; }
#define SCALE_A 1.f
#define SCALE_B 1.f
#define SCALE_C 1.f
#define GLA_NO_INTER 0
#define GLA_ZERO_DEC 0
#ifndef GEMM_BODY
#define GEMM_BODY gemm_phase
#endif
#define LDS_WAIT() asm volatile("s_waitcnt lgkmcnt(0)" ::: "memory")
#define GAS __attribute__((address_space(1)))
template <class T> DEV T* asglobal(T* p) { return (T*)(GAS T*)p; }

namespace pg8 {
constexpr int BM = 256, BK = 64, HALF = 128, HTB = HALF * BK * 2, STAGE_BYTES = 8 * HTB, NXCD = 8, WGM = 8;
DEV int lds_byte(int r, int c) { const int st = (r >> 4) * 2 + (c >> 5), rr = r & 15, cc = c & 31, ob = rr * 64 + cc * 2; return st * 1024 + (ob ^ (((ob >> 9) & 1) << 5)); }
DEV void stage_rc(int b, int& R, int& C) { const int st = b / 1024, sb = b % 1024, swz = sb ^ (((sb >> 9) & 1) << 5); R = (st >> 1) * 16 + swz / 64; C = (st & 1) * 32 + (swz % 64) / 2; }
DEV int perm32(int rho) { const int n = rho >> 4, i = rho & 15; return 8 * (i >> 2) + 4 * n + (i & 3); }

struct Job { const bf16_t* A; const bf16_t* B; void* out; const void* aux; int nM, nN, ldc, kind; };
struct Unit { const char* A; const char* B; int jid, pm, pn; };
constexpr int JT_OFF = 131072;
DEV int rfl(int v) { return __builtin_amdgcn_readfirstlane(v); }
DEV const char* rflp(const LAS int* p) { const unsigned lo = (unsigned)rfl(p[0]), hi = (unsigned)rfl(p[1]); return asglobal((const char*)(((unsigned long long)hi << 32) | lo)); }
DEV void job_put(LAS unsigned char* lds, int q, const void* A, const void* B, void* out, const void* aux, int nM, int nN, int ldc, int kind) {
    LAS int* jt = (LAS int*)(lds + JT_OFF) + q * 12;
    const unsigned long long a = (unsigned long long)A, b = (unsigned long long)B, o = (unsigned long long)out, x = (unsigned long long)aux;
    jt[0] = (int)(unsigned)a; jt[1] = (int)(unsigned)(a >> 32); jt[2] = (int)(unsigned)b; jt[3] = (int)(unsigned)(b >> 32);
    jt[4] = (int)(unsigned)o; jt[5] = (int)(unsigned)(o >> 32); jt[6] = (int)(unsigned)x; jt[7] = (int)(unsigned)(x >> 32);
    jt[8] = nM; jt[9] = nN; jt[10] = ldc; jt[11] = kind;
}
struct Sched {
    LAS unsigned char* lds; int nj, total, G, c; size_t tstep;
    DEV void init(LAS unsigned char* lds_, int nj_, int G_, int c_, int K, int tid_) {
        lds = lds_; nj = nj_; G = G_; c = c_; tstep = (size_t)BM * K * 2;
        __syncthreads();
        LAS int* jt = (LAS int*)(lds + JT_OFF);
        if (tid_ == 0) { int s = 0; for (int q = 0; q < nj; ++q) { jt[48 + q] = s; s += jt[q * 12 + 8] * jt[q * 12 + 9]; } for (int q = nj; q < 5; ++q) jt[48 + q] = s; }
        __syncthreads();
        total = rfl(jt[48 + 4]);
    }
    DEV bool next(int i, Unit& u) const {
        const int L = i * G + c; if (L >= total) return false;
        const LAS int* jt = (const LAS int*)(lds + JT_OFF);
        int jid = 0;
        for (int q = 1; q < nj; ++q) if (L >= rfl(jt[48 + q])) jid = q;
        const LAS int* J = jt + jid * 12;
        const int base = rfl(jt[48 + jid]), nM = rfl(J[8]), nN = rfl(J[9]);
        int wgid = L - base; const int nwg = nM * nN;
        { const int q = nwg / NXCD, r = nwg % NXCD, xcd = wgid % NXCD, off = wgid / NXCD; wgid = (xcd < r ? xcd * (q + 1) : r * (q + 1) + (xcd - r) * q) + off; }
        const int nig = WGM * nN, gid = wgid / nig, fm = gid * WGM, gsz = (nM - fm) < WGM ? (nM - fm) : WGM;
        u.pm = fm + ((wgid % nig) % gsz); u.pn = (wgid % nig) / gsz; u.jid = jid;
        u.A = rflp(J) + (size_t)u.pm * tstep; u.B = rflp(J + 2) + (size_t)u.pn * tstep;
        return true;
    }
};

DEV void st16_wt(GAS u32x4* p, u32x4 v) { asm volatile("global_store_dwordx4 %0, %1, off sc1" :: "v"(p), "v"(v) : "memory"); }
DEV void st16f_wt(GAS f32x4* p, f32x4 v) { asm volatile("global_store_dwordx4 %0, %1, off sc1" :: "v"(p), "v"(v) : "memory"); }
DEV unsigned cvt_pk_bf16(float lo, float hi) { return pk2(lo, hi); }

template <int KIND> DEV void epi_loop(const f32x4 (&acc)[2][2][4][2], const Job& J, const Unit& u, int wr, int wc, int fr, int fq) {
    const int row0 = u.pm * BM + wr * 64 + fr, col0 = u.pn * BM + wc * 32 + 8 * fq;
    GAS bf16_t* const outb = (GAS bf16_t*)J.out; GAS float* const outf = (GAS float*)J.out;
    const GAS float* const auxf = (const GAS float*)J.aux; GAS bf16_t* const auxb = (GAS bf16_t*)const_cast<void*>(J.aux);
#pragma unroll
    for (int ai = 0; ai < 2; ++ai)
#pragma unroll
        for (int m = 0; m < 4; ++m) {
            const size_t row = (size_t)(row0 + ai * HALF + m * 16);
#pragma unroll
            for (int bj = 0; bj < 2; ++bj) {
                const int col = col0 + bj * HALF;
                f32x4 v0 = acc[ai][bj][m][0], v1 = acc[ai][bj][m][1];
                if (KIND <= 3) {
                    if (KIND == 1) {
#pragma unroll
                        for (int e = 0; e < 4; ++e) { v0[e] = sigmoidf_(v0[e]); v1[e] = sigmoidf_(v1[e]); } }
                    if (KIND == 2) {
#pragma unroll
                        for (int e = 0; e < 4; ++e) { v0[e] = siluf_(v0[e]); v1[e] = siluf_(v1[e]); } }
                    if (KIND == 3) {
#pragma unroll
                        for (int e = 0; e < 4; ++e) { float a = fmaxf(v0[e], 0.f), b = fmaxf(v1[e], 0.f); v0[e] = a * a; v1[e] = b * b; } }
                    u32x4 w; w.x = cvt_pk_bf16(v0[0], v0[1]); w.y = cvt_pk_bf16(v0[2], v0[3]); w.z = cvt_pk_bf16(v1[0], v1[1]); w.w = cvt_pk_bf16(v1[2], v1[3]);
                    *(GAS u32x4*)(outb + row * J.ldc + col) = w;
                } else if (KIND == 7) {
                    const GAS float* xin = auxf + row * DM + col; GAS float* xo = outf + row * DM + col;
                    const f32x4 a = *(const GAS f32x4*)xin, b = *(const GAS f32x4*)(xin + 4);
                    const float sc = (J.ldc == 0) ? 0.f : 1.f; *(GAS f32x4*)xo = a + v0 * sc; *(GAS f32x4*)(xo + 4) = b + v1 * sc;
                } else if (KIND == 4) {
                    const u32x4 gw = *(const GAS u32x4*)(auxb + row * DM + col); float g[8]; unpack8(gw, g);
                    f32x4 r0, r1;
#pragma unroll
                    for (int e = 0; e < 4; ++e) { r0[e] = g[e] * v0[e] * SCALE_A; r1[e] = g[4 + e] * v1[e] * SCALE_A; }
                    GAS float* mo = outf + row * DM + col; *(GAS f32x4*)mo = r0; *(GAS f32x4*)(mo + 4) = r1;
                } else if (KIND == 5) {
                    const u32x4 gw = *(const GAS u32x4*)(auxb + row * DM + col); float g[8]; unpack8(gw, g);
                    const GAS float* mo = outf + row * DM + col; const f32x4 m0 = *(const GAS f32x4*)mo, m1 = *(const GAS f32x4*)(mo + 4);
#pragma unroll
                    for (int e = 0; e < 8; ++e) g[e] *= SCALE_B;
                    u32x4 w; w.x = cvt_pk_bf16(m0[0] + g[0] * v0[0], m0[1] + g[1] * v0[1]); w.y = cvt_pk_bf16(m0[2] + g[2] * v0[2], m0[3] + g[3] * v0[3]);
                    w.z = cvt_pk_bf16(m1[0] + g[4] * v1[0], m1[1] + g[5] * v1[1]); w.w = cvt_pk_bf16(m1[2] + g[6] * v1[2], m1[3] + g[7] * v1[3]);
                    *(GAS u32x4*)((GAS bf16_t*)(outf + (size_t)J.ldc) + row * DM + col) = w;
                } else {
                    GAS bf16_t* gp = auxb + row * DM + col;
                    const u32x4 gw = *(const GAS u32x4*)gp, aw = *(const GAS u32x4*)(outb + row * DM + col);
                    float g[8], a[8]; unpack8(gw, g); unpack8(aw, a);
#pragma unroll
                    for (int e = 0; e < 8; ++e) g[e] *= SCALE_C;
                    u32x4 w; w.x = cvt_pk_bf16(a[0] + g[0] * v0[0], a[1] + g[1] * v0[1]); w.y = cvt_pk_bf16(a[2] + g[2] * v0[2], a[3] + g[3] * v0[3]);
                    w.z = cvt_pk_bf16(a[4] + g[4] * v1[0], a[5] + g[5] * v1[1]); w.w = cvt_pk_bf16(a[6] + g[6] * v1[2], a[7] + g[7] * v1[3]);
                    *(GAS u32x4*)gp = w;
                }
            }
        }
}

template <int MASK> DEV void run_epi(const Sched& S, const Unit& u, const f32x4 (&acc)[2][2][4][2], int wr, int wc, int fr, int fq) {
    const LAS int* Jp = (const LAS int*)(S.lds + JT_OFF) + u.jid * 12;
    Job J; J.A = nullptr; J.B = nullptr; J.out = (void*)rflp(Jp + 4); J.aux = (const void*)rflp(Jp + 6); J.nM = 0; J.nN = 0; J.ldc = rfl(Jp[10]); J.kind = rfl(Jp[11]);
    const int k = J.kind;
    if ((MASK & 1) && k == 0) epi_loop<0>(acc, J, u, wr, wc, fr, fq);
    else if ((MASK & 2) && k == 1) epi_loop<1>(acc, J, u, wr, wc, fr, fq);
    else if ((MASK & 4) && k == 2) epi_loop<2>(acc, J, u, wr, wc, fr, fq);
    else if ((MASK & 8) && k == 3) epi_loop<3>(acc, J, u, wr, wc, fr, fq);
    else if ((MASK & 16) && k == 4) epi_loop<4>(acc, J, u, wr, wc, fr, fq);
    else if ((MASK & 32) && k == 5) epi_loop<5>(acc, J, u, wr, wc, fr, fq);
    else if ((MASK & 64) && k == 6) epi_loop<6>(acc, J, u, wr, wc, fr, fq);
    else if ((MASK & 128) && k == 7) epi_loop<7>(acc, J, u, wr, wc, fr, fq);
}

template <int MASK>
DEV void gemm_phase(LAS unsigned char* lds, const int K, const Sched& S, const int tid) {
    const int wid = __builtin_amdgcn_readfirstlane(tid >> 6), lane = tid & 63, wr = wid >> 2, wc = wid & 3, fr = lane & 15, fq = lane >> 4;
    const int nt = K / BK;
    unsigned voffA[2], voffB[2];
#pragma unroll
    for (int i = 0; i < 2; ++i) { int R, C; stage_rc(tid * 16 + i * 8192, R, C); const int Rb = (R & ~31) + perm32(R & 31);
        voffA[i] = (unsigned)(R * K + C) * 2u; voffB[i] = (unsigned)(Rb * K + C) * 2u; }
    const size_t kstep = (size_t)(BK * 2);
    const size_t hstep = (size_t)HALF * K * 2;
    const unsigned ldsw = (unsigned)wid * 1024u;
    const int aoff = lds_byte(wr * 64 + fr, fq * 8), boff = lds_byte(wc * 32 + fr, fq * 8);
#define PG8_SA(b, h) (((b) * 2 + (h)) * HTB)
#define PG8_SB(b, h) ((4 + (b) * 2 + (h)) * HTB)
#define PG8_STAGE(bufoff, gbase, voff) do { _Pragma("unroll") for (int _i = 0; _i < 2; ++_i) \
        __builtin_amdgcn_global_load_lds((const unsigned*)((const char*)(gbase) + (voff)[_i]), (LAS unsigned*)(lds + (bufoff) + ldsw + _i * 8192), 16, 0, 0); } while (0)
#define PG8_LDA(dst, b, h) do { _Pragma("unroll") for (int m = 0; m < 4; ++m) _Pragma("unroll") for (int k = 0; k < 2; ++k) dst[m][k] = *(const LAS bf16x8*)(lds + PG8_SA(b, h) + aoff + m * 2048 + k * 1024); } while (0)
#define PG8_LDB(dst, b, h) do { _Pragma("unroll") for (int n = 0; n < 2; ++n) _Pragma("unroll") for (int k = 0; k < 2; ++k) dst[n][k] = *(const LAS bf16x8*)(lds + PG8_SB(b, h) + boff + n * 2048 + k * 1024); } while (0)
#define PG8_MMA(ai, bj, At, Bt) do { __builtin_amdgcn_s_setprio(1); _Pragma("unroll") for (int m = 0; m < 4; ++m) _Pragma("unroll") for (int n = 0; n < 2; ++n) _Pragma("unroll") for (int k = 0; k < 2; ++k) \
        acc[ai][bj][m][n] = __builtin_amdgcn_mfma_f32_16x16x32_bf16(Bt[n][k], At[m][k], acc[ai][bj][m][n], 0, 0, 0); __builtin_amdgcn_s_setprio(0); } while (0)
#define PG8_WAIT_V(n) asm volatile("s_waitcnt vmcnt(" #n ")" ::: "memory")
#define PG8_WAIT_L(n) asm volatile("s_waitcnt lgkmcnt(" #n ")" ::: "memory")
#define PG8_BAR __builtin_amdgcn_s_barrier()
#define PG8_SCHED __builtin_amdgcn_sched_barrier(0)
    Unit cur, nxt; int ui = 0;
    if (!S.next(0, cur)) return;
    f32x4 acc[2][2][4][2];
#pragma unroll
    for (int a = 0; a < 2; ++a)
#pragma unroll
        for (int b = 0; b < 2; ++b)
#pragma unroll
            for (int m = 0; m < 4; ++m)
#pragma unroll
                for (int n = 0; n < 2; ++n) acc[a][b][m][n] = (f32x4){0.f, 0.f, 0.f, 0.f};
    bf16x8 At[4][2], B0[2][2], B1[2][2];
    const char* cA = cur.A; const char* cB = cur.B;
    PG8_STAGE(PG8_SB(0, 0), cB, voffB); PG8_STAGE(PG8_SA(0, 0), cA, voffA); PG8_STAGE(PG8_SB(0, 1), cB + hstep, voffB); PG8_STAGE(PG8_SA(0, 1), cA + hstep, voffA);
    if (wr == 1) PG8_BAR;
    PG8_WAIT_V(4); PG8_BAR;
    PG8_STAGE(PG8_SB(1, 0), cB + kstep, voffB); PG8_STAGE(PG8_SA(1, 0), cA + kstep, voffA); PG8_STAGE(PG8_SB(1, 1), cB + hstep + kstep, voffB);
    PG8_WAIT_V(6); PG8_BAR;
    for (;;) {
        const bool has_next = S.next(ui + 1, nxt);
        const char* nA = has_next ? nxt.A : cA; const char* nB = has_next ? nxt.B : cB;
        for (int t = 0; t < nt; t += 2) {
            const bool last = (t == nt - 2);
            const char* a1 = cA + (size_t)(t + 1) * kstep;
            const char* a2 = last ? nA : cA + (size_t)(t + 2) * kstep; const char* b2 = last ? nB : cB + (size_t)(t + 2) * kstep;
            const char* a3 = a2 + kstep; const char* b3 = b2 + kstep;
            PG8_LDB(B0, 0, 0); PG8_SCHED; PG8_LDA(At, 0, 0); PG8_STAGE(PG8_SA(1, 1), a1 + hstep, voffA);
            PG8_WAIT_L(8); PG8_BAR; PG8_WAIT_L(0); PG8_MMA(0, 0, At, B0); PG8_BAR; PG8_SCHED;
            PG8_LDB(B1, 0, 1); PG8_STAGE(PG8_SB(0, 0), b2, voffB);
            PG8_BAR; PG8_WAIT_L(0); PG8_MMA(0, 1, At, B1); PG8_BAR;
            PG8_LDA(At, 0, 1); PG8_STAGE(PG8_SA(0, 0), a2, voffA);
            PG8_BAR; PG8_WAIT_L(0); PG8_MMA(1, 0, At, B0); PG8_BAR; PG8_SCHED;
            PG8_STAGE(PG8_SB(0, 1), b2 + hstep, voffB);
            PG8_WAIT_V(6); PG8_BAR; PG8_MMA(1, 1, At, B1); PG8_BAR;
            PG8_LDB(B0, 1, 0); PG8_SCHED; PG8_LDA(At, 1, 0); PG8_STAGE(PG8_SA(0, 1), a2 + hstep, voffA);
            PG8_WAIT_L(8); PG8_BAR; PG8_WAIT_L(0); PG8_MMA(0, 0, At, B0); PG8_BAR; PG8_SCHED;
            PG8_LDB(B1, 1, 1); PG8_STAGE(PG8_SB(1, 0), b3, voffB);
            PG8_BAR; PG8_WAIT_L(0); PG8_MMA(0, 1, At, B1); PG8_BAR;
            PG8_LDA(At, 1, 1); PG8_STAGE(PG8_SA(1, 0), a3, voffA);
            PG8_BAR; PG8_WAIT_L(0); PG8_MMA(1, 0, At, B0); PG8_BAR; PG8_SCHED;
            PG8_STAGE(PG8_SB(1, 1), b3 + hstep, voffB);
            PG8_WAIT_V(6); PG8_BAR; PG8_MMA(1, 1, At, B1); PG8_BAR;
        }
        run_epi<MASK>(S, cur, acc, wr, wc, fr, fq);
        if (!has_next) break;
#pragma unroll
        for (int a = 0; a < 2; ++a)
#pragma unroll
            for (int b = 0; b < 2; ++b)
#pragma unroll
                for (int m = 0; m < 4; ++m)
#pragma unroll
                    for (int n = 0; n < 2; ++n) acc[a][b][m][n] = (f32x4){0.f, 0.f, 0.f, 0.f};
        cur = nxt; cA = nA; cB = nB; ++ui;
    }
    PG8_WAIT_V(0);
    if (wr == 0) PG8_BAR;
    PG8_BAR;
#undef PG8_SA
#undef PG8_SB
#undef PG8_STAGE
#undef PG8_LDA
#undef PG8_LDB
#undef PG8_MMA
#undef PG8_WAIT_V
#undef PG8_WAIT_L
#undef PG8_BAR
#undef PG8_SCHED
}

template <int MASK>
DEV void gemm_simple(LAS unsigned char* lds, const int K, const Sched& S, const int tid) {
    const int wid = __builtin_amdgcn_readfirstlane(tid >> 6), lane = tid & 63, wr = wid >> 2, wc = wid & 3, fr = lane & 15, fq = lane >> 4;
    const int nt = K / BK;
    unsigned voffA[2], voffB[2];
#pragma unroll
    for (int i = 0; i < 2; ++i) { int R, C; stage_rc(tid * 16 + i * 8192, R, C); const int Rb = (R & ~31) + perm32(R & 31);
        voffA[i] = (unsigned)(R * K + C) * 2u; voffB[i] = (unsigned)(Rb * K + C) * 2u; }
    const size_t kstep = (size_t)(BK * 2), hstep = (size_t)HALF * K * 2;
    const unsigned ldsl = (unsigned)wid * 1024u + (unsigned)lane * 16u;
    const int aoff = lds_byte(wr * 64 + fr, fq * 8), boff = lds_byte(wc * 32 + fr, fq * 8);
#define GS_SA(b, h) (((b) * 2 + (h)) * HTB)
#define GS_SB(b, h) ((4 + (b) * 2 + (h)) * HTB)
#define GS_LOAD(dst, pa, pb) do { _Pragma("unroll") for (int _i = 0; _i < 2; ++_i) { \
        dst[0][_i] = *(const GAS u32x4*)((const GAS char*)(pa) + voffA[_i]); dst[1][_i] = *(const GAS u32x4*)((const GAS char*)(pa) + hstep + voffA[_i]); \
        dst[2][_i] = *(const GAS u32x4*)((const GAS char*)(pb) + voffB[_i]); dst[3][_i] = *(const GAS u32x4*)((const GAS char*)(pb) + hstep + voffB[_i]); } } while (0)
#define GS_WRITE(b, src) do { _Pragma("unroll") for (int _i = 0; _i < 2; ++_i) { \
        *(LAS u32x4*)(lds + GS_SA(b, 0) + ldsl + _i * 8192) = src[0][_i]; *(LAS u32x4*)(lds + GS_SA(b, 1) + ldsl + _i * 8192) = src[1][_i]; \
        *(LAS u32x4*)(lds + GS_SB(b, 0) + ldsl + _i * 8192) = src[2][_i]; *(LAS u32x4*)(lds + GS_SB(b, 1) + ldsl + _i * 8192) = src[3][_i]; } } while (0)
    Unit cur; int ui = 0;
    while (S.next(ui, cur)) {
        f32x4 acc[2][2][4][2];
#pragma unroll
        for (int a = 0; a < 2; ++a)
#pragma unroll
            for (int b = 0; b < 2; ++b)
#pragma unroll
                for (int m = 0; m < 4; ++m)
#pragma unroll
                    for (int n = 0; n < 2; ++n) acc[a][b][m][n] = (f32x4){0.f, 0.f, 0.f, 0.f};
        const char* cA = cur.A; const char* cB = cur.B;
        u32x4 st[4][2];
        GS_LOAD(st, cA, cB);
        GS_WRITE(0, st);
        __syncthreads();
        for (int t = 0; t < nt; ++t) {
            const int b = t & 1;
            if (t + 1 < nt) GS_LOAD(st, cA + (size_t)(t + 1) * kstep, cB + (size_t)(t + 1) * kstep);
#pragma unroll
            for (int ai = 0; ai < 2; ++ai) {
                bf16x8 At[4][2];
#pragma unroll
                for (int m = 0; m < 4; ++m)
#pragma unroll
                    for (int k = 0; k < 2; ++k) At[m][k] = *(const LAS bf16x8*)(lds + (b ? GS_SA(1, 0) : GS_SA(0, 0)) + ai * HTB + aoff + m * 2048 + k * 1024);
#pragma unroll
                for (int bj = 0; bj < 2; ++bj) {
                    bf16x8 Bt[2][2];
#pragma unroll
                    for (int n = 0; n < 2; ++n)
#pragma unroll
                        for (int k = 0; k < 2; ++k) Bt[n][k] = *(const LAS bf16x8*)(lds + (b ? GS_SB(1, 0) : GS_SB(0, 0)) + bj * HTB + boff + n * 2048 + k * 1024);
#pragma unroll
                    for (int m = 0; m < 4; ++m)
#pragma unroll
                        for (int n = 0; n < 2; ++n)
#pragma unroll
                            for (int k = 0; k < 2; ++k) acc[ai][bj][m][n] = __builtin_amdgcn_mfma_f32_16x16x32_bf16(Bt[n][k], At[m][k], acc[ai][bj][m][n], 0, 0, 0);
                }
            }
            if (t + 1 < nt) { if (b) GS_WRITE(0, st); else GS_WRITE(1, st); }
            __syncthreads();
        }
        run_epi<MASK>(S, cur, acc, wr, wc, fr, fq);
        ++ui;
    }
    __syncthreads();
#undef GS_SA
#undef GS_SB
#undef GS_LOAD
#undef GS_WRITE
}
}

DEV void transpose_item(const float* W, int K, int N, bf16_t* WT, LAS float* scr, int item, int lane) {
    const int nblk = N / 32, kb = item / nblk, nb = item % nblk, k0 = 64 * kb, n0 = 32 * nb;
#pragma unroll 8
    for (int i = 0; i < 32; ++i) { const int kk = 2 * i + (lane >> 5); scr[kk * 33 + (lane & 31)] = W[(size_t)(k0 + kk) * N + n0 + (lane & 31)]; }
    LDS_WAIT();
    const int c = lane & 7;
#pragma unroll
    for (int jj = 0; jj < 4; ++jj) { const int n = (lane >> 3) + 8 * jj; const LAS float* s = scr + (8 * c) * 33 + n;
        u32x4 o; o.x = pk2(s[0 * 33], s[1 * 33]); o.y = pk2(s[2 * 33], s[3 * 33]); o.z = pk2(s[4 * 33], s[5 * 33]); o.w = pk2(s[6 * 33], s[7 * 33]);
        *(u32x4*)(WT + (size_t)(n0 + n) * K + k0 + 8 * c) = o; }
    LDS_WAIT();
}

DEV void phase_weights(unsigned char* ws, const float* w_in, const float* w_oa, const float* w_os, const float* w_og, const float* w_o, const float* w_up, const float* w_dn, LAS unsigned char* lds, int gw, int NGW, int wave, int lane) {
    LAS float* scr = (LAS float*)(lds + wave * 8704);
    constexpr int I_IN = 16 * (INW / 32), I_SQ = 16 * 32, I_UP = 16 * 128, I_DN = 64 * 32;
    constexpr int NIT = I_IN + 4 * I_SQ + I_UP + I_DN;
    for (int it = gw; it < NIT; it += NGW) {
        int r = it;
        if (r < I_IN) { transpose_item(w_in, 1024, INW, (bf16_t*)(ws + WS_WIN), scr, r, lane); continue; } r -= I_IN;
        if (r < I_SQ) { transpose_item(w_oa, 1024, 1024, (bf16_t*)(ws + WS_WOA), scr, r, lane); continue; } r -= I_SQ;
        if (r < I_SQ) { transpose_item(w_os, 1024, 1024, (bf16_t*)(ws + WS_WOS), scr, r, lane); continue; } r -= I_SQ;
        if (r < I_SQ) { transpose_item(w_og, 1024, 1024, (bf16_t*)(ws + WS_WOG), scr, r, lane); continue; } r -= I_SQ;
        if (r < I_SQ) { transpose_item(w_o, 1024, 1024, (bf16_t*)(ws + WS_WO), scr, r, lane); continue; } r -= I_SQ;
        if (r < I_UP) { transpose_item(w_up, 1024, 4096, (bf16_t*)(ws + WS_WUP), scr, r, lane); continue; } r -= I_UP;
        transpose_item(w_dn, 4096, 1024, (bf16_t*)(ws + WS_WDN), scr, r, lane);
    }
}

DEV void phase_rmsnorm_bf16(const float* x, const float* w, bf16_t* o, int nrows, int gw, int NGW, int lane) {
    for (int m = gw; m < nrows; m += NGW) {
        const f32x4* xr = (const f32x4*)(x + (size_t)m * DM) + lane;
        f32x4 v[4]; float s = 0.f;
#pragma unroll
        for (int j = 0; j < 4; ++j) { v[j] = xr[64 * j]; s += (v[j].x * v[j].x + v[j].y * v[j].y) + (v[j].z * v[j].z + v[j].w * v[j].w); }
        const float rstd = rsqrtf(wave_sum(s) * (1.f / DM) + EPS);
        u32x2* o8 = (u32x2*)(o + (size_t)m * DM) + lane;
#pragma unroll
        for (int j = 0; j < 4; ++j) { const f32x4 ww = ((const f32x4*)w)[lane + 64 * j]; u32x2 r; r.x = pk2(v[j].x * rstd * ww.x, v[j].y * rstd * ww.y); r.y = pk2(v[j].z * rstd * ww.z, v[j].w * rstd * ww.w); o8[64 * j] = r; }
    }
}
DEV void phase_rmsnorm_f32(float* x, const float* w, int nrows, int gw, int NGW, int lane) {
    for (int m = gw; m < nrows; m += NGW) {
        f32x4* xr = (f32x4*)(x + (size_t)m * DM) + lane;
        f32x4 v[4]; float s = 0.f;
#pragma unroll
        for (int j = 0; j < 4; ++j) { v[j] = xr[64 * j]; s += (v[j].x * v[j].x + v[j].y * v[j].y) + (v[j].z * v[j].z + v[j].w * v[j].w); }
        const float rstd = rsqrtf(wave_sum(s) * (1.f / DM) + EPS);
#pragma unroll
        for (int j = 0; j < 4; ++j) { const f32x4 ww = ((const f32x4*)w)[lane + 64 * j]; xr[64 * j] = v[j] * rstd * ww; }
    }
}

DEV void phase_narrow(const bf16_t* HB, const bf16_t* Wdt, const bf16_t* Wgk, float* DTGK, int gw, int NGW, int lane) {
    const int fr = lane & 15, fq = lane >> 4;
    for (int u = gw; u < HT / 16; u += NGW) {
        const int t0 = u * 16;
        f32x4 a0 = {0.f, 0.f, 0.f, 0.f}, a1 = {0.f, 0.f, 0.f, 0.f};
        const bf16_t* ap = HB + (size_t)(t0 + fr) * DM + fq * 8;
        const bf16_t* b0p = Wdt + (size_t)fr * DM + fq * 8;
        const bf16_t* b1p = Wgk + (size_t)fr * DM + fq * 8;
#pragma unroll 4
        for (int k = 0; k < DM; k += 32) {
            const bf16x8 a = *(const bf16x8*)(ap + k), b0 = *(const bf16x8*)(b0p + k), b1 = *(const bf16x8*)(b1p + k);
            a0 = mma(a, b0, a0); a1 = mma(a, b1, a1);
        }
#pragma unroll
        for (int j = 0; j < 4; ++j) { float* d = DTGK + (size_t)(t0 + 4 * fq + j) * 32; d[fr] = a0[j]; d[16 + fr] = a1[j]; }
    }
}

DEV void phase_conv_a(const bf16_t* UA, const float* cw, bf16_t* YIN, int gtid, int NT) {
    for (int u = gtid; u < (HT / 16) * 128; u += NT) {
        const int c0 = (u & 127) * 8, t0 = (u >> 7) * 16;
        float w0[8], w1[8], w2[8], p1[8], p2[8];
#pragma unroll
        for (int j = 0; j < 8; ++j) { w0[j] = cw[c0 + j]; w1[j] = cw[1024 + c0 + j]; w2[j] = cw[2048 + c0 + j]; p1[j] = 0.f; p2[j] = 0.f; }
        if ((t0 & (SEQ - 1)) != 0) {
            float ax[8], ac[8];
            unpack8(*(const u32x4*)(UA + (size_t)(t0 - 2) * 3072 + c0), ax); unpack8(*(const u32x4*)(UA + (size_t)(t0 - 2) * 3072 + 2048 + c0), ac);
#pragma unroll
            for (int j = 0; j < 8; ++j) p2[j] = ax[j] * ac[j];
            unpack8(*(const u32x4*)(UA + (size_t)(t0 - 1) * 3072 + c0), ax); unpack8(*(const u32x4*)(UA + (size_t)(t0 - 1) * 3072 + 2048 + c0), ac);
#pragma unroll
            for (int j = 0; j < 8; ++j) p1[j] = ax[j] * ac[j];
        }
#pragma unroll 4
        for (int i = 0; i < 16; ++i) {
            const bf16_t* rp = UA + (size_t)(t0 + i) * 3072 + c0;
            float ax[8], ab[8], ac[8], o[8];
            unpack8(*(const u32x4*)rp, ax); unpack8(*(const u32x4*)(rp + 1024), ab); unpack8(*(const u32x4*)(rp + 2048), ac);
#pragma unroll
            for (int j = 0; j < 8; ++j) { const float p0 = ax[j] * ac[j]; o[j] = ab[j] * (w0[j] * p2[j] + w1[j] * p1[j] + w2[j] * p0); p2[j] = p1[j]; p1[j] = p0; }
            *(u32x4*)(YIN + (size_t)(t0 + i) * DM + c0) = pack8(o);
        }
    }
}

DEV void phase_ssd_prep(unsigned char* ws, const float* cw, const float* cb, const float* dtb, const float* alog, int gtid, int NT, int tid, int nblk, int blk) {
    const bf16_t* XST = (const bf16_t*)(ws + RB_XST); bf16_t* XSTC = (bf16_t*)(ws + RB_XSTC);
    for (int u = gtid; u < 1024 * (HT / 8); u += NT) {
        const int tb = u & (HT / 8 - 1), c = u >> 11, t0 = tb * 8;
        float x[11], cur[8];
        unpack8(*(const u32x4*)(XST + (size_t)c * HT + t0), cur);
        if ((t0 & (SEQ - 1)) != 0) { float pv[8]; unpack8(*(const u32x4*)(XST + (size_t)c * HT + t0 - 8), pv); x[0] = pv[5]; x[1] = pv[6]; x[2] = pv[7]; }
        else { x[0] = 0.f; x[1] = 0.f; x[2] = 0.f; }
#pragma unroll
        for (int i = 0; i < 8; ++i) x[3 + i] = cur[i];
        const float w0 = cw[c], w1 = cw[2048 + c], w2 = cw[4096 + c], w3 = cw[6144 + c], b = cb[c];
        float y[8];
#pragma unroll
        for (int i = 0; i < 8; ++i) y[i] = siluf_(b + w0 * x[i] + w1 * x[i + 1] + w2 * x[i + 2] + w3 * x[i + 3]);
        *(u32x4*)(XSTC + (size_t)c * HT + t0) = pack8(y);
    }
    const bf16_t* BC = (const bf16_t*)(ws + RB_BC); bf16_t* BCC = (bf16_t*)(ws + RB_BCC); bf16_t* BTC = (bf16_t*)(ws + RB_BTC);
    for (int u = gtid; u < (HT / 8) * 128; u += NT) {
        const int cg8 = u & 127, c0 = cg8 * 8, t0 = (u >> 7) * 8, cc = 1024 + c0;
        float w0[8], w1[8], w2[8], w3[8], bb[8], x1[8], x2[8], x3[8];
#pragma unroll
        for (int j = 0; j < 8; ++j) { w0[j] = cw[cc + j]; w1[j] = cw[2048 + cc + j]; w2[j] = cw[4096 + cc + j]; w3[j] = cw[6144 + cc + j]; bb[j] = cb[cc + j]; x1[j] = 0.f; x2[j] = 0.f; x3[j] = 0.f; }
        if ((t0 & (SEQ - 1)) != 0) {
            unpack8(*(const u32x4*)(BC + (size_t)(t0 - 1) * DM + c0), x1); unpack8(*(const u32x4*)(BC + (size_t)(t0 - 2) * DM + c0), x2); unpack8(*(const u32x4*)(BC + (size_t)(t0 - 3) * DM + c0), x3);
        }
        unsigned tr[8][4];
#pragma unroll
        for (int i = 0; i < 8; ++i) {
            float x0[8], y[8];
            unpack8(*(const u32x4*)(BC + (size_t)(t0 + i) * DM + c0), x0);
#pragma unroll
            for (int j = 0; j < 8; ++j) { y[j] = siluf_(bb[j] + w3[j] * x0[j] + w2[j] * x1[j] + w1[j] * x2[j] + w0[j] * x3[j]); x3[j] = x2[j]; x2[j] = x1[j]; x1[j] = x0[j]; }
            *(u32x4*)(BCC + (size_t)(t0 + i) * DM + c0) = pack8(y);
#pragma unroll
            for (int j = 0; j < 8; ++j) { if (i & 1) tr[j][i >> 1] |= f2bf(y[j]) << 16; else tr[j][i >> 1] = f2bf(y[j]); }
        }
        if (cg8 < 64) {
#pragma unroll
            for (int j = 0; j < 8; ++j) *(u32x4*)(BTC + (size_t)(c0 + j) * HT + t0) = (u32x4){tr[j][0], tr[j][1], tr[j][2], tr[j][3]};
        }
    }
    const float* DTGK = (const float*)(ws + WS_DTGK); float* DT = (float*)(ws + RB_DT); float* AC = (float*)(ws + RB_ACUM);
    {
        const int idx = tid * nblk + blk;
        for (int e = idx; e < (HT / 128) * 16; e += NT) {
            const int h = e & 15, ch = e >> 4; const float a = -__expf(alog[h]), bias = dtb[h]; float acc = 0.f;
            for (int i = 0; i < 128; ++i) { const size_t t = (size_t)ch * 128 + i; const float d = softplusf_(DTGK[t * 32 + h] + bias); acc += d * a; DT[t * 16 + h] = d; AC[t * 16 + h] = acc; }
        }
    }
}

DEV void phase_ssd_states(unsigned char* ws, LAS unsigned char* lds, int tid, int wave, int lane) {
    const bf16_t* XSTC = (const bf16_t*)(ws + RB_XSTC); const bf16_t* BTC = (const bf16_t*)(ws + RB_BTC);
    const float* DT = (const float*)(ws + RB_DT); const float* AC = (const float*)(ws + RB_ACUM); float* ST = (float*)(ws + RB_ST);
    constexpr int BT_OFF = 0, XW_OFF = 34816, TAB_OFF = 34816 + 69632, RS = 272;
    LAS float* wt = (LAS float*)(lds + TAB_OFF);
    const int fr = lane & 15, fq = lane >> 4;
    for (int unit = blockIdx.x; unit < (HT / 128) * 4; unit += gridDim.x) {
        const int cidx = unit >> 2, g = unit & 3, t0 = cidx * 128;
        { const int r = tid >> 7, l = tid & 127, h = g * 4 + r;
          const float al = AC[(size_t)(t0 + 127) * 16 + h], a = AC[(size_t)(t0 + l) * 16 + h];
          wt[r * 128 + l] = DT[(size_t)(t0 + l) * 16 + h] * __expf(al - a); }
        for (int i = tid; i < 2048; i += NTHR) { const int row = i >> 4, ch = i & 15;
            *(LAS u32x4*)(lds + BT_OFF + row * RS + ch * 16) = *(const u32x4*)(BTC + (size_t)(g * 128 + row) * HT + t0 + ch * 8); }
        __syncthreads();
        for (int i = tid; i < 4096; i += NTHR) { const int row = i >> 4, ch = i & 15; float f[8];
            unpack8(*(const u32x4*)(XSTC + (size_t)(g * 256 + row) * HT + t0 + ch * 8), f);
            const LAS float* wp = wt + (row >> 6) * 128 + ch * 8;
#pragma unroll
            for (int e = 0; e < 8; ++e) f[e] *= wp[e];
            *(LAS u32x4*)(lds + XW_OFF + row * RS + ch * 16) = pack8(f); }
        __syncthreads();
        f32x4 acc[2][8];
#pragma unroll
        for (int a = 0; a < 2; ++a)
#pragma unroll
            for (int b = 0; b < 8; ++b) acc[a][b] = (f32x4){0.f, 0.f, 0.f, 0.f};
#pragma unroll
        for (int ks = 0; ks < 4; ++ks) {
            const bf16x8 y0 = ldsfrag(lds + XW_OFF + (wave * 32 + fr) * RS + ks * 64 + fq * 16), y1 = ldsfrag(lds + XW_OFF + (wave * 32 + 16 + fr) * RS + ks * 64 + fq * 16);
#pragma unroll
            for (int nt = 0; nt < 8; ++nt) { const bf16x8 x = ldsfrag(lds + BT_OFF + (nt * 16 + fr) * RS + ks * 64 + fq * 16); acc[0][nt] = mma(x, y0, acc[0][nt]); acc[1][nt] = mma(x, y1, acc[1][nt]); }
        }
#pragma unroll
        for (int yt = 0; yt < 2; ++yt) { const int pp = wave * 32 + yt * 16 + fr, h = g * 4 + (pp >> 6), p = pp & 63;
            float* d = ST + (((size_t)cidx * 16 + h) * 64 + p) * 128 + 4 * fq;
#pragma unroll
            for (int nt = 0; nt < 8; ++nt) *(f32x4*)(d + nt * 16) = acc[yt][nt]; }
        __syncthreads();
    }
}

DEV void phase_ssd_scan(unsigned char* ws, int gtid, int NT) {
    float* ST = (float*)(ws + RB_ST); const float* AC = (const float*)(ws + RB_ACUM);
    for (int e = gtid; e < 2 * 65536; e += NT) {
        const int bl = e >> 16, rem = e & 65535, h = rem >> 12;
        f32x2 carry = {0.f, 0.f};
        for (int c0 = 0; c0 < 64; c0 += 8) {
            f32x2 v[8]; float dec[8];
#pragma unroll
            for (int i = 0; i < 8; ++i) { const int cidx = bl * 64 + c0 + i; v[i] = *(const f32x2*)(ST + (size_t)cidx * 131072 + rem * 2); dec[i] = __expf(AC[((size_t)cidx * 128 + 127) * 16 + h]); }
#pragma unroll
            for (int i = 0; i < 8; ++i) { const int cidx = bl * 64 + c0 + i; *(f32x2*)(ST + (size_t)cidx * 131072 + rem * 2) = carry; carry = carry * dec[i] + v[i]; }
        }
    }
}

DEV void phase_ssd_out(unsigned char* ws, const float* dsk, const float* nw, LAS unsigned char* lds, int tid, int wave, int lane) {
    const bf16_t* XSTC = (const bf16_t*)(ws + RB_XSTC); const bf16_t* BCC = (const bf16_t*)(ws + RB_BCC); const bf16_t* Z = (const bf16_t*)(ws + RB_Z);
    const float* DT = (const float*)(ws + RB_DT); const float* AC = (const float*)(ws + RB_ACUM); const float* ST = (const float*)(ws + RB_ST);
    bf16_t* YIN = (bf16_t*)(ws + WS_YIN);
    float* YT = (float*)(ws + RB_XST);
    constexpr int C_OFF = 0, B_OFF = 34816, PV_OFF = 34816, XS_OFF = 34816 + 17408, M_OFF = 69632, TAB_OFF = 104448, RS = 272;
    LAS float* tac = (LAS float*)(lds + TAB_OFF); LAS float* tdt = tac + 512;
    const int fr = lane & 15, fq = lane >> 4;
    LAS unsigned char* Mw = lds + M_OFF + wave * 4352;
    for (int unit = blockIdx.x; unit < (HT / 128) * 4; unit += gridDim.x) {
        const int cidx = unit >> 2, g = unit & 3, t0 = cidx * 128;
        for (int i = tid; i < 2048; i += NTHR) { const int row = i >> 4, ch = i & 15;
            *(LAS u32x4*)(lds + C_OFF + row * RS + ch * 16) = *(const u32x4*)(BCC + (size_t)(t0 + row) * DM + 512 + g * 128 + ch * 8);
            *(LAS u32x4*)(lds + B_OFF + row * RS + ch * 16) = *(const u32x4*)(BCC + (size_t)(t0 + row) * DM + g * 128 + ch * 8); }
        { const int r = tid >> 7, l = tid & 127, h = g * 4 + r; tac[tid] = AC[(size_t)(t0 + l) * 16 + h]; tdt[tid] = DT[(size_t)(t0 + l) * 16 + h]; }
        __syncthreads();
        f32x4 cb[8];
#pragma unroll
        for (int st = 0; st < 8; ++st) cb[st] = (f32x4){0.f, 0.f, 0.f, 0.f};
#pragma unroll
        for (int ks = 0; ks < 4; ++ks) {
            const bf16x8 y = ldsfrag(lds + C_OFF + (wave * 16 + fr) * RS + ks * 64 + fq * 16);
#pragma unroll
            for (int st = 0; st < 8; ++st) cb[st] = mma(ldsfrag(lds + B_OFF + (st * 16 + fr) * RS + ks * 64 + fq * 16), y, cb[st]);
        }
        __syncthreads();
        const int l = wave * 16 + fr;
        const size_t t = (size_t)(t0 + l);
        float ssq = 0.f;
#pragma unroll 1
        for (int r = 0; r < 4; ++r) {
            const int h = g * 4 + r;
            for (int i = tid; i < 2048; i += NTHR) { const int row = i >> 5, c4 = i & 31;
                const f32x4 v = *(const f32x4*)(ST + (((size_t)cidx * 16 + h) * 64 + row) * 128 + c4 * 4);
                u32x2 w; w.x = pk2(v.x, v.y); w.y = pk2(v.z, v.w); *(LAS u32x2*)(lds + PV_OFF + row * RS + c4 * 8) = w; }
            for (int i = tid; i < 1024; i += NTHR) { const int row = i >> 4, ch = i & 15;
                *(LAS u32x4*)(lds + XS_OFF + row * RS + ch * 16) = *(const u32x4*)(XSTC + (size_t)(h * 64 + row) * HT + t0 + ch * 8); }
            const float al = tac[r * 128 + l];
#pragma unroll
            for (int st = 0; st < 8; ++st) { float m[4];
#pragma unroll
                for (int j = 0; j < 4; ++j) { const int s = st * 16 + 4 * fq + j; const float d = fminf(al - tac[r * 128 + s], 0.f); m[j] = (s <= l) ? cb[st][j] * __expf(d) * tdt[r * 128 + s] : 0.f; }
                u32x2 w; w.x = pk2(m[0], m[1]); w.y = pk2(m[2], m[3]); *(LAS u32x2*)(Mw + fr * RS + (st * 16 + 4 * fq) * 2) = w; }
            __syncthreads();
            f32x4 acc[4];
#pragma unroll
            for (int pt = 0; pt < 4; ++pt) acc[pt] = (f32x4){0.f, 0.f, 0.f, 0.f};
#pragma unroll
            for (int ks = 0; ks < 4; ++ks) { const bf16x8 y = ldsfrag(lds + C_OFF + l * RS + ks * 64 + fq * 16);
#pragma unroll
                for (int pt = 0; pt < 4; ++pt) acc[pt] = mma(ldsfrag(lds + PV_OFF + (pt * 16 + fr) * RS + ks * 64 + fq * 16), y, acc[pt]); }
            const float el = __expf(al);
#pragma unroll
            for (int pt = 0; pt < 4; ++pt) acc[pt] *= el;
#pragma unroll
            for (int ks = 0; ks < 4; ++ks) { const bf16x8 y = ldsfrag(Mw + fr * RS + ks * 64 + fq * 16);
#pragma unroll
                for (int pt = 0; pt < 4; ++pt) acc[pt] = mma(ldsfrag(lds + XS_OFF + (pt * 16 + fr) * RS + ks * 64 + fq * 16), y, acc[pt]); }
            const float dh = dsk[h];
#pragma unroll
            for (int pt = 0; pt < 4; ++pt) {
#pragma unroll
                for (int j = 0; j < 4; ++j) { const bf16_t xv = *(const LAS bf16_t*)(lds + XS_OFF + (pt * 16 + 4 * fq + j) * RS + l * 2); acc[pt][j] += dh * bf1(xv); }
                const int c = g * 256 + r * 64 + pt * 16 + 4 * fq;
                const u32x2 zw = *(const u32x2*)(Z + t * DM + c);
                f32x4 v = acc[pt]; v[0] *= bf_lo(zw.x); v[1] *= bf_hi(zw.x); v[2] *= bf_lo(zw.y); v[3] *= bf_hi(zw.y);
                ssq += (v[0] * v[0] + v[1] * v[1]) + (v[2] * v[2] + v[3] * v[3]);
                *(f32x4*)(YT + t * DM + c) = v;
            }
            __syncthreads();
        }
        ssq += __shfl_xor(ssq, 16); ssq += __shfl_xor(ssq, 32);
        const float rstd = rsqrtf(ssq * (1.f / 256.f) + EPS);
#pragma unroll 4
        for (int q = 0; q < 16; ++q) { const int c = g * 256 + q * 16 + 4 * fq;
            const f32x4 w4 = *(const f32x4*)(nw + c); const f32x4 v = *(const f32x4*)(YT + t * DM + c);
            u32x2 o; o.x = pk2(v[0] * rstd * w4[0], v[1] * rstd * w4[1]); o.y = pk2(v[2] * rstd * w4[2], v[3] * rstd * w4[3]);
            *(u32x2*)(YIN + t * DM + c) = o; }
        __syncthreads();
    }
}

DEV float gla_gk(const float* DTGK, size_t t, const float (&w)[16], float b) {
    const f32x4* gl = (const f32x4*)(DTGK + t * 32 + 16);
    const f32x4 g0 = gl[0], g1 = gl[1], g2 = gl[2], g3 = gl[3];
    float z = b;
    z += g0[0] * w[0] + g0[1] * w[1] + g0[2] * w[2] + g0[3] * w[3];
    z += g1[0] * w[4] + g1[1] * w[5] + g1[2] * w[6] + g1[3] * w[7];
    z += g2[0] * w[8] + g2[1] * w[9] + g2[2] * w[10] + g2[3] * w[11];
    z += g3[0] * w[12] + g3[1] * w[13] + g3[2] * w[14] + g3[3] * w[15];
    return logsigf_(z) * (1.f / 16.f);
}
DEV void phase_gla_prep(unsigned char* ws, const float* w2, const float* bg, int gtid, int NT) {
    bf16_t* QK = (bf16_t*)(ws + RC_QK); bf16_t* KT = (bf16_t*)(ws + RC_KT); float* DEC = (float*)(ws + WS_DEC);
    const float* DTGK = (const float*)(ws + WS_DTGK);
    for (int e = gtid; e < (HT / 64) * 512; e += NT) {
        const int d = e & 511, ch = e >> 9, t0 = ch * 64;
        float w[16];
#pragma unroll
        for (int j = 0; j < 16; ++j) w[j] = w2[j * 512 + d];
        const float b = bg[d];
        float glast = 0.f;
#pragma unroll 4
        for (int i = 0; i < 64; ++i) glast += gla_gk(DTGK, (size_t)(t0 + i), w, b);
        float run = 0.f;
        bf16_t* kd = KT + (size_t)d * HT + t0;
#pragma unroll 1
        for (int m = 0; m < 8; ++m) {
            unsigned tr[4];
#pragma unroll
            for (int ii = 0; ii < 8; ++ii) {
                const int i = m * 8 + ii;
                run += gla_gk(DTGK, (size_t)(t0 + i), w, b);
                bf16_t* qp = QK + (size_t)(t0 + i) * DM + d;
                const float q = bf1(qp[0]), k = bf1(qp[512]);
                qp[0] = (bf16_t)f2bf(q * 0.08838834764831845f * __expf(run));
                qp[512] = (bf16_t)f2bf(k * __expf(-run));
                const unsigned ke = f2bf(k * __expf(glast - run));
                if (ii & 1) tr[ii >> 1] |= ke << 16; else tr[ii >> 1] = ke;
            }
            *(u32x4*)(kd + 8 * m) = (u32x4){tr[0], tr[1], tr[2], tr[3]};
        }
        DEC[(size_t)ch * 512 + d] = __expf(glast);
    }
}

DEV void phase_gla_states(unsigned char* ws, LAS unsigned char* lds, int tid, int wave, int lane) {
    const bf16_t* KT = (const bf16_t*)(ws + RC_KT); const bf16_t* VT = (const bf16_t*)(ws + RC_VT); float* ST = (float*)(ws + RC_ST);
    constexpr int V_OFF = 0, K_OFF = 36864, RS = 144;
    const int fr = lane & 15, fq = lane >> 4;
    for (int unit = blockIdx.x; unit < (HT / 64) * 4; unit += gridDim.x) {
        const int cidx = unit >> 2, h = unit & 3, t0 = cidx * 64;
        for (int i = tid; i < 2048; i += NTHR) { const int row = i >> 3, ch = i & 7;
            *(LAS u32x4*)(lds + V_OFF + row * RS + ch * 16) = *(const u32x4*)(VT + (size_t)(h * 256 + row) * HT + t0 + ch * 8); }
        for (int i = tid; i < 1024; i += NTHR) { const int row = i >> 3, ch = i & 7;
            *(LAS u32x4*)(lds + K_OFF + row * RS + ch * 16) = *(const u32x4*)(KT + (size_t)(h * 128 + row) * HT + t0 + ch * 8); }
        __syncthreads();
        f32x4 acc[2][8];
#pragma unroll
        for (int a = 0; a < 2; ++a)
#pragma unroll
            for (int b = 0; b < 8; ++b) acc[a][b] = (f32x4){0.f, 0.f, 0.f, 0.f};
#pragma unroll
        for (int ks = 0; ks < 2; ++ks) {
            const bf16x8 y0 = ldsfrag(lds + V_OFF + (wave * 32 + fr) * RS + ks * 64 + fq * 16), y1 = ldsfrag(lds + V_OFF + (wave * 32 + 16 + fr) * RS + ks * 64 + fq * 16);
#pragma unroll
            for (int dt = 0; dt < 8; ++dt) { const bf16x8 x = ldsfrag(lds + K_OFF + (dt * 16 + fr) * RS + ks * 64 + fq * 16); acc[0][dt] = mma(x, y0, acc[0][dt]); acc[1][dt] = mma(x, y1, acc[1][dt]); }
        }
#pragma unroll
        for (int yt = 0; yt < 2; ++yt) { const int v = wave * 32 + yt * 16 + fr;
            float* dp = ST + (((size_t)cidx * 4 + h) * 256 + v) * 128 + 4 * fq;
#pragma unroll
            for (int dt = 0; dt < 8; ++dt) *(f32x4*)(dp + dt * 16) = acc[yt][dt]; }
        __syncthreads();
    }
}

DEV void phase_gla_scan(unsigned char* ws, int gtid, int NT) {
    float* ST = (float*)(ws + RC_ST); const float* DEC = (const float*)(ws + WS_DEC);
    for (int e = gtid; e < 2 * 65536; e += NT) {
        const int bl = e >> 16, rem = e & 65535, h = rem >> 14, d = (rem * 2) & 127;
        f32x2 carry = {0.f, 0.f};
        for (int c0 = 0; c0 < 128; c0 += 8) {
            f32x2 v[8], dec[8];
#pragma unroll
            for (int i = 0; i < 8; ++i) { const int cidx = bl * 128 + c0 + i; v[i] = *(const f32x2*)(ST + (size_t)cidx * 131072 + rem * 2); dec[i] = *(const f32x2*)(DEC + (size_t)cidx * 512 + h * 128 + d); if (GLA_ZERO_DEC) dec[i] = (f32x2){0.f, 0.f}; }
#pragma unroll
            for (int i = 0; i < 8; ++i) { const int cidx = bl * 128 + c0 + i; *(f32x2*)(ST + (size_t)cidx * 131072 + rem * 2) = carry; carry = carry * dec[i] + v[i]; }
        }
    }
}

DEV void phase_gla_out(unsigned char* ws, const float* nw, LAS unsigned char* lds, int tid, int wave, int lane) {
    const bf16_t* QK = (const bf16_t*)(ws + RC_QK); const bf16_t* VT = (const bf16_t*)(ws + RC_VT); const bf16_t* GS = (const bf16_t*)(ws + RC_GS);
    const float* ST = (const float*)(ws + RC_ST); bf16_t* YIN = (bf16_t*)(ws + WS_YIN);
    constexpr int Q_OFF = 0, K_OFF = 17408, V_OFF = 34816, P_OFF = 71680, S_OFF = 80896, RSD = 272, RST = 144;
    LAS float* ssqt = (LAS float*)(lds + S_OFF);
    const int fr = lane & 15, fq = lane >> 4, lt = wave >> 1, vh = wave & 1;
    for (int unit = blockIdx.x; unit < (HT / 64) * 4; unit += gridDim.x) {
        const int cidx = unit >> 2, h = unit & 3, t0 = cidx * 64;
        for (int i = tid; i < 1024; i += NTHR) { const int row = i >> 4, ch = i & 15;
            *(LAS u32x4*)(lds + Q_OFF + row * RSD + ch * 16) = *(const u32x4*)(QK + (size_t)(t0 + row) * DM + h * 128 + ch * 8);
            *(LAS u32x4*)(lds + K_OFF + row * RSD + ch * 16) = *(const u32x4*)(QK + (size_t)(t0 + row) * DM + 512 + h * 128 + ch * 8); }
        for (int i = tid; i < 2048; i += NTHR) { const int row = i >> 3, ch = i & 7;
            *(LAS u32x4*)(lds + V_OFF + row * RST + ch * 16) = *(const u32x4*)(VT + (size_t)(h * 256 + row) * HT + t0 + ch * 8); }
        __syncthreads();
        const int l = lt * 16 + fr;
        {
            f32x4 sc[2] = {(f32x4){0.f, 0.f, 0.f, 0.f}, (f32x4){0.f, 0.f, 0.f, 0.f}};
#pragma unroll
            for (int ks = 0; ks < 4; ++ks) { const bf16x8 y = ldsfrag(lds + Q_OFF + l * RSD + ks * 64 + fq * 16);
#pragma unroll
                for (int i = 0; i < 2; ++i) sc[i] = mma(ldsfrag(lds + K_OFF + ((2 * vh + i) * 16 + fr) * RSD + ks * 64 + fq * 16), y, sc[i]); }
#pragma unroll
            for (int i = 0; i < 2; ++i) { const int s0 = (2 * vh + i) * 16 + 4 * fq; float m[4];
#pragma unroll
                for (int j = 0; j < 4; ++j) m[j] = (s0 + j <= l) ? sc[i][j] : 0.f;
                u32x2 w; w.x = pk2(m[0], m[1]); w.y = pk2(m[2], m[3]); *(LAS u32x2*)(lds + P_OFF + l * RST + s0 * 2) = w; }
        }
        __syncthreads();
        f32x4 acc[8];
#pragma unroll
        for (int i = 0; i < 8; ++i) acc[i] = (f32x4){0.f, 0.f, 0.f, 0.f};
#pragma unroll
        for (int ks = 0; ks < 2; ++ks) { const bf16x8 y = ldsfrag(lds + P_OFF + l * RST + ks * 64 + fq * 16);
#pragma unroll
            for (int i = 0; i < 8; ++i) acc[i] = mma(ldsfrag(lds + V_OFF + ((vh * 8 + i) * 16 + fr) * RST + ks * 64 + fq * 16), y, acc[i]); }
        const float* sp = ST + (((size_t)cidx * 4 + h) * 256 + vh * 128 + fr) * 128 + fq * 8;
#pragma unroll
        for (int ks = 0; ks < (GLA_NO_INTER ? 0 : 4); ++ks) { const bf16x8 y = ldsfrag(lds + Q_OFF + l * RSD + ks * 64 + fq * 16);
#pragma unroll
            for (int i = 0; i < 8; ++i) { const float* pp = sp + (size_t)i * 16 * 128 + ks * 32; const f32x4 a = *(const f32x4*)pp, b = *(const f32x4*)(pp + 4);
                u32x4 w; w.x = pk2(a[0], a[1]); w.y = pk2(a[2], a[3]); w.z = pk2(b[0], b[1]); w.w = pk2(b[2], b[3]);
                acc[i] = mma(__builtin_bit_cast(bf16x8, w), y, acc[i]); } }
        float ssq = 0.f;
#pragma unroll
        for (int i = 0; i < 8; ++i) ssq += (acc[i][0] * acc[i][0] + acc[i][1] * acc[i][1]) + (acc[i][2] * acc[i][2] + acc[i][3] * acc[i][3]);
        ssq += __shfl_xor(ssq, 16); ssq += __shfl_xor(ssq, 32);
        if (fq == 0) ssqt[l * 2 + vh] = ssq;
        __syncthreads();
        const float rstd = rsqrtf((ssqt[l * 2] + ssqt[l * 2 + 1]) * (1.f / 256.f) + EPS);
        const size_t t = (size_t)(t0 + l);
#pragma unroll
        for (int i = 0; i < 8; ++i) { const int v = (vh * 8 + i) * 16 + 4 * fq, c = h * 256 + v;
            const u32x2 gw = *(const u32x2*)(GS + t * DM + c); const f32x4 w4 = *(const f32x4*)(nw + v);
            u32x2 o; o.x = pk2(acc[i][0] * rstd * w4[0] * bf_lo(gw.x), acc[i][1] * rstd * w4[1] * bf_hi(gw.x));
            o.y = pk2(acc[i][2] * rstd * w4[2] * bf_lo(gw.y), acc[i][3] * rstd * w4[3] * bf_hi(gw.y));
            *(u32x2*)(YIN + t * DM + c) = o; }
        __syncthreads();
    }
}


#define XB_TMO      128
#define XB_XCNT(j)  (256  + 64 * (j))
#define XB_XSUB(j)  (1280 + 64 * (j))
#define XB_XGEN(j)  (2304 + 64 * (j))
#define XB_TOP      3328
#define XB_TOPGEN   3392
#define XCD_BAR_WORDS 3456
#define XB_SPIN_CAP (1u << 22)
DEV unsigned xb_ld(unsigned* p)              { return __hip_atomic_load(p, __ATOMIC_RELAXED, __HIP_MEMORY_SCOPE_AGENT); }
DEV unsigned xb_add(unsigned* p, unsigned v) { return __hip_atomic_fetch_add(p, v, __ATOMIC_RELAXED, __HIP_MEMORY_SCOPE_AGENT); }
DEV unsigned xb_xcc_id() { return (unsigned)__builtin_amdgcn_s_getreg((3 << 11) | 20) & 0xFu; }
#define XB_SPIN(cond, bar) do { unsigned _sp = 0; while (cond) { __builtin_amdgcn_s_sleep(1); \
    if ((++_sp & 255u) == 0u) { if (xb_ld(&(bar)[XB_TMO])) break; if (_sp > XB_SPIN_CAP) { atomicAdd(&(bar)[XB_TMO], 1u); break; } } } } while (0)
DEV void xcd_barrier_complete(unsigned* bar, unsigned x, unsigned Gn, unsigned& nloc, unsigned& nx) {
    unsigned sum, cnt, mine, sp = 0u;
    for (;;) {
        sum = 0u; cnt = 0u; mine = 0u;
#pragma unroll
        for (unsigned j = 0; j < 16; ++j) { const unsigned c = xb_ld(&bar[XB_XCNT(j)]); sum += c; cnt += (c > 0u) ? 1u : 0u; mine = (j == x) ? c : mine; }
        if (sum == Gn) break;
        __builtin_amdgcn_s_sleep(1);
        if ((++sp & 255u) == 0u) { if (xb_ld(&bar[XB_TMO])) break; if (sp > XB_SPIN_CAP) { atomicAdd(&bar[XB_TMO], 1u); break; } }
    }
    nloc = mine > 0u ? mine : 1u; nx = cnt > 0u ? cnt : 1u;
}
DEV void xcd_barrier(unsigned* bar, unsigned x, volatile LAS unsigned* st, int tid, unsigned Gn) {
    asm volatile("s_waitcnt vmcnt(0)" ::: "memory");
    __syncthreads();
    if (tid == 0) {
        __builtin_amdgcn_s_waitcnt(0);
        unsigned nloc = st[0], nx = st[1];
        if (nloc == 0u) { xcd_barrier_complete(bar, x, Gn, nloc, nx); st[0] = nloc; st[1] = nx; }
        const unsigned old = xb_add(&bar[XB_XSUB(x)], 1u);
        const unsigned gen = old / nloc;
        if (old + 1u == (gen + 1u) * nloc) {
            __builtin_amdgcn_fence(__ATOMIC_RELEASE, "agent");
            asm volatile("s_waitcnt vmcnt(0)" ::: "memory");
            const unsigned og = xb_add(&bar[XB_TOP], 1u);
            const unsigned tg = og / nx;
            if (og + 1u == (tg + 1u) * nx) xb_add(&bar[XB_TOPGEN], 1u);
            else XB_SPIN(xb_ld(&bar[XB_TOPGEN]) == tg, bar);
            __builtin_amdgcn_fence(__ATOMIC_ACQUIRE, "agent");
            xb_add(&bar[XB_XGEN(x)], 1u);
            asm volatile("s_waitcnt vmcnt(0)" ::: "memory");
        } else {
            XB_SPIN(xb_ld(&bar[XB_XGEN(x)]) == gen, bar);
            __builtin_amdgcn_fence(__ATOMIC_ACQUIRE, "agent");
            asm volatile("s_waitcnt vmcnt(0)" ::: "memory");
        }
    }
    __syncthreads();
}

typedef const __attribute__((address_space(4))) Params* KParams;
DEV KParams kargs() { unsigned long long kp = (unsigned long long)__builtin_amdgcn_kernarg_segment_ptr(); asm volatile("" : "+s"(kp)); return (KParams)kp; }

__global__ void __launch_bounds__(NTHR, 2) mega_fwd(Params Parg, int pc_lo, int pc_hi, int coop, int pad_) {
    extern __shared__ __attribute__((aligned(16))) unsigned char smem[];
    cg::grid_group grid = cg::this_grid();
    if (coop) grid.sync();
    volatile LAS unsigned* xst = (volatile LAS unsigned*)((LAS unsigned char*)smem + 139264 - 16);
    const unsigned xcc = xb_xcc_id();
    if (threadIdx.x == 0) { xst[0] = 0u; xst[1] = 0u; (void)xb_add((unsigned*)(asglobal(kargs()->ws) + WS_BAR) + XB_XCNT(xcc), 1u); }
    __syncthreads();
    using pg8::Sched; using pg8::job_put;
    constexpr int PER_LAYER = 1 + 34 + 3, NPC = 2 * PER_LAYER + 1;
#pragma unroll 1
    for (int pc0 = pc_lo; pc0 < pc_hi; ++pc0) {
        int pc = pc0; asm volatile("" : "+s"(pc));
        int tid = threadIdx.x; asm volatile("" : "+v"(tid));
        const int lane = tid & 63, wave = __builtin_amdgcn_readfirstlane(tid >> 6);
        unsigned ldso = 0; asm volatile("" : "+s"(ldso));
        LAS unsigned char* lds = (LAS unsigned char*)smem + ldso;
        int bxv = blockIdx.x, gdv = gridDim.x; asm volatile("" : "+s"(bxv), "+s"(gdv));
        const int layer = pc / PER_LAYER; const int r = pc - layer * PER_LAYER;
        int ph, hf = 0;
        if (pc == NPC - 1) ph = 21; else if (r == 0) ph = 0; else if (r <= 34) { hf = (r - 1) / 17; ph = (r - 1) - hf * 17 + 1; } else ph = 18 + (r - 35);
        asm volatile("" : "+s"(ph), "+s"(hf));
#define P kargs()
#define ws asglobal(kargs()->ws)
#define INP(i) asglobal(kargs()->in[i])
#define OUTP asglobal(kargs()->out)
#define G gdv
#define bx bxv
#define gw (bx * NWAVES + wave)
#define NGW (G * NWAVES)
#define gtid (bx * NTHR + tid)
#define NT (G * NTHR)
#define WIN ((bf16_t*)(ws + WS_WIN))
#define HB ((bf16_t*)(ws + WS_HB))
#define MERGED ((float*)(ws + WS_MERGED))
#define GB ((bf16_t*)(ws + WS_G))
#define YIN ((bf16_t*)(ws + WS_YIN))
#define xsrc (((layer == 0) ? INP(0) : (const float*)OUTP) + (size_t)hf * HT * DM)
#define xdst (OUTP + (size_t)hf * HT * DM)

#define PROBE11 0
#define NOMIX 0
#define NOMLP 0
#ifndef SKIPMASK

#define SKIPMASK 0u
#endif
        if ((SKIPMASK >> ph) & 1u) ph = 99;
#ifdef DELAY_PROBE
        if (bxv == 3) { const unsigned long long t0 = __builtin_amdgcn_s_memrealtime(); while (__builtin_amdgcn_s_memrealtime() - t0 < 30000ull) __builtin_amdgcn_s_sleep(64); }
#endif
        switch (ph) {
        case 0:
            phase_weights(ws, INP(2) + (size_t)layer * 1024 * INW, INP(4) + (size_t)layer * 1048576, INP(11) + (size_t)layer * 1048576, INP(15) + (size_t)layer * 1048576,
                          INP(16) + (size_t)layer * 1048576, INP(18) + (size_t)layer * 4194304, INP(19) + (size_t)layer * 4194304, lds, gw, NGW, wave, lane);
            break;
        case 1:
            phase_rmsnorm_bf16(xsrc, INP(1) + layer * DM, HB, HT, gw, NGW, lane);
            break;
        case 2: {
            if (tid == 0) { job_put(lds, 0, HB, WIN, ws + RA_UA, nullptr, 64, 12, 3072, 0); job_put(lds, 1, HB, WIN + (size_t)9248 * DM, GB, nullptr, 64, 4, 1024, 1); }
            Sched S; S.init(lds, 2, G, bx, DM, tid);
            pg8::GEMM_BODY<3>(lds, DM, S, tid);
            phase_narrow(HB, WIN + (size_t)6144 * DM, WIN + (size_t)9232 * DM, (float*)(ws + WS_DTGK), gw, NGW, lane);
            break; }
        case 3:
            phase_conv_a((const bf16_t*)(ws + RA_UA), INP(3) + (size_t)layer * 3 * 1024, YIN, gtid, NT);
            break;
        case 4: {
            if (tid == 0) job_put(lds, 0, YIN, ws + WS_WOA, ws + WS_MERGED, GB, 64, 4, 1024, 4);
            Sched S; S.init(lds, 1, G, bx, DM, tid); pg8::GEMM_BODY<16>(lds, DM, S, tid);
            break; }
        case 5: {
            if (tid == 0) { job_put(lds, 0, HB, WIN + (size_t)3072 * DM, ws + RB_Z, nullptr, 64, 4, 1024, 2); job_put(lds, 1, WIN + (size_t)4096 * DM, HB, ws + RB_XST, nullptr, 4, 64, HT, 0);
                            job_put(lds, 2, HB, WIN + (size_t)5120 * DM, ws + RB_BC, nullptr, 64, 4, 1024, 0); job_put(lds, 3, HB, WIN + (size_t)10272 * DM, GB, nullptr, 64, 4, 1024, 1); }
            Sched S; S.init(lds, 4, G, bx, DM, tid); pg8::GEMM_BODY<7>(lds, DM, S, tid);
            break; }
        case 6:
            phase_ssd_prep(ws, INP(5) + (size_t)layer * 4 * 2048, INP(6) + (size_t)layer * 2048, INP(7) + layer * 16, INP(8) + layer * 16, gtid, NT, tid, G, bx);
            break;
        case 7: phase_ssd_states(ws, lds, tid, wave, lane); break;
        case 8: phase_ssd_scan(ws, gtid, NT); break;
        case 9: phase_ssd_out(ws, INP(9) + layer * 16, INP(10) + layer * 1024, lds, tid, wave, lane); break;
        case 10: {
            if (tid == 0) job_put(lds, 0, YIN, ws + WS_WOS, ws + WS_MERGED, GB, 64, 4, (int)((WS_MSUM - WS_MERGED) / 4), 5);
            Sched S; S.init(lds, 1, G, bx, DM, tid); pg8::GEMM_BODY<32>(lds, DM, S, tid);
            break; }
        case 11: {
#if PROBE11 == 1
            if (tid == 0) { job_put(lds, 0, HB, WIN + (size_t)11296 * DM, GB, nullptr, 64, 4, 1024, 1); }
            Sched S; S.init(lds, 1, G, bx, DM, tid); pg8::GEMM_BODY<7>(lds, DM, S, tid);
#elif PROBE11 == 2
            if (tid == 0) { job_put(lds, 1, HB, WIN + (size_t)3072 * DM, ws + RB_Z, nullptr, 64, 4, 1024, 2); job_put(lds, 2, WIN + (size_t)4096 * DM, HB, ws + RB_XST, nullptr, 4, 64, HT, 0);
                            job_put(lds, 3, HB, WIN + (size_t)5120 * DM, ws + RB_BC, nullptr, 64, 4, 1024, 0); job_put(lds, 0, HB, WIN + (size_t)10272 * DM, GB, nullptr, 64, 4, 1024, 1); }
            Sched S; S.init(lds, 4, G, bx, DM, tid); pg8::GEMM_BODY<7>(lds, DM, S, tid);
#else
            if (tid == 0) { job_put(lds, 0, HB, WIN + (size_t)6160 * DM, ws + RC_QK, nullptr, 64, 4, 1024, 0); job_put(lds, 1, WIN + (size_t)7184 * DM, HB, ws + RC_VT, nullptr, 4, 64, HT, 0);
                            job_put(lds, 2, HB, WIN + (size_t)8208 * DM, ws + RC_GS, nullptr, 64, 4, 1024, 2); job_put(lds, 3, HB, WIN + (size_t)11296 * DM, GB, nullptr, 64, 4, 1024, 1); }
            Sched S; S.init(lds, 4, G, bx, DM, tid); pg8::GEMM_BODY<7>(lds, DM, S, tid);
#endif
            break; }
        case 12: phase_gla_prep(ws, INP(12) + (size_t)layer * 16 * 512, INP(13) + layer * 512, gtid, NT); break;
        case 13: phase_gla_states(ws, lds, tid, wave, lane); break;
        case 14: phase_gla_scan(ws, gtid, NT); break;
        case 15: phase_gla_out(ws, INP(14) + layer * 256, lds, tid, wave, lane); break;
        case 16: {
            if (tid == 0) job_put(lds, 0, YIN, ws + WS_WOG, ws + WS_MSUM, GB, 64, 4, 1024, 6);
            Sched S; S.init(lds, 1, G, bx, DM, tid); pg8::GEMM_BODY<64>(lds, DM, S, tid);
            break; }
        case 17: {
            if (tid == 0) job_put(lds, 0, GB, ws + WS_WO, xdst, xsrc, 64, 4, NOMIX ? 0 : 1024, 7);
            Sched S; S.init(lds, 1, G, bx, DM, tid); pg8::GEMM_BODY<128>(lds, DM, S, tid);
            break; }
        case 18:
            phase_rmsnorm_bf16(OUTP, INP(17) + layer * DM, (bf16_t*)(ws + WS_MERGED), T_ALL, gw, NGW, lane);
            break;
        case 19: {
            if (tid == 0) job_put(lds, 0, ws + WS_MERGED, ws + WS_WUP, ws + WS_R, nullptr, 128, 16, DFF, 3);
            Sched S; S.init(lds, 1, G, bx, DM, tid); pg8::GEMM_BODY<8>(lds, DM, S, tid);
            break; }
        case 20: {
            if (tid == 0) job_put(lds, 0, ws + WS_R, ws + WS_WDN, OUTP, OUTP, 128, 4, NOMLP ? 0 : 1024, 7);
            Sched S; S.init(lds, 1, G, bx, DFF, tid); pg8::GEMM_BODY<128>(lds, DFF, S, tid);
            break; }
        case 99: {
#ifdef SPIN_PROBE
            if (pc == 6 || pc == 23) { const unsigned long long t0 = __builtin_amdgcn_s_memrealtime(); while (__builtin_amdgcn_s_memrealtime() - t0 < 500000ull) __builtin_amdgcn_s_sleep(64); }
#endif
            break; }
        default:
            phase_rmsnorm_f32(OUTP, INP(20), T_ALL, gw, NGW, lane);
            break;
        }
        if (pc0 != pc_hi - 1) {
            xcd_barrier((unsigned*)(ws + WS_BAR), xcc, xst, tid, (unsigned)gdv);
        }
    }
#undef P
#undef ws
#undef INP
#undef OUTP
#undef G
#undef bx
#undef gw
#undef NGW
#undef gtid
#undef NT
#undef WIN
#undef HB
#undef MERGED
#undef GB
#undef YIN
#undef xsrc
#undef xdst
}

extern "C" void kernel_launch(void* const* d_in, const int* in_sizes, int n_in, void* d_out, int out_size, void* d_ws, size_t ws_size, hipStream_t stream) {
    static int grid = 0;
    if (grid == 0) {
        if (n_in != 21 || out_size != T_ALL * DM || ws_size < WS_TOTAL) { fprintf(stderr, "kernel_launch: unexpected shapes (n_in %d out %d ws %zu need %zu)\n", n_in, out_size, ws_size, (size_t)WS_TOTAL); grid = -1; return; }
        int dev = 0, cus = 0, per_cu = 0;
        hipGetDevice(&dev);
        hipDeviceGetAttribute(&cus, hipDeviceAttributeMultiprocessorCount, dev);
        if (hipFuncSetAttribute((const void*)mega_fwd, hipFuncAttributeMaxDynamicSharedMemorySize, LDS_BYTES) != hipSuccess) { fprintf(stderr, "kernel_launch: hipFuncSetAttribute failed\n"); }
        if (hipOccupancyMaxActiveBlocksPerMultiprocessor(&per_cu, (const void*)mega_fwd, NTHR, LDS_BYTES) != hipSuccess || per_cu < 1) { fprintf(stderr, "kernel_launch: occupancy query says %d\n", per_cu); per_cu = 1; }
        (void)hipGetLastError();
        grid = cus > 0 ? cus : 256;
    }
    if (grid < 0) return;
    if (hipMemsetAsync((char*)d_ws + WS_BAR, 0, 16384, stream) != hipSuccess) { fprintf(stderr, "kernel_launch: memset failed\n"); return; }
    Params p{};
    for (int i = 0; i < 21; ++i) p.in[i] = (const float*)d_in[i];
    p.out = (float*)d_out; p.ws = (unsigned char*)d_ws;
#ifndef N_LAUNCH_SPLIT
#define N_LAUNCH_SPLIT 0
#endif
    constexpr int NPC_H = 2 * 38 + 1;
    if (N_LAUNCH_SPLIT) {
        for (int pc = 0; pc < NPC_H; ++pc) {
            hipLaunchKernelGGL(mega_fwd, dim3(grid), dim3(NTHR), LDS_BYTES, stream, p, pc, pc + 1, 0, 0);
        }
        hipError_t e = hipPeekAtLastError();
        if (e != hipSuccess) fprintf(stderr, "launch failed: %s (grid %d)\n", hipGetErrorString(e), grid);
    } else {
        int lo = 0, hi = NPC_H, coop = 1, pad = 0;
        void* args[] = {&p, &lo, &hi, &coop, &pad};
        hipError_t e = hipLaunchCooperativeKernel((const void*)mega_fwd, dim3(grid), dim3(NTHR), args, LDS_BYTES, stream);
        if (e != hipSuccess) fprintf(stderr, "cooperative launch failed: %s (grid %d)\n", hipGetErrorString(e), grid);
    }
}
```

```cpp
#include <hip/hip_runtime.h>
#include <hip/hip_cooperative_groups.h>
#include <cstdio>
namespace cg = cooperative_groups;

#define LAS __attribute__((address_space(3)))
#define DEV __device__ __forceinline__
typedef unsigned short bf16_t;
typedef short bf16x8 __attribute__((ext_vector_type(8)));
typedef float f32x4 __attribute__((ext_vector_type(4)));
typedef float f32x2 __attribute__((ext_vector_type(2)));
typedef unsigned u32x4 __attribute__((ext_vector_type(4)));
typedef unsigned u32x2 __attribute__((ext_vector_type(2)));

constexpr int T_ALL = 32768, HT = 16384, DM = 1024, SEQ = 8192, INW = 12320, DFF = 4096;
constexpr int NTHR = 512, NWAVES = 8;
constexpr int LDS_BYTES = 136 * 1024;
constexpr float EPS = 1e-6f;

constexpr size_t WS_WIN = 1048576;
constexpr size_t WS_WOA = WS_WIN + (size_t)INW * 1024 * 2 + 1048576;
constexpr size_t WS_WOS = WS_WOA + 2097152;
constexpr size_t WS_WOG = WS_WOS + 2097152;
constexpr size_t WS_WO = WS_WOG + 2097152;
constexpr size_t WS_WUP = WS_WO + 2097152;
constexpr size_t WS_WDN = WS_WUP + 8388608;
constexpr size_t WS_HB = WS_WDN + 8388608;
constexpr size_t WS_MERGED = WS_HB + (size_t)HT * 1024 * 2;
constexpr size_t WS_G = WS_MERGED + (size_t)HT * 1024 * 4;
constexpr size_t WS_YIN = WS_G + (size_t)HT * 1024 * 2;
constexpr size_t WS_DTGK = WS_YIN + (size_t)HT * 1024 * 2;
constexpr size_t WS_R = WS_DTGK + (size_t)HT * 32 * 4;
constexpr size_t RA_UA = WS_R;
constexpr size_t RB_Z = WS_R;
constexpr size_t RB_XST = RB_Z + 33554432;
constexpr size_t RB_BC = RB_XST + 33554432;
constexpr size_t RB_XSTC = RB_BC + 33554432;
constexpr size_t RB_BCC = RB_XSTC + 33554432;
constexpr size_t RB_BTC = RB_BCC + 33554432;
constexpr size_t RB_DT = RB_BTC + 16777216;
constexpr size_t RB_ACUM = RB_DT + 1048576;
constexpr size_t RB_ST = RB_ACUM + 1048576;
constexpr size_t RB_END = RB_ST + 67108864;
constexpr size_t RC_QK = WS_R;
constexpr size_t RC_KT = RC_QK + 33554432;
constexpr size_t RC_VT = RC_KT + 16777216;
constexpr size_t RC_GS = RC_VT + 33554432;
constexpr size_t RC_DEC = RC_GS + 33554432;
constexpr size_t RC_ST = RC_DEC + 524288;
constexpr size_t RC_END = RC_ST + 134217728;
constexpr size_t R_HID_END = WS_R + (size_t)T_ALL * DFF * 2;
constexpr size_t WS_END = (RB_END > RC_END ? (RB_END > R_HID_END ? RB_END : R_HID_END) : (RC_END > R_HID_END ? RC_END : R_HID_END));

constexpr size_t WS_MSUM = (WS_END + 255) & ~(size_t)255;
constexpr size_t WS_BAR = WS_MSUM + (size_t)HT * 1024 * 2;
constexpr size_t WS_DEC = WS_BAR + 16384;
constexpr size_t WS_TOTAL = WS_DEC + 524288;
struct Params { const float* in[21]; float* out; unsigned char* ws; };

DEV unsigned f2bf(float f) { unsigned u = __float_as_uint(f); return (u + 0x7fffu + ((u >> 16) & 1u)) >> 16; }
typedef __bf16 bf16x2_t __attribute__((ext_vector_type(2)));
DEV unsigned pk2(float lo, float hi) { const f32x2 v = {lo, hi}; const bf16x2_t r = __builtin_convertvector(v, bf16x2_t); return __builtin_bit_cast(unsigned, r); }
DEV float bf_lo(unsigned w) { return __uint_as_float(w << 16); }
DEV float bf_hi(unsigned w) { return __uint_as_float(w & 0xffff0000u); }
DEV float bf1(bf16_t h) { return __uint_as_float(((unsigned)h) << 16); }
DEV void unpack8(const u32x4 w, float (&f)[8]) {
    f[0] = bf_lo(w.x); f[1] = bf_hi(w.x); f[2] = bf_lo(w.y); f[3] = bf_hi(w.y);
    f[4] = bf_lo(w.z); f[5] = bf_hi(w.z); f[6] = bf_lo(w.w); f[7] = bf_hi(w.w);
}
DEV u32x4 pack8(const float (&f)[8]) { u32x4 w; w.x = pk2(f[0], f[1]); w.y = pk2(f[2], f[3]); w.z = pk2(f[4], f[5]); w.w = pk2(f[6], f[7]); return w; }
DEV float sigmoidf_(float x) { return __builtin_amdgcn_rcpf(1.0f + __expf(-x)); }
DEV float siluf_(float x) { return x * sigmoidf_(x); }
DEV float softplusf_(float x) { return x > 20.f ? x : (x < -15.f ? __expf(x) : __logf(1.0f + __expf(x))); }
DEV float logsigf_(float x) { const float e = __expf(-fabsf(x)); return fminf(x, 0.f) - (e < 1e-4f ? e : __logf(1.0f + e)); }
DEV float wave_sum(float v) {
#pragma unroll
    for (int o = 1; o < 64; o <<= 1) v += __shfl_xor(v, o);
    return v;
}
DEV f32x4 mma(bf16x8 x, bf16x8 y, f32x4 acc) { return __builtin_amdgcn_mfma_f32_16x16x32_bf16(x, y, acc, 0, 0, 0); }
DEV bf16x8 ldsfrag(const LAS unsigned char* p) { return *(const LAS bf16x8*)p; }
#define SCALE_A 1.f
#define SCALE_B 1.f
#define SCALE_C 1.f
#define DUP 0
#define DUP2 0
#define GLA_NO_INTER 0
#define GLA_ZERO_DEC 0
#ifndef GEMM_BODY
#define GEMM_BODY gemm_phase
#endif
#define LDS_WAIT() asm volatile("s_waitcnt lgkmcnt(0)" ::: "memory")
#define GAS __attribute__((address_space(1)))
template <class T> DEV T* asglobal(T* p) { return (T*)(GAS T*)p; }

namespace pg8 {
constexpr int BM = 256, BK = 64, HALF = 128, HTB = HALF * BK * 2, STAGE_BYTES = 8 * HTB, NXCD = 8, WGM = 8;
DEV int lds_byte(int r, int c) { const int st = (r >> 4) * 2 + (c >> 5), rr = r & 15, cc = c & 31, ob = rr * 64 + cc * 2; return st * 1024 + (ob ^ (((ob >> 9) & 1) << 5)); }
DEV void stage_rc(int b, int& R, int& C) { const int st = b / 1024, sb = b % 1024, swz = sb ^ (((sb >> 9) & 1) << 5); R = (st >> 1) * 16 + swz / 64; C = (st & 1) * 32 + (swz % 64) / 2; }
DEV int perm32(int rho) { const int n = rho >> 4, i = rho & 15; return 8 * (i >> 2) + 4 * n + (i & 3); }

struct Job { const bf16_t* A; const bf16_t* B; void* out; const void* aux; int nM, nN, ldc, kind; };
struct Unit { const char* A; const char* B; int jid, pm, pn; };
constexpr int JT_OFF = 131072;
DEV int rfl(int v) { return __builtin_amdgcn_readfirstlane(v); }
DEV const char* rflp(const LAS int* p) { const unsigned lo = (unsigned)rfl(p[0]), hi = (unsigned)rfl(p[1]); return asglobal((const char*)(((unsigned long long)hi << 32) | lo)); }
DEV void job_put(LAS unsigned char* lds, int q, const void* A, const void* B, void* out, const void* aux, int nM, int nN, int ldc, int kind) {
    LAS int* jt = (LAS int*)(lds + JT_OFF) + q * 12;
    const unsigned long long a = (unsigned long long)A, b = (unsigned long long)B, o = (unsigned long long)out, x = (unsigned long long)aux;
    jt[0] = (int)(unsigned)a; jt[1] = (int)(unsigned)(a >> 32); jt[2] = (int)(unsigned)b; jt[3] = (int)(unsigned)(b >> 32);
    jt[4] = (int)(unsigned)o; jt[5] = (int)(unsigned)(o >> 32); jt[6] = (int)(unsigned)x; jt[7] = (int)(unsigned)(x >> 32);
    jt[8] = nM; jt[9] = nN; jt[10] = ldc; jt[11] = kind;
}
struct Sched {
    LAS unsigned char* lds; int nj, total, G, c; size_t tstep;
    DEV void init(LAS unsigned char* lds_, int nj_, int G_, int c_, int K, int tid_) {
        lds = lds_; nj = nj_; G = G_; c = c_; tstep = (size_t)BM * K * 2;
        __syncthreads();
        LAS int* jt = (LAS int*)(lds + JT_OFF);
        if (tid_ == 0) { int s = 0; for (int q = 0; q < nj; ++q) { jt[48 + q] = s; s += jt[q * 12 + 8] * jt[q * 12 + 9]; } for (int q = nj; q < 5; ++q) jt[48 + q] = s; }
        __syncthreads();
        total = rfl(jt[48 + 4]);
    }
    DEV bool next(int i, Unit& u) const {
        const int L = i * G + c; if (L >= total) return false;
        const LAS int* jt = (const LAS int*)(lds + JT_OFF);
        int jid = 0;
        for (int q = 1; q < nj; ++q) if (L >= rfl(jt[48 + q])) jid = q;
        const LAS int* J = jt + jid * 12;
        const int base = rfl(jt[48 + jid]), nM = rfl(J[8]), nN = rfl(J[9]);
        int wgid = L - base; const int nwg = nM * nN;
        { const int q = nwg / NXCD, r = nwg % NXCD, xcd = wgid % NXCD, off = wgid / NXCD; wgid = (xcd < r ? xcd * (q + 1) : r * (q + 1) + (xcd - r) * q) + off; }
        const int nig = WGM * nN, gid = wgid / nig, fm = gid * WGM, gsz = (nM - fm) < WGM ? (nM - fm) : WGM;
        u.pm = fm + ((wgid % nig) % gsz); u.pn = (wgid % nig) / gsz; u.jid = jid;
        u.A = rflp(J) + (size_t)u.pm * tstep; u.B = rflp(J + 2) + (size_t)u.pn * tstep;
        return true;
    }
};

DEV void st16_wt(GAS u32x4* p, u32x4 v) { asm volatile("global_store_dwordx4 %0, %1, off sc1" :: "v"(p), "v"(v) : "memory"); }
DEV void st16f_wt(GAS f32x4* p, f32x4 v) { asm volatile("global_store_dwordx4 %0, %1, off sc1" :: "v"(p), "v"(v) : "memory"); }
DEV unsigned cvt_pk_bf16(float lo, float hi) { return pk2(lo, hi); }

template <int KIND> DEV void epi_loop(const f32x4 (&acc)[2][2][4][2], const Job& J, const Unit& u, int wr, int wc, int fr, int fq) {
    const int row0 = u.pm * BM + wr * 64 + fr, col0 = u.pn * BM + wc * 32 + 8 * fq;
    GAS bf16_t* const outb = (GAS bf16_t*)J.out; GAS float* const outf = (GAS float*)J.out;
    const GAS float* const auxf = (const GAS float*)J.aux; GAS bf16_t* const auxb = (GAS bf16_t*)const_cast<void*>(J.aux);
#pragma unroll
    for (int ai = 0; ai < 2; ++ai)
#pragma unroll
        for (int m = 0; m < 4; ++m) {
            const size_t row = (size_t)(row0 + ai * HALF + m * 16);
#pragma unroll
            for (int bj = 0; bj < 2; ++bj) {
                const int col = col0 + bj * HALF;
                f32x4 v0 = acc[ai][bj][m][0], v1 = acc[ai][bj][m][1];
                if (KIND <= 3) {
                    if (KIND == 1) {
#pragma unroll
                        for (int e = 0; e < 4; ++e) { v0[e] = sigmoidf_(v0[e]); v1[e] = sigmoidf_(v1[e]); } }
                    if (KIND == 2) {
#pragma unroll
                        for (int e = 0; e < 4; ++e) { v0[e] = siluf_(v0[e]); v1[e] = siluf_(v1[e]); } }
                    if (KIND == 3) {
#pragma unroll
                        for (int e = 0; e < 4; ++e) { float a = fmaxf(v0[e], 0.f), b = fmaxf(v1[e], 0.f); v0[e] = a * a; v1[e] = b * b; } }
                    u32x4 w; w.x = cvt_pk_bf16(v0[0], v0[1]); w.y = cvt_pk_bf16(v0[2], v0[3]); w.z = cvt_pk_bf16(v1[0], v1[1]); w.w = cvt_pk_bf16(v1[2], v1[3]);
                    *(GAS u32x4*)(outb + row * J.ldc + col) = w;
                } else if (KIND == 7) {
                    const GAS float* xin = auxf + row * DM + col; GAS float* xo = outf + row * DM + col;
                    const f32x4 a = *(const GAS f32x4*)xin, b = *(const GAS f32x4*)(xin + 4);
                    const float sc = (J.ldc == 0) ? 0.f : 1.f; *(GAS f32x4*)xo = a + v0 * sc; *(GAS f32x4*)(xo + 4) = b + v1 * sc;
                } else if (KIND == 4) {
                    const u32x4 gw = *(const GAS u32x4*)(auxb + row * DM + col); float g[8]; unpack8(gw, g);
                    f32x4 r0, r1;
#pragma unroll
                    for (int e = 0; e < 4; ++e) { r0[e] = g[e] * v0[e] * SCALE_A; r1[e] = g[4 + e] * v1[e] * SCALE_A; }
                    GAS float* mo = outf + row * DM + col; *(GAS f32x4*)mo = r0; *(GAS f32x4*)(mo + 4) = r1;
                } else if (KIND == 5) {
                    const u32x4 gw = *(const GAS u32x4*)(auxb + row * DM + col); float g[8]; unpack8(gw, g);
                    const GAS float* mo = outf + row * DM + col; const f32x4 m0 = *(const GAS f32x4*)mo, m1 = *(const GAS f32x4*)(mo + 4);
#pragma unroll
                    for (int e = 0; e < 8; ++e) g[e] *= SCALE_B;
                    u32x4 w; w.x = cvt_pk_bf16(m0[0] + g[0] * v0[0], m0[1] + g[1] * v0[1]); w.y = cvt_pk_bf16(m0[2] + g[2] * v0[2], m0[3] + g[3] * v0[3]);
                    w.z = cvt_pk_bf16(m1[0] + g[4] * v1[0], m1[1] + g[5] * v1[1]); w.w = cvt_pk_bf16(m1[2] + g[6] * v1[2], m1[3] + g[7] * v1[3]);
                    *(GAS u32x4*)((GAS bf16_t*)(outf + (size_t)J.ldc) + row * DM + col) = w;
                } else {
                    GAS bf16_t* gp = auxb + row * DM + col;
                    const u32x4 gw = *(const GAS u32x4*)gp, aw = *(const GAS u32x4*)(outb + row * DM + col);
                    float g[8], a[8]; unpack8(gw, g); unpack8(aw, a);
#pragma unroll
                    for (int e = 0; e < 8; ++e) g[e] *= SCALE_C;
                    u32x4 w; w.x = cvt_pk_bf16(a[0] + g[0] * v0[0], a[1] + g[1] * v0[1]); w.y = cvt_pk_bf16(a[2] + g[2] * v0[2], a[3] + g[3] * v0[3]);
                    w.z = cvt_pk_bf16(a[4] + g[4] * v1[0], a[5] + g[5] * v1[1]); w.w = cvt_pk_bf16(a[6] + g[6] * v1[2], a[7] + g[7] * v1[3]);
                    *(GAS u32x4*)gp = w;
                }
            }
        }
}

template <int MASK> DEV void run_epi(const Sched& S, const Unit& u, const f32x4 (&acc)[2][2][4][2], int wr, int wc, int fr, int fq) {
    const LAS int* Jp = (const LAS int*)(S.lds + JT_OFF) + u.jid * 12;
    Job J; J.A = nullptr; J.B = nullptr; J.out = (void*)rflp(Jp + 4); J.aux = (const void*)rflp(Jp + 6); J.nM = 0; J.nN = 0; J.ldc = rfl(Jp[10]); J.kind = rfl(Jp[11]);
    const int k = J.kind;
    if ((MASK & 1) && k == 0) epi_loop<0>(acc, J, u, wr, wc, fr, fq);
    else if ((MASK & 2) && k == 1) epi_loop<1>(acc, J, u, wr, wc, fr, fq);
    else if ((MASK & 4) && k == 2) epi_loop<2>(acc, J, u, wr, wc, fr, fq);
    else if ((MASK & 8) && k == 3) epi_loop<3>(acc, J, u, wr, wc, fr, fq);
    else if ((MASK & 16) && k == 4) epi_loop<4>(acc, J, u, wr, wc, fr, fq);
    else if ((MASK & 32) && k == 5) epi_loop<5>(acc, J, u, wr, wc, fr, fq);
    else if ((MASK & 64) && k == 6) epi_loop<6>(acc, J, u, wr, wc, fr, fq);
    else if ((MASK & 128) && k == 7) epi_loop<7>(acc, J, u, wr, wc, fr, fq);
}

template <int MASK>
DEV void gemm_phase(LAS unsigned char* lds, const int K, const Sched& S, const int tid) {
    const int wid = __builtin_amdgcn_readfirstlane(tid >> 6), lane = tid & 63, wr = wid >> 2, wc = wid & 3, fr = lane & 15, fq = lane >> 4;
    const int nt = K / BK;
    unsigned voffA[2], voffB[2];
#pragma unroll
    for (int i = 0; i < 2; ++i) { int R, C; stage_rc(tid * 16 + i * 8192, R, C); const int Rb = (R & ~31) + perm32(R & 31);
        voffA[i] = (unsigned)(R * K + C) * 2u; voffB[i] = (unsigned)(Rb * K + C) * 2u; }
    const size_t kstep = (size_t)(BK * 2);
    const size_t hstep = (size_t)HALF * K * 2;
    const unsigned ldsw = (unsigned)wid * 1024u;
    const int aoff = lds_byte(wr * 64 + fr, fq * 8), boff = lds_byte(wc * 32 + fr, fq * 8);
#define PG8_SA(b, h) (((b) * 2 + (h)) * HTB)
#define PG8_SB(b, h) ((4 + (b) * 2 + (h)) * HTB)
#define PG8_STAGE(bufoff, gbase, voff) do { _Pragma("unroll") for (int _i = 0; _i < 2; ++_i) \
        __builtin_amdgcn_global_load_lds((const unsigned*)((const char*)(gbase) + (voff)[_i]), (LAS unsigned*)(lds + (bufoff) + ldsw + _i * 8192), 16, 0, 0); } while (0)
#define PG8_LDA(dst, b, h) do { _Pragma("unroll") for (int m = 0; m < 4; ++m) _Pragma("unroll") for (int k = 0; k < 2; ++k) dst[m][k] = *(const LAS bf16x8*)(lds + PG8_SA(b, h) + aoff + m * 2048 + k * 1024); } while (0)
#define PG8_LDB(dst, b, h) do { _Pragma("unroll") for (int n = 0; n < 2; ++n) _Pragma("unroll") for (int k = 0; k < 2; ++k) dst[n][k] = *(const LAS bf16x8*)(lds + PG8_SB(b, h) + boff + n * 2048 + k * 1024); } while (0)
#define PG8_MMA(ai, bj, At, Bt) do { __builtin_amdgcn_s_setprio(1); _Pragma("unroll") for (int m = 0; m < 4; ++m) _Pragma("unroll") for (int n = 0; n < 2; ++n) _Pragma("unroll") for (int k = 0; k < 2; ++k) \
        acc[ai][bj][m][n] = __builtin_amdgcn_mfma_f32_16x16x32_bf16(Bt[n][k], At[m][k], acc[ai][bj][m][n], 0, 0, 0); __builtin_amdgcn_s_setprio(0); } while (0)
#define PG8_WAIT_V(n) asm volatile("s_waitcnt vmcnt(" #n ")" ::: "memory")
#define PG8_WAIT_L(n) asm volatile("s_waitcnt lgkmcnt(" #n ")" ::: "memory")
#define PG8_BAR __builtin_amdgcn_s_barrier()
#define PG8_SCHED __builtin_amdgcn_sched_barrier(0)
    Unit cur, nxt; int ui = 0;
    if (!S.next(0, cur)) return;
    f32x4 acc[2][2][4][2];
#pragma unroll
    for (int a = 0; a < 2; ++a)
#pragma unroll
        for (int b = 0; b < 2; ++b)
#pragma unroll
            for (int m = 0; m < 4; ++m)
#pragma unroll
                for (int n = 0; n < 2; ++n) acc[a][b][m][n] = (f32x4){0.f, 0.f, 0.f, 0.f};
    bf16x8 At[4][2], B0[2][2], B1[2][2];
    const char* cA = cur.A; const char* cB = cur.B;
    PG8_STAGE(PG8_SB(0, 0), cB, voffB); PG8_STAGE(PG8_SA(0, 0), cA, voffA); PG8_STAGE(PG8_SB(0, 1), cB + hstep, voffB); PG8_STAGE(PG8_SA(0, 1), cA + hstep, voffA);
    if (wr == 1) PG8_BAR;
    PG8_WAIT_V(4); PG8_BAR;
    PG8_STAGE(PG8_SB(1, 0), cB + kstep, voffB); PG8_STAGE(PG8_SA(1, 0), cA + kstep, voffA); PG8_STAGE(PG8_SB(1, 1), cB + hstep + kstep, voffB);
    PG8_WAIT_V(6); PG8_BAR;
    for (;;) {
        const bool has_next = S.next(ui + 1, nxt);
        const char* nA = has_next ? nxt.A : cA; const char* nB = has_next ? nxt.B : cB;
        for (int t = 0; t < nt; t += 2) {
            const bool last = (t == nt - 2);
            const char* a1 = cA + (size_t)(t + 1) * kstep;
            const char* a2 = last ? nA : cA + (size_t)(t + 2) * kstep; const char* b2 = last ? nB : cB + (size_t)(t + 2) * kstep;
            const char* a3 = a2 + kstep; const char* b3 = b2 + kstep;
            PG8_LDB(B0, 0, 0); PG8_SCHED; PG8_LDA(At, 0, 0); PG8_STAGE(PG8_SA(1, 1), a1 + hstep, voffA);
            PG8_WAIT_L(8); PG8_BAR; PG8_WAIT_L(0); PG8_MMA(0, 0, At, B0); PG8_BAR; PG8_SCHED;
            PG8_LDB(B1, 0, 1); PG8_STAGE(PG8_SB(0, 0), b2, voffB);
            PG8_BAR; PG8_WAIT_L(0); PG8_MMA(0, 1, At, B1); PG8_BAR;
            PG8_LDA(At, 0, 1); PG8_STAGE(PG8_SA(0, 0), a2, voffA);
            PG8_BAR; PG8_WAIT_L(0); PG8_MMA(1, 0, At, B0); PG8_BAR; PG8_SCHED;
            PG8_STAGE(PG8_SB(0, 1), b2 + hstep, voffB);
            PG8_WAIT_V(6); PG8_BAR; PG8_MMA(1, 1, At, B1); PG8_BAR;
            PG8_LDB(B0, 1, 0); PG8_SCHED; PG8_LDA(At, 1, 0); PG8_STAGE(PG8_SA(0, 1), a2 + hstep, voffA);
            PG8_WAIT_L(8); PG8_BAR; PG8_WAIT_L(0); PG8_MMA(0, 0, At, B0); PG8_BAR; PG8_SCHED;
            PG8_LDB(B1, 1, 1); PG8_STAGE(PG8_SB(1, 0), b3, voffB);
            PG8_BAR; PG8_WAIT_L(0); PG8_MMA(0, 1, At, B1); PG8_BAR;
            PG8_LDA(At, 1, 1); PG8_STAGE(PG8_SA(1, 0), a3, voffA);
            PG8_BAR; PG8_WAIT_L(0); PG8_MMA(1, 0, At, B0); PG8_BAR; PG8_SCHED;
            PG8_STAGE(PG8_SB(1, 1), b3 + hstep, voffB);
            PG8_WAIT_V(6); PG8_BAR; PG8_MMA(1, 1, At, B1); PG8_BAR;
        }
        run_epi<MASK>(S, cur, acc, wr, wc, fr, fq);
        if (!has_next) break;
#pragma unroll
        for (int a = 0; a < 2; ++a)
#pragma unroll
            for (int b = 0; b < 2; ++b)
#pragma unroll
                for (int m = 0; m < 4; ++m)
#pragma unroll
                    for (int n = 0; n < 2; ++n) acc[a][b][m][n] = (f32x4){0.f, 0.f, 0.f, 0.f};
        cur = nxt; cA = nA; cB = nB; ++ui;
    }
    PG8_WAIT_V(0);
    if (wr == 0) PG8_BAR;
    PG8_BAR;
#undef PG8_SA
#undef PG8_SB
#undef PG8_STAGE
#undef PG8_LDA
#undef PG8_LDB
#undef PG8_MMA
#undef PG8_WAIT_V
#undef PG8_WAIT_L
#undef PG8_BAR
#undef PG8_SCHED
}

template <int MASK>
DEV void gemm_simple(LAS unsigned char* lds, const int K, const Sched& S, const int tid) {
    const int wid = __builtin_amdgcn_readfirstlane(tid >> 6), lane = tid & 63, wr = wid >> 2, wc = wid & 3, fr = lane & 15, fq = lane >> 4;
    const int nt = K / BK;
    unsigned voffA[2], voffB[2];
#pragma unroll
    for (int i = 0; i < 2; ++i) { int R, C; stage_rc(tid * 16 + i * 8192, R, C); const int Rb = (R & ~31) + perm32(R & 31);
        voffA[i] = (unsigned)(R * K + C) * 2u; voffB[i] = (unsigned)(Rb * K + C) * 2u; }
    const size_t kstep = (size_t)(BK * 2), hstep = (size_t)HALF * K * 2;
    const unsigned ldsl = (unsigned)wid * 1024u + (unsigned)lane * 16u;
    const int aoff = lds_byte(wr * 64 + fr, fq * 8), boff = lds_byte(wc * 32 + fr, fq * 8);
#define GS_SA(b, h) (((b) * 2 + (h)) * HTB)
#define GS_SB(b, h) ((4 + (b) * 2 + (h)) * HTB)
#define GS_LOAD(dst, pa, pb) do { _Pragma("unroll") for (int _i = 0; _i < 2; ++_i) { \
        dst[0][_i] = *(const GAS u32x4*)((const GAS char*)(pa) + voffA[_i]); dst[1][_i] = *(const GAS u32x4*)((const GAS char*)(pa) + hstep + voffA[_i]); \
        dst[2][_i] = *(const GAS u32x4*)((const GAS char*)(pb) + voffB[_i]); dst[3][_i] = *(const GAS u32x4*)((const GAS char*)(pb) + hstep + voffB[_i]); } } while (0)
#define GS_WRITE(b, src) do { _Pragma("unroll") for (int _i = 0; _i < 2; ++_i) { \
        *(LAS u32x4*)(lds + GS_SA(b, 0) + ldsl + _i * 8192) = src[0][_i]; *(LAS u32x4*)(lds + GS_SA(b, 1) + ldsl + _i * 8192) = src[1][_i]; \
        *(LAS u32x4*)(lds + GS_SB(b, 0) + ldsl + _i * 8192) = src[2][_i]; *(LAS u32x4*)(lds + GS_SB(b, 1) + ldsl + _i * 8192) = src[3][_i]; } } while (0)
    Unit cur; int ui = 0;
    while (S.next(ui, cur)) {
        f32x4 acc[2][2][4][2];
#pragma unroll
        for (int a = 0; a < 2; ++a)
#pragma unroll
            for (int b = 0; b < 2; ++b)
#pragma unroll
                for (int m = 0; m < 4; ++m)
#pragma unroll
                    for (int n = 0; n < 2; ++n) acc[a][b][m][n] = (f32x4){0.f, 0.f, 0.f, 0.f};
        const char* cA = cur.A; const char* cB = cur.B;
        u32x4 st[4][2];
        GS_LOAD(st, cA, cB);
        GS_WRITE(0, st);
        __syncthreads();
        for (int t = 0; t < nt; ++t) {
            const int b = t & 1;
            if (t + 1 < nt) GS_LOAD(st, cA + (size_t)(t + 1) * kstep, cB + (size_t)(t + 1) * kstep);
#pragma unroll
            for (int ai = 0; ai < 2; ++ai) {
                bf16x8 At[4][2];
#pragma unroll
                for (int m = 0; m < 4; ++m)
#pragma unroll
                    for (int k = 0; k < 2; ++k) At[m][k] = *(const LAS bf16x8*)(lds + (b ? GS_SA(1, 0) : GS_SA(0, 0)) + ai * HTB + aoff + m * 2048 + k * 1024);
#pragma unroll
                for (int bj = 0; bj < 2; ++bj) {
                    bf16x8 Bt[2][2];
#pragma unroll
                    for (int n = 0; n < 2; ++n)
#pragma unroll
                        for (int k = 0; k < 2; ++k) Bt[n][k] = *(const LAS bf16x8*)(lds + (b ? GS_SB(1, 0) : GS_SB(0, 0)) + bj * HTB + boff + n * 2048 + k * 1024);
#pragma unroll
                    for (int m = 0; m < 4; ++m)
#pragma unroll
                        for (int n = 0; n < 2; ++n)
#pragma unroll
                            for (int k = 0; k < 2; ++k) acc[ai][bj][m][n] = __builtin_amdgcn_mfma_f32_16x16x32_bf16(Bt[n][k], At[m][k], acc[ai][bj][m][n], 0, 0, 0);
                }
            }
            if (t + 1 < nt) { if (b) GS_WRITE(0, st); else GS_WRITE(1, st); }
            __syncthreads();
        }
        run_epi<MASK>(S, cur, acc, wr, wc, fr, fq);
        ++ui;
    }
    __syncthreads();
#undef GS_SA
#undef GS_SB
#undef GS_LOAD
#undef GS_WRITE
}
}

DEV void transpose_item(const float* W, int K, int N, bf16_t* WT, LAS float* scr, int item, int lane) {
    const int nblk = N / 32, kb = item / nblk, nb = item % nblk, k0 = 64 * kb, n0 = 32 * nb;
#pragma unroll 8
    for (int i = 0; i < 32; ++i) { const int kk = 2 * i + (lane >> 5); scr[kk * 33 + (lane & 31)] = W[(size_t)(k0 + kk) * N + n0 + (lane & 31)]; }
    LDS_WAIT();
    const int c = lane & 7;
#pragma unroll
    for (int jj = 0; jj < 4; ++jj) { const int n = (lane >> 3) + 8 * jj; const LAS float* s = scr + (8 * c) * 33 + n;
        u32x4 o; o.x = pk2(s[0 * 33], s[1 * 33]); o.y = pk2(s[2 * 33], s[3 * 33]); o.z = pk2(s[4 * 33], s[5 * 33]); o.w = pk2(s[6 * 33], s[7 * 33]);
        *(u32x4*)(WT + (size_t)(n0 + n) * K + k0 + 8 * c) = o; }
    LDS_WAIT();
}

DEV void phase_weights(unsigned char* ws, const float* w_in, const float* w_oa, const float* w_os, const float* w_og, const float* w_o, const float* w_up, const float* w_dn, LAS unsigned char* lds, int gw, int NGW, int wave, int lane) {
    LAS float* scr = (LAS float*)(lds + wave * 8704);
    constexpr int I_IN = 16 * (INW / 32), I_SQ = 16 * 32, I_UP = 16 * 128, I_DN = 64 * 32;
    constexpr int NIT = I_IN + 4 * I_SQ + I_UP + I_DN;
    for (int it = gw; it < NIT; it += NGW) {
        int r = it;
        if (r < I_IN) { transpose_item(w_in, 1024, INW, (bf16_t*)(ws + WS_WIN), scr, r, lane); continue; } r -= I_IN;
        if (r < I_SQ) { transpose_item(w_oa, 1024, 1024, (bf16_t*)(ws + WS_WOA), scr, r, lane); continue; } r -= I_SQ;
        if (r < I_SQ) { transpose_item(w_os, 1024, 1024, (bf16_t*)(ws + WS_WOS), scr, r, lane); continue; } r -= I_SQ;
        if (r < I_SQ) { transpose_item(w_og, 1024, 1024, (bf16_t*)(ws + WS_WOG), scr, r, lane); continue; } r -= I_SQ;
        if (r < I_SQ) { transpose_item(w_o, 1024, 1024, (bf16_t*)(ws + WS_WO), scr, r, lane); continue; } r -= I_SQ;
        if (r < I_UP) { transpose_item(w_up, 1024, 4096, (bf16_t*)(ws + WS_WUP), scr, r, lane); continue; } r -= I_UP;
        transpose_item(w_dn, 4096, 1024, (bf16_t*)(ws + WS_WDN), scr, r, lane);
    }
}

DEV void phase_rmsnorm_bf16(const float* x, const float* w, bf16_t* o, int nrows, int gw, int NGW, int lane) {
    for (int m = gw; m < nrows; m += NGW) {
        const f32x4* xr = (const f32x4*)(x + (size_t)m * DM) + lane;
        f32x4 v[4]; float s = 0.f;
#pragma unroll
        for (int j = 0; j < 4; ++j) { v[j] = xr[64 * j]; s += (v[j].x * v[j].x + v[j].y * v[j].y) + (v[j].z * v[j].z + v[j].w * v[j].w); }
        const float rstd = rsqrtf(wave_sum(s) * (1.f / DM) + EPS);
        u32x2* o8 = (u32x2*)(o + (size_t)m * DM) + lane;
#pragma unroll
        for (int j = 0; j < 4; ++j) { const f32x4 ww = ((const f32x4*)w)[lane + 64 * j]; u32x2 r; r.x = pk2(v[j].x * rstd * ww.x, v[j].y * rstd * ww.y); r.y = pk2(v[j].z * rstd * ww.z, v[j].w * rstd * ww.w); o8[64 * j] = r; }
    }
}
DEV void phase_rmsnorm_f32(float* x, const float* w, int nrows, int gw, int NGW, int lane) {
    for (int m = gw; m < nrows; m += NGW) {
        f32x4* xr = (f32x4*)(x + (size_t)m * DM) + lane;
        f32x4 v[4]; float s = 0.f;
#pragma unroll
        for (int j = 0; j < 4; ++j) { v[j] = xr[64 * j]; s += (v[j].x * v[j].x + v[j].y * v[j].y) + (v[j].z * v[j].z + v[j].w * v[j].w); }
        const float rstd = rsqrtf(wave_sum(s) * (1.f / DM) + EPS);
#pragma unroll
        for (int j = 0; j < 4; ++j) { const f32x4 ww = ((const f32x4*)w)[lane + 64 * j]; xr[64 * j] = v[j] * rstd * ww; }
    }
}

DEV void phase_narrow(const bf16_t* HB, const bf16_t* Wdt, const bf16_t* Wgk, float* DTGK, int gw, int NGW, int lane) {
    const int fr = lane & 15, fq = lane >> 4;
    for (int u = gw; u < HT / 16; u += NGW) {
        const int t0 = u * 16;
        f32x4 a0 = {0.f, 0.f, 0.f, 0.f}, a1 = {0.f, 0.f, 0.f, 0.f};
        const bf16_t* ap = HB + (size_t)(t0 + fr) * DM + fq * 8;
        const bf16_t* b0p = Wdt + (size_t)fr * DM + fq * 8;
        const bf16_t* b1p = Wgk + (size_t)fr * DM + fq * 8;
#pragma unroll 4
        for (int k = 0; k < DM; k += 32) {
            const bf16x8 a = *(const bf16x8*)(ap + k), b0 = *(const bf16x8*)(b0p + k), b1 = *(const bf16x8*)(b1p + k);
            a0 = mma(a, b0, a0); a1 = mma(a, b1, a1);
        }
#pragma unroll
        for (int j = 0; j < 4; ++j) { float* d = DTGK + (size_t)(t0 + 4 * fq + j) * 32; d[fr] = a0[j]; d[16 + fr] = a1[j]; }
    }
}

DEV void phase_conv_a(const bf16_t* UA, const float* cw, bf16_t* YIN, int gtid, int NT) {
    for (int u = gtid; u < (HT / 16) * 128; u += NT) {
        const int c0 = (u & 127) * 8, t0 = (u >> 7) * 16;
        float w0[8], w1[8], w2[8], p1[8], p2[8];
#pragma unroll
        for (int j = 0; j < 8; ++j) { w0[j] = cw[c0 + j]; w1[j] = cw[1024 + c0 + j]; w2[j] = cw[2048 + c0 + j]; p1[j] = 0.f; p2[j] = 0.f; }
        if ((t0 & (SEQ - 1)) != 0) {
            float ax[8], ac[8];
            unpack8(*(const u32x4*)(UA + (size_t)(t0 - 2) * 3072 + c0), ax); unpack8(*(const u32x4*)(UA + (size_t)(t0 - 2) * 3072 + 2048 + c0), ac);
#pragma unroll
            for (int j = 0; j < 8; ++j) p2[j] = ax[j] * ac[j];
            unpack8(*(const u32x4*)(UA + (size_t)(t0 - 1) * 3072 + c0), ax); unpack8(*(const u32x4*)(UA + (size_t)(t0 - 1) * 3072 + 2048 + c0), ac);
#pragma unroll
            for (int j = 0; j < 8; ++j) p1[j] = ax[j] * ac[j];
        }
#pragma unroll 4
        for (int i = 0; i < 16; ++i) {
            const bf16_t* rp = UA + (size_t)(t0 + i) * 3072 + c0;
            float ax[8], ab[8], ac[8], o[8];
            unpack8(*(const u32x4*)rp, ax); unpack8(*(const u32x4*)(rp + 1024), ab); unpack8(*(const u32x4*)(rp + 2048), ac);
#pragma unroll
            for (int j = 0; j < 8; ++j) { const float p0 = ax[j] * ac[j]; o[j] = ab[j] * (w0[j] * p2[j] + w1[j] * p1[j] + w2[j] * p0); p2[j] = p1[j]; p1[j] = p0; }
            *(u32x4*)(YIN + (size_t)(t0 + i) * DM + c0) = pack8(o);
        }
    }
}

DEV void phase_ssd_prep(unsigned char* ws, const float* cw, const float* cb, const float* dtb, const float* alog, int gtid, int NT, int tid, int nblk, int blk) {
    const bf16_t* XST = (const bf16_t*)(ws + RB_XST); bf16_t* XSTC = (bf16_t*)(ws + RB_XSTC);
    for (int u = gtid; u < 1024 * (HT / 8); u += NT) {
        const int tb = u & (HT / 8 - 1), c = u >> 11, t0 = tb * 8;
        float x[11], cur[8];
        unpack8(*(const u32x4*)(XST + (size_t)c * HT + t0), cur);
        if ((t0 & (SEQ - 1)) != 0) { float pv[8]; unpack8(*(const u32x4*)(XST + (size_t)c * HT + t0 - 8), pv); x[0] = pv[5]; x[1] = pv[6]; x[2] = pv[7]; }
        else { x[0] = 0.f; x[1] = 0.f; x[2] = 0.f; }
#pragma unroll
        for (int i = 0; i < 8; ++i) x[3 + i] = cur[i];
        const float w0 = cw[c], w1 = cw[2048 + c], w2 = cw[4096 + c], w3 = cw[6144 + c], b = cb[c];
        float y[8];
#pragma unroll
        for (int i = 0; i < 8; ++i) y[i] = siluf_(b + w0 * x[i] + w1 * x[i + 1] + w2 * x[i + 2] + w3 * x[i + 3]);
        *(u32x4*)(XSTC + (size_t)c * HT + t0) = pack8(y);
    }
    const bf16_t* BC = (const bf16_t*)(ws + RB_BC); bf16_t* BCC = (bf16_t*)(ws + RB_BCC); bf16_t* BTC = (bf16_t*)(ws + RB_BTC);
    for (int u = gtid; u < (HT / 8) * 128; u += NT) {
        const int cg8 = u & 127, c0 = cg8 * 8, t0 = (u >> 7) * 8, cc = 1024 + c0;
        float w0[8], w1[8], w2[8], w3[8], bb[8], x1[8], x2[8], x3[8];
#pragma unroll
        for (int j = 0; j < 8; ++j) { w0[j] = cw[cc + j]; w1[j] = cw[2048 + cc + j]; w2[j] = cw[4096 + cc + j]; w3[j] = cw[6144 + cc + j]; bb[j] = cb[cc + j]; x1[j] = 0.f; x2[j] = 0.f; x3[j] = 0.f; }
        if ((t0 & (SEQ - 1)) != 0) {
            unpack8(*(const u32x4*)(BC + (size_t)(t0 - 1) * DM + c0), x1); unpack8(*(const u32x4*)(BC + (size_t)(t0 - 2) * DM + c0), x2); unpack8(*(const u32x4*)(BC + (size_t)(t0 - 3) * DM + c0), x3);
        }
        unsigned tr[8][4];
#pragma unroll
        for (int i = 0; i < 8; ++i) {
            float x0[8], y[8];
            unpack8(*(const u32x4*)(BC + (size_t)(t0 + i) * DM + c0), x0);
#pragma unroll
            for (int j = 0; j < 8; ++j) { y[j] = siluf_(bb[j] + w3[j] * x0[j] + w2[j] * x1[j] + w1[j] * x2[j] + w0[j] * x3[j]); x3[j] = x2[j]; x2[j] = x1[j]; x1[j] = x0[j]; }
            *(u32x4*)(BCC + (size_t)(t0 + i) * DM + c0) = pack8(y);
#pragma unroll
            for (int j = 0; j < 8; ++j) { if (i & 1) tr[j][i >> 1] |= f2bf(y[j]) << 16; else tr[j][i >> 1] = f2bf(y[j]); }
        }
        if (cg8 < 64) {
#pragma unroll
            for (int j = 0; j < 8; ++j) *(u32x4*)(BTC + (size_t)(c0 + j) * HT + t0) = (u32x4){tr[j][0], tr[j][1], tr[j][2], tr[j][3]};
        }
    }
    const float* DTGK = (const float*)(ws + WS_DTGK); float* DT = (float*)(ws + RB_DT); float* AC = (float*)(ws + RB_ACUM);
    {
        const int idx = tid * nblk + blk;
        for (int e = idx; e < (HT / 128) * 16; e += NT) {
            const int h = e & 15, ch = e >> 4; const float a = -__expf(alog[h]), bias = dtb[h]; float acc = 0.f;
            for (int i = 0; i < 128; ++i) { const size_t t = (size_t)ch * 128 + i; const float d = softplusf_(DTGK[t * 32 + h] + bias); acc += d * a; DT[t * 16 + h] = d; AC[t * 16 + h] = acc; }
        }
    }
}

DEV void phase_ssd_states(unsigned char* ws, LAS unsigned char* lds, int tid, int wave, int lane) {
    const bf16_t* XSTC = (const bf16_t*)(ws + RB_XSTC); const bf16_t* BTC = (const bf16_t*)(ws + RB_BTC);
    const float* DT = (const float*)(ws + RB_DT); const float* AC = (const float*)(ws + RB_ACUM); float* ST = (float*)(ws + RB_ST);
    constexpr int BT_OFF = 0, XW_OFF = 34816, TAB_OFF = 34816 + 69632, RS = 272;
    LAS float* wt = (LAS float*)(lds + TAB_OFF);
    const int fr = lane & 15, fq = lane >> 4;
    for (int unit = blockIdx.x; unit < (HT / 128) * 4; unit += gridDim.x) {
        const int cidx = unit >> 2, g = unit & 3, t0 = cidx * 128;
        { const int r = tid >> 7, l = tid & 127, h = g * 4 + r;
          const float al = AC[(size_t)(t0 + 127) * 16 + h], a = AC[(size_t)(t0 + l) * 16 + h];
          wt[r * 128 + l] = DT[(size_t)(t0 + l) * 16 + h] * __expf(al - a); }
        for (int i = tid; i < 2048; i += NTHR) { const int row = i >> 4, ch = i & 15;
            *(LAS u32x4*)(lds + BT_OFF + row * RS + ch * 16) = *(const u32x4*)(BTC + (size_t)(g * 128 + row) * HT + t0 + ch * 8); }
        __syncthreads();
        for (int i = tid; i < 4096; i += NTHR) { const int row = i >> 4, ch = i & 15; float f[8];
            unpack8(*(const u32x4*)(XSTC + (size_t)(g * 256 + row) * HT + t0 + ch * 8), f);
            const LAS float* wp = wt + (row >> 6) * 128 + ch * 8;
#pragma unroll
            for (int e = 0; e < 8; ++e) f[e] *= wp[e];
            *(LAS u32x4*)(lds + XW_OFF + row * RS + ch * 16) = pack8(f); }
        __syncthreads();
        f32x4 acc[2][8];
#pragma unroll
        for (int a = 0; a < 2; ++a)
#pragma unroll
            for (int b = 0; b < 8; ++b) acc[a][b] = (f32x4){0.f, 0.f, 0.f, 0.f};
#pragma unroll
        for (int ks = 0; ks < 4; ++ks) {
            const bf16x8 y0 = ldsfrag(lds + XW_OFF + (wave * 32 + fr) * RS + ks * 64 + fq * 16), y1 = ldsfrag(lds + XW_OFF + (wave * 32 + 16 + fr) * RS + ks * 64 + fq * 16);
#pragma unroll
            for (int nt = 0; nt < 8; ++nt) { const bf16x8 x = ldsfrag(lds + BT_OFF + (nt * 16 + fr) * RS + ks * 64 + fq * 16); acc[0][nt] = mma(x, y0, acc[0][nt]); acc[1][nt] = mma(x, y1, acc[1][nt]); }
        }
#pragma unroll
        for (int yt = 0; yt < 2; ++yt) { const int pp = wave * 32 + yt * 16 + fr, h = g * 4 + (pp >> 6), p = pp & 63;
            float* d = ST + (((size_t)cidx * 16 + h) * 64 + p) * 128 + 4 * fq;
#pragma unroll
            for (int nt = 0; nt < 8; ++nt) *(f32x4*)(d + nt * 16) = acc[yt][nt]; }
        __syncthreads();
    }
}

DEV void phase_ssd_scan(unsigned char* ws, int gtid, int NT) {
    float* ST = (float*)(ws + RB_ST); const float* AC = (const float*)(ws + RB_ACUM);
    for (int e = gtid; e < 2 * 65536; e += NT) {
        const int bl = e >> 16, rem = e & 65535, h = rem >> 12;
        f32x2 carry = {0.f, 0.f};
        for (int c0 = 0; c0 < 64; c0 += 8) {
            f32x2 v[8]; float dec[8];
#pragma unroll
            for (int i = 0; i < 8; ++i) { const int cidx = bl * 64 + c0 + i; v[i] = *(const f32x2*)(ST + (size_t)cidx * 131072 + rem * 2); dec[i] = __expf(AC[((size_t)cidx * 128 + 127) * 16 + h]); }
#pragma unroll
            for (int i = 0; i < 8; ++i) { const int cidx = bl * 64 + c0 + i; *(f32x2*)(ST + (size_t)cidx * 131072 + rem * 2) = carry; carry = carry * dec[i] + v[i]; }
        }
    }
}

DEV void phase_ssd_out(unsigned char* ws, const float* dsk, const float* nw, LAS unsigned char* lds, int tid, int wave, int lane) {
    const bf16_t* XSTC = (const bf16_t*)(ws + RB_XSTC); const bf16_t* BCC = (const bf16_t*)(ws + RB_BCC); const bf16_t* Z = (const bf16_t*)(ws + RB_Z);
    const float* DT = (const float*)(ws + RB_DT); const float* AC = (const float*)(ws + RB_ACUM); const float* ST = (const float*)(ws + RB_ST);
    bf16_t* YIN = (bf16_t*)(ws + WS_YIN);
    float* YT = (float*)(ws + RB_XST);
    constexpr int C_OFF = 0, B_OFF = 34816, PV_OFF = 34816, XS_OFF = 34816 + 17408, M_OFF = 69632, TAB_OFF = 104448, RS = 272;
    LAS float* tac = (LAS float*)(lds + TAB_OFF); LAS float* tdt = tac + 512;
    const int fr = lane & 15, fq = lane >> 4;
    LAS unsigned char* Mw = lds + M_OFF + wave * 4352;
    for (int unit = blockIdx.x; unit < (HT / 128) * 4; unit += gridDim.x) {
        const int cidx = unit >> 2, g = unit & 3, t0 = cidx * 128;
        for (int i = tid; i < 2048; i += NTHR) { const int row = i >> 4, ch = i & 15;
            *(LAS u32x4*)(lds + C_OFF + row * RS + ch * 16) = *(const u32x4*)(BCC + (size_t)(t0 + row) * DM + 512 + g * 128 + ch * 8);
            *(LAS u32x4*)(lds + B_OFF + row * RS + ch * 16) = *(const u32x4*)(BCC + (size_t)(t0 + row) * DM + g * 128 + ch * 8); }
        { const int r = tid >> 7, l = tid & 127, h = g * 4 + r; tac[tid] = AC[(size_t)(t0 + l) * 16 + h]; tdt[tid] = DT[(size_t)(t0 + l) * 16 + h]; }
        __syncthreads();
        f32x4 cb[8];
#pragma unroll
        for (int st = 0; st < 8; ++st) cb[st] = (f32x4){0.f, 0.f, 0.f, 0.f};
#pragma unroll
        for (int ks = 0; ks < 4; ++ks) {
            const bf16x8 y = ldsfrag(lds + C_OFF + (wave * 16 + fr) * RS + ks * 64 + fq * 16);
#pragma unroll
            for (int st = 0; st < 8; ++st) cb[st] = mma(ldsfrag(lds + B_OFF + (st * 16 + fr) * RS + ks * 64 + fq * 16), y, cb[st]);
        }
        __syncthreads();
        const int l = wave * 16 + fr;
        const size_t t = (size_t)(t0 + l);
        float ssq = 0.f;
#pragma unroll 1
        for (int r = 0; r < 4; ++r) {
            const int h = g * 4 + r;
            for (int i = tid; i < 2048; i += NTHR) { const int row = i >> 5, c4 = i & 31;
                const f32x4 v = *(const f32x4*)(ST + (((size_t)cidx * 16 + h) * 64 + row) * 128 + c4 * 4);
                u32x2 w; w.x = pk2(v.x, v.y); w.y = pk2(v.z, v.w); *(LAS u32x2*)(lds + PV_OFF + row * RS + c4 * 8) = w; }
            for (int i = tid; i < 1024; i += NTHR) { const int row = i >> 4, ch = i & 15;
                *(LAS u32x4*)(lds + XS_OFF + row * RS + ch * 16) = *(const u32x4*)(XSTC + (size_t)(h * 64 + row) * HT + t0 + ch * 8); }
            const float al = tac[r * 128 + l];
#pragma unroll
            for (int st = 0; st < 8; ++st) { float m[4];
#pragma unroll
                for (int j = 0; j < 4; ++j) { const int s = st * 16 + 4 * fq + j; const float d = fminf(al - tac[r * 128 + s], 0.f); m[j] = (s <= l) ? cb[st][j] * __expf(d) * tdt[r * 128 + s] : 0.f; }
                u32x2 w; w.x = pk2(m[0], m[1]); w.y = pk2(m[2], m[3]); *(LAS u32x2*)(Mw + fr * RS + (st * 16 + 4 * fq) * 2) = w; }
            __syncthreads();
            f32x4 acc[4];
#pragma unroll
            for (int pt = 0; pt < 4; ++pt) acc[pt] = (f32x4){0.f, 0.f, 0.f, 0.f};
#pragma unroll
            for (int ks = 0; ks < 4; ++ks) { const bf16x8 y = ldsfrag(lds + C_OFF + l * RS + ks * 64 + fq * 16);
#pragma unroll
                for (int pt = 0; pt < 4; ++pt) acc[pt] = mma(ldsfrag(lds + PV_OFF + (pt * 16 + fr) * RS + ks * 64 + fq * 16), y, acc[pt]); }
            const float el = __expf(al);
#pragma unroll
            for (int pt = 0; pt < 4; ++pt) acc[pt] *= el;
#pragma unroll
            for (int ks = 0; ks < 4; ++ks) { const bf16x8 y = ldsfrag(Mw + fr * RS + ks * 64 + fq * 16);
#pragma unroll
                for (int pt = 0; pt < 4; ++pt) acc[pt] = mma(ldsfrag(lds + XS_OFF + (pt * 16 + fr) * RS + ks * 64 + fq * 16), y, acc[pt]); }
            const float dh = dsk[h];
#pragma unroll
            for (int pt = 0; pt < 4; ++pt) {
#pragma unroll
                for (int j = 0; j < 4; ++j) { const bf16_t xv = *(const LAS bf16_t*)(lds + XS_OFF + (pt * 16 + 4 * fq + j) * RS + l * 2); acc[pt][j] += dh * bf1(xv); }
                const int c = g * 256 + r * 64 + pt * 16 + 4 * fq;
                const u32x2 zw = *(const u32x2*)(Z + t * DM + c);
                f32x4 v = acc[pt]; v[0] *= bf_lo(zw.x); v[1] *= bf_hi(zw.x); v[2] *= bf_lo(zw.y); v[3] *= bf_hi(zw.y);
                ssq += (v[0] * v[0] + v[1] * v[1]) + (v[2] * v[2] + v[3] * v[3]);
                *(f32x4*)(YT + t * DM + c) = v;
            }
            __syncthreads();
        }
        ssq += __shfl_xor(ssq, 16); ssq += __shfl_xor(ssq, 32);
        const float rstd = rsqrtf(ssq * (1.f / 256.f) + EPS);
#pragma unroll 4
        for (int q = 0; q < 16; ++q) { const int c = g * 256 + q * 16 + 4 * fq;
            const f32x4 w4 = *(const f32x4*)(nw + c); const f32x4 v = *(const f32x4*)(YT + t * DM + c);
            u32x2 o; o.x = pk2(v[0] * rstd * w4[0], v[1] * rstd * w4[1]); o.y = pk2(v[2] * rstd * w4[2], v[3] * rstd * w4[3]);
            *(u32x2*)(YIN + t * DM + c) = o; }
        __syncthreads();
    }
}

DEV float gla_gk(const float* DTGK, size_t t, const float (&w)[16], float b) {
    const f32x4* gl = (const f32x4*)(DTGK + t * 32 + 16);
    const f32x4 g0 = gl[0], g1 = gl[1], g2 = gl[2], g3 = gl[3];
    float z = b;
    z += g0[0] * w[0] + g0[1] * w[1] + g0[2] * w[2] + g0[3] * w[3];
    z += g1[0] * w[4] + g1[1] * w[5] + g1[2] * w[6] + g1[3] * w[7];
    z += g2[0] * w[8] + g2[1] * w[9] + g2[2] * w[10] + g2[3] * w[11];
    z += g3[0] * w[12] + g3[1] * w[13] + g3[2] * w[14] + g3[3] * w[15];
    return logsigf_(z) * (1.f / 16.f);
}
DEV void phase_gla_prep(unsigned char* ws, const float* w2, const float* bg, int gtid, int NT) {
    bf16_t* QK = (bf16_t*)(ws + RC_QK); bf16_t* KT = (bf16_t*)(ws + RC_KT); float* DEC = (float*)(ws + WS_DEC);
    const float* DTGK = (const float*)(ws + WS_DTGK);
    for (int e = gtid; e < (HT / 64) * 512; e += NT) {
        const int d = e & 511, ch = e >> 9, t0 = ch * 64;
        float w[16];
#pragma unroll
        for (int j = 0; j < 16; ++j) w[j] = w2[j * 512 + d];
        const float b = bg[d];
        float glast = 0.f;
#pragma unroll 4
        for (int i = 0; i < 64; ++i) glast += gla_gk(DTGK, (size_t)(t0 + i), w, b);
        float run = 0.f;
        bf16_t* kd = KT + (size_t)d * HT + t0;
#pragma unroll 1
        for (int m = 0; m < 8; ++m) {
            unsigned tr[4];
#pragma unroll
            for (int ii = 0; ii < 8; ++ii) {
                const int i = m * 8 + ii;
                run += gla_gk(DTGK, (size_t)(t0 + i), w, b);
                bf16_t* qp = QK + (size_t)(t0 + i) * DM + d;
                const float q = bf1(qp[0]), k = bf1(qp[512]);
                qp[0] = (bf16_t)f2bf(q * 0.08838834764831845f * __expf(run));
                qp[512] = (bf16_t)f2bf(k * __expf(-run));
                const unsigned ke = f2bf(k * __expf(glast - run));
                if (ii & 1) tr[ii >> 1] |= ke << 16; else tr[ii >> 1] = ke;
            }
            *(u32x4*)(kd + 8 * m) = (u32x4){tr[0], tr[1], tr[2], tr[3]};
        }
        DEC[(size_t)ch * 512 + d] = __expf(glast);
    }
}

DEV void phase_gla_states(unsigned char* ws, LAS unsigned char* lds, int tid, int wave, int lane) {
    const bf16_t* KT = (const bf16_t*)(ws + RC_KT); const bf16_t* VT = (const bf16_t*)(ws + RC_VT); float* ST = (float*)(ws + RC_ST);
    constexpr int V_OFF = 0, K_OFF = 36864, RS = 144;
    const int fr = lane & 15, fq = lane >> 4;
    for (int unit = blockIdx.x; unit < (HT / 64) * 4; unit += gridDim.x) {
        const int cidx = unit >> 2, h = unit & 3, t0 = cidx * 64;
        for (int i = tid; i < 2048; i += NTHR) { const int row = i >> 3, ch = i & 7;
            *(LAS u32x4*)(lds + V_OFF + row * RS + ch * 16) = *(const u32x4*)(VT + (size_t)(h * 256 + row) * HT + t0 + ch * 8); }
        for (int i = tid; i < 1024; i += NTHR) { const int row = i >> 3, ch = i & 7;
            *(LAS u32x4*)(lds + K_OFF + row * RS + ch * 16) = *(const u32x4*)(KT + (size_t)(h * 128 + row) * HT + t0 + ch * 8); }
        __syncthreads();
        f32x4 acc[2][8];
#pragma unroll
        for (int a = 0; a < 2; ++a)
#pragma unroll
            for (int b = 0; b < 8; ++b) acc[a][b] = (f32x4){0.f, 0.f, 0.f, 0.f};
#pragma unroll
        for (int ks = 0; ks < 2; ++ks) {
            const bf16x8 y0 = ldsfrag(lds + V_OFF + (wave * 32 + fr) * RS + ks * 64 + fq * 16), y1 = ldsfrag(lds + V_OFF + (wave * 32 + 16 + fr) * RS + ks * 64 + fq * 16);
#pragma unroll
            for (int dt = 0; dt < 8; ++dt) { const bf16x8 x = ldsfrag(lds + K_OFF + (dt * 16 + fr) * RS + ks * 64 + fq * 16); acc[0][dt] = mma(x, y0, acc[0][dt]); acc[1][dt] = mma(x, y1, acc[1][dt]); }
        }
#pragma unroll
        for (int yt = 0; yt < 2; ++yt) { const int v = wave * 32 + yt * 16 + fr;
            float* dp = ST + (((size_t)cidx * 4 + h) * 256 + v) * 128 + 4 * fq;
#pragma unroll
            for (int dt = 0; dt < 8; ++dt) *(f32x4*)(dp + dt * 16) = acc[yt][dt]; }
        __syncthreads();
    }
}

DEV void phase_gla_scan(unsigned char* ws, int gtid, int NT) {
    float* ST = (float*)(ws + RC_ST); const float* DEC = (const float*)(ws + WS_DEC);
    for (int e = gtid; e < 2 * 65536; e += NT) {
        const int bl = e >> 16, rem = e & 65535, h = rem >> 14, d = (rem * 2) & 127;
        f32x2 carry = {0.f, 0.f};
        for (int c0 = 0; c0 < 128; c0 += 8) {
            f32x2 v[8], dec[8];
#pragma unroll
            for (int i = 0; i < 8; ++i) { const int cidx = bl * 128 + c0 + i; v[i] = *(const f32x2*)(ST + (size_t)cidx * 131072 + rem * 2); dec[i] = *(const f32x2*)(DEC + (size_t)cidx * 512 + h * 128 + d); if (GLA_ZERO_DEC) dec[i] = (f32x2){0.f, 0.f}; }
#pragma unroll
            for (int i = 0; i < 8; ++i) { const int cidx = bl * 128 + c0 + i; *(f32x2*)(ST + (size_t)cidx * 131072 + rem * 2) = carry; carry = carry * dec[i] + v[i]; }
        }
    }
}

DEV void phase_gla_out(unsigned char* ws, const float* nw, LAS unsigned char* lds, int tid, int wave, int lane) {
    const bf16_t* QK = (const bf16_t*)(ws + RC_QK); const bf16_t* VT = (const bf16_t*)(ws + RC_VT); const bf16_t* GS = (const bf16_t*)(ws + RC_GS);
    const float* ST = (const float*)(ws + RC_ST); bf16_t* YIN = (bf16_t*)(ws + WS_YIN);
    constexpr int Q_OFF = 0, K_OFF = 17408, V_OFF = 34816, P_OFF = 71680, S_OFF = 80896, RSD = 272, RST = 144;
    LAS float* ssqt = (LAS float*)(lds + S_OFF);
    const int fr = lane & 15, fq = lane >> 4, lt = wave >> 1, vh = wave & 1;
    for (int unit = blockIdx.x; unit < (HT / 64) * 4; unit += gridDim.x) {
        const int cidx = unit >> 2, h = unit & 3, t0 = cidx * 64;
        for (int i = tid; i < 1024; i += NTHR) { const int row = i >> 4, ch = i & 15;
            *(LAS u32x4*)(lds + Q_OFF + row * RSD + ch * 16) = *(const u32x4*)(QK + (size_t)(t0 + row) * DM + h * 128 + ch * 8);
            *(LAS u32x4*)(lds + K_OFF + row * RSD + ch * 16) = *(const u32x4*)(QK + (size_t)(t0 + row) * DM + 512 + h * 128 + ch * 8); }
        for (int i = tid; i < 2048; i += NTHR) { const int row = i >> 3, ch = i & 7;
            *(LAS u32x4*)(lds + V_OFF + row * RST + ch * 16) = *(const u32x4*)(VT + (size_t)(h * 256 + row) * HT + t0 + ch * 8); }
        __syncthreads();
        const int l = lt * 16 + fr;
        {
            f32x4 sc[2] = {(f32x4){0.f, 0.f, 0.f, 0.f}, (f32x4){0.f, 0.f, 0.f, 0.f}};
#pragma unroll
            for (int ks = 0; ks < 4; ++ks) { const bf16x8 y = ldsfrag(lds + Q_OFF + l * RSD + ks * 64 + fq * 16);
#pragma unroll
                for (int i = 0; i < 2; ++i) sc[i] = mma(ldsfrag(lds + K_OFF + ((2 * vh + i) * 16 + fr) * RSD + ks * 64 + fq * 16), y, sc[i]); }
#pragma unroll
            for (int i = 0; i < 2; ++i) { const int s0 = (2 * vh + i) * 16 + 4 * fq; float m[4];
#pragma unroll
                for (int j = 0; j < 4; ++j) m[j] = (s0 + j <= l) ? sc[i][j] : 0.f;
                u32x2 w; w.x = pk2(m[0], m[1]); w.y = pk2(m[2], m[3]); *(LAS u32x2*)(lds + P_OFF + l * RST + s0 * 2) = w; }
        }
        __syncthreads();
        f32x4 acc[8];
#pragma unroll
        for (int i = 0; i < 8; ++i) acc[i] = (f32x4){0.f, 0.f, 0.f, 0.f};
#pragma unroll
        for (int ks = 0; ks < 2; ++ks) { const bf16x8 y = ldsfrag(lds + P_OFF + l * RST + ks * 64 + fq * 16);
#pragma unroll
            for (int i = 0; i < 8; ++i) acc[i] = mma(ldsfrag(lds + V_OFF + ((vh * 8 + i) * 16 + fr) * RST + ks * 64 + fq * 16), y, acc[i]); }
        const float* sp = ST + (((size_t)cidx * 4 + h) * 256 + vh * 128 + fr) * 128 + fq * 8;
#pragma unroll
        for (int ks = 0; ks < (GLA_NO_INTER ? 0 : 4); ++ks) { const bf16x8 y = ldsfrag(lds + Q_OFF + l * RSD + ks * 64 + fq * 16);
#pragma unroll
            for (int i = 0; i < 8; ++i) { const float* pp = sp + (size_t)i * 16 * 128 + ks * 32; const f32x4 a = *(const f32x4*)pp, b = *(const f32x4*)(pp + 4);
                u32x4 w; w.x = pk2(a[0], a[1]); w.y = pk2(a[2], a[3]); w.z = pk2(b[0], b[1]); w.w = pk2(b[2], b[3]);
                acc[i] = mma(__builtin_bit_cast(bf16x8, w), y, acc[i]); } }
        float ssq = 0.f;
#pragma unroll
        for (int i = 0; i < 8; ++i) ssq += (acc[i][0] * acc[i][0] + acc[i][1] * acc[i][1]) + (acc[i][2] * acc[i][2] + acc[i][3] * acc[i][3]);
        ssq += __shfl_xor(ssq, 16); ssq += __shfl_xor(ssq, 32);
        if (fq == 0) ssqt[l * 2 + vh] = ssq;
        __syncthreads();
        const float rstd = rsqrtf((ssqt[l * 2] + ssqt[l * 2 + 1]) * (1.f / 256.f) + EPS);
        const size_t t = (size_t)(t0 + l);
#pragma unroll
        for (int i = 0; i < 8; ++i) { const int v = (vh * 8 + i) * 16 + 4 * fq, c = h * 256 + v;
            const u32x2 gw = *(const u32x2*)(GS + t * DM + c); const f32x4 w4 = *(const f32x4*)(nw + v);
            u32x2 o; o.x = pk2(acc[i][0] * rstd * w4[0] * bf_lo(gw.x), acc[i][1] * rstd * w4[1] * bf_hi(gw.x));
            o.y = pk2(acc[i][2] * rstd * w4[2] * bf_lo(gw.y), acc[i][3] * rstd * w4[3] * bf_hi(gw.y));
            *(u32x2*)(YIN + t * DM + c) = o; }
        __syncthreads();
    }
}


#define XB_TMO      128
#define XB_XCNT(j)  (256  + 64 * (j))
#define XB_XSUB(j)  (1280 + 64 * (j))
#define XB_XGEN(j)  (2304 + 64 * (j))
#define XB_TOP      3328
#define XB_TOPGEN   3392
#define XCD_BAR_WORDS 3456
#define XB_SPIN_CAP (1u << 22)
DEV unsigned xb_ld(unsigned* p)              { return __hip_atomic_load(p, __ATOMIC_RELAXED, __HIP_MEMORY_SCOPE_AGENT); }
DEV unsigned xb_add(unsigned* p, unsigned v) { return __hip_atomic_fetch_add(p, v, __ATOMIC_RELAXED, __HIP_MEMORY_SCOPE_AGENT); }
DEV unsigned xb_xcc_id() { return (unsigned)__builtin_amdgcn_s_getreg((3 << 11) | 20) & 0xFu; }
#define XB_SPIN(cond, bar) do { unsigned _sp = 0; while (cond) { __builtin_amdgcn_s_sleep(1); \
    if ((++_sp & 255u) == 0u) { if (xb_ld(&(bar)[XB_TMO])) break; if (_sp > XB_SPIN_CAP) { atomicAdd(&(bar)[XB_TMO], 1u); break; } } } } while (0)
DEV void xcd_barrier_complete(unsigned* bar, unsigned x, unsigned Gn, unsigned& nloc, unsigned& nx) {
    unsigned sum, cnt, mine, sp = 0u;
    for (;;) {
        sum = 0u; cnt = 0u; mine = 0u;
#pragma unroll
        for (unsigned j = 0; j < 16; ++j) { const unsigned c = xb_ld(&bar[XB_XCNT(j)]); sum += c; cnt += (c > 0u) ? 1u : 0u; mine = (j == x) ? c : mine; }
        if (sum == Gn) break;
        __builtin_amdgcn_s_sleep(1);
        if ((++sp & 255u) == 0u) { if (xb_ld(&bar[XB_TMO])) break; if (sp > XB_SPIN_CAP) { atomicAdd(&bar[XB_TMO], 1u); break; } }
    }
    nloc = mine > 0u ? mine : 1u; nx = cnt > 0u ? cnt : 1u;
}
DEV void xcd_barrier(unsigned* bar, unsigned x, volatile LAS unsigned* st, int tid, unsigned Gn) {
    asm volatile("s_waitcnt vmcnt(0)" ::: "memory");
    __syncthreads();
    if (tid == 0) {
        __builtin_amdgcn_s_waitcnt(0);
        unsigned nloc = st[0], nx = st[1];
        if (nloc == 0u) { xcd_barrier_complete(bar, x, Gn, nloc, nx); st[0] = nloc; st[1] = nx; }
        const unsigned old = xb_add(&bar[XB_XSUB(x)], 1u);
        const unsigned gen = old / nloc;
        if (old + 1u == (gen + 1u) * nloc) {
            __builtin_amdgcn_fence(__ATOMIC_RELEASE, "agent");
            asm volatile("s_waitcnt vmcnt(0)" ::: "memory");
            const unsigned og = xb_add(&bar[XB_TOP], 1u);
            const unsigned tg = og / nx;
            if (og + 1u == (tg + 1u) * nx) xb_add(&bar[XB_TOPGEN], 1u);
            else XB_SPIN(xb_ld(&bar[XB_TOPGEN]) == tg, bar);
            __builtin_amdgcn_fence(__ATOMIC_ACQUIRE, "agent");
            xb_add(&bar[XB_XGEN(x)], 1u);
            asm volatile("s_waitcnt vmcnt(0)" ::: "memory");
        } else {
            XB_SPIN(xb_ld(&bar[XB_XGEN(x)]) == gen, bar);
            __builtin_amdgcn_fence(__ATOMIC_ACQUIRE, "agent");
            asm volatile("s_waitcnt vmcnt(0)" ::: "memory");
        }
    }
    __syncthreads();
}

typedef const __attribute__((address_space(4))) Params* KParams;
DEV KParams kargs() { unsigned long long kp = (unsigned long long)__builtin_amdgcn_kernarg_segment_ptr(); asm volatile("" : "+s"(kp)); return (KParams)kp; }

__global__ void __launch_bounds__(NTHR, 2) mega_fwd(Params Parg, int pc_lo, int pc_hi, int coop, int pad_) {
    extern __shared__ __attribute__((aligned(16))) unsigned char smem[];
    cg::grid_group grid = cg::this_grid();
    if (coop) grid.sync();
    volatile LAS unsigned* xst = (volatile LAS unsigned*)((LAS unsigned char*)smem + 139264 - 16);
    const unsigned xcc = xb_xcc_id();
    if (threadIdx.x == 0) { xst[0] = 0u; xst[1] = 0u; (void)xb_add((unsigned*)(asglobal(kargs()->ws) + WS_BAR) + XB_XCNT(xcc), 1u); }
    __syncthreads();
    using pg8::Sched; using pg8::job_put;
    constexpr int PER_LAYER = 1 + 34 + 3, NPC = 2 * PER_LAYER + 1;
#pragma unroll 1
    for (int pc0 = pc_lo; pc0 < pc_hi; ++pc0) {
        int pc = pc0; asm volatile("" : "+s"(pc));
        int tid = threadIdx.x; asm volatile("" : "+v"(tid));
        const int lane = tid & 63, wave = __builtin_amdgcn_readfirstlane(tid >> 6);
        unsigned ldso = 0; asm volatile("" : "+s"(ldso));
        LAS unsigned char* lds = (LAS unsigned char*)smem + ldso;
        int bxv = blockIdx.x, gdv = gridDim.x; asm volatile("" : "+s"(bxv), "+s"(gdv));
        const int layer = pc / PER_LAYER; const int r = pc - layer * PER_LAYER;
        int ph, hf = 0;
        if (pc == NPC - 1) ph = 21; else if (r == 0) ph = 0; else if (r <= 34) { hf = (r - 1) / 17; ph = (r - 1) - hf * 17 + 1; } else ph = 18 + (r - 35);
        asm volatile("" : "+s"(ph), "+s"(hf));
#define P kargs()
#define ws asglobal(kargs()->ws)
#define INP(i) asglobal(kargs()->in[i])
#define OUTP asglobal(kargs()->out)
#define G gdv
#define bx bxv
#define gw (bx * NWAVES + wave)
#define NGW (G * NWAVES)
#define gtid (bx * NTHR + tid)
#define NT (G * NTHR)
#define WIN ((bf16_t*)(ws + WS_WIN))
#define HB ((bf16_t*)(ws + WS_HB))
#define MERGED ((float*)(ws + WS_MERGED))
#define GB ((bf16_t*)(ws + WS_G))
#define YIN ((bf16_t*)(ws + WS_YIN))
#define xsrc (((layer == 0) ? INP(0) : (const float*)OUTP) + (size_t)hf * HT * DM)
#define xdst (OUTP + (size_t)hf * HT * DM)

#define PROBE11 0
#define NOMIX 0
#define NOMLP 0
#ifndef SKIPMASK

#define SKIPMASK 0u
#endif
        if ((SKIPMASK >> ph) & 1u) ph = 99;
#ifdef DELAY_PROBE
        if (bxv == 3) { const unsigned long long t0 = __builtin_amdgcn_s_memrealtime(); while (__builtin_amdgcn_s_memrealtime() - t0 < 30000ull) __builtin_amdgcn_s_sleep(64); }
#endif
        switch (ph) {
        case 0:
            phase_weights(ws, INP(2) + (size_t)layer * 1024 * INW, INP(4) + (size_t)layer * 1048576, INP(11) + (size_t)layer * 1048576, INP(15) + (size_t)layer * 1048576,
                          INP(16) + (size_t)layer * 1048576, INP(18) + (size_t)layer * 4194304, INP(19) + (size_t)layer * 4194304, lds, gw, NGW, wave, lane);
            break;
        case 1:
            phase_rmsnorm_bf16(xsrc, INP(1) + layer * DM, HB, HT, gw, NGW, lane);
            if (DUP2) phase_rmsnorm_bf16(xsrc, INP(1) + layer * DM, HB, HT, gw, NGW, lane);
            break;
        case 2: {
            if (tid == 0) { job_put(lds, 0, HB, WIN, ws + RA_UA, nullptr, 64, 12, 3072, 0); job_put(lds, 1, HB, WIN + (size_t)9248 * DM, GB, nullptr, 64, 4, 1024, 1); }
            Sched S; S.init(lds, 2, G, bx, DM, tid);
            pg8::GEMM_BODY<3>(lds, DM, S, tid);
            phase_narrow(HB, WIN + (size_t)6144 * DM, WIN + (size_t)9232 * DM, (float*)(ws + WS_DTGK), gw, NGW, lane);
            break; }
        case 3:
            phase_conv_a((const bf16_t*)(ws + RA_UA), INP(3) + (size_t)layer * 3 * 1024, YIN, gtid, NT);
            if (DUP2) phase_conv_a((const bf16_t*)(ws + RA_UA), INP(3) + (size_t)layer * 3 * 1024, YIN, gtid, NT);
            break;
        case 4: {
            if (tid == 0) job_put(lds, 0, YIN, ws + WS_WOA, ws + WS_MERGED, GB, 64, 4, 1024, 4);
            Sched S; S.init(lds, 1, G, bx, DM, tid); pg8::GEMM_BODY<16>(lds, DM, S, tid);
            break; }
        case 5: {
            if (tid == 0) { job_put(lds, 0, HB, WIN + (size_t)3072 * DM, ws + RB_Z, nullptr, 64, 4, 1024, 2); job_put(lds, 1, WIN + (size_t)4096 * DM, HB, ws + RB_XST, nullptr, 4, 64, HT, 0);
                            job_put(lds, 2, HB, WIN + (size_t)5120 * DM, ws + RB_BC, nullptr, 64, 4, 1024, 0); job_put(lds, 3, HB, WIN + (size_t)10272 * DM, GB, nullptr, 64, 4, 1024, 1); }
            Sched S; S.init(lds, 4, G, bx, DM, tid); pg8::GEMM_BODY<7>(lds, DM, S, tid);
            break; }
        case 6:
            phase_ssd_prep(ws, INP(5) + (size_t)layer * 4 * 2048, INP(6) + (size_t)layer * 2048, INP(7) + layer * 16, INP(8) + layer * 16, gtid, NT, tid, G, bx);
            if (DUP2) phase_ssd_prep(ws, INP(5) + (size_t)layer * 4 * 2048, INP(6) + (size_t)layer * 2048, INP(7) + layer * 16, INP(8) + layer * 16, gtid, NT, tid, G, bx);
            break;
        case 7: phase_ssd_states(ws, lds, tid, wave, lane); if (DUP) { __syncthreads(); phase_ssd_states(ws, lds, tid, wave, lane); } break;
        case 8: phase_ssd_scan(ws, gtid, NT); break;
        case 9: phase_ssd_out(ws, INP(9) + layer * 16, INP(10) + layer * 1024, lds, tid, wave, lane); if (DUP) { __syncthreads(); phase_ssd_out(ws, INP(9) + layer * 16, INP(10) + layer * 1024, lds, tid, wave, lane); } break;
        case 10: {
            if (tid == 0) job_put(lds, 0, YIN, ws + WS_WOS, ws + WS_MERGED, GB, 64, 4, (int)((WS_MSUM - WS_MERGED) / 4), 5);
            Sched S; S.init(lds, 1, G, bx, DM, tid); pg8::GEMM_BODY<32>(lds, DM, S, tid);
            break; }
        case 11: {
#if PROBE11 == 1
            if (tid == 0) { job_put(lds, 0, HB, WIN + (size_t)11296 * DM, GB, nullptr, 64, 4, 1024, 1); }
            Sched S; S.init(lds, 1, G, bx, DM, tid); pg8::GEMM_BODY<7>(lds, DM, S, tid);
#elif PROBE11 == 2
            if (tid == 0) { job_put(lds, 1, HB, WIN + (size_t)3072 * DM, ws + RB_Z, nullptr, 64, 4, 1024, 2); job_put(lds, 2, WIN + (size_t)4096 * DM, HB, ws + RB_XST, nullptr, 4, 64, HT, 0);
                            job_put(lds, 3, HB, WIN + (size_t)5120 * DM, ws + RB_BC, nullptr, 64, 4, 1024, 0); job_put(lds, 0, HB, WIN + (size_t)10272 * DM, GB, nullptr, 64, 4, 1024, 1); }
            Sched S; S.init(lds, 4, G, bx, DM, tid); pg8::GEMM_BODY<7>(lds, DM, S, tid);
#else
            if (tid == 0) { job_put(lds, 0, HB, WIN + (size_t)6160 * DM, ws + RC_QK, nullptr, 64, 4, 1024, 0); job_put(lds, 1, WIN + (size_t)7184 * DM, HB, ws + RC_VT, nullptr, 4, 64, HT, 0);
                            job_put(lds, 2, HB, WIN + (size_t)8208 * DM, ws + RC_GS, nullptr, 64, 4, 1024, 2); job_put(lds, 3, HB, WIN + (size_t)11296 * DM, GB, nullptr, 64, 4, 1024, 1); }
            Sched S; S.init(lds, 4, G, bx, DM, tid); pg8::GEMM_BODY<7>(lds, DM, S, tid);
#endif
            break; }
        case 12: phase_gla_prep(ws, INP(12) + (size_t)layer * 16 * 512, INP(13) + layer * 512, gtid, NT); break;
        case 13: phase_gla_states(ws, lds, tid, wave, lane); if (DUP) { __syncthreads(); phase_gla_states(ws, lds, tid, wave, lane); } break;
        case 14: phase_gla_scan(ws, gtid, NT); break;
        case 15: phase_gla_out(ws, INP(14) + layer * 256, lds, tid, wave, lane); if (DUP) { __syncthreads(); phase_gla_out(ws, INP(14) + layer * 256, lds, tid, wave, lane); } break;
        case 16: {
            if (tid == 0) job_put(lds, 0, YIN, ws + WS_WOG, ws + WS_MSUM, GB, 64, 4, 1024, 6);
            Sched S; S.init(lds, 1, G, bx, DM, tid); pg8::GEMM_BODY<64>(lds, DM, S, tid);
            break; }
        case 17: {
            if (tid == 0) job_put(lds, 0, GB, ws + WS_WO, xdst, xsrc, 64, 4, NOMIX ? 0 : 1024, 7);
            Sched S; S.init(lds, 1, G, bx, DM, tid); pg8::GEMM_BODY<128>(lds, DM, S, tid);
            break; }
        case 18:
            phase_rmsnorm_bf16(OUTP, INP(17) + layer * DM, (bf16_t*)(ws + WS_MERGED), T_ALL, gw, NGW, lane);
            break;
        case 19: {
            if (tid == 0) job_put(lds, 0, ws + WS_MERGED, ws + WS_WUP, ws + WS_R, nullptr, 128, 16, DFF, 3);
            Sched S; S.init(lds, 1, G, bx, DM, tid); pg8::GEMM_BODY<8>(lds, DM, S, tid);
            break; }
        case 20: {
            if (tid == 0) job_put(lds, 0, ws + WS_R, ws + WS_WDN, OUTP, OUTP, 128, 4, NOMLP ? 0 : 1024, 7);
            Sched S; S.init(lds, 1, G, bx, DFF, tid); pg8::GEMM_BODY<128>(lds, DFF, S, tid);
            break; }
        case 99: {
#ifdef SPIN_PROBE
            if (pc == 6 || pc == 23) { const unsigned long long t0 = __builtin_amdgcn_s_memrealtime(); while (__builtin_amdgcn_s_memrealtime() - t0 < 500000ull) __builtin_amdgcn_s_sleep(64); }
#endif
            break; }
        default:
            phase_rmsnorm_f32(OUTP, INP(20), T_ALL, gw, NGW, lane);
            break;
        }
        if (pc0 != pc_hi - 1) {
            xcd_barrier((unsigned*)(ws + WS_BAR), xcc, xst, tid, (unsigned)gdv);
        }
    }
#undef P
#undef ws
#undef INP
#undef OUTP
#undef G
#undef bx
#undef gw
#undef NGW
#undef gtid
#undef NT
#undef WIN
#undef HB
#undef MERGED
#undef GB
#undef YIN
#undef xsrc
#undef xdst
}

extern "C" void kernel_launch(void* const* d_in, const int* in_sizes, int n_in, void* d_out, int out_size, void* d_ws, size_t ws_size, hipStream_t stream) {
    static int grid = 0;
    if (grid == 0) {
        if (n_in != 21 || out_size != T_ALL * DM || ws_size < WS_TOTAL) { fprintf(stderr, "kernel_launch: unexpected shapes (n_in %d out %d ws %zu need %zu)\n", n_in, out_size, ws_size, (size_t)WS_TOTAL); grid = -1; return; }
        int dev = 0, cus = 0, per_cu = 0;
        hipGetDevice(&dev);
        hipDeviceGetAttribute(&cus, hipDeviceAttributeMultiprocessorCount, dev);
        if (hipFuncSetAttribute((const void*)mega_fwd, hipFuncAttributeMaxDynamicSharedMemorySize, LDS_BYTES) != hipSuccess) { fprintf(stderr, "kernel_launch: hipFuncSetAttribute failed\n"); }
        if (hipOccupancyMaxActiveBlocksPerMultiprocessor(&per_cu, (const void*)mega_fwd, NTHR, LDS_BYTES) != hipSuccess || per_cu < 1) { fprintf(stderr, "kernel_launch: occupancy query says %d\n", per_cu); per_cu = 1; }
        (void)hipGetLastError();
        grid = cus > 0 ? cus : 256;
    }
    if (grid < 0) return;
    if (hipMemsetAsync((char*)d_ws + WS_BAR, 0, 16384, stream) != hipSuccess) { fprintf(stderr, "kernel_launch: memset failed\n"); return; }
    Params p{};
    for (int i = 0; i < 21; ++i) p.in[i] = (const float*)d_in[i];
    p.out = (float*)d_out; p.ws = (unsigned char*)d_ws;
#ifndef N_LAUNCH_SPLIT
#define N_LAUNCH_SPLIT 0
#endif
    constexpr int NPC_H = 2 * 38 + 1;
    if (N_LAUNCH_SPLIT) {
        for (int pc = 0; pc < NPC_H; ++pc) {
            hipLaunchKernelGGL(mega_fwd, dim3(grid), dim3(NTHR), LDS_BYTES, stream, p, pc, pc + 1, 0, 0);
        }
        hipError_t e = hipPeekAtLastError();
        if (e != hipSuccess) fprintf(stderr, "launch failed: %s (grid %d)\n", hipGetErrorString(e), grid);
    } else {
        int lo = 0, hi = NPC_H, coop = 1, pad = 0;
        void* args[] = {&p, &lo, &hi, &coop, &pad};
        hipError_t e = hipLaunchCooperativeKernel((const void*)mega_fwd, dim3(grid), dim3(NTHR), args, LDS_BYTES, stream);
        if (e != hipSuccess) fprintf(stderr, "cooperative launch failed: %s (grid %d)\n", hipGetErrorString(e), grid);
    }
}
```

```cpp
#include <hip/hip_runtime.h>
#include <hip/hip_cooperative_groups.h>
#include <cstdio>
namespace cg = cooperative_groups;

#define LAS __attribute__((address_space(3)))
#define DEV __device__ __forceinline__
typedef unsigned short bf16_t;
typedef short bf16x8 __attribute__((ext_vector_type(8)));
typedef float f32x4 __attribute__((ext_vector_type(4)));
typedef float f32x2 __attribute__((ext_vector_type(2)));
typedef unsigned u32x4 __attribute__((ext_vector_type(4)));
typedef unsigned u32x2 __attribute__((ext_vector_type(2)));

constexpr int T_ALL = 32768, HT = 16384, DM = 1024, SEQ = 8192, INW = 12320, DFF = 4096;
constexpr int NTHR = 512, NWAVES = 8;
constexpr int LDS_BYTES = 136 * 1024;
constexpr float EPS = 1e-6f;

constexpr size_t WS_WIN = 1048576;
constexpr size_t WS_WOA = WS_WIN + (size_t)INW * 1024 * 2 + 1048576;
constexpr size_t WS_WOS = WS_WOA + 2097152;
constexpr size_t WS_WOG = WS_WOS + 2097152;
constexpr size_t WS_WO = WS_WOG + 2097152;
constexpr size_t WS_WUP = WS_WO + 2097152;
constexpr size_t WS_WDN = WS_WUP + 8388608;
constexpr size_t WS_HB = WS_WDN + 8388608;
constexpr size_t WS_MERGED = WS_HB + (size_t)HT * 1024 * 2;
constexpr size_t WS_G = WS_MERGED + (size_t)HT * 1024 * 4;
constexpr size_t WS_YIN = WS_G + (size_t)HT * 1024 * 2;
constexpr size_t WS_DTGK = WS_YIN + (size_t)HT * 1024 * 2;
constexpr size_t WS_R = WS_DTGK + (size_t)HT * 32 * 4;
constexpr size_t RA_UA = WS_R;
constexpr size_t RB_Z = WS_R;
constexpr size_t RB_XST = RB_Z + 33554432;
constexpr size_t RB_BC = RB_XST + 33554432;
constexpr size_t RB_XSTC = RB_BC + 33554432;
constexpr size_t RB_BCC = RB_XSTC + 33554432;
constexpr size_t RB_BTC = RB_BCC + 33554432;
constexpr size_t RB_DT = RB_BTC + 16777216;
constexpr size_t RB_ACUM = RB_DT + 1048576;
constexpr size_t RB_ST = RB_ACUM + 1048576;
constexpr size_t RB_END = RB_ST + 67108864;
constexpr size_t RC_QK = WS_R;
constexpr size_t RC_KT = RC_QK + 33554432;
constexpr size_t RC_VT = RC_KT + 16777216;
constexpr size_t RC_GS = RC_VT + 33554432;
constexpr size_t RC_DEC = RC_GS + 33554432;
constexpr size_t RC_ST = RC_DEC + 524288;
constexpr size_t RC_END = RC_ST + 134217728;
constexpr size_t R_HID_END = WS_R + (size_t)T_ALL * DFF * 2;
constexpr size_t WS_END = (RB_END > RC_END ? (RB_END > R_HID_END ? RB_END : R_HID_END) : (RC_END > R_HID_END ? RC_END : R_HID_END));

constexpr size_t WS_MSUM = (WS_END + 255) & ~(size_t)255;
constexpr size_t WS_BAR = WS_MSUM + (size_t)HT * 1024 * 2;
constexpr size_t WS_DEC = WS_BAR + 16384;
constexpr size_t WS_TOTAL = WS_DEC + 524288;
struct Params { const float* in[21]; float* out; unsigned char* ws; };

DEV unsigned f2bf(float f) { unsigned u = __float_as_uint(f); return (u + 0x7fffu + ((u >> 16) & 1u)) >> 16; }
typedef __bf16 bf16x2_t __attribute__((ext_vector_type(2)));
DEV unsigned pk2(float lo, float hi) { const f32x2 v = {lo, hi}; const bf16x2_t r = __builtin_convertvector(v, bf16x2_t); return __builtin_bit_cast(unsigned, r); }
DEV float bf_lo(unsigned w) { return __uint_as_float(w << 16); }
DEV float bf_hi(unsigned w) { return __uint_as_float(w & 0xffff0000u); }
DEV float bf1(bf16_t h) { return __uint_as_float(((unsigned)h) << 16); }
DEV void unpack8(const u32x4 w, float (&f)[8]) {
    f[0] = bf_lo(w.x); f[1] = bf_hi(w.x); f[2] = bf_lo(w.y); f[3] = bf_hi(w.y);
    f[4] = bf_lo(w.z); f[5] = bf_hi(w.z); f[6] = bf_lo(w.w); f[7] = bf_hi(w.w);
}
DEV u32x4 pack8(const float (&f)[8]) { u32x4 w; w.x = pk2(f[0], f[1]); w.y = pk2(f[2], f[3]); w.z = pk2(f[4], f[5]); w.w = pk2(f[6], f[7]); return w; }
DEV float sigmoidf_(float x) { return __builtin_amdgcn_rcpf(1.0f + __expf(-x)); }
DEV float siluf_(float x) { return x * sigmoidf_(x); }
DEV float softplusf_(float x) { return x > 20.f ? x : (x < -15.f ? __expf(x) : __logf(1.0f + __expf(x))); }
DEV float logsigf_(float x) { const float e = __expf(-fabsf(x)); return fminf(x, 0.f) - (e < 1e-4f ? e : __logf(1.0f + e)); }
DEV float wave_sum(float v) {
#pragma unroll
    for (int o = 1; o < 64; o <<= 1) v += __shfl_xor(v, o);
    return v;
}
DEV f32x4 mma(bf16x8 x, bf16x8 y, f32x4 acc) { return __builtin_amdgcn_mfma_f32_16x16x32_bf16(x, y, acc, 0, 0, 0); }
DEV bf16x8 ldsfrag(const LAS unsigned char* p) { return *(const LAS bf16x8*)p; }
#define SCALE_A 1.f
#define SCALE_B 1.f
#define SCALE_C 1.f
#define DUP 0
#define DUP2 0
#define BAR2 0
#define GLA_NO_INTER 0
#define GLA_ZERO_DEC 0
#ifndef GEMM_BODY
#define GEMM_BODY gemm_phase
#endif
#define LDS_WAIT() asm volatile("s_waitcnt lgkmcnt(0)" ::: "memory")
#define GAS __attribute__((address_space(1)))
template <class T> DEV T* asglobal(T* p) { return (T*)(GAS T*)p; }

namespace pg8 {
constexpr int BM = 256, BK = 64, HALF = 128, HTB = HALF * BK * 2, STAGE_BYTES = 8 * HTB, NXCD = 8, WGM = 8;
DEV int lds_byte(int r, int c) { const int st = (r >> 4) * 2 + (c >> 5), rr = r & 15, cc = c & 31, ob = rr * 64 + cc * 2; return st * 1024 + (ob ^ (((ob >> 9) & 1) << 5)); }
DEV void stage_rc(int b, int& R, int& C) { const int st = b / 1024, sb = b % 1024, swz = sb ^ (((sb >> 9) & 1) << 5); R = (st >> 1) * 16 + swz / 64; C = (st & 1) * 32 + (swz % 64) / 2; }
DEV int perm32(int rho) { const int n = rho >> 4, i = rho & 15; return 8 * (i >> 2) + 4 * n + (i & 3); }

struct Job { const bf16_t* A; const bf16_t* B; void* out; const void* aux; int nM, nN, ldc, kind; };
struct Unit { const char* A; const char* B; int jid, pm, pn; };
constexpr int JT_OFF = 131072;
DEV int rfl(int v) { return __builtin_amdgcn_readfirstlane(v); }
DEV const char* rflp(const LAS int* p) { const unsigned lo = (unsigned)rfl(p[0]), hi = (unsigned)rfl(p[1]); return asglobal((const char*)(((unsigned long long)hi << 32) | lo)); }
DEV void job_put(LAS unsigned char* lds, int q, const void* A, const void* B, void* out, const void* aux, int nM, int nN, int ldc, int kind) {
    LAS int* jt = (LAS int*)(lds + JT_OFF) + q * 12;
    const unsigned long long a = (unsigned long long)A, b = (unsigned long long)B, o = (unsigned long long)out, x = (unsigned long long)aux;
    jt[0] = (int)(unsigned)a; jt[1] = (int)(unsigned)(a >> 32); jt[2] = (int)(unsigned)b; jt[3] = (int)(unsigned)(b >> 32);
    jt[4] = (int)(unsigned)o; jt[5] = (int)(unsigned)(o >> 32); jt[6] = (int)(unsigned)x; jt[7] = (int)(unsigned)(x >> 32);
    jt[8] = nM; jt[9] = nN; jt[10] = ldc; jt[11] = kind;
}
struct Sched {
    LAS unsigned char* lds; int nj, total, G, c; size_t tstep;
    DEV void init(LAS unsigned char* lds_, int nj_, int G_, int c_, int K, int tid_) {
        lds = lds_; nj = nj_; G = G_; c = c_; tstep = (size_t)BM * K * 2;
        __syncthreads();
        LAS int* jt = (LAS int*)(lds + JT_OFF);
        if (tid_ == 0) { int s = 0; for (int q = 0; q < nj; ++q) { jt[48 + q] = s; s += jt[q * 12 + 8] * jt[q * 12 + 9]; } for (int q = nj; q < 5; ++q) jt[48 + q] = s; }
        __syncthreads();
        total = rfl(jt[48 + 4]);
    }
    DEV bool next(int i, Unit& u) const {
        const int L = i * G + c; if (L >= total) return false;
        const LAS int* jt = (const LAS int*)(lds + JT_OFF);
        int jid = 0;
        for (int q = 1; q < nj; ++q) if (L >= rfl(jt[48 + q])) jid = q;
        const LAS int* J = jt + jid * 12;
        const int base = rfl(jt[48 + jid]), nM = rfl(J[8]), nN = rfl(J[9]);
        int wgid = L - base; const int nwg = nM * nN;
        { const int q = nwg / NXCD, r = nwg % NXCD, xcd = wgid % NXCD, off = wgid / NXCD; wgid = (xcd < r ? xcd * (q + 1) : r * (q + 1) + (xcd - r) * q) + off; }
        const int nig = WGM * nN, gid = wgid / nig, fm = gid * WGM, gsz = (nM - fm) < WGM ? (nM - fm) : WGM;
        u.pm = fm + ((wgid % nig) % gsz); u.pn = (wgid % nig) / gsz; u.jid = jid;
        u.A = rflp(J) + (size_t)u.pm * tstep; u.B = rflp(J + 2) + (size_t)u.pn * tstep;
        return true;
    }
};

DEV void st16_wt(GAS u32x4* p, u32x4 v) { asm volatile("global_store_dwordx4 %0, %1, off sc1" :: "v"(p), "v"(v) : "memory"); }
DEV void st16f_wt(GAS f32x4* p, f32x4 v) { asm volatile("global_store_dwordx4 %0, %1, off sc1" :: "v"(p), "v"(v) : "memory"); }
DEV unsigned cvt_pk_bf16(float lo, float hi) { return pk2(lo, hi); }

template <int KIND> DEV void epi_loop(const f32x4 (&acc)[2][2][4][2], const Job& J, const Unit& u, int wr, int wc, int fr, int fq) {
    const int row0 = u.pm * BM + wr * 64 + fr, col0 = u.pn * BM + wc * 32 + 8 * fq;
    GAS bf16_t* const outb = (GAS bf16_t*)J.out; GAS float* const outf = (GAS float*)J.out;
    const GAS float* const auxf = (const GAS float*)J.aux; GAS bf16_t* const auxb = (GAS bf16_t*)const_cast<void*>(J.aux);
#pragma unroll
    for (int ai = 0; ai < 2; ++ai)
#pragma unroll
        for (int m = 0; m < 4; ++m) {
            const size_t row = (size_t)(row0 + ai * HALF + m * 16);
#pragma unroll
            for (int bj = 0; bj < 2; ++bj) {
                const int col = col0 + bj * HALF;
                f32x4 v0 = acc[ai][bj][m][0], v1 = acc[ai][bj][m][1];
                if (KIND <= 3) {
                    if (KIND == 1) {
#pragma unroll
                        for (int e = 0; e < 4; ++e) { v0[e] = sigmoidf_(v0[e]); v1[e] = sigmoidf_(v1[e]); } }
                    if (KIND == 2) {
#pragma unroll
                        for (int e = 0; e < 4; ++e) { v0[e] = siluf_(v0[e]); v1[e] = siluf_(v1[e]); } }
                    if (KIND == 3) {
#pragma unroll
                        for (int e = 0; e < 4; ++e) { float a = fmaxf(v0[e], 0.f), b = fmaxf(v1[e], 0.f); v0[e] = a * a; v1[e] = b * b; } }
                    u32x4 w; w.x = cvt_pk_bf16(v0[0], v0[1]); w.y = cvt_pk_bf16(v0[2], v0[3]); w.z = cvt_pk_bf16(v1[0], v1[1]); w.w = cvt_pk_bf16(v1[2], v1[3]);
                    *(GAS u32x4*)(outb + row * J.ldc + col) = w;
                } else if (KIND == 7) {
                    const GAS float* xin = auxf + row * DM + col; GAS float* xo = outf + row * DM + col;
                    const f32x4 a = *(const GAS f32x4*)xin, b = *(const GAS f32x4*)(xin + 4);
                    const float sc = (J.ldc == 0) ? 0.f : 1.f; *(GAS f32x4*)xo = a + v0 * sc; *(GAS f32x4*)(xo + 4) = b + v1 * sc;
                } else if (KIND == 4) {
                    const u32x4 gw = *(const GAS u32x4*)(auxb + row * DM + col); float g[8]; unpack8(gw, g);
                    f32x4 r0, r1;
#pragma unroll
                    for (int e = 0; e < 4; ++e) { r0[e] = g[e] * v0[e] * SCALE_A; r1[e] = g[4 + e] * v1[e] * SCALE_A; }
                    GAS float* mo = outf + row * DM + col; *(GAS f32x4*)mo = r0; *(GAS f32x4*)(mo + 4) = r1;
                } else if (KIND == 5) {
                    const u32x4 gw = *(const GAS u32x4*)(auxb + row * DM + col); float g[8]; unpack8(gw, g);
                    const GAS float* mo = outf + row * DM + col; const f32x4 m0 = *(const GAS f32x4*)mo, m1 = *(const GAS f32x4*)(mo + 4);
#pragma unroll
                    for (int e = 0; e < 8; ++e) g[e] *= SCALE_B;
                    u32x4 w; w.x = cvt_pk_bf16(m0[0] + g[0] * v0[0], m0[1] + g[1] * v0[1]); w.y = cvt_pk_bf16(m0[2] + g[2] * v0[2], m0[3] + g[3] * v0[3]);
                    w.z = cvt_pk_bf16(m1[0] + g[4] * v1[0], m1[1] + g[5] * v1[1]); w.w = cvt_pk_bf16(m1[2] + g[6] * v1[2], m1[3] + g[7] * v1[3]);
                    *(GAS u32x4*)((GAS bf16_t*)(outf + (size_t)J.ldc) + row * DM + col) = w;
                } else {
                    GAS bf16_t* gp = auxb + row * DM + col;
                    const u32x4 gw = *(const GAS u32x4*)gp, aw = *(const GAS u32x4*)(outb + row * DM + col);
                    float g[8], a[8]; unpack8(gw, g); unpack8(aw, a);
#pragma unroll
                    for (int e = 0; e < 8; ++e) g[e] *= SCALE_C;
                    u32x4 w; w.x = cvt_pk_bf16(a[0] + g[0] * v0[0], a[1] + g[1] * v0[1]); w.y = cvt_pk_bf16(a[2] + g[2] * v0[2], a[3] + g[3] * v0[3]);
                    w.z = cvt_pk_bf16(a[4] + g[4] * v1[0], a[5] + g[5] * v1[1]); w.w = cvt_pk_bf16(a[6] + g[6] * v1[2], a[7] + g[7] * v1[3]);
                    *(GAS u32x4*)gp = w;
                }
            }
        }
}

template <int MASK> DEV void run_epi(const Sched& S, const Unit& u, const f32x4 (&acc)[2][2][4][2], int wr, int wc, int fr, int fq) {
    const LAS int* Jp = (const LAS int*)(S.lds + JT_OFF) + u.jid * 12;
    Job J; J.A = nullptr; J.B = nullptr; J.out = (void*)rflp(Jp + 4); J.aux = (const void*)rflp(Jp + 6); J.nM = 0; J.nN = 0; J.ldc = rfl(Jp[10]); J.kind = rfl(Jp[11]);
    const int k = J.kind;
    if ((MASK & 1) && k == 0) epi_loop<0>(acc, J, u, wr, wc, fr, fq);
    else if ((MASK & 2) && k == 1) epi_loop<1>(acc, J, u, wr, wc, fr, fq);
    else if ((MASK & 4) && k == 2) epi_loop<2>(acc, J, u, wr, wc, fr, fq);
    else if ((MASK & 8) && k == 3) epi_loop<3>(acc, J, u, wr, wc, fr, fq);
    else if ((MASK & 16) && k == 4) epi_loop<4>(acc, J, u, wr, wc, fr, fq);
    else if ((MASK & 32) && k == 5) epi_loop<5>(acc, J, u, wr, wc, fr, fq);
    else if ((MASK & 64) && k == 6) epi_loop<6>(acc, J, u, wr, wc, fr, fq);
    else if ((MASK & 128) && k == 7) epi_loop<7>(acc, J, u, wr, wc, fr, fq);
}

template <int MASK>
DEV void gemm_phase(LAS unsigned char* lds, const int K, const Sched& S, const int tid) {
    const int wid = __builtin_amdgcn_readfirstlane(tid >> 6), lane = tid & 63, wr = wid >> 2, wc = wid & 3, fr = lane & 15, fq = lane >> 4;
    const int nt = K / BK;
    unsigned voffA[2], voffB[2];
#pragma unroll
    for (int i = 0; i < 2; ++i) { int R, C; stage_rc(tid * 16 + i * 8192, R, C); const int Rb = (R & ~31) + perm32(R & 31);
        voffA[i] = (unsigned)(R * K + C) * 2u; voffB[i] = (unsigned)(Rb * K + C) * 2u; }
    const size_t kstep = (size_t)(BK * 2);
    const size_t hstep = (size_t)HALF * K * 2;
    const unsigned ldsw = (unsigned)wid * 1024u;
    const int aoff = lds_byte(wr * 64 + fr, fq * 8), boff = lds_byte(wc * 32 + fr, fq * 8);
#define PG8_SA(b, h) (((b) * 2 + (h)) * HTB)
#define PG8_SB(b, h) ((4 + (b) * 2 + (h)) * HTB)
#define PG8_STAGE(bufoff, gbase, voff) do { _Pragma("unroll") for (int _i = 0; _i < 2; ++_i) \
        __builtin_amdgcn_global_load_lds((const unsigned*)((const char*)(gbase) + (voff)[_i]), (LAS unsigned*)(lds + (bufoff) + ldsw + _i * 8192), 16, 0, 0); } while (0)
#define PG8_LDA(dst, b, h) do { _Pragma("unroll") for (int m = 0; m < 4; ++m) _Pragma("unroll") for (int k = 0; k < 2; ++k) dst[m][k] = *(const LAS bf16x8*)(lds + PG8_SA(b, h) + aoff + m * 2048 + k * 1024); } while (0)
#define PG8_LDB(dst, b, h) do { _Pragma("unroll") for (int n = 0; n < 2; ++n) _Pragma("unroll") for (int k = 0; k < 2; ++k) dst[n][k] = *(const LAS bf16x8*)(lds + PG8_SB(b, h) + boff + n * 2048 + k * 1024); } while (0)
#define PG8_MMA(ai, bj, At, Bt) do { __builtin_amdgcn_s_setprio(1); _Pragma("unroll") for (int m = 0; m < 4; ++m) _Pragma("unroll") for (int n = 0; n < 2; ++n) _Pragma("unroll") for (int k = 0; k < 2; ++k) \
        acc[ai][bj][m][n] = __builtin_amdgcn_mfma_f32_16x16x32_bf16(Bt[n][k], At[m][k], acc[ai][bj][m][n], 0, 0, 0); __builtin_amdgcn_s_setprio(0); } while (0)
#define PG8_WAIT_V(n) asm volatile("s_waitcnt vmcnt(" #n ")" ::: "memory")
#define PG8_WAIT_L(n) asm volatile("s_waitcnt lgkmcnt(" #n ")" ::: "memory")
#define PG8_BAR __builtin_amdgcn_s_barrier()
#define PG8_SCHED __builtin_amdgcn_sched_barrier(0)
    Unit cur, nxt; int ui = 0;
    if (!S.next(0, cur)) return;
    f32x4 acc[2][2][4][2];
#pragma unroll
    for (int a = 0; a < 2; ++a)
#pragma unroll
        for (int b = 0; b < 2; ++b)
#pragma unroll
            for (int m = 0; m < 4; ++m)
#pragma unroll
                for (int n = 0; n < 2; ++n) acc[a][b][m][n] = (f32x4){0.f, 0.f, 0.f, 0.f};
    bf16x8 At[4][2], B0[2][2], B1[2][2];
    const char* cA = cur.A; const char* cB = cur.B;
    PG8_STAGE(PG8_SB(0, 0), cB, voffB); PG8_STAGE(PG8_SA(0, 0), cA, voffA); PG8_STAGE(PG8_SB(0, 1), cB + hstep, voffB); PG8_STAGE(PG8_SA(0, 1), cA + hstep, voffA);
    if (wr == 1) PG8_BAR;
    PG8_WAIT_V(4); PG8_BAR;
    PG8_STAGE(PG8_SB(1, 0), cB + kstep, voffB); PG8_STAGE(PG8_SA(1, 0), cA + kstep, voffA); PG8_STAGE(PG8_SB(1, 1), cB + hstep + kstep, voffB);
    PG8_WAIT_V(6); PG8_BAR;
    for (;;) {
        const bool has_next = S.next(ui + 1, nxt);
        const char* nA = has_next ? nxt.A : cA; const char* nB = has_next ? nxt.B : cB;
        for (int t = 0; t < nt; t += 2) {
            const bool last = (t == nt - 2);
            const char* a1 = cA + (size_t)(t + 1) * kstep;
            const char* a2 = last ? nA : cA + (size_t)(t + 2) * kstep; const char* b2 = last ? nB : cB + (size_t)(t + 2) * kstep;
            const char* a3 = a2 + kstep; const char* b3 = b2 + kstep;
            PG8_LDB(B0, 0, 0); PG8_SCHED; PG8_LDA(At, 0, 0); PG8_STAGE(PG8_SA(1, 1), a1 + hstep, voffA);
            PG8_WAIT_L(8); PG8_BAR; PG8_WAIT_L(0); PG8_MMA(0, 0, At, B0); PG8_BAR; PG8_SCHED;
            PG8_LDB(B1, 0, 1); PG8_STAGE(PG8_SB(0, 0), b2, voffB);
            PG8_BAR; PG8_WAIT_L(0); PG8_MMA(0, 1, At, B1); PG8_BAR;
            PG8_LDA(At, 0, 1); PG8_STAGE(PG8_SA(0, 0), a2, voffA);
            PG8_BAR; PG8_WAIT_L(0); PG8_MMA(1, 0, At, B0); PG8_BAR; PG8_SCHED;
            PG8_STAGE(PG8_SB(0, 1), b2 + hstep, voffB);
            PG8_WAIT_V(6); PG8_BAR; PG8_MMA(1, 1, At, B1); PG8_BAR;
            PG8_LDB(B0, 1, 0); PG8_SCHED; PG8_LDA(At, 1, 0); PG8_STAGE(PG8_SA(0, 1), a2 + hstep, voffA);
            PG8_WAIT_L(8); PG8_BAR; PG8_WAIT_L(0); PG8_MMA(0, 0, At, B0); PG8_BAR; PG8_SCHED;
            PG8_LDB(B1, 1, 1); PG8_STAGE(PG8_SB(1, 0), b3, voffB);
            PG8_BAR; PG8_WAIT_L(0); PG8_MMA(0, 1, At, B1); PG8_BAR;
            PG8_LDA(At, 1, 1); PG8_STAGE(PG8_SA(1, 0), a3, voffA);
            PG8_BAR; PG8_WAIT_L(0); PG8_MMA(1, 0, At, B0); PG8_BAR; PG8_SCHED;
            PG8_STAGE(PG8_SB(1, 1), b3 + hstep, voffB);
            PG8_WAIT_V(6); PG8_BAR; PG8_MMA(1, 1, At, B1); PG8_BAR;
        }
        run_epi<MASK>(S, cur, acc, wr, wc, fr, fq);
        if (!has_next) break;
#pragma unroll
        for (int a = 0; a < 2; ++a)
#pragma unroll
            for (int b = 0; b < 2; ++b)
#pragma unroll
                for (int m = 0; m < 4; ++m)
#pragma unroll
                    for (int n = 0; n < 2; ++n) acc[a][b][m][n] = (f32x4){0.f, 0.f, 0.f, 0.f};
        cur = nxt; cA = nA; cB = nB; ++ui;
    }
    PG8_WAIT_V(0);
    if (wr == 0) PG8_BAR;
    PG8_BAR;
#undef PG8_SA
#undef PG8_SB
#undef PG8_STAGE
#undef PG8_LDA
#undef PG8_LDB
#undef PG8_MMA
#undef PG8_WAIT_V
#undef PG8_WAIT_L
#undef PG8_BAR
#undef PG8_SCHED
}

template <int MASK>
DEV void gemm_simple(LAS unsigned char* lds, const int K, const Sched& S, const int tid) {
    const int wid = __builtin_amdgcn_readfirstlane(tid >> 6), lane = tid & 63, wr = wid >> 2, wc = wid & 3, fr = lane & 15, fq = lane >> 4;
    const int nt = K / BK;
    unsigned voffA[2], voffB[2];
#pragma unroll
    for (int i = 0; i < 2; ++i) { int R, C; stage_rc(tid * 16 + i * 8192, R, C); const int Rb = (R & ~31) + perm32(R & 31);
        voffA[i] = (unsigned)(R * K + C) * 2u; voffB[i] = (unsigned)(Rb * K + C) * 2u; }
    const size_t kstep = (size_t)(BK * 2), hstep = (size_t)HALF * K * 2;
    const unsigned ldsl = (unsigned)wid * 1024u + (unsigned)lane * 16u;
    const int aoff = lds_byte(wr * 64 + fr, fq * 8), boff = lds_byte(wc * 32 + fr, fq * 8);
#define GS_SA(b, h) (((b) * 2 + (h)) * HTB)
#define GS_SB(b, h) ((4 + (b) * 2 + (h)) * HTB)
#define GS_LOAD(dst, pa, pb) do { _Pragma("unroll") for (int _i = 0; _i < 2; ++_i) { \
        dst[0][_i] = *(const GAS u32x4*)((const GAS char*)(pa) + voffA[_i]); dst[1][_i] = *(const GAS u32x4*)((const GAS char*)(pa) + hstep + voffA[_i]); \
        dst[2][_i] = *(const GAS u32x4*)((const GAS char*)(pb) + voffB[_i]); dst[3][_i] = *(const GAS u32x4*)((const GAS char*)(pb) + hstep + voffB[_i]); } } while (0)
#define GS_WRITE(b, src) do { _Pragma("unroll") for (int _i = 0; _i < 2; ++_i) { \
        *(LAS u32x4*)(lds + GS_SA(b, 0) + ldsl + _i * 8192) = src[0][_i]; *(LAS u32x4*)(lds + GS_SA(b, 1) + ldsl + _i * 8192) = src[1][_i]; \
        *(LAS u32x4*)(lds + GS_SB(b, 0) + ldsl + _i * 8192) = src[2][_i]; *(LAS u32x4*)(lds + GS_SB(b, 1) + ldsl + _i * 8192) = src[3][_i]; } } while (0)
    Unit cur; int ui = 0;
    while (S.next(ui, cur)) {
        f32x4 acc[2][2][4][2];
#pragma unroll
        for (int a = 0; a < 2; ++a)
#pragma unroll
            for (int b = 0; b < 2; ++b)
#pragma unroll
                for (int m = 0; m < 4; ++m)
#pragma unroll
                    for (int n = 0; n < 2; ++n) acc[a][b][m][n] = (f32x4){0.f, 0.f, 0.f, 0.f};
        const char* cA = cur.A; const char* cB = cur.B;
        u32x4 st[4][2];
        GS_LOAD(st, cA, cB);
        GS_WRITE(0, st);
        __syncthreads();
        for (int t = 0; t < nt; ++t) {
            const int b = t & 1;
            if (t + 1 < nt) GS_LOAD(st, cA + (size_t)(t + 1) * kstep, cB + (size_t)(t + 1) * kstep);
#pragma unroll
            for (int ai = 0; ai < 2; ++ai) {
                bf16x8 At[4][2];
#pragma unroll
                for (int m = 0; m < 4; ++m)
#pragma unroll
                    for (int k = 0; k < 2; ++k) At[m][k] = *(const LAS bf16x8*)(lds + (b ? GS_SA(1, 0) : GS_SA(0, 0)) + ai * HTB + aoff + m * 2048 + k * 1024);
#pragma unroll
                for (int bj = 0; bj < 2; ++bj) {
                    bf16x8 Bt[2][2];
#pragma unroll
                    for (int n = 0; n < 2; ++n)
#pragma unroll
                        for (int k = 0; k < 2; ++k) Bt[n][k] = *(const LAS bf16x8*)(lds + (b ? GS_SB(1, 0) : GS_SB(0, 0)) + bj * HTB + boff + n * 2048 + k * 1024);
#pragma unroll
                    for (int m = 0; m < 4; ++m)
#pragma unroll
                        for (int n = 0; n < 2; ++n)
#pragma unroll
                            for (int k = 0; k < 2; ++k) acc[ai][bj][m][n] = __builtin_amdgcn_mfma_f32_16x16x32_bf16(Bt[n][k], At[m][k], acc[ai][bj][m][n], 0, 0, 0);
                }
            }
            if (t + 1 < nt) { if (b) GS_WRITE(0, st); else GS_WRITE(1, st); }
            __syncthreads();
        }
        run_epi<MASK>(S, cur, acc, wr, wc, fr, fq);
        ++ui;
    }
    __syncthreads();
#undef GS_SA
#undef GS_SB
#undef GS_LOAD
#undef GS_WRITE
}
}

DEV void transpose_item(const float* W, int K, int N, bf16_t* WT, LAS float* scr, int item, int lane) {
    const int nblk = N / 32, kb = item / nblk, nb = item % nblk, k0 = 64 * kb, n0 = 32 * nb;
#pragma unroll 8
    for (int i = 0; i < 32; ++i) { const int kk = 2 * i + (lane >> 5); scr[kk * 33 + (lane & 31)] = W[(size_t)(k0 + kk) * N + n0 + (lane & 31)]; }
    LDS_WAIT();
    const int c = lane & 7;
#pragma unroll
    for (int jj = 0; jj < 4; ++jj) { const int n = (lane >> 3) + 8 * jj; const LAS float* s = scr + (8 * c) * 33 + n;
        u32x4 o; o.x = pk2(s[0 * 33], s[1 * 33]); o.y = pk2(s[2 * 33], s[3 * 33]); o.z = pk2(s[4 * 33], s[5 * 33]); o.w = pk2(s[6 * 33], s[7 * 33]);
        *(u32x4*)(WT + (size_t)(n0 + n) * K + k0 + 8 * c) = o; }
    LDS_WAIT();
}

DEV void phase_weights(unsigned char* ws, const float* w_in, const float* w_oa, const float* w_os, const float* w_og, const float* w_o, const float* w_up, const float* w_dn, LAS unsigned char* lds, int gw, int NGW, int wave, int lane) {
    LAS float* scr = (LAS float*)(lds + wave * 8704);
    constexpr int I_IN = 16 * (INW / 32), I_SQ = 16 * 32, I_UP = 16 * 128, I_DN = 64 * 32;
    constexpr int NIT = I_IN + 4 * I_SQ + I_UP + I_DN;
    for (int it = gw; it < NIT; it += NGW) {
        int r = it;
        if (r < I_IN) { transpose_item(w_in, 1024, INW, (bf16_t*)(ws + WS_WIN), scr, r, lane); continue; } r -= I_IN;
        if (r < I_SQ) { transpose_item(w_oa, 1024, 1024, (bf16_t*)(ws + WS_WOA), scr, r, lane); continue; } r -= I_SQ;
        if (r < I_SQ) { transpose_item(w_os, 1024, 1024, (bf16_t*)(ws + WS_WOS), scr, r, lane); continue; } r -= I_SQ;
        if (r < I_SQ) { transpose_item(w_og, 1024, 1024, (bf16_t*)(ws + WS_WOG), scr, r, lane); continue; } r -= I_SQ;
        if (r < I_SQ) { transpose_item(w_o, 1024, 1024, (bf16_t*)(ws + WS_WO), scr, r, lane); continue; } r -= I_SQ;
        if (r < I_UP) { transpose_item(w_up, 1024, 4096, (bf16_t*)(ws + WS_WUP), scr, r, lane); continue; } r -= I_UP;
        transpose_item(w_dn, 4096, 1024, (bf16_t*)(ws + WS_WDN), scr, r, lane);
    }
}

DEV void phase_rmsnorm_bf16(const float* x, const float* w, bf16_t* o, int nrows, int gw, int NGW, int lane) {
    for (int m = gw; m < nrows; m += NGW) {
        const f32x4* xr = (const f32x4*)(x + (size_t)m * DM) + lane;
        f32x4 v[4]; float s = 0.f;
#pragma unroll
        for (int j = 0; j < 4; ++j) { v[j] = xr[64 * j]; s += (v[j].x * v[j].x + v[j].y * v[j].y) + (v[j].z * v[j].z + v[j].w * v[j].w); }
        const float rstd = rsqrtf(wave_sum(s) * (1.f / DM) + EPS);
        u32x2* o8 = (u32x2*)(o + (size_t)m * DM) + lane;
#pragma unroll
        for (int j = 0; j < 4; ++j) { const f32x4 ww = ((const f32x4*)w)[lane + 64 * j]; u32x2 r; r.x = pk2(v[j].x * rstd * ww.x, v[j].y * rstd * ww.y); r.y = pk2(v[j].z * rstd * ww.z, v[j].w * rstd * ww.w); o8[64 * j] = r; }
    }
}
DEV void phase_rmsnorm_f32(float* x, const float* w, int nrows, int gw, int NGW, int lane) {
    for (int m = gw; m < nrows; m += NGW) {
        f32x4* xr = (f32x4*)(x + (size_t)m * DM) + lane;
        f32x4 v[4]; float s = 0.f;
#pragma unroll
        for (int j = 0; j < 4; ++j) { v[j] = xr[64 * j]; s += (v[j].x * v[j].x + v[j].y * v[j].y) + (v[j].z * v[j].z + v[j].w * v[j].w); }
        const float rstd = rsqrtf(wave_sum(s) * (1.f / DM) + EPS);
#pragma unroll
        for (int j = 0; j < 4; ++j) { const f32x4 ww = ((const f32x4*)w)[lane + 64 * j]; xr[64 * j] = v[j] * rstd * ww; }
    }
}

DEV void phase_narrow(const bf16_t* HB, const bf16_t* Wdt, const bf16_t* Wgk, float* DTGK, int gw, int NGW, int lane) {
    const int fr = lane & 15, fq = lane >> 4;
    for (int u = gw; u < HT / 16; u += NGW) {
        const int t0 = u * 16;
        f32x4 a0 = {0.f, 0.f, 0.f, 0.f}, a1 = {0.f, 0.f, 0.f, 0.f};
        const bf16_t* ap = HB + (size_t)(t0 + fr) * DM + fq * 8;
        const bf16_t* b0p = Wdt + (size_t)fr * DM + fq * 8;
        const bf16_t* b1p = Wgk + (size_t)fr * DM + fq * 8;
#pragma unroll 4
        for (int k = 0; k < DM; k += 32) {
            const bf16x8 a = *(const bf16x8*)(ap + k), b0 = *(const bf16x8*)(b0p + k), b1 = *(const bf16x8*)(b1p + k);
            a0 = mma(a, b0, a0); a1 = mma(a, b1, a1);
        }
#pragma unroll
        for (int j = 0; j < 4; ++j) { float* d = DTGK + (size_t)(t0 + 4 * fq + j) * 32; d[fr] = a0[j]; d[16 + fr] = a1[j]; }
    }
}

DEV void phase_conv_a(const bf16_t* UA, const float* cw, bf16_t* YIN, int gtid, int NT) {
    for (int u = gtid; u < (HT / 16) * 128; u += NT) {
        const int c0 = (u & 127) * 8, t0 = (u >> 7) * 16;
        float w0[8], w1[8], w2[8], p1[8], p2[8];
#pragma unroll
        for (int j = 0; j < 8; ++j) { w0[j] = cw[c0 + j]; w1[j] = cw[1024 + c0 + j]; w2[j] = cw[2048 + c0 + j]; p1[j] = 0.f; p2[j] = 0.f; }
        if ((t0 & (SEQ - 1)) != 0) {
            float ax[8], ac[8];
            unpack8(*(const u32x4*)(UA + (size_t)(t0 - 2) * 3072 + c0), ax); unpack8(*(const u32x4*)(UA + (size_t)(t0 - 2) * 3072 + 2048 + c0), ac);
#pragma unroll
            for (int j = 0; j < 8; ++j) p2[j] = ax[j] * ac[j];
            unpack8(*(const u32x4*)(UA + (size_t)(t0 - 1) * 3072 + c0), ax); unpack8(*(const u32x4*)(UA + (size_t)(t0 - 1) * 3072 + 2048 + c0), ac);
#pragma unroll
            for (int j = 0; j < 8; ++j) p1[j] = ax[j] * ac[j];
        }
#pragma unroll 4
        for (int i = 0; i < 16; ++i) {
            const bf16_t* rp = UA + (size_t)(t0 + i) * 3072 + c0;
            float ax[8], ab[8], ac[8], o[8];
            unpack8(*(const u32x4*)rp, ax); unpack8(*(const u32x4*)(rp + 1024), ab); unpack8(*(const u32x4*)(rp + 2048), ac);
#pragma unroll
            for (int j = 0; j < 8; ++j) { const float p0 = ax[j] * ac[j]; o[j] = ab[j] * (w0[j] * p2[j] + w1[j] * p1[j] + w2[j] * p0); p2[j] = p1[j]; p1[j] = p0; }
            *(u32x4*)(YIN + (size_t)(t0 + i) * DM + c0) = pack8(o);
        }
    }
}

DEV void phase_ssd_prep(unsigned char* ws, const float* cw, const float* cb, const float* dtb, const float* alog, int gtid, int NT, int tid, int nblk, int blk) {
    const bf16_t* XST = (const bf16_t*)(ws + RB_XST); bf16_t* XSTC = (bf16_t*)(ws + RB_XSTC);
    for (int u = gtid; u < 1024 * (HT / 8); u += NT) {
        const int tb = u & (HT / 8 - 1), c = u >> 11, t0 = tb * 8;
        float x[11], cur[8];
        unpack8(*(const u32x4*)(XST + (size_t)c * HT + t0), cur);
        if ((t0 & (SEQ - 1)) != 0) { float pv[8]; unpack8(*(const u32x4*)(XST + (size_t)c * HT + t0 - 8), pv); x[0] = pv[5]; x[1] = pv[6]; x[2] = pv[7]; }
        else { x[0] = 0.f; x[1] = 0.f; x[2] = 0.f; }
#pragma unroll
        for (int i = 0; i < 8; ++i) x[3 + i] = cur[i];
        const float w0 = cw[c], w1 = cw[2048 + c], w2 = cw[4096 + c], w3 = cw[6144 + c], b = cb[c];
        float y[8];
#pragma unroll
        for (int i = 0; i < 8; ++i) y[i] = siluf_(b + w0 * x[i] + w1 * x[i + 1] + w2 * x[i + 2] + w3 * x[i + 3]);
        *(u32x4*)(XSTC + (size_t)c * HT + t0) = pack8(y);
    }
    const bf16_t* BC = (const bf16_t*)(ws + RB_BC); bf16_t* BCC = (bf16_t*)(ws + RB_BCC); bf16_t* BTC = (bf16_t*)(ws + RB_BTC);
    for (int u = gtid; u < (HT / 8) * 128; u += NT) {
        const int cg8 = u & 127, c0 = cg8 * 8, t0 = (u >> 7) * 8, cc = 1024 + c0;
        float w0[8], w1[8], w2[8], w3[8], bb[8], x1[8], x2[8], x3[8];
#pragma unroll
        for (int j = 0; j < 8; ++j) { w0[j] = cw[cc + j]; w1[j] = cw[2048 + cc + j]; w2[j] = cw[4096 + cc + j]; w3[j] = cw[6144 + cc + j]; bb[j] = cb[cc + j]; x1[j] = 0.f; x2[j] = 0.f; x3[j] = 0.f; }
        if ((t0 & (SEQ - 1)) != 0) {
            unpack8(*(const u32x4*)(BC + (size_t)(t0 - 1) * DM + c0), x1); unpack8(*(const u32x4*)(BC + (size_t)(t0 - 2) * DM + c0), x2); unpack8(*(const u32x4*)(BC + (size_t)(t0 - 3) * DM + c0), x3);
        }
        unsigned tr[8][4];
#pragma unroll
        for (int i = 0; i < 8; ++i) {
            float x0[8], y[8];
            unpack8(*(const u32x4*)(BC + (size_t)(t0 + i) * DM + c0), x0);
#pragma unroll
            for (int j = 0; j < 8; ++j) { y[j] = siluf_(bb[j] + w3[j] * x0[j] + w2[j] * x1[j] + w1[j] * x2[j] + w0[j] * x3[j]); x3[j] = x2[j]; x2[j] = x1[j]; x1[j] = x0[j]; }
            *(u32x4*)(BCC + (size_t)(t0 + i) * DM + c0) = pack8(y);
#pragma unroll
            for (int j = 0; j < 8; ++j) { if (i & 1) tr[j][i >> 1] |= f2bf(y[j]) << 16; else tr[j][i >> 1] = f2bf(y[j]); }
        }
        if (cg8 < 64) {
#pragma unroll
            for (int j = 0; j < 8; ++j) *(u32x4*)(BTC + (size_t)(c0 + j) * HT + t0) = (u32x4){tr[j][0], tr[j][1], tr[j][2], tr[j][3]};
        }
    }
    const float* DTGK = (const float*)(ws + WS_DTGK); float* DT = (float*)(ws + RB_DT); float* AC = (float*)(ws + RB_ACUM);
    {
        const int idx = tid * nblk + blk;
        for (int e = idx; e < (HT / 128) * 16; e += NT) {
            const int h = e & 15, ch = e >> 4; const float a = -__expf(alog[h]), bias = dtb[h]; float acc = 0.f;
            for (int i = 0; i < 128; ++i) { const size_t t = (size_t)ch * 128 + i; const float d = softplusf_(DTGK[t * 32 + h] + bias); acc += d * a; DT[t * 16 + h] = d; AC[t * 16 + h] = acc; }
        }
    }
}

DEV void phase_ssd_states(unsigned char* ws, LAS unsigned char* lds, int tid, int wave, int lane) {
    const bf16_t* XSTC = (const bf16_t*)(ws + RB_XSTC); const bf16_t* BTC = (const bf16_t*)(ws + RB_BTC);
    const float* DT = (const float*)(ws + RB_DT); const float* AC = (const float*)(ws + RB_ACUM); float* ST = (float*)(ws + RB_ST);
    constexpr int BT_OFF = 0, XW_OFF = 34816, TAB_OFF = 34816 + 69632, RS = 272;
    LAS float* wt = (LAS float*)(lds + TAB_OFF);
    const int fr = lane & 15, fq = lane >> 4;
    for (int unit = blockIdx.x; unit < (HT / 128) * 4; unit += gridDim.x) {
        const int cidx = unit >> 2, g = unit & 3, t0 = cidx * 128;
        { const int r = tid >> 7, l = tid & 127, h = g * 4 + r;
          const float al = AC[(size_t)(t0 + 127) * 16 + h], a = AC[(size_t)(t0 + l) * 16 + h];
          wt[r * 128 + l] = DT[(size_t)(t0 + l) * 16 + h] * __expf(al - a); }
        for (int i = tid; i < 2048; i += NTHR) { const int row = i >> 4, ch = i & 15;
            *(LAS u32x4*)(lds + BT_OFF + row * RS + ch * 16) = *(const u32x4*)(BTC + (size_t)(g * 128 + row) * HT + t0 + ch * 8); }
        __syncthreads();
        for (int i = tid; i < 4096; i += NTHR) { const int row = i >> 4, ch = i & 15; float f[8];
            unpack8(*(const u32x4*)(XSTC + (size_t)(g * 256 + row) * HT + t0 + ch * 8), f);
            const LAS float* wp = wt + (row >> 6) * 128 + ch * 8;
#pragma unroll
            for (int e = 0; e < 8; ++e) f[e] *= wp[e];
            *(LAS u32x4*)(lds + XW_OFF + row * RS + ch * 16) = pack8(f); }
        __syncthreads();
        f32x4 acc[2][8];
#pragma unroll
        for (int a = 0; a < 2; ++a)
#pragma unroll
            for (int b = 0; b < 8; ++b) acc[a][b] = (f32x4){0.f, 0.f, 0.f, 0.f};
#pragma unroll
        for (int ks = 0; ks < 4; ++ks) {
            const bf16x8 y0 = ldsfrag(lds + XW_OFF + (wave * 32 + fr) * RS + ks * 64 + fq * 16), y1 = ldsfrag(lds + XW_OFF + (wave * 32 + 16 + fr) * RS + ks * 64 + fq * 16);
#pragma unroll
            for (int nt = 0; nt < 8; ++nt) { const bf16x8 x = ldsfrag(lds + BT_OFF + (nt * 16 + fr) * RS + ks * 64 + fq * 16); acc[0][nt] = mma(x, y0, acc[0][nt]); acc[1][nt] = mma(x, y1, acc[1][nt]); }
        }
#pragma unroll
        for (int yt = 0; yt < 2; ++yt) { const int pp = wave * 32 + yt * 16 + fr, h = g * 4 + (pp >> 6), p = pp & 63;
            float* d = ST + (((size_t)cidx * 16 + h) * 64 + p) * 128 + 4 * fq;
#pragma unroll
            for (int nt = 0; nt < 8; ++nt) *(f32x4*)(d + nt * 16) = acc[yt][nt]; }
        __syncthreads();
    }
}

DEV void phase_ssd_scan(unsigned char* ws, int gtid, int NT) {
    float* ST = (float*)(ws + RB_ST); const float* AC = (const float*)(ws + RB_ACUM);
    for (int e = gtid; e < 2 * 65536; e += NT) {
        const int bl = e >> 16, rem = e & 65535, h = rem >> 12;
        f32x2 carry = {0.f, 0.f};
        for (int c0 = 0; c0 < 64; c0 += 8) {
            f32x2 v[8]; float dec[8];
#pragma unroll
            for (int i = 0; i < 8; ++i) { const int cidx = bl * 64 + c0 + i; v[i] = *(const f32x2*)(ST + (size_t)cidx * 131072 + rem * 2); dec[i] = __expf(AC[((size_t)cidx * 128 + 127) * 16 + h]); }
#pragma unroll
            for (int i = 0; i < 8; ++i) { const int cidx = bl * 64 + c0 + i; *(f32x2*)(ST + (size_t)cidx * 131072 + rem * 2) = carry; carry = carry * dec[i] + v[i]; }
        }
    }
}

DEV void phase_ssd_out(unsigned char* ws, const float* dsk, const float* nw, LAS unsigned char* lds, int tid, int wave, int lane) {
    const bf16_t* XSTC = (const bf16_t*)(ws + RB_XSTC); const bf16_t* BCC = (const bf16_t*)(ws + RB_BCC); const bf16_t* Z = (const bf16_t*)(ws + RB_Z);
    const float* DT = (const float*)(ws + RB_DT); const float* AC = (const float*)(ws + RB_ACUM); const float* ST = (const float*)(ws + RB_ST);
    bf16_t* YIN = (bf16_t*)(ws + WS_YIN);
    float* YT = (float*)(ws + RB_XST);
    constexpr int C_OFF = 0, B_OFF = 34816, PV_OFF = 34816, XS_OFF = 34816 + 17408, M_OFF = 69632, TAB_OFF = 104448, RS = 272;
    LAS float* tac = (LAS float*)(lds + TAB_OFF); LAS float* tdt = tac + 512;
    const int fr = lane & 15, fq = lane >> 4;
    LAS unsigned char* Mw = lds + M_OFF + wave * 4352;
    for (int unit = blockIdx.x; unit < (HT / 128) * 4; unit += gridDim.x) {
        const int cidx = unit >> 2, g = unit & 3, t0 = cidx * 128;
        for (int i = tid; i < 2048; i += NTHR) { const int row = i >> 4, ch = i & 15;
            *(LAS u32x4*)(lds + C_OFF + row * RS + ch * 16) = *(const u32x4*)(BCC + (size_t)(t0 + row) * DM + 512 + g * 128 + ch * 8);
            *(LAS u32x4*)(lds + B_OFF + row * RS + ch * 16) = *(const u32x4*)(BCC + (size_t)(t0 + row) * DM + g * 128 + ch * 8); }
        { const int r = tid >> 7, l = tid & 127, h = g * 4 + r; tac[tid] = AC[(size_t)(t0 + l) * 16 + h]; tdt[tid] = DT[(size_t)(t0 + l) * 16 + h]; }
        __syncthreads();
        f32x4 cb[8];
#pragma unroll
        for (int st = 0; st < 8; ++st) cb[st] = (f32x4){0.f, 0.f, 0.f, 0.f};
#pragma unroll
        for (int ks = 0; ks < 4; ++ks) {
            const bf16x8 y = ldsfrag(lds + C_OFF + (wave * 16 + fr) * RS + ks * 64 + fq * 16);
#pragma unroll
            for (int st = 0; st < 8; ++st) cb[st] = mma(ldsfrag(lds + B_OFF + (st * 16 + fr) * RS + ks * 64 + fq * 16), y, cb[st]);
        }
        __syncthreads();
        const int l = wave * 16 + fr;
        const size_t t = (size_t)(t0 + l);
        float ssq = 0.f;
#pragma unroll 1
        for (int r = 0; r < 4; ++r) {
            const int h = g * 4 + r;
            for (int i = tid; i < 2048; i += NTHR) { const int row = i >> 5, c4 = i & 31;
                const f32x4 v = *(const f32x4*)(ST + (((size_t)cidx * 16 + h) * 64 + row) * 128 + c4 * 4);
                u32x2 w; w.x = pk2(v.x, v.y); w.y = pk2(v.z, v.w); *(LAS u32x2*)(lds + PV_OFF + row * RS + c4 * 8) = w; }
            for (int i = tid; i < 1024; i += NTHR) { const int row = i >> 4, ch = i & 15;
                *(LAS u32x4*)(lds + XS_OFF + row * RS + ch * 16) = *(const u32x4*)(XSTC + (size_t)(h * 64 + row) * HT + t0 + ch * 8); }
            const float al = tac[r * 128 + l];
#pragma unroll
            for (int st = 0; st < 8; ++st) { float m[4];
#pragma unroll
                for (int j = 0; j < 4; ++j) { const int s = st * 16 + 4 * fq + j; const float d = fminf(al - tac[r * 128 + s], 0.f); m[j] = (s <= l) ? cb[st][j] * __expf(d) * tdt[r * 128 + s] : 0.f; }
                u32x2 w; w.x = pk2(m[0], m[1]); w.y = pk2(m[2], m[3]); *(LAS u32x2*)(Mw + fr * RS + (st * 16 + 4 * fq) * 2) = w; }
            __syncthreads();
            f32x4 acc[4];
#pragma unroll
            for (int pt = 0; pt < 4; ++pt) acc[pt] = (f32x4){0.f, 0.f, 0.f, 0.f};
#pragma unroll
            for (int ks = 0; ks < 4; ++ks) { const bf16x8 y = ldsfrag(lds + C_OFF + l * RS + ks * 64 + fq * 16);
#pragma unroll
                for (int pt = 0; pt < 4; ++pt) acc[pt] = mma(ldsfrag(lds + PV_OFF + (pt * 16 + fr) * RS + ks * 64 + fq * 16), y, acc[pt]); }
            const float el = __expf(al);
#pragma unroll
            for (int pt = 0; pt < 4; ++pt) acc[pt] *= el;
#pragma unroll
            for (int ks = 0; ks < 4; ++ks) { const bf16x8 y = ldsfrag(Mw + fr * RS + ks * 64 + fq * 16);
#pragma unroll
                for (int pt = 0; pt < 4; ++pt) acc[pt] = mma(ldsfrag(lds + XS_OFF + (pt * 16 + fr) * RS + ks * 64 + fq * 16), y, acc[pt]); }
            const float dh = dsk[h];
#pragma unroll
            for (int pt = 0; pt < 4; ++pt) {
#pragma unroll
                for (int j = 0; j < 4; ++j) { const bf16_t xv = *(const LAS bf16_t*)(lds + XS_OFF + (pt * 16 + 4 * fq + j) * RS + l * 2); acc[pt][j] += dh * bf1(xv); }
                const int c = g * 256 + r * 64 + pt * 16 + 4 * fq;
                const u32x2 zw = *(const u32x2*)(Z + t * DM + c);
                f32x4 v = acc[pt]; v[0] *= bf_lo(zw.x); v[1] *= bf_hi(zw.x); v[2] *= bf_lo(zw.y); v[3] *= bf_hi(zw.y);
                ssq += (v[0] * v[0] + v[1] * v[1]) + (v[2] * v[2] + v[3] * v[3]);
                *(f32x4*)(YT + t * DM + c) = v;
            }
            __syncthreads();
        }
        ssq += __shfl_xor(ssq, 16); ssq += __shfl_xor(ssq, 32);
        const float rstd = rsqrtf(ssq * (1.f / 256.f) + EPS);
#pragma unroll 4
        for (int q = 0; q < 16; ++q) { const int c = g * 256 + q * 16 + 4 * fq;
            const f32x4 w4 = *(const f32x4*)(nw + c); const f32x4 v = *(const f32x4*)(YT + t * DM + c);
            u32x2 o; o.x = pk2(v[0] * rstd * w4[0], v[1] * rstd * w4[1]); o.y = pk2(v[2] * rstd * w4[2], v[3] * rstd * w4[3]);
            *(u32x2*)(YIN + t * DM + c) = o; }
        __syncthreads();
    }
}

DEV float gla_gk(const float* DTGK, size_t t, const float (&w)[16], float b) {
    const f32x4* gl = (const f32x4*)(DTGK + t * 32 + 16);
    const f32x4 g0 = gl[0], g1 = gl[1], g2 = gl[2], g3 = gl[3];
    float z = b;
    z += g0[0] * w[0] + g0[1] * w[1] + g0[2] * w[2] + g0[3] * w[3];
    z += g1[0] * w[4] + g1[1] * w[5] + g1[2] * w[6] + g1[3] * w[7];
    z += g2[0] * w[8] + g2[1] * w[9] + g2[2] * w[10] + g2[3] * w[11];
    z += g3[0] * w[12] + g3[1] * w[13] + g3[2] * w[14] + g3[3] * w[15];
    return logsigf_(z) * (1.f / 16.f);
}
DEV void phase_gla_prep(unsigned char* ws, const float* w2, const float* bg, int gtid, int NT) {
    bf16_t* QK = (bf16_t*)(ws + RC_QK); bf16_t* KT = (bf16_t*)(ws + RC_KT); float* DEC = (float*)(ws + WS_DEC);
    const float* DTGK = (const float*)(ws + WS_DTGK);
    for (int e = gtid; e < (HT / 64) * 512; e += NT) {
        const int d = e & 511, ch = e >> 9, t0 = ch * 64;
        float w[16];
#pragma unroll
        for (int j = 0; j < 16; ++j) w[j] = w2[j * 512 + d];
        const float b = bg[d];
        float glast = 0.f;
#pragma unroll 4
        for (int i = 0; i < 64; ++i) glast += gla_gk(DTGK, (size_t)(t0 + i), w, b);
        float run = 0.f;
        bf16_t* kd = KT + (size_t)d * HT + t0;
#pragma unroll 1
        for (int m = 0; m < 8; ++m) {
            unsigned tr[4];
#pragma unroll
            for (int ii = 0; ii < 8; ++ii) {
                const int i = m * 8 + ii;
                run += gla_gk(DTGK, (size_t)(t0 + i), w, b);
                bf16_t* qp = QK + (size_t)(t0 + i) * DM + d;
                const float q = bf1(qp[0]), k = bf1(qp[512]);
                qp[0] = (bf16_t)f2bf(q * 0.08838834764831845f * __expf(run));
                qp[512] = (bf16_t)f2bf(k * __expf(-run));
                const unsigned ke = f2bf(k * __expf(glast - run));
                if (ii & 1) tr[ii >> 1] |= ke << 16; else tr[ii >> 1] = ke;
            }
            *(u32x4*)(kd + 8 * m) = (u32x4){tr[0], tr[1], tr[2], tr[3]};
        }
        DEC[(size_t)ch * 512 + d] = __expf(glast);
    }
}

DEV void phase_gla_states(unsigned char* ws, LAS unsigned char* lds, int tid, int wave, int lane) {
    const bf16_t* KT = (const bf16_t*)(ws + RC_KT); const bf16_t* VT = (const bf16_t*)(ws + RC_VT); bf16_t* ST = (bf16_t*)(ws + RC_ST);
    constexpr int V_OFF = 0, K_OFF = 36864, RS = 144;
    const int fr = lane & 15, fq = lane >> 4;
    for (int unit = blockIdx.x; unit < (HT / 64) * 4; unit += gridDim.x) {
        const int cidx = unit >> 2, h = unit & 3, t0 = cidx * 64;
        for (int i = tid; i < 2048; i += NTHR) { const int row = i >> 3, ch = i & 7;
            *(LAS u32x4*)(lds + V_OFF + row * RS + ch * 16) = *(const u32x4*)(VT + (size_t)(h * 256 + row) * HT + t0 + ch * 8); }
        for (int i = tid; i < 1024; i += NTHR) { const int row = i >> 3, ch = i & 7;
            *(LAS u32x4*)(lds + K_OFF + row * RS + ch * 16) = *(const u32x4*)(KT + (size_t)(h * 128 + row) * HT + t0 + ch * 8); }
        __syncthreads();
        f32x4 acc[2][8];
#pragma unroll
        for (int a = 0; a < 2; ++a)
#pragma unroll
            for (int b = 0; b < 8; ++b) acc[a][b] = (f32x4){0.f, 0.f, 0.f, 0.f};
#pragma unroll
        for (int ks = 0; ks < 2; ++ks) {
            const bf16x8 y0 = ldsfrag(lds + V_OFF + (wave * 32 + fr) * RS + ks * 64 + fq * 16), y1 = ldsfrag(lds + V_OFF + (wave * 32 + 16 + fr) * RS + ks * 64 + fq * 16);
#pragma unroll
            for (int dt = 0; dt < 8; ++dt) { const bf16x8 x = ldsfrag(lds + K_OFF + (dt * 16 + fr) * RS + ks * 64 + fq * 16); acc[0][dt] = mma(x, y0, acc[0][dt]); acc[1][dt] = mma(x, y1, acc[1][dt]); }
        }
#pragma unroll
        for (int yt = 0; yt < 2; ++yt) { const int v = wave * 32 + yt * 16 + fr;
            bf16_t* dp = ST + (((size_t)cidx * 4 + h) * 256 + v) * 128 + 4 * fq;
#pragma unroll
            for (int dt = 0; dt < 8; ++dt) { u32x2 w; w.x = pk2(acc[yt][dt][0], acc[yt][dt][1]); w.y = pk2(acc[yt][dt][2], acc[yt][dt][3]); *(u32x2*)(dp + dt * 16) = w; } }
        __syncthreads();
    }
}

DEV void phase_gla_scan(unsigned char* ws, int gtid, int NT) {
    unsigned* ST = (unsigned*)(ws + RC_ST); const float* DEC = (const float*)(ws + WS_DEC);
    for (int e = gtid; e < 2 * 65536; e += NT) {
        const int bl = e >> 16, rem = e & 65535, h = rem >> 14, d = (rem * 2) & 127;
        f32x2 carry = {0.f, 0.f};
        for (int c0 = 0; c0 < 128; c0 += 8) {
            unsigned v[8]; f32x2 dec[8];
#pragma unroll
            for (int i = 0; i < 8; ++i) { const int cidx = bl * 128 + c0 + i; v[i] = ST[(size_t)cidx * 65536 + rem]; dec[i] = *(const f32x2*)(DEC + (size_t)cidx * 512 + h * 128 + d); }
#pragma unroll
            for (int i = 0; i < 8; ++i) { const int cidx = bl * 128 + c0 + i; ST[(size_t)cidx * 65536 + rem] = pk2(carry[0], carry[1]);
                carry[0] = carry[0] * dec[i][0] + bf_lo(v[i]); carry[1] = carry[1] * dec[i][1] + bf_hi(v[i]); }
        }
    }
}

DEV void phase_gla_out(unsigned char* ws, const float* nw, LAS unsigned char* lds, int tid, int wave, int lane) {
    const bf16_t* QK = (const bf16_t*)(ws + RC_QK); const bf16_t* VT = (const bf16_t*)(ws + RC_VT); const bf16_t* GS = (const bf16_t*)(ws + RC_GS);
    const bf16_t* ST = (const bf16_t*)(ws + RC_ST); bf16_t* YIN = (bf16_t*)(ws + WS_YIN);
    constexpr int Q_OFF = 0, K_OFF = 17408, V_OFF = 34816, P_OFF = 71680, S_OFF = 80896, RSD = 272, RST = 144;
    LAS float* ssqt = (LAS float*)(lds + S_OFF);
    const int fr = lane & 15, fq = lane >> 4, lt = wave >> 1, vh = wave & 1;
    for (int unit = blockIdx.x; unit < (HT / 64) * 4; unit += gridDim.x) {
        const int cidx = unit >> 2, h = unit & 3, t0 = cidx * 64;
        for (int i = tid; i < 1024; i += NTHR) { const int row = i >> 4, ch = i & 15;
            *(LAS u32x4*)(lds + Q_OFF + row * RSD + ch * 16) = *(const u32x4*)(QK + (size_t)(t0 + row) * DM + h * 128 + ch * 8);
            *(LAS u32x4*)(lds + K_OFF + row * RSD + ch * 16) = *(const u32x4*)(QK + (size_t)(t0 + row) * DM + 512 + h * 128 + ch * 8); }
        for (int i = tid; i < 2048; i += NTHR) { const int row = i >> 3, ch = i & 7;
            *(LAS u32x4*)(lds + V_OFF + row * RST + ch * 16) = *(const u32x4*)(VT + (size_t)(h * 256 + row) * HT + t0 + ch * 8); }
        __syncthreads();
        const int l = lt * 16 + fr;
        {
            f32x4 sc[2] = {(f32x4){0.f, 0.f, 0.f, 0.f}, (f32x4){0.f, 0.f, 0.f, 0.f}};
#pragma unroll
            for (int ks = 0; ks < 4; ++ks) { const bf16x8 y = ldsfrag(lds + Q_OFF + l * RSD + ks * 64 + fq * 16);
#pragma unroll
                for (int i = 0; i < 2; ++i) sc[i] = mma(ldsfrag(lds + K_OFF + ((2 * vh + i) * 16 + fr) * RSD + ks * 64 + fq * 16), y, sc[i]); }
#pragma unroll
            for (int i = 0; i < 2; ++i) { const int s0 = (2 * vh + i) * 16 + 4 * fq; float m[4];
#pragma unroll
                for (int j = 0; j < 4; ++j) m[j] = (s0 + j <= l) ? sc[i][j] : 0.f;
                u32x2 w; w.x = pk2(m[0], m[1]); w.y = pk2(m[2], m[3]); *(LAS u32x2*)(lds + P_OFF + l * RST + s0 * 2) = w; }
        }
        __syncthreads();
        f32x4 acc[8];
#pragma unroll
        for (int i = 0; i < 8; ++i) acc[i] = (f32x4){0.f, 0.f, 0.f, 0.f};
#pragma unroll
        for (int ks = 0; ks < 2; ++ks) { const bf16x8 y = ldsfrag(lds + P_OFF + l * RST + ks * 64 + fq * 16);
#pragma unroll
            for (int i = 0; i < 8; ++i) acc[i] = mma(ldsfrag(lds + V_OFF + ((vh * 8 + i) * 16 + fr) * RST + ks * 64 + fq * 16), y, acc[i]); }
        const bf16_t* sp = ST + (((size_t)cidx * 4 + h) * 256 + vh * 128 + fr) * 128 + fq * 8;
#pragma unroll
        for (int ks = 0; ks < (GLA_NO_INTER ? 0 : 4); ++ks) { const bf16x8 y = ldsfrag(lds + Q_OFF + l * RSD + ks * 64 + fq * 16);
#pragma unroll
            for (int i = 0; i < 8; ++i) acc[i] = mma(*(const bf16x8*)(sp + (size_t)i * 16 * 128 + ks * 32), y, acc[i]); }
        float ssq = 0.f;
#pragma unroll
        for (int i = 0; i < 8; ++i) ssq += (acc[i][0] * acc[i][0] + acc[i][1] * acc[i][1]) + (acc[i][2] * acc[i][2] + acc[i][3] * acc[i][3]);
        ssq += __shfl_xor(ssq, 16); ssq += __shfl_xor(ssq, 32);
        if (fq == 0) ssqt[l * 2 + vh] = ssq;
        __syncthreads();
        const float rstd = rsqrtf((ssqt[l * 2] + ssqt[l * 2 + 1]) * (1.f / 256.f) + EPS);
        const size_t t = (size_t)(t0 + l);
#pragma unroll
        for (int i = 0; i < 8; ++i) { const int v = (vh * 8 + i) * 16 + 4 * fq, c = h * 256 + v;
            const u32x2 gw = *(const u32x2*)(GS + t * DM + c); const f32x4 w4 = *(const f32x4*)(nw + v);
            u32x2 o; o.x = pk2(acc[i][0] * rstd * w4[0] * bf_lo(gw.x), acc[i][1] * rstd * w4[1] * bf_hi(gw.x));
            o.y = pk2(acc[i][2] * rstd * w4[2] * bf_lo(gw.y), acc[i][3] * rstd * w4[3] * bf_hi(gw.y));
            *(u32x2*)(YIN + t * DM + c) = o; }
        __syncthreads();
    }
}


#define XB_TMO      128
#define XB_XCNT(j)  (256  + 64 * (j))
#define XB_XSUB(j)  (1280 + 64 * (j))
#define XB_XGEN(j)  (2304 + 64 * (j))
#define XB_TOP      3328
#define XB_TOPGEN   3392
#define XCD_BAR_WORDS 3456
#define XB_SPIN_CAP (1u << 22)
DEV unsigned xb_ld(unsigned* p)              { return __hip_atomic_load(p, __ATOMIC_RELAXED, __HIP_MEMORY_SCOPE_AGENT); }
DEV unsigned xb_add(unsigned* p, unsigned v) { return __hip_atomic_fetch_add(p, v, __ATOMIC_RELAXED, __HIP_MEMORY_SCOPE_AGENT); }
DEV unsigned xb_xcc_id() { return (unsigned)__builtin_amdgcn_s_getreg((3 << 11) | 20) & 0xFu; }
#define XB_SPIN(cond, bar) do { unsigned _sp = 0; while (cond) { __builtin_amdgcn_s_sleep(1); \
    if ((++_sp & 255u) == 0u) { if (xb_ld(&(bar)[XB_TMO])) break; if (_sp > XB_SPIN_CAP) { atomicAdd(&(bar)[XB_TMO], 1u); break; } } } } while (0)
DEV void xcd_barrier_complete(unsigned* bar, unsigned x, unsigned Gn, unsigned& nloc, unsigned& nx) {
    unsigned sum, cnt, mine, sp = 0u;
    for (;;) {
        sum = 0u; cnt = 0u; mine = 0u;
#pragma unroll
        for (unsigned j = 0; j < 16; ++j) { const unsigned c = xb_ld(&bar[XB_XCNT(j)]); sum += c; cnt += (c > 0u) ? 1u : 0u; mine = (j == x) ? c : mine; }
        if (sum == Gn) break;
        __builtin_amdgcn_s_sleep(1);
        if ((++sp & 255u) == 0u) { if (xb_ld(&bar[XB_TMO])) break; if (sp > XB_SPIN_CAP) { atomicAdd(&bar[XB_TMO], 1u); break; } }
    }
    nloc = mine > 0u ? mine : 1u; nx = cnt > 0u ? cnt : 1u;
}
DEV void xcd_barrier(unsigned* bar, unsigned x, volatile LAS unsigned* st, int tid, unsigned Gn) {
    asm volatile("s_waitcnt vmcnt(0)" ::: "memory");
    __syncthreads();
    if (tid == 0) {
        __builtin_amdgcn_s_waitcnt(0);
        unsigned nloc = st[0], nx = st[1];
        if (nloc == 0u) { xcd_barrier_complete(bar, x, Gn, nloc, nx); st[0] = nloc; st[1] = nx; }
        const unsigned old = xb_add(&bar[XB_XSUB(x)], 1u);
        const unsigned gen = old / nloc;
        if (old + 1u == (gen + 1u) * nloc) {
            __builtin_amdgcn_fence(__ATOMIC_RELEASE, "agent");
            asm volatile("s_waitcnt vmcnt(0)" ::: "memory");
            const unsigned og = xb_add(&bar[XB_TOP], 1u);
            const unsigned tg = og / nx;
            if (og + 1u == (tg + 1u) * nx) xb_add(&bar[XB_TOPGEN], 1u);
            else XB_SPIN(xb_ld(&bar[XB_TOPGEN]) == tg, bar);
            __builtin_amdgcn_fence(__ATOMIC_ACQUIRE, "agent");
            xb_add(&bar[XB_XGEN(x)], 1u);
            asm volatile("s_waitcnt vmcnt(0)" ::: "memory");
        } else {
            XB_SPIN(xb_ld(&bar[XB_XGEN(x)]) == gen, bar);
            __builtin_amdgcn_fence(__ATOMIC_ACQUIRE, "agent");
            asm volatile("s_waitcnt vmcnt(0)" ::: "memory");
        }
    }
    __syncthreads();
}

typedef const __attribute__((address_space(4))) Params* KParams;
DEV KParams kargs() { unsigned long long kp = (unsigned long long)__builtin_amdgcn_kernarg_segment_ptr(); asm volatile("" : "+s"(kp)); return (KParams)kp; }

__global__ void __launch_bounds__(NTHR, 2) mega_fwd(Params Parg, int pc_lo, int pc_hi, int coop, int pad_) {
    extern __shared__ __attribute__((aligned(16))) unsigned char smem[];
    cg::grid_group grid = cg::this_grid();
    if (coop) grid.sync();
    volatile LAS unsigned* xst = (volatile LAS unsigned*)((LAS unsigned char*)smem + 139264 - 16);
    const unsigned xcc = xb_xcc_id();
    if (threadIdx.x == 0) { xst[0] = 0u; xst[1] = 0u; (void)xb_add((unsigned*)(asglobal(kargs()->ws) + WS_BAR) + XB_XCNT(xcc), 1u); }
    __syncthreads();
    using pg8::Sched; using pg8::job_put;
    constexpr int PER_LAYER = 1 + 34 + 3, NPC = 2 * PER_LAYER + 1;
#pragma unroll 1
    for (int pc0 = pc_lo; pc0 < pc_hi; ++pc0) {
        int pc = pc0; asm volatile("" : "+s"(pc));
        int tid = threadIdx.x; asm volatile("" : "+v"(tid));
        const int lane = tid & 63, wave = __builtin_amdgcn_readfirstlane(tid >> 6);
        unsigned ldso = 0; asm volatile("" : "+s"(ldso));
        LAS unsigned char* lds = (LAS unsigned char*)smem + ldso;
        int bxv = blockIdx.x, gdv = gridDim.x; asm volatile("" : "+s"(bxv), "+s"(gdv));
        const int layer = pc / PER_LAYER; const int r = pc - layer * PER_LAYER;
        int ph, hf = 0;
        if (pc == NPC - 1) ph = 21; else if (r == 0) ph = 0; else if (r <= 34) { hf = (r - 1) / 17; ph = (r - 1) - hf * 17 + 1; } else ph = 18 + (r - 35);
        asm volatile("" : "+s"(ph), "+s"(hf));
#define P kargs()
#define ws asglobal(kargs()->ws)
#define INP(i) asglobal(kargs()->in[i])
#define OUTP asglobal(kargs()->out)
#define G gdv
#define bx bxv
#define gw (bx * NWAVES + wave)
#define NGW (G * NWAVES)
#define gtid (bx * NTHR + tid)
#define NT (G * NTHR)
#define WIN ((bf16_t*)(ws + WS_WIN))
#define HB ((bf16_t*)(ws + WS_HB))
#define MERGED ((float*)(ws + WS_MERGED))
#define GB ((bf16_t*)(ws + WS_G))
#define YIN ((bf16_t*)(ws + WS_YIN))
#define xsrc (((layer == 0) ? INP(0) : (const float*)OUTP) + (size_t)hf * HT * DM)
#define xdst (OUTP + (size_t)hf * HT * DM)

#define PROBE11 0
#define NOMIX 0
#define NOMLP 0
#ifndef SKIPMASK

#define SKIPMASK 0u
#endif
        if ((SKIPMASK >> ph) & 1u) ph = 99;
#ifdef DELAY_PROBE
        if (bxv == 3) { const unsigned long long t0 = __builtin_amdgcn_s_memrealtime(); while (__builtin_amdgcn_s_memrealtime() - t0 < 30000ull) __builtin_amdgcn_s_sleep(64); }
#endif
        switch (ph) {
        case 0:
            phase_weights(ws, INP(2) + (size_t)layer * 1024 * INW, INP(4) + (size_t)layer * 1048576, INP(11) + (size_t)layer * 1048576, INP(15) + (size_t)layer * 1048576,
                          INP(16) + (size_t)layer * 1048576, INP(18) + (size_t)layer * 4194304, INP(19) + (size_t)layer * 4194304, lds, gw, NGW, wave, lane);
            break;
        case 1:
            phase_rmsnorm_bf16(xsrc, INP(1) + layer * DM, HB, HT, gw, NGW, lane);
            if (DUP2) phase_rmsnorm_bf16(xsrc, INP(1) + layer * DM, HB, HT, gw, NGW, lane);
            break;
        case 2: {
            if (tid == 0) { job_put(lds, 0, HB, WIN, ws + RA_UA, nullptr, 64, 12, 3072, 0); job_put(lds, 1, HB, WIN + (size_t)9248 * DM, GB, nullptr, 64, 4, 1024, 1); }
            Sched S; S.init(lds, 2, G, bx, DM, tid);
            pg8::GEMM_BODY<3>(lds, DM, S, tid);
            phase_narrow(HB, WIN + (size_t)6144 * DM, WIN + (size_t)9232 * DM, (float*)(ws + WS_DTGK), gw, NGW, lane);
            break; }
        case 3:
            phase_conv_a((const bf16_t*)(ws + RA_UA), INP(3) + (size_t)layer * 3 * 1024, YIN, gtid, NT);
            if (DUP2) phase_conv_a((const bf16_t*)(ws + RA_UA), INP(3) + (size_t)layer * 3 * 1024, YIN, gtid, NT);
            break;
        case 4: {
            if (tid == 0) job_put(lds, 0, YIN, ws + WS_WOA, ws + WS_MERGED, GB, 64, 4, 1024, 4);
            Sched S; S.init(lds, 1, G, bx, DM, tid); pg8::GEMM_BODY<16>(lds, DM, S, tid);
            break; }
        case 5: {
            if (tid == 0) { job_put(lds, 0, HB, WIN + (size_t)3072 * DM, ws + RB_Z, nullptr, 64, 4, 1024, 2); job_put(lds, 1, WIN + (size_t)4096 * DM, HB, ws + RB_XST, nullptr, 4, 64, HT, 0);
                            job_put(lds, 2, HB, WIN + (size_t)5120 * DM, ws + RB_BC, nullptr, 64, 4, 1024, 0); job_put(lds, 3, HB, WIN + (size_t)10272 * DM, GB, nullptr, 64, 4, 1024, 1); }
            Sched S; S.init(lds, 4, G, bx, DM, tid); pg8::GEMM_BODY<7>(lds, DM, S, tid);
            break; }
        case 6:
            phase_ssd_prep(ws, INP(5) + (size_t)layer * 4 * 2048, INP(6) + (size_t)layer * 2048, INP(7) + layer * 16, INP(8) + layer * 16, gtid, NT, tid, G, bx);
            if (DUP2) phase_ssd_prep(ws, INP(5) + (size_t)layer * 4 * 2048, INP(6) + (size_t)layer * 2048, INP(7) + layer * 16, INP(8) + layer * 16, gtid, NT, tid, G, bx);
            break;
        case 7: phase_ssd_states(ws, lds, tid, wave, lane); if (DUP) { __syncthreads(); phase_ssd_states(ws, lds, tid, wave, lane); } break;
        case 8: phase_ssd_scan(ws, gtid, NT); break;
        case 9: phase_ssd_out(ws, INP(9) + layer * 16, INP(10) + layer * 1024, lds, tid, wave, lane); if (DUP) { __syncthreads(); phase_ssd_out(ws, INP(9) + layer * 16, INP(10) + layer * 1024, lds, tid, wave, lane); } break;
        case 10: {
            if (tid == 0) job_put(lds, 0, YIN, ws + WS_WOS, ws + WS_MERGED, GB, 64, 4, (int)((WS_MSUM - WS_MERGED) / 4), 5);
            Sched S; S.init(lds, 1, G, bx, DM, tid); pg8::GEMM_BODY<32>(lds, DM, S, tid);
            break; }
        case 11: {
#if PROBE11 == 1
            if (tid == 0) { job_put(lds, 0, HB, WIN + (size_t)11296 * DM, GB, nullptr, 64, 4, 1024, 1); }
            Sched S; S.init(lds, 1, G, bx, DM, tid); pg8::GEMM_BODY<7>(lds, DM, S, tid);
#elif PROBE11 == 2
            if (tid == 0) { job_put(lds, 1, HB, WIN + (size_t)3072 * DM, ws + RB_Z, nullptr, 64, 4, 1024, 2); job_put(lds, 2, WIN + (size_t)4096 * DM, HB, ws + RB_XST, nullptr, 4, 64, HT, 0);
                            job_put(lds, 3, HB, WIN + (size_t)5120 * DM, ws + RB_BC, nullptr, 64, 4, 1024, 0); job_put(lds, 0, HB, WIN + (size_t)10272 * DM, GB, nullptr, 64, 4, 1024, 1); }
            Sched S; S.init(lds, 4, G, bx, DM, tid); pg8::GEMM_BODY<7>(lds, DM, S, tid);
#else
            if (tid == 0) { job_put(lds, 0, HB, WIN + (size_t)6160 * DM, ws + RC_QK, nullptr, 64, 4, 1024, 0); job_put(lds, 1, WIN + (size_t)7184 * DM, HB, ws + RC_VT, nullptr, 4, 64, HT, 0);
                            job_put(lds, 2, HB, WIN + (size_t)8208 * DM, ws + RC_GS, nullptr, 64, 4, 1024, 2); job_put(lds, 3, HB, WIN + (size_t)11296 * DM, GB, nullptr, 64, 4, 1024, 1); }
            Sched S; S.init(lds, 4, G, bx, DM, tid); pg8::GEMM_BODY<7>(lds, DM, S, tid);
#endif
            break; }
        case 12: phase_gla_prep(ws, INP(12) + (size_t)layer * 16 * 512, INP(13) + layer * 512, gtid, NT); break;
        case 13: phase_gla_states(ws, lds, tid, wave, lane); if (DUP) { __syncthreads(); phase_gla_states(ws, lds, tid, wave, lane); } break;
        case 14: phase_gla_scan(ws, gtid, NT); break;
        case 15: phase_gla_out(ws, INP(14) + layer * 256, lds, tid, wave, lane); if (DUP) { __syncthreads(); phase_gla_out(ws, INP(14) + layer * 256, lds, tid, wave, lane); } break;
        case 16: {
            if (tid == 0) job_put(lds, 0, YIN, ws + WS_WOG, ws + WS_MSUM, GB, 64, 4, 1024, 6);
            Sched S; S.init(lds, 1, G, bx, DM, tid); pg8::GEMM_BODY<64>(lds, DM, S, tid);
            break; }
        case 17: {
            if (tid == 0) job_put(lds, 0, GB, ws + WS_WO, xdst, xsrc, 64, 4, NOMIX ? 0 : 1024, 7);
            Sched S; S.init(lds, 1, G, bx, DM, tid); pg8::GEMM_BODY<128>(lds, DM, S, tid);
            break; }
        case 18:
            phase_rmsnorm_bf16(OUTP, INP(17) + layer * DM, (bf16_t*)(ws + WS_MERGED), T_ALL, gw, NGW, lane);
            break;
        case 19: {
            if (tid == 0) job_put(lds, 0, ws + WS_MERGED, ws + WS_WUP, ws + WS_R, nullptr, 128, 16, DFF, 3);
            Sched S; S.init(lds, 1, G, bx, DM, tid); pg8::GEMM_BODY<8>(lds, DM, S, tid);
            break; }
        case 20: {
            if (tid == 0) job_put(lds, 0, ws + WS_R, ws + WS_WDN, OUTP, OUTP, 128, 4, NOMLP ? 0 : 1024, 7);
            Sched S; S.init(lds, 1, G, bx, DFF, tid); pg8::GEMM_BODY<128>(lds, DFF, S, tid);
            break; }
        case 99: {
#ifdef SPIN_PROBE
            if (pc == 6 || pc == 23) { const unsigned long long t0 = __builtin_amdgcn_s_memrealtime(); while (__builtin_amdgcn_s_memrealtime() - t0 < 500000ull) __builtin_amdgcn_s_sleep(64); }
#endif
            break; }
        default:
            phase_rmsnorm_f32(OUTP, INP(20), T_ALL, gw, NGW, lane);
            break;
        }
        if (pc0 != pc_hi - 1) {
            xcd_barrier((unsigned*)(ws + WS_BAR), xcc, xst, tid, (unsigned)gdv);
            if (BAR2) xcd_barrier((unsigned*)(ws + WS_BAR), xcc, xst, tid, (unsigned)gdv);
        }
    }
#undef P
#undef ws
#undef INP
#undef OUTP
#undef G
#undef bx
#undef gw
#undef NGW
#undef gtid
#undef NT
#undef WIN
#undef HB
#undef MERGED
#undef GB
#undef YIN
#undef xsrc
#undef xdst
}

extern "C" void kernel_launch(void* const* d_in, const int* in_sizes, int n_in, void* d_out, int out_size, void* d_ws, size_t ws_size, hipStream_t stream) {
    static int grid = 0;
    if (grid == 0) {
        if (n_in != 21 || out_size != T_ALL * DM || ws_size < WS_TOTAL) { fprintf(stderr, "kernel_launch: unexpected shapes (n_in %d out %d ws %zu need %zu)\n", n_in, out_size, ws_size, (size_t)WS_TOTAL); grid = -1; return; }
        int dev = 0, cus = 0, per_cu = 0;
        hipGetDevice(&dev);
        hipDeviceGetAttribute(&cus, hipDeviceAttributeMultiprocessorCount, dev);
        if (hipFuncSetAttribute((const void*)mega_fwd, hipFuncAttributeMaxDynamicSharedMemorySize, LDS_BYTES) != hipSuccess) { fprintf(stderr, "kernel_launch: hipFuncSetAttribute failed\n"); }
        if (hipOccupancyMaxActiveBlocksPerMultiprocessor(&per_cu, (const void*)mega_fwd, NTHR, LDS_BYTES) != hipSuccess || per_cu < 1) { fprintf(stderr, "kernel_launch: occupancy query says %d\n", per_cu); per_cu = 1; }
        (void)hipGetLastError();
        grid = cus > 0 ? cus : 256;
    }
    if (grid < 0) return;
    if (hipMemsetAsync((char*)d_ws + WS_BAR, 0, 16384, stream) != hipSuccess) { fprintf(stderr, "kernel_launch: memset failed\n"); return; }
    Params p{};
    for (int i = 0; i < 21; ++i) p.in[i] = (const float*)d_in[i];
    p.out = (float*)d_out; p.ws = (unsigned char*)d_ws;
#ifndef N_LAUNCH_SPLIT
#define N_LAUNCH_SPLIT 0
#endif
    constexpr int NPC_H = 2 * 38 + 1;
    if (N_LAUNCH_SPLIT) {
        for (int pc = 0; pc < NPC_H; ++pc) {
            hipLaunchKernelGGL(mega_fwd, dim3(grid), dim3(NTHR), LDS_BYTES, stream, p, pc, pc + 1, 0, 0);
        }
        hipError_t e = hipPeekAtLastError();
        if (e != hipSuccess) fprintf(stderr, "launch failed: %s (grid %d)\n", hipGetErrorString(e), grid);
    } else {
        int lo = 0, hi = NPC_H, coop = 1, pad = 0;
        void* args[] = {&p, &lo, &hi, &coop, &pad};
        hipError_t e = hipLaunchCooperativeKernel((const void*)mega_fwd, dim3(grid), dim3(NTHR), args, LDS_BYTES, stream);
        if (e != hipSuccess) fprintf(stderr, "cooperative launch failed: %s (grid %d)\n", hipGetErrorString(e), grid);
    }
}
```

```cpp
#include <hip/hip_runtime.h>
#include <hip/hip_cooperative_groups.h>
#include <cstdio>
namespace cg = cooperative_groups;

#define LAS __attribute__((address_space(3)))
#define DEV __device__ __forceinline__
typedef unsigned short bf16_t;
typedef short bf16x8 __attribute__((ext_vector_type(8)));
typedef float f32x4 __attribute__((ext_vector_type(4)));
typedef float f32x2 __attribute__((ext_vector_type(2)));
typedef unsigned u32x4 __attribute__((ext_vector_type(4)));
typedef unsigned u32x2 __attribute__((ext_vector_type(2)));

constexpr int T_ALL = 32768, HT = 16384, DM = 1024, SEQ = 8192, INW = 12320, DFF = 4096;
constexpr int NTHR = 512, NWAVES = 8;
constexpr int LDS_BYTES = 136 * 1024;
constexpr float EPS = 1e-6f;

constexpr size_t WS_WIN = 1048576;
constexpr size_t WS_WOA = WS_WIN + (size_t)INW * 1024 * 2 + 1048576;
constexpr size_t WS_WOS = WS_WOA + 2097152;
constexpr size_t WS_WOG = WS_WOS + 2097152;
constexpr size_t WS_WO = WS_WOG + 2097152;
constexpr size_t WS_WUP = WS_WO + 2097152;
constexpr size_t WS_WDN = WS_WUP + 8388608;
constexpr size_t WS_HB = WS_WDN + 8388608;
constexpr size_t WS_MERGED = WS_HB + (size_t)HT * 1024 * 2;
constexpr size_t WS_G = WS_MERGED + (size_t)HT * 1024 * 4;
constexpr size_t WS_YIN = WS_G + (size_t)HT * 1024 * 2;
constexpr size_t WS_DTGK = WS_YIN + (size_t)HT * 1024 * 2;
constexpr size_t WS_R = WS_DTGK + (size_t)HT * 32 * 4;
constexpr size_t RA_UA = WS_R;
constexpr size_t RB_Z = WS_R;
constexpr size_t RB_XST = RB_Z + 33554432;
constexpr size_t RB_BC = RB_XST + 33554432;
constexpr size_t RB_XSTC = RB_BC + 33554432;
constexpr size_t RB_BCC = RB_XSTC + 33554432;
constexpr size_t RB_BTC = RB_BCC + 33554432;
constexpr size_t RB_DT = RB_BTC + 16777216;
constexpr size_t RB_ACUM = RB_DT + 1048576;
constexpr size_t RB_ST = RB_ACUM + 1048576;
constexpr size_t RB_END = RB_ST + 67108864;
constexpr size_t RC_QK = WS_R;
constexpr size_t RC_KT = RC_QK + 33554432;
constexpr size_t RC_VT = RC_KT + 16777216;
constexpr size_t RC_GS = RC_VT + 33554432;
constexpr size_t RC_DEC = RC_GS + 33554432;
constexpr size_t RC_ST = RC_DEC + 524288;
constexpr size_t RC_END = RC_ST + 134217728;
constexpr size_t R_HID_END = WS_R + (size_t)T_ALL * DFF * 2;
constexpr size_t WS_END = (RB_END > RC_END ? (RB_END > R_HID_END ? RB_END : R_HID_END) : (RC_END > R_HID_END ? RC_END : R_HID_END));

constexpr size_t WS_MSUM = (WS_END + 255) & ~(size_t)255;
constexpr size_t WS_BAR = WS_MSUM + (size_t)HT * 1024 * 2;
constexpr size_t WS_DEC = WS_BAR + 16384;
constexpr size_t WS_TOTAL = WS_DEC + 524288;
struct Params { const float* in[21]; float* out; unsigned char* ws; };

DEV unsigned f2bf(float f) { unsigned u = __float_as_uint(f); return (u + 0x7fffu + ((u >> 16) & 1u)) >> 16; }
typedef __bf16 bf16x2_t __attribute__((ext_vector_type(2)));
DEV unsigned pk2(float lo, float hi) { const f32x2 v = {lo, hi}; const bf16x2_t r = __builtin_convertvector(v, bf16x2_t); return __builtin_bit_cast(unsigned, r); }
DEV float bf_lo(unsigned w) { return __uint_as_float(w << 16); }
DEV float bf_hi(unsigned w) { return __uint_as_float(w & 0xffff0000u); }
DEV float bf1(bf16_t h) { return __uint_as_float(((unsigned)h) << 16); }
DEV void unpack8(const u32x4 w, float (&f)[8]) {
    f[0] = bf_lo(w.x); f[1] = bf_hi(w.x); f[2] = bf_lo(w.y); f[3] = bf_hi(w.y);
    f[4] = bf_lo(w.z); f[5] = bf_hi(w.z); f[6] = bf_lo(w.w); f[7] = bf_hi(w.w);
}
DEV u32x4 pack8(const float (&f)[8]) { u32x4 w; w.x = pk2(f[0], f[1]); w.y = pk2(f[2], f[3]); w.z = pk2(f[4], f[5]); w.w = pk2(f[6], f[7]); return w; }
DEV float sigmoidf_(float x) { return __builtin_amdgcn_rcpf(1.0f + __expf(-x)); }
DEV float siluf_(float x) { return x * sigmoidf_(x); }
DEV float softplusf_(float x) { return x > 20.f ? x : (x < -15.f ? __expf(x) : __logf(1.0f + __expf(x))); }
DEV float logsigf_(float x) { const float e = __expf(-fabsf(x)); return fminf(x, 0.f) - (e < 1e-4f ? e : __logf(1.0f + e)); }
DEV float wave_sum(float v) {
#pragma unroll
    for (int o = 1; o < 64; o <<= 1) v += __shfl_xor(v, o);
    return v;
}
DEV f32x4 mma(bf16x8 x, bf16x8 y, f32x4 acc) { return __builtin_amdgcn_mfma_f32_16x16x32_bf16(x, y, acc, 0, 0, 0); }
DEV bf16x8 ldsfrag(const LAS unsigned char* p) { return *(const LAS bf16x8*)p; }
#define SCALE_A 1.f
#define SCALE_B 1.f
#define SCALE_C 1.f
#define DUP 0
#define DUP2 0
#define BAR2 0
#define GLA_NO_INTER 0
#define GLA_ZERO_DEC 0
#ifndef GEMM_BODY
#define GEMM_BODY gemm_phase
#endif
#define LDS_WAIT() asm volatile("s_waitcnt lgkmcnt(0)" ::: "memory")
#define GAS __attribute__((address_space(1)))
template <class T> DEV T* asglobal(T* p) { return (T*)(GAS T*)p; }

namespace pg8 {
constexpr int BM = 256, BK = 64, HALF = 128, HTB = HALF * BK * 2, STAGE_BYTES = 8 * HTB, NXCD = 8, WGM = 8;
DEV int lds_byte(int r, int c) { const int st = (r >> 4) * 2 + (c >> 5), rr = r & 15, cc = c & 31, ob = rr * 64 + cc * 2; return st * 1024 + (ob ^ (((ob >> 9) & 1) << 5)); }
DEV void stage_rc(int b, int& R, int& C) { const int st = b / 1024, sb = b % 1024, swz = sb ^ (((sb >> 9) & 1) << 5); R = (st >> 1) * 16 + swz / 64; C = (st & 1) * 32 + (swz % 64) / 2; }
DEV int perm32(int rho) { const int n = rho >> 4, i = rho & 15; return 8 * (i >> 2) + 4 * n + (i & 3); }

struct Job { const bf16_t* A; const bf16_t* B; void* out; const void* aux; int nM, nN, ldc, kind; };
struct Unit { const char* A; const char* B; int jid, pm, pn; };
constexpr int JT_OFF = 131072;
DEV int rfl(int v) { return __builtin_amdgcn_readfirstlane(v); }
DEV const char* rflp(const LAS int* p) { const unsigned lo = (unsigned)rfl(p[0]), hi = (unsigned)rfl(p[1]); return asglobal((const char*)(((unsigned long long)hi << 32) | lo)); }
DEV void job_put(LAS unsigned char* lds, int q, const void* A, const void* B, void* out, const void* aux, int nM, int nN, int ldc, int kind) {
    LAS int* jt = (LAS int*)(lds + JT_OFF) + q * 12;
    const unsigned long long a = (unsigned long long)A, b = (unsigned long long)B, o = (unsigned long long)out, x = (unsigned long long)aux;
    jt[0] = (int)(unsigned)a; jt[1] = (int)(unsigned)(a >> 32); jt[2] = (int)(unsigned)b; jt[3] = (int)(unsigned)(b >> 32);
    jt[4] = (int)(unsigned)o; jt[5] = (int)(unsigned)(o >> 32); jt[6] = (int)(unsigned)x; jt[7] = (int)(unsigned)(x >> 32);
    jt[8] = nM; jt[9] = nN; jt[10] = ldc; jt[11] = kind;
}
struct Sched {
    LAS unsigned char* lds; int nj, total, G, c; size_t tstep;
    DEV void init(LAS unsigned char* lds_, int nj_, int G_, int c_, int K, int tid_) {
        lds = lds_; nj = nj_; G = G_; c = c_; tstep = (size_t)BM * K * 2;
        __syncthreads();
        LAS int* jt = (LAS int*)(lds + JT_OFF);
        if (tid_ == 0) { int s = 0; for (int q = 0; q < nj; ++q) { jt[48 + q] = s; s += jt[q * 12 + 8] * jt[q * 12 + 9]; } for (int q = nj; q < 5; ++q) jt[48 + q] = s; }
        __syncthreads();
        total = rfl(jt[48 + 4]);
    }
    DEV bool next(int i, Unit& u) const {
        const int L = i * G + c; if (L >= total) return false;
        const LAS int* jt = (const LAS int*)(lds + JT_OFF);
        int jid = 0;
        for (int q = 1; q < nj; ++q) if (L >= rfl(jt[48 + q])) jid = q;
        const LAS int* J = jt + jid * 12;
        const int base = rfl(jt[48 + jid]), nM = rfl(J[8]), nN = rfl(J[9]);
        int wgid = L - base; const int nwg = nM * nN;
        { const int q = nwg / NXCD, r = nwg % NXCD, xcd = wgid % NXCD, off = wgid / NXCD; wgid = (xcd < r ? xcd * (q + 1) : r * (q + 1) + (xcd - r) * q) + off; }
        const int nig = WGM * nN, gid = wgid / nig, fm = gid * WGM, gsz = (nM - fm) < WGM ? (nM - fm) : WGM;
        u.pm = fm + ((wgid % nig) % gsz); u.pn = (wgid % nig) / gsz; u.jid = jid;
        u.A = rflp(J) + (size_t)u.pm * tstep; u.B = rflp(J + 2) + (size_t)u.pn * tstep;
        return true;
    }
};

DEV void st16_wt(GAS u32x4* p, u32x4 v) { asm volatile("global_store_dwordx4 %0, %1, off sc1" :: "v"(p), "v"(v) : "memory"); }
DEV void st16f_wt(GAS f32x4* p, f32x4 v) { asm volatile("global_store_dwordx4 %0, %1, off sc1" :: "v"(p), "v"(v) : "memory"); }
DEV unsigned cvt_pk_bf16(float lo, float hi) { return pk2(lo, hi); }

template <int KIND> DEV void epi_loop(const f32x4 (&acc)[2][2][4][2], const Job& J, const Unit& u, int wr, int wc, int fr, int fq) {
    const int row0 = u.pm * BM + wr * 64 + fr, col0 = u.pn * BM + wc * 32 + 8 * fq;
    GAS bf16_t* const outb = (GAS bf16_t*)J.out; GAS float* const outf = (GAS float*)J.out;
    const GAS float* const auxf = (const GAS float*)J.aux; GAS bf16_t* const auxb = (GAS bf16_t*)const_cast<void*>(J.aux);
#pragma unroll
    for (int ai = 0; ai < 2; ++ai)
#pragma unroll
        for (int m = 0; m < 4; ++m) {
            const size_t row = (size_t)(row0 + ai * HALF + m * 16);
#pragma unroll
            for (int bj = 0; bj < 2; ++bj) {
                const int col = col0 + bj * HALF;
                f32x4 v0 = acc[ai][bj][m][0], v1 = acc[ai][bj][m][1];
                if (KIND <= 3) {
                    if (KIND == 1) {
#pragma unroll
                        for (int e = 0; e < 4; ++e) { v0[e] = sigmoidf_(v0[e]); v1[e] = sigmoidf_(v1[e]); } }
                    if (KIND == 2) {
#pragma unroll
                        for (int e = 0; e < 4; ++e) { v0[e] = siluf_(v0[e]); v1[e] = siluf_(v1[e]); } }
                    if (KIND == 3) {
#pragma unroll
                        for (int e = 0; e < 4; ++e) { float a = fmaxf(v0[e], 0.f), b = fmaxf(v1[e], 0.f); v0[e] = a * a; v1[e] = b * b; } }
                    u32x4 w; w.x = cvt_pk_bf16(v0[0], v0[1]); w.y = cvt_pk_bf16(v0[2], v0[3]); w.z = cvt_pk_bf16(v1[0], v1[1]); w.w = cvt_pk_bf16(v1[2], v1[3]);
                    *(GAS u32x4*)(outb + row * J.ldc + col) = w;
                } else if (KIND == 7) {
                    const GAS float* xin = auxf + row * DM + col; GAS float* xo = outf + row * DM + col;
                    const f32x4 a = *(const GAS f32x4*)xin, b = *(const GAS f32x4*)(xin + 4);
                    const float sc = (J.ldc == 0) ? 0.f : 1.f; *(GAS f32x4*)xo = a + v0 * sc; *(GAS f32x4*)(xo + 4) = b + v1 * sc;
                } else if (KIND == 4) {
                    const u32x4 gw = *(const GAS u32x4*)(auxb + row * DM + col); float g[8]; unpack8(gw, g);
                    f32x4 r0, r1;
#pragma unroll
                    for (int e = 0; e < 4; ++e) { r0[e] = g[e] * v0[e] * SCALE_A; r1[e] = g[4 + e] * v1[e] * SCALE_A; }
                    GAS float* mo = outf + row * DM + col; *(GAS f32x4*)mo = r0; *(GAS f32x4*)(mo + 4) = r1;
                } else if (KIND == 5) {
                    const u32x4 gw = *(const GAS u32x4*)(auxb + row * DM + col); float g[8]; unpack8(gw, g);
                    const GAS float* mo = outf + row * DM + col; const f32x4 m0 = *(const GAS f32x4*)mo, m1 = *(const GAS f32x4*)(mo + 4);
#pragma unroll
                    for (int e = 0; e < 8; ++e) g[e] *= SCALE_B;
                    u32x4 w; w.x = cvt_pk_bf16(m0[0] + g[0] * v0[0], m0[1] + g[1] * v0[1]); w.y = cvt_pk_bf16(m0[2] + g[2] * v0[2], m0[3] + g[3] * v0[3]);
                    w.z = cvt_pk_bf16(m1[0] + g[4] * v1[0], m1[1] + g[5] * v1[1]); w.w = cvt_pk_bf16(m1[2] + g[6] * v1[2], m1[3] + g[7] * v1[3]);
                    *(GAS u32x4*)((GAS bf16_t*)(outf + (size_t)J.ldc) + row * DM + col) = w;
                } else {
                    GAS bf16_t* gp = auxb + row * DM + col;
                    const u32x4 gw = *(const GAS u32x4*)gp, aw = *(const GAS u32x4*)(outb + row * DM + col);
                    float g[8], a[8]; unpack8(gw, g); unpack8(aw, a);
#pragma unroll
                    for (int e = 0; e < 8; ++e) g[e] *= SCALE_C;
                    u32x4 w; w.x = cvt_pk_bf16(a[0] + g[0] * v0[0], a[1] + g[1] * v0[1]); w.y = cvt_pk_bf16(a[2] + g[2] * v0[2], a[3] + g[3] * v0[3]);
                    w.z = cvt_pk_bf16(a[4] + g[4] * v1[0], a[5] + g[5] * v1[1]); w.w = cvt_pk_bf16(a[6] + g[6] * v1[2], a[7] + g[7] * v1[3]);
                    *(GAS u32x4*)gp = w;
                }
            }
        }
}

template <int MASK> DEV void run_epi(const Sched& S, const Unit& u, const f32x4 (&acc)[2][2][4][2], int wr, int wc, int fr, int fq) {
    const LAS int* Jp = (const LAS int*)(S.lds + JT_OFF) + u.jid * 12;
    Job J; J.A = nullptr; J.B = nullptr; J.out = (void*)rflp(Jp + 4); J.aux = (const void*)rflp(Jp + 6); J.nM = 0; J.nN = 0; J.ldc = rfl(Jp[10]); J.kind = rfl(Jp[11]);
    const int k = J.kind;
    if ((MASK & 1) && k == 0) epi_loop<0>(acc, J, u, wr, wc, fr, fq);
    else if ((MASK & 2) && k == 1) epi_loop<1>(acc, J, u, wr, wc, fr, fq);
    else if ((MASK & 4) && k == 2) epi_loop<2>(acc, J, u, wr, wc, fr, fq);
    else if ((MASK & 8) && k == 3) epi_loop<3>(acc, J, u, wr, wc, fr, fq);
    else if ((MASK & 16) && k == 4) epi_loop<4>(acc, J, u, wr, wc, fr, fq);
    else if ((MASK & 32) && k == 5) epi_loop<5>(acc, J, u, wr, wc, fr, fq);
    else if ((MASK & 64) && k == 6) epi_loop<6>(acc, J, u, wr, wc, fr, fq);
    else if ((MASK & 128) && k == 7) epi_loop<7>(acc, J, u, wr, wc, fr, fq);
}

template <int MASK>
DEV void gemm_phase(LAS unsigned char* lds, const int K, const Sched& S, const int tid) {
    const int wid = __builtin_amdgcn_readfirstlane(tid >> 6), lane = tid & 63, wr = wid >> 2, wc = wid & 3, fr = lane & 15, fq = lane >> 4;
    const int nt = K / BK;
    unsigned voffA[2], voffB[2];
#pragma unroll
    for (int i = 0; i < 2; ++i) { int R, C; stage_rc(tid * 16 + i * 8192, R, C); const int Rb = (R & ~31) + perm32(R & 31);
        voffA[i] = (unsigned)(R * K + C) * 2u; voffB[i] = (unsigned)(Rb * K + C) * 2u; }
    const size_t kstep = (size_t)(BK * 2);
    const size_t hstep = (size_t)HALF * K * 2;
    const unsigned ldsw = (unsigned)wid * 1024u;
    const int aoff = lds_byte(wr * 64 + fr, fq * 8), boff = lds_byte(wc * 32 + fr, fq * 8);
#define PG8_SA(b, h) (((b) * 2 + (h)) * HTB)
#define PG8_SB(b, h) ((4 + (b) * 2 + (h)) * HTB)
#define PG8_STAGE(bufoff, gbase, voff) do { _Pragma("unroll") for (int _i = 0; _i < 2; ++_i) \
        __builtin_amdgcn_global_load_lds((const unsigned*)((const char*)(gbase) + (voff)[_i]), (LAS unsigned*)(lds + (bufoff) + ldsw + _i * 8192), 16, 0, 0); } while (0)
#define PG8_LDA(dst, b, h) do { _Pragma("unroll") for (int m = 0; m < 4; ++m) _Pragma("unroll") for (int k = 0; k < 2; ++k) dst[m][k] = *(const LAS bf16x8*)(lds + PG8_SA(b, h) + aoff + m * 2048 + k * 1024); } while (0)
#define PG8_LDB(dst, b, h) do { _Pragma("unroll") for (int n = 0; n < 2; ++n) _Pragma("unroll") for (int k = 0; k < 2; ++k) dst[n][k] = *(const LAS bf16x8*)(lds + PG8_SB(b, h) + boff + n * 2048 + k * 1024); } while (0)
#define PG8_MMA(ai, bj, At, Bt) do { __builtin_amdgcn_s_setprio(1); _Pragma("unroll") for (int m = 0; m < 4; ++m) _Pragma("unroll") for (int n = 0; n < 2; ++n) _Pragma("unroll") for (int k = 0; k < 2; ++k) \
        acc[ai][bj][m][n] = __builtin_amdgcn_mfma_f32_16x16x32_bf16(Bt[n][k], At[m][k], acc[ai][bj][m][n], 0, 0, 0); __builtin_amdgcn_s_setprio(0); } while (0)
#define PG8_WAIT_V(n) asm volatile("s_waitcnt vmcnt(" #n ")" ::: "memory")
#define PG8_WAIT_L(n) asm volatile("s_waitcnt lgkmcnt(" #n ")" ::: "memory")
#define PG8_BAR __builtin_amdgcn_s_barrier()
#define PG8_SCHED __builtin_amdgcn_sched_barrier(0)
    Unit cur, nxt; int ui = 0;
    if (!S.next(0, cur)) return;
    f32x4 acc[2][2][4][2];
#pragma unroll
    for (int a = 0; a < 2; ++a)
#pragma unroll
        for (int b = 0; b < 2; ++b)
#pragma unroll
            for (int m = 0; m < 4; ++m)
#pragma unroll
                for (int n = 0; n < 2; ++n) acc[a][b][m][n] = (f32x4){0.f, 0.f, 0.f, 0.f};
    bf16x8 At[4][2], B0[2][2], B1[2][2];
    const char* cA = cur.A; const char* cB = cur.B;
    PG8_STAGE(PG8_SB(0, 0), cB, voffB); PG8_STAGE(PG8_SA(0, 0), cA, voffA); PG8_STAGE(PG8_SB(0, 1), cB + hstep, voffB); PG8_STAGE(PG8_SA(0, 1), cA + hstep, voffA);
    if (wr == 1) PG8_BAR;
    PG8_WAIT_V(4); PG8_BAR;
    PG8_STAGE(PG8_SB(1, 0), cB + kstep, voffB); PG8_STAGE(PG8_SA(1, 0), cA + kstep, voffA); PG8_STAGE(PG8_SB(1, 1), cB + hstep + kstep, voffB);
    PG8_WAIT_V(6); PG8_BAR;
    for (;;) {
        const bool has_next = S.next(ui + 1, nxt);
        const char* nA = has_next ? nxt.A : cA; const char* nB = has_next ? nxt.B : cB;
        for (int t = 0; t < nt; t += 2) {
            const bool last = (t == nt - 2);
            const char* a1 = cA + (size_t)(t + 1) * kstep;
            const char* a2 = last ? nA : cA + (size_t)(t + 2) * kstep; const char* b2 = last ? nB : cB + (size_t)(t + 2) * kstep;
            const char* a3 = a2 + kstep; const char* b3 = b2 + kstep;
            PG8_LDB(B0, 0, 0); PG8_SCHED; PG8_LDA(At, 0, 0); PG8_STAGE(PG8_SA(1, 1), a1 + hstep, voffA);
            PG8_WAIT_L(8); PG8_BAR; PG8_WAIT_L(0); PG8_MMA(0, 0, At, B0); PG8_BAR; PG8_SCHED;
            PG8_LDB(B1, 0, 1); PG8_STAGE(PG8_SB(0, 0), b2, voffB);
            PG8_BAR; PG8_WAIT_L(0); PG8_MMA(0, 1, At, B1); PG8_BAR;
            PG8_LDA(At, 0, 1); PG8_STAGE(PG8_SA(0, 0), a2, voffA);
            PG8_BAR; PG8_WAIT_L(0); PG8_MMA(1, 0, At, B0); PG8_BAR; PG8_SCHED;
            PG8_STAGE(PG8_SB(0, 1), b2 + hstep, voffB);
            PG8_WAIT_V(6); PG8_BAR; PG8_MMA(1, 1, At, B1); PG8_BAR;
            PG8_LDB(B0, 1, 0); PG8_SCHED; PG8_LDA(At, 1, 0); PG8_STAGE(PG8_SA(0, 1), a2 + hstep, voffA);
            PG8_WAIT_L(8); PG8_BAR; PG8_WAIT_L(0); PG8_MMA(0, 0, At, B0); PG8_BAR; PG8_SCHED;
            PG8_LDB(B1, 1, 1); PG8_STAGE(PG8_SB(1, 0), b3, voffB);
            PG8_BAR; PG8_WAIT_L(0); PG8_MMA(0, 1, At, B1); PG8_BAR;
            PG8_LDA(At, 1, 1); PG8_STAGE(PG8_SA(1, 0), a3, voffA);
            PG8_BAR; PG8_WAIT_L(0); PG8_MMA(1, 0, At, B0); PG8_BAR; PG8_SCHED;
            PG8_STAGE(PG8_SB(1, 1), b3 + hstep, voffB);
            PG8_WAIT_V(6); PG8_BAR; PG8_MMA(1, 1, At, B1); PG8_BAR;
        }
        run_epi<MASK>(S, cur, acc, wr, wc, fr, fq);
        if (!has_next) break;
#pragma unroll
        for (int a = 0; a < 2; ++a)
#pragma unroll
            for (int b = 0; b < 2; ++b)
#pragma unroll
                for (int m = 0; m < 4; ++m)
#pragma unroll
                    for (int n = 0; n < 2; ++n) acc[a][b][m][n] = (f32x4){0.f, 0.f, 0.f, 0.f};
        cur = nxt; cA = nA; cB = nB; ++ui;
    }
    PG8_WAIT_V(0);
    if (wr == 0) PG8_BAR;
    PG8_BAR;
#undef PG8_SA
#undef PG8_SB
#undef PG8_STAGE
#undef PG8_LDA
#undef PG8_LDB
#undef PG8_MMA
#undef PG8_WAIT_V
#undef PG8_WAIT_L
#undef PG8_BAR
#undef PG8_SCHED
}

template <int MASK>
DEV void gemm_simple(LAS unsigned char* lds, const int K, const Sched& S, const int tid) {
    const int wid = __builtin_amdgcn_readfirstlane(tid >> 6), lane = tid & 63, wr = wid >> 2, wc = wid & 3, fr = lane & 15, fq = lane >> 4;
    const int nt = K / BK;
    unsigned voffA[2], voffB[2];
#pragma unroll
    for (int i = 0; i < 2; ++i) { int R, C; stage_rc(tid * 16 + i * 8192, R, C); const int Rb = (R & ~31) + perm32(R & 31);
        voffA[i] = (unsigned)(R * K + C) * 2u; voffB[i] = (unsigned)(Rb * K + C) * 2u; }
    const size_t kstep = (size_t)(BK * 2), hstep = (size_t)HALF * K * 2;
    const unsigned ldsl = (unsigned)wid * 1024u + (unsigned)lane * 16u;
    const int aoff = lds_byte(wr * 64 + fr, fq * 8), boff = lds_byte(wc * 32 + fr, fq * 8);
#define GS_SA(b, h) (((b) * 2 + (h)) * HTB)
#define GS_SB(b, h) ((4 + (b) * 2 + (h)) * HTB)
#define GS_LOAD(dst, pa, pb) do { _Pragma("unroll") for (int _i = 0; _i < 2; ++_i) { \
        dst[0][_i] = *(const GAS u32x4*)((const GAS char*)(pa) + voffA[_i]); dst[1][_i] = *(const GAS u32x4*)((const GAS char*)(pa) + hstep + voffA[_i]); \
        dst[2][_i] = *(const GAS u32x4*)((const GAS char*)(pb) + voffB[_i]); dst[3][_i] = *(const GAS u32x4*)((const GAS char*)(pb) + hstep + voffB[_i]); } } while (0)
#define GS_WRITE(b, src) do { _Pragma("unroll") for (int _i = 0; _i < 2; ++_i) { \
        *(LAS u32x4*)(lds + GS_SA(b, 0) + ldsl + _i * 8192) = src[0][_i]; *(LAS u32x4*)(lds + GS_SA(b, 1) + ldsl + _i * 8192) = src[1][_i]; \
        *(LAS u32x4*)(lds + GS_SB(b, 0) + ldsl + _i * 8192) = src[2][_i]; *(LAS u32x4*)(lds + GS_SB(b, 1) + ldsl + _i * 8192) = src[3][_i]; } } while (0)
    Unit cur; int ui = 0;
    while (S.next(ui, cur)) {
        f32x4 acc[2][2][4][2];
#pragma unroll
        for (int a = 0; a < 2; ++a)
#pragma unroll
            for (int b = 0; b < 2; ++b)
#pragma unroll
                for (int m = 0; m < 4; ++m)
#pragma unroll
                    for (int n = 0; n < 2; ++n) acc[a][b][m][n] = (f32x4){0.f, 0.f, 0.f, 0.f};
        const char* cA = cur.A; const char* cB = cur.B;
        u32x4 st[4][2];
        GS_LOAD(st, cA, cB);
        GS_WRITE(0, st);
        __syncthreads();
        for (int t = 0; t < nt; ++t) {
            const int b = t & 1;
            if (t + 1 < nt) GS_LOAD(st, cA + (size_t)(t + 1) * kstep, cB + (size_t)(t + 1) * kstep);
#pragma unroll
            for (int ai = 0; ai < 2; ++ai) {
                bf16x8 At[4][2];
#pragma unroll
                for (int m = 0; m < 4; ++m)
#pragma unroll
                    for (int k = 0; k < 2; ++k) At[m][k] = *(const LAS bf16x8*)(lds + (b ? GS_SA(1, 0) : GS_SA(0, 0)) + ai * HTB + aoff + m * 2048 + k * 1024);
#pragma unroll
                for (int bj = 0; bj < 2; ++bj) {
                    bf16x8 Bt[2][2];
#pragma unroll
                    for (int n = 0; n < 2; ++n)
#pragma unroll
                        for (int k = 0; k < 2; ++k) Bt[n][k] = *(const LAS bf16x8*)(lds + (b ? GS_SB(1, 0) : GS_SB(0, 0)) + bj * HTB + boff + n * 2048 + k * 1024);
#pragma unroll
                    for (int m = 0; m < 4; ++m)
#pragma unroll
                        for (int n = 0; n < 2; ++n)
#pragma unroll
                            for (int k = 0; k < 2; ++k) acc[ai][bj][m][n] = __builtin_amdgcn_mfma_f32_16x16x32_bf16(Bt[n][k], At[m][k], acc[ai][bj][m][n], 0, 0, 0);
                }
            }
            if (t + 1 < nt) { if (b) GS_WRITE(0, st); else GS_WRITE(1, st); }
            __syncthreads();
        }
        run_epi<MASK>(S, cur, acc, wr, wc, fr, fq);
        ++ui;
    }
    __syncthreads();
#undef GS_SA
#undef GS_SB
#undef GS_LOAD
#undef GS_WRITE
}
}

DEV void transpose_item(const float* W, int K, int N, bf16_t* WT, LAS float* scr, int item, int lane) {
    const int nblk = N / 32, kb = item / nblk, nb = item % nblk, k0 = 64 * kb, n0 = 32 * nb;
#pragma unroll 8
    for (int i = 0; i < 32; ++i) { const int kk = 2 * i + (lane >> 5); scr[kk * 33 + (lane & 31)] = W[(size_t)(k0 + kk) * N + n0 + (lane & 31)]; }
    LDS_WAIT();
    const int c = lane & 7;
#pragma unroll
    for (int jj = 0; jj < 4; ++jj) { const int n = (lane >> 3) + 8 * jj; const LAS float* s = scr + (8 * c) * 33 + n;
        u32x4 o; o.x = pk2(s[0 * 33], s[1 * 33]); o.y = pk2(s[2 * 33], s[3 * 33]); o.z = pk2(s[4 * 33], s[5 * 33]); o.w = pk2(s[6 * 33], s[7 * 33]);
        *(u32x4*)(WT + (size_t)(n0 + n) * K + k0 + 8 * c) = o; }
    LDS_WAIT();
}

DEV void phase_weights(unsigned char* ws, const float* w_in, const float* w_oa, const float* w_os, const float* w_og, const float* w_o, const float* w_up, const float* w_dn, LAS unsigned char* lds, int gw, int NGW, int wave, int lane) {
    LAS float* scr = (LAS float*)(lds + wave * 8704);
    constexpr int I_IN = 16 * (INW / 32), I_SQ = 16 * 32, I_UP = 16 * 128, I_DN = 64 * 32;
    constexpr int NIT = I_IN + 4 * I_SQ + I_UP + I_DN;
    for (int it = gw; it < NIT; it += NGW) {
        int r = it;
        if (r < I_IN) { transpose_item(w_in, 1024, INW, (bf16_t*)(ws + WS_WIN), scr, r, lane); continue; } r -= I_IN;
        if (r < I_SQ) { transpose_item(w_oa, 1024, 1024, (bf16_t*)(ws + WS_WOA), scr, r, lane); continue; } r -= I_SQ;
        if (r < I_SQ) { transpose_item(w_os, 1024, 1024, (bf16_t*)(ws + WS_WOS), scr, r, lane); continue; } r -= I_SQ;
        if (r < I_SQ) { transpose_item(w_og, 1024, 1024, (bf16_t*)(ws + WS_WOG), scr, r, lane); continue; } r -= I_SQ;
        if (r < I_SQ) { transpose_item(w_o, 1024, 1024, (bf16_t*)(ws + WS_WO), scr, r, lane); continue; } r -= I_SQ;
        if (r < I_UP) { transpose_item(w_up, 1024, 4096, (bf16_t*)(ws + WS_WUP), scr, r, lane); continue; } r -= I_UP;
        transpose_item(w_dn, 4096, 1024, (bf16_t*)(ws + WS_WDN), scr, r, lane);
    }
}

DEV void phase_rmsnorm_bf16(const float* x, const float* w, bf16_t* o, int nrows, int gw, int NGW, int lane) {
    for (int m = gw; m < nrows; m += NGW) {
        const f32x4* xr = (const f32x4*)(x + (size_t)m * DM) + lane;
        f32x4 v[4]; float s = 0.f;
#pragma unroll
        for (int j = 0; j < 4; ++j) { v[j] = xr[64 * j]; s += (v[j].x * v[j].x + v[j].y * v[j].y) + (v[j].z * v[j].z + v[j].w * v[j].w); }
        const float rstd = rsqrtf(wave_sum(s) * (1.f / DM) + EPS);
        u32x2* o8 = (u32x2*)(o + (size_t)m * DM) + lane;
#pragma unroll
        for (int j = 0; j < 4; ++j) { const f32x4 ww = ((const f32x4*)w)[lane + 64 * j]; u32x2 r; r.x = pk2(v[j].x * rstd * ww.x, v[j].y * rstd * ww.y); r.y = pk2(v[j].z * rstd * ww.z, v[j].w * rstd * ww.w); o8[64 * j] = r; }
    }
}
DEV void phase_rmsnorm_f32(float* x, const float* w, int nrows, int gw, int NGW, int lane) {
    for (int m = gw; m < nrows; m += NGW) {
        f32x4* xr = (f32x4*)(x + (size_t)m * DM) + lane;
        f32x4 v[4]; float s = 0.f;
#pragma unroll
        for (int j = 0; j < 4; ++j) { v[j] = xr[64 * j]; s += (v[j].x * v[j].x + v[j].y * v[j].y) + (v[j].z * v[j].z + v[j].w * v[j].w); }
        const float rstd = rsqrtf(wave_sum(s) * (1.f / DM) + EPS);
#pragma unroll
        for (int j = 0; j < 4; ++j) { const f32x4 ww = ((const f32x4*)w)[lane + 64 * j]; xr[64 * j] = v[j] * rstd * ww; }
    }
}

DEV void phase_narrow(const bf16_t* HB, const bf16_t* Wdt, const bf16_t* Wgk, float* DTGK, int gw, int NGW, int lane) {
    const int fr = lane & 15, fq = lane >> 4;
    for (int u = gw; u < HT / 16; u += NGW) {
        const int t0 = u * 16;
        f32x4 a0 = {0.f, 0.f, 0.f, 0.f}, a1 = {0.f, 0.f, 0.f, 0.f};
        const bf16_t* ap = HB + (size_t)(t0 + fr) * DM + fq * 8;
        const bf16_t* b0p = Wdt + (size_t)fr * DM + fq * 8;
        const bf16_t* b1p = Wgk + (size_t)fr * DM + fq * 8;
#pragma unroll 4
        for (int k = 0; k < DM; k += 32) {
            const bf16x8 a = *(const bf16x8*)(ap + k), b0 = *(const bf16x8*)(b0p + k), b1 = *(const bf16x8*)(b1p + k);
            a0 = mma(a, b0, a0); a1 = mma(a, b1, a1);
        }
#pragma unroll
        for (int j = 0; j < 4; ++j) { float* d = DTGK + (size_t)(t0 + 4 * fq + j) * 32; d[fr] = a0[j]; d[16 + fr] = a1[j]; }
    }
}

DEV void phase_conv_a(const bf16_t* UA, const float* cw, bf16_t* YIN, int gtid, int NT) {
    for (int u = gtid; u < (HT / 16) * 128; u += NT) {
        const int c0 = (u & 127) * 8, t0 = (u >> 7) * 16;
        float w0[8], w1[8], w2[8], p1[8], p2[8];
#pragma unroll
        for (int j = 0; j < 8; ++j) { w0[j] = cw[c0 + j]; w1[j] = cw[1024 + c0 + j]; w2[j] = cw[2048 + c0 + j]; p1[j] = 0.f; p2[j] = 0.f; }
        if ((t0 & (SEQ - 1)) != 0) {
            float ax[8], ac[8];
            unpack8(*(const u32x4*)(UA + (size_t)(t0 - 2) * 3072 + c0), ax); unpack8(*(const u32x4*)(UA + (size_t)(t0 - 2) * 3072 + 2048 + c0), ac);
#pragma unroll
            for (int j = 0; j < 8; ++j) p2[j] = ax[j] * ac[j];
            unpack8(*(const u32x4*)(UA + (size_t)(t0 - 1) * 3072 + c0), ax); unpack8(*(const u32x4*)(UA + (size_t)(t0 - 1) * 3072 + 2048 + c0), ac);
#pragma unroll
            for (int j = 0; j < 8; ++j) p1[j] = ax[j] * ac[j];
        }
#pragma unroll 4
        for (int i = 0; i < 16; ++i) {
            const bf16_t* rp = UA + (size_t)(t0 + i) * 3072 + c0;
            float ax[8], ab[8], ac[8], o[8];
            unpack8(*(const u32x4*)rp, ax); unpack8(*(const u32x4*)(rp + 1024), ab); unpack8(*(const u32x4*)(rp + 2048), ac);
#pragma unroll
            for (int j = 0; j < 8; ++j) { const float p0 = ax[j] * ac[j]; o[j] = ab[j] * (w0[j] * p2[j] + w1[j] * p1[j] + w2[j] * p0); p2[j] = p1[j]; p1[j] = p0; }
            *(u32x4*)(YIN + (size_t)(t0 + i) * DM + c0) = pack8(o);
        }
    }
}

DEV void phase_ssd_prep(unsigned char* ws, const float* cw, const float* cb, const float* dtb, const float* alog, int gtid, int NT, int tid, int nblk, int blk) {
    const bf16_t* XST = (const bf16_t*)(ws + RB_XST); bf16_t* XSTC = (bf16_t*)(ws + RB_XSTC);
    for (int u = gtid; u < 1024 * (HT / 8); u += NT) {
        const int tb = u & (HT / 8 - 1), c = u >> 11, t0 = tb * 8;
        float x[11], cur[8];
        unpack8(*(const u32x4*)(XST + (size_t)c * HT + t0), cur);
        if ((t0 & (SEQ - 1)) != 0) { float pv[8]; unpack8(*(const u32x4*)(XST + (size_t)c * HT + t0 - 8), pv); x[0] = pv[5]; x[1] = pv[6]; x[2] = pv[7]; }
        else { x[0] = 0.f; x[1] = 0.f; x[2] = 0.f; }
#pragma unroll
        for (int i = 0; i < 8; ++i) x[3 + i] = cur[i];
        const float w0 = cw[c], w1 = cw[2048 + c], w2 = cw[4096 + c], w3 = cw[6144 + c], b = cb[c];
        float y[8];
#pragma unroll
        for (int i = 0; i < 8; ++i) y[i] = siluf_(b + w0 * x[i] + w1 * x[i + 1] + w2 * x[i + 2] + w3 * x[i + 3]);
        *(u32x4*)(XSTC + (size_t)c * HT + t0) = pack8(y);
    }
    const bf16_t* BC = (const bf16_t*)(ws + RB_BC); bf16_t* BCC = (bf16_t*)(ws + RB_BCC); bf16_t* BTC = (bf16_t*)(ws + RB_BTC);
    for (int u = gtid; u < (HT / 8) * 128; u += NT) {
        const int cg8 = u & 127, c0 = cg8 * 8, t0 = (u >> 7) * 8, cc = 1024 + c0;
        float w0[8], w1[8], w2[8], w3[8], bb[8], x1[8], x2[8], x3[8];
#pragma unroll
        for (int j = 0; j < 8; ++j) { w0[j] = cw[cc + j]; w1[j] = cw[2048 + cc + j]; w2[j] = cw[4096 + cc + j]; w3[j] = cw[6144 + cc + j]; bb[j] = cb[cc + j]; x1[j] = 0.f; x2[j] = 0.f; x3[j] = 0.f; }
        if ((t0 & (SEQ - 1)) != 0) {
            unpack8(*(const u32x4*)(BC + (size_t)(t0 - 1) * DM + c0), x1); unpack8(*(const u32x4*)(BC + (size_t)(t0 - 2) * DM + c0), x2); unpack8(*(const u32x4*)(BC + (size_t)(t0 - 3) * DM + c0), x3);
        }
        unsigned tr[8][4];
#pragma unroll
        for (int i = 0; i < 8; ++i) {
            float x0[8], y[8];
            unpack8(*(const u32x4*)(BC + (size_t)(t0 + i) * DM + c0), x0);
#pragma unroll
            for (int j = 0; j < 8; ++j) { y[j] = siluf_(bb[j] + w3[j] * x0[j] + w2[j] * x1[j] + w1[j] * x2[j] + w0[j] * x3[j]); x3[j] = x2[j]; x2[j] = x1[j]; x1[j] = x0[j]; }
            *(u32x4*)(BCC + (size_t)(t0 + i) * DM + c0) = pack8(y);
#pragma unroll
            for (int j = 0; j < 8; ++j) { if (i & 1) tr[j][i >> 1] |= f2bf(y[j]) << 16; else tr[j][i >> 1] = f2bf(y[j]); }
        }
        if (cg8 < 64) {
#pragma unroll
            for (int j = 0; j < 8; ++j) *(u32x4*)(BTC + (size_t)(c0 + j) * HT + t0) = (u32x4){tr[j][0], tr[j][1], tr[j][2], tr[j][3]};
        }
    }
    const float* DTGK = (const float*)(ws + WS_DTGK); float* DT = (float*)(ws + RB_DT); float* AC = (float*)(ws + RB_ACUM);
    {
        const int idx = tid * nblk + blk;
        for (int e = idx; e < (HT / 128) * 16; e += NT) {
            const int h = e & 15, ch = e >> 4; const float a = -__expf(alog[h]), bias = dtb[h]; float acc = 0.f;
            for (int i = 0; i < 128; ++i) { const size_t t = (size_t)ch * 128 + i; const float d = softplusf_(DTGK[t * 32 + h] + bias); acc += d * a; DT[t * 16 + h] = d; AC[t * 16 + h] = acc; }
        }
    }
}

DEV void phase_ssd_states(unsigned char* ws, LAS unsigned char* lds, int tid, int wave, int lane) {
    const bf16_t* XSTC = (const bf16_t*)(ws + RB_XSTC); const bf16_t* BTC = (const bf16_t*)(ws + RB_BTC);
    const float* DT = (const float*)(ws + RB_DT); const float* AC = (const float*)(ws + RB_ACUM); bf16_t* ST = (bf16_t*)(ws + RB_ST);
    constexpr int BT_OFF = 0, XW_OFF = 34816, TAB_OFF = 34816 + 69632, RS = 272;
    LAS float* wt = (LAS float*)(lds + TAB_OFF);
    const int fr = lane & 15, fq = lane >> 4;
    for (int unit = blockIdx.x; unit < (HT / 128) * 4; unit += gridDim.x) {
        const int cidx = unit >> 2, g = unit & 3, t0 = cidx * 128;
        { const int r = tid >> 7, l = tid & 127, h = g * 4 + r;
          const float al = AC[(size_t)(t0 + 127) * 16 + h], a = AC[(size_t)(t0 + l) * 16 + h];
          wt[r * 128 + l] = DT[(size_t)(t0 + l) * 16 + h] * __expf(al - a); }
        for (int i = tid; i < 2048; i += NTHR) { const int row = i >> 4, ch = i & 15;
            *(LAS u32x4*)(lds + BT_OFF + row * RS + ch * 16) = *(const u32x4*)(BTC + (size_t)(g * 128 + row) * HT + t0 + ch * 8); }
        __syncthreads();
        for (int i = tid; i < 4096; i += NTHR) { const int row = i >> 4, ch = i & 15; float f[8];
            unpack8(*(const u32x4*)(XSTC + (size_t)(g * 256 + row) * HT + t0 + ch * 8), f);
            const LAS float* wp = wt + (row >> 6) * 128 + ch * 8;
#pragma unroll
            for (int e = 0; e < 8; ++e) f[e] *= wp[e];
            *(LAS u32x4*)(lds + XW_OFF + row * RS + ch * 16) = pack8(f); }
        __syncthreads();
        f32x4 acc[2][8];
#pragma unroll
        for (int a = 0; a < 2; ++a)
#pragma unroll
            for (int b = 0; b < 8; ++b) acc[a][b] = (f32x4){0.f, 0.f, 0.f, 0.f};
#pragma unroll
        for (int ks = 0; ks < 4; ++ks) {
            const bf16x8 y0 = ldsfrag(lds + XW_OFF + (wave * 32 + fr) * RS + ks * 64 + fq * 16), y1 = ldsfrag(lds + XW_OFF + (wave * 32 + 16 + fr) * RS + ks * 64 + fq * 16);
#pragma unroll
            for (int nt = 0; nt < 8; ++nt) { const bf16x8 x = ldsfrag(lds + BT_OFF + (nt * 16 + fr) * RS + ks * 64 + fq * 16); acc[0][nt] = mma(x, y0, acc[0][nt]); acc[1][nt] = mma(x, y1, acc[1][nt]); }
        }
#pragma unroll
        for (int yt = 0; yt < 2; ++yt) { const int pp = wave * 32 + yt * 16 + fr, h = g * 4 + (pp >> 6), p = pp & 63;
            bf16_t* d = ST + (((size_t)cidx * 16 + h) * 64 + p) * 128 + 4 * fq;
#pragma unroll
            for (int nt = 0; nt < 8; ++nt) { u32x2 w; w.x = pk2(acc[yt][nt][0], acc[yt][nt][1]); w.y = pk2(acc[yt][nt][2], acc[yt][nt][3]); *(u32x2*)(d + nt * 16) = w; } }
        __syncthreads();
    }
}

DEV void phase_ssd_scan(unsigned char* ws, int gtid, int NT) {
    unsigned* ST = (unsigned*)(ws + RB_ST); const float* AC = (const float*)(ws + RB_ACUM);
    for (int e = gtid; e < 2 * 65536; e += NT) {
        const int bl = e >> 16, rem = e & 65535, h = rem >> 12;
        f32x2 carry = {0.f, 0.f};
        for (int c0 = 0; c0 < 64; c0 += 8) {
            unsigned v[8]; float dec[8];
#pragma unroll
            for (int i = 0; i < 8; ++i) { const int cidx = bl * 64 + c0 + i; v[i] = ST[(size_t)cidx * 65536 + rem]; dec[i] = __expf(AC[((size_t)cidx * 128 + 127) * 16 + h]); }
#pragma unroll
            for (int i = 0; i < 8; ++i) { const int cidx = bl * 64 + c0 + i; ST[(size_t)cidx * 65536 + rem] = pk2(carry[0], carry[1]);
                carry[0] = carry[0] * dec[i] + bf_lo(v[i]); carry[1] = carry[1] * dec[i] + bf_hi(v[i]); }
        }
    }
}

DEV void phase_ssd_out(unsigned char* ws, const float* dsk, const float* nw, LAS unsigned char* lds, int tid, int wave, int lane) {
    const bf16_t* XSTC = (const bf16_t*)(ws + RB_XSTC); const bf16_t* BCC = (const bf16_t*)(ws + RB_BCC); const bf16_t* Z = (const bf16_t*)(ws + RB_Z);
    const float* DT = (const float*)(ws + RB_DT); const float* AC = (const float*)(ws + RB_ACUM); const bf16_t* ST = (const bf16_t*)(ws + RB_ST);
    bf16_t* YIN = (bf16_t*)(ws + WS_YIN);
    float* YT = (float*)(ws + RB_XST);
    constexpr int C_OFF = 0, B_OFF = 34816, PV_OFF = 34816, XS_OFF = 34816 + 17408, M_OFF = 69632, TAB_OFF = 104448, RS = 272;
    LAS float* tac = (LAS float*)(lds + TAB_OFF); LAS float* tdt = tac + 512;
    const int fr = lane & 15, fq = lane >> 4;
    LAS unsigned char* Mw = lds + M_OFF + wave * 4352;
    for (int unit = blockIdx.x; unit < (HT / 128) * 4; unit += gridDim.x) {
        const int cidx = unit >> 2, g = unit & 3, t0 = cidx * 128;
        for (int i = tid; i < 2048; i += NTHR) { const int row = i >> 4, ch = i & 15;
            *(LAS u32x4*)(lds + C_OFF + row * RS + ch * 16) = *(const u32x4*)(BCC + (size_t)(t0 + row) * DM + 512 + g * 128 + ch * 8);
            *(LAS u32x4*)(lds + B_OFF + row * RS + ch * 16) = *(const u32x4*)(BCC + (size_t)(t0 + row) * DM + g * 128 + ch * 8); }
        { const int r = tid >> 7, l = tid & 127, h = g * 4 + r; tac[tid] = AC[(size_t)(t0 + l) * 16 + h]; tdt[tid] = DT[(size_t)(t0 + l) * 16 + h]; }
        __syncthreads();
        f32x4 cb[8];
#pragma unroll
        for (int st = 0; st < 8; ++st) cb[st] = (f32x4){0.f, 0.f, 0.f, 0.f};
#pragma unroll
        for (int ks = 0; ks < 4; ++ks) {
            const bf16x8 y = ldsfrag(lds + C_OFF + (wave * 16 + fr) * RS + ks * 64 + fq * 16);
#pragma unroll
            for (int st = 0; st < 8; ++st) cb[st] = mma(ldsfrag(lds + B_OFF + (st * 16 + fr) * RS + ks * 64 + fq * 16), y, cb[st]);
        }
        __syncthreads();
        const int l = wave * 16 + fr;
        const size_t t = (size_t)(t0 + l);
        float ssq = 0.f;
#pragma unroll 1
        for (int r = 0; r < 4; ++r) {
            const int h = g * 4 + r;
            for (int i = tid; i < 1024; i += NTHR) { const int row = i >> 4, ch = i & 15;
                *(LAS u32x4*)(lds + PV_OFF + row * RS + ch * 16) = *(const u32x4*)(ST + (((size_t)cidx * 16 + h) * 64 + row) * 128 + ch * 8); }
            for (int i = tid; i < 1024; i += NTHR) { const int row = i >> 4, ch = i & 15;
                *(LAS u32x4*)(lds + XS_OFF + row * RS + ch * 16) = *(const u32x4*)(XSTC + (size_t)(h * 64 + row) * HT + t0 + ch * 8); }
            const float al = tac[r * 128 + l];
#pragma unroll
            for (int st = 0; st < 8; ++st) { float m[4];
#pragma unroll
                for (int j = 0; j < 4; ++j) { const int s = st * 16 + 4 * fq + j; const float d = fminf(al - tac[r * 128 + s], 0.f); m[j] = (s <= l) ? cb[st][j] * __expf(d) * tdt[r * 128 + s] : 0.f; }
                u32x2 w; w.x = pk2(m[0], m[1]); w.y = pk2(m[2], m[3]); *(LAS u32x2*)(Mw + fr * RS + (st * 16 + 4 * fq) * 2) = w; }
            __syncthreads();
            f32x4 acc[4];
#pragma unroll
            for (int pt = 0; pt < 4; ++pt) acc[pt] = (f32x4){0.f, 0.f, 0.f, 0.f};
#pragma unroll
            for (int ks = 0; ks < 4; ++ks) { const bf16x8 y = ldsfrag(lds + C_OFF + l * RS + ks * 64 + fq * 16);
#pragma unroll
                for (int pt = 0; pt < 4; ++pt) acc[pt] = mma(ldsfrag(lds + PV_OFF + (pt * 16 + fr) * RS + ks * 64 + fq * 16), y, acc[pt]); }
            const float el = __expf(al);
#pragma unroll
            for (int pt = 0; pt < 4; ++pt) acc[pt] *= el;
#pragma unroll
            for (int ks = 0; ks < 4; ++ks) { const bf16x8 y = ldsfrag(Mw + fr * RS + ks * 64 + fq * 16);
#pragma unroll
                for (int pt = 0; pt < 4; ++pt) acc[pt] = mma(ldsfrag(lds + XS_OFF + (pt * 16 + fr) * RS + ks * 64 + fq * 16), y, acc[pt]); }
            const float dh = dsk[h];
#pragma unroll
            for (int pt = 0; pt < 4; ++pt) {
#pragma unroll
                for (int j = 0; j < 4; ++j) { const bf16_t xv = *(const LAS bf16_t*)(lds + XS_OFF + (pt * 16 + 4 * fq + j) * RS + l * 2); acc[pt][j] += dh * bf1(xv); }
                const int c = g * 256 + r * 64 + pt * 16 + 4 * fq;
                const u32x2 zw = *(const u32x2*)(Z + t * DM + c);
                f32x4 v = acc[pt]; v[0] *= bf_lo(zw.x); v[1] *= bf_hi(zw.x); v[2] *= bf_lo(zw.y); v[3] *= bf_hi(zw.y);
                ssq += (v[0] * v[0] + v[1] * v[1]) + (v[2] * v[2] + v[3] * v[3]);
                *(f32x4*)(YT + t * DM + c) = v;
            }
            __syncthreads();
        }
        ssq += __shfl_xor(ssq, 16); ssq += __shfl_xor(ssq, 32);
        const float rstd = rsqrtf(ssq * (1.f / 256.f) + EPS);
#pragma unroll 4
        for (int q = 0; q < 16; ++q) { const int c = g * 256 + q * 16 + 4 * fq;
            const f32x4 w4 = *(const f32x4*)(nw + c); const f32x4 v = *(const f32x4*)(YT + t * DM + c);
            u32x2 o; o.x = pk2(v[0] * rstd * w4[0], v[1] * rstd * w4[1]); o.y = pk2(v[2] * rstd * w4[2], v[3] * rstd * w4[3]);
            *(u32x2*)(YIN + t * DM + c) = o; }
        __syncthreads();
    }
}

DEV float gla_gk(const float* DTGK, size_t t, const float (&w)[16], float b) {
    const f32x4* gl = (const f32x4*)(DTGK + t * 32 + 16);
    const f32x4 g0 = gl[0], g1 = gl[1], g2 = gl[2], g3 = gl[3];
    float z = b;
    z += g0[0] * w[0] + g0[1] * w[1] + g0[2] * w[2] + g0[3] * w[3];
    z += g1[0] * w[4] + g1[1] * w[5] + g1[2] * w[6] + g1[3] * w[7];
    z += g2[0] * w[8] + g2[1] * w[9] + g2[2] * w[10] + g2[3] * w[11];
    z += g3[0] * w[12] + g3[1] * w[13] + g3[2] * w[14] + g3[3] * w[15];
    return logsigf_(z) * (1.f / 16.f);
}
DEV void phase_gla_prep(unsigned char* ws, const float* w2, const float* bg, int gtid, int NT) {
    bf16_t* QK = (bf16_t*)(ws + RC_QK); bf16_t* KT = (bf16_t*)(ws + RC_KT); float* DEC = (float*)(ws + WS_DEC);
    const float* DTGK = (const float*)(ws + WS_DTGK);
    for (int e = gtid; e < (HT / 64) * 512; e += NT) {
        const int d = e & 511, ch = e >> 9, t0 = ch * 64;
        float w[16];
#pragma unroll
        for (int j = 0; j < 16; ++j) w[j] = w2[j * 512 + d];
        const float b = bg[d];
        float glast = 0.f;
#pragma unroll 4
        for (int i = 0; i < 64; ++i) glast += gla_gk(DTGK, (size_t)(t0 + i), w, b);
        float run = 0.f;
        bf16_t* kd = KT + (size_t)d * HT + t0;
#pragma unroll 1
        for (int m = 0; m < 8; ++m) {
            unsigned tr[4];
#pragma unroll
            for (int ii = 0; ii < 8; ++ii) {
                const int i = m * 8 + ii;
                run += gla_gk(DTGK, (size_t)(t0 + i), w, b);
                bf16_t* qp = QK + (size_t)(t0 + i) * DM + d;
                const float q = bf1(qp[0]), k = bf1(qp[512]);
                qp[0] = (bf16_t)f2bf(q * 0.08838834764831845f * __expf(run));
                qp[512] = (bf16_t)f2bf(k * __expf(-run));
                const unsigned ke = f2bf(k * __expf(glast - run));
                if (ii & 1) tr[ii >> 1] |= ke << 16; else tr[ii >> 1] = ke;
            }
            *(u32x4*)(kd + 8 * m) = (u32x4){tr[0], tr[1], tr[2], tr[3]};
        }
        DEC[(size_t)ch * 512 + d] = __expf(glast);
    }
}

DEV void phase_gla_states(unsigned char* ws, LAS unsigned char* lds, int tid, int wave, int lane) {
    const bf16_t* KT = (const bf16_t*)(ws + RC_KT); const bf16_t* VT = (const bf16_t*)(ws + RC_VT); bf16_t* ST = (bf16_t*)(ws + RC_ST);
    constexpr int V_OFF = 0, K_OFF = 36864, RS = 144;
    const int fr = lane & 15, fq = lane >> 4;
    for (int unit = blockIdx.x; unit < (HT / 64) * 4; unit += gridDim.x) {
        const int cidx = unit >> 2, h = unit & 3, t0 = cidx * 64;
        for (int i = tid; i < 2048; i += NTHR) { const int row = i >> 3, ch = i & 7;
            *(LAS u32x4*)(lds + V_OFF + row * RS + ch * 16) = *(const u32x4*)(VT + (size_t)(h * 256 + row) * HT + t0 + ch * 8); }
        for (int i = tid; i < 1024; i += NTHR) { const int row = i >> 3, ch = i & 7;
            *(LAS u32x4*)(lds + K_OFF + row * RS + ch * 16) = *(const u32x4*)(KT + (size_t)(h * 128 + row) * HT + t0 + ch * 8); }
        __syncthreads();
        f32x4 acc[2][8];
#pragma unroll
        for (int a = 0; a < 2; ++a)
#pragma unroll
            for (int b = 0; b < 8; ++b) acc[a][b] = (f32x4){0.f, 0.f, 0.f, 0.f};
#pragma unroll
        for (int ks = 0; ks < 2; ++ks) {
            const bf16x8 y0 = ldsfrag(lds + V_OFF + (wave * 32 + fr) * RS + ks * 64 + fq * 16), y1 = ldsfrag(lds + V_OFF + (wave * 32 + 16 + fr) * RS + ks * 64 + fq * 16);
#pragma unroll
            for (int dt = 0; dt < 8; ++dt) { const bf16x8 x = ldsfrag(lds + K_OFF + (dt * 16 + fr) * RS + ks * 64 + fq * 16); acc[0][dt] = mma(x, y0, acc[0][dt]); acc[1][dt] = mma(x, y1, acc[1][dt]); }
        }
#pragma unroll
        for (int yt = 0; yt < 2; ++yt) { const int v = wave * 32 + yt * 16 + fr;
            bf16_t* dp = ST + (((size_t)cidx * 4 + h) * 256 + v) * 128 + 4 * fq;
#pragma unroll
            for (int dt = 0; dt < 8; ++dt) { u32x2 w; w.x = pk2(acc[yt][dt][0], acc[yt][dt][1]); w.y = pk2(acc[yt][dt][2], acc[yt][dt][3]); *(u32x2*)(dp + dt * 16) = w; } }
        __syncthreads();
    }
}

DEV void phase_gla_scan(unsigned char* ws, int gtid, int NT) {
    unsigned* ST = (unsigned*)(ws + RC_ST); const float* DEC = (const float*)(ws + WS_DEC);
    for (int e = gtid; e < 2 * 65536; e += NT) {
        const int bl = e >> 16, rem = e & 65535, h = rem >> 14, d = (rem * 2) & 127;
        f32x2 carry = {0.f, 0.f};
        for (int c0 = 0; c0 < 128; c0 += 8) {
            unsigned v[8]; f32x2 dec[8];
#pragma unroll
            for (int i = 0; i < 8; ++i) { const int cidx = bl * 128 + c0 + i; v[i] = ST[(size_t)cidx * 65536 + rem]; dec[i] = *(const f32x2*)(DEC + (size_t)cidx * 512 + h * 128 + d); }
#pragma unroll
            for (int i = 0; i < 8; ++i) { const int cidx = bl * 128 + c0 + i; ST[(size_t)cidx * 65536 + rem] = pk2(carry[0], carry[1]);
                carry[0] = carry[0] * dec[i][0] + bf_lo(v[i]); carry[1] = carry[1] * dec[i][1] + bf_hi(v[i]); }
        }
    }
}

DEV void phase_gla_out(unsigned char* ws, const float* nw, LAS unsigned char* lds, int tid, int wave, int lane) {
    const bf16_t* QK = (const bf16_t*)(ws + RC_QK); const bf16_t* VT = (const bf16_t*)(ws + RC_VT); const bf16_t* GS = (const bf16_t*)(ws + RC_GS);
    const bf16_t* ST = (const bf16_t*)(ws + RC_ST); bf16_t* YIN = (bf16_t*)(ws + WS_YIN);
    constexpr int Q_OFF = 0, K_OFF = 17408, V_OFF = 34816, P_OFF = 71680, S_OFF = 80896, RSD = 272, RST = 144;
    LAS float* ssqt = (LAS float*)(lds + S_OFF);
    const int fr = lane & 15, fq = lane >> 4, lt = wave >> 1, vh = wave & 1;
    for (int unit = blockIdx.x; unit < (HT / 64) * 4; unit += gridDim.x) {
        const int cidx = unit >> 2, h = unit & 3, t0 = cidx * 64;
        for (int i = tid; i < 1024; i += NTHR) { const int row = i >> 4, ch = i & 15;
            *(LAS u32x4*)(lds + Q_OFF + row * RSD + ch * 16) = *(const u32x4*)(QK + (size_t)(t0 + row) * DM + h * 128 + ch * 8);
            *(LAS u32x4*)(lds + K_OFF + row * RSD + ch * 16) = *(const u32x4*)(QK + (size_t)(t0 + row) * DM + 512 + h * 128 + ch * 8); }
        for (int i = tid; i < 2048; i += NTHR) { const int row = i >> 3, ch = i & 7;
            *(LAS u32x4*)(lds + V_OFF + row * RST + ch * 16) = *(const u32x4*)(VT + (size_t)(h * 256 + row) * HT + t0 + ch * 8); }
        __syncthreads();
        const int l = lt * 16 + fr;
        {
            f32x4 sc[2] = {(f32x4){0.f, 0.f, 0.f, 0.f}, (f32x4){0.f, 0.f, 0.f, 0.f}};
#pragma unroll
            for (int ks = 0; ks < 4; ++ks) { const bf16x8 y = ldsfrag(lds + Q_OFF + l * RSD + ks * 64 + fq * 16);
#pragma unroll
                for (int i = 0; i < 2; ++i) sc[i] = mma(ldsfrag(lds + K_OFF + ((2 * vh + i) * 16 + fr) * RSD + ks * 64 + fq * 16), y, sc[i]); }
#pragma unroll
            for (int i = 0; i < 2; ++i) { const int s0 = (2 * vh + i) * 16 + 4 * fq; float m[4];
#pragma unroll
                for (int j = 0; j < 4; ++j) m[j] = (s0 + j <= l) ? sc[i][j] : 0.f;
                u32x2 w; w.x = pk2(m[0], m[1]); w.y = pk2(m[2], m[3]); *(LAS u32x2*)(lds + P_OFF + l * RST + s0 * 2) = w; }
        }
        __syncthreads();
        f32x4 acc[8];
#pragma unroll
        for (int i = 0; i < 8; ++i) acc[i] = (f32x4){0.f, 0.f, 0.f, 0.f};
#pragma unroll
        for (int ks = 0; ks < 2; ++ks) { const bf16x8 y = ldsfrag(lds + P_OFF + l * RST + ks * 64 + fq * 16);
#pragma unroll
            for (int i = 0; i < 8; ++i) acc[i] = mma(ldsfrag(lds + V_OFF + ((vh * 8 + i) * 16 + fr) * RST + ks * 64 + fq * 16), y, acc[i]); }
        const bf16_t* sp = ST + (((size_t)cidx * 4 + h) * 256 + vh * 128 + fr) * 128 + fq * 8;
#pragma unroll
        for (int ks = 0; ks < (GLA_NO_INTER ? 0 : 4); ++ks) { const bf16x8 y = ldsfrag(lds + Q_OFF + l * RSD + ks * 64 + fq * 16);
#pragma unroll
            for (int i = 0; i < 8; ++i) acc[i] = mma(*(const bf16x8*)(sp + (size_t)i * 16 * 128 + ks * 32), y, acc[i]); }
        float ssq = 0.f;
#pragma unroll
        for (int i = 0; i < 8; ++i) ssq += (acc[i][0] * acc[i][0] + acc[i][1] * acc[i][1]) + (acc[i][2] * acc[i][2] + acc[i][3] * acc[i][3]);
        ssq += __shfl_xor(ssq, 16); ssq += __shfl_xor(ssq, 32);
        if (fq == 0) ssqt[l * 2 + vh] = ssq;
        __syncthreads();
        const float rstd = rsqrtf((ssqt[l * 2] + ssqt[l * 2 + 1]) * (1.f / 256.f) + EPS);
        const size_t t = (size_t)(t0 + l);
#pragma unroll
        for (int i = 0; i < 8; ++i) { const int v = (vh * 8 + i) * 16 + 4 * fq, c = h * 256 + v;
            const u32x2 gw = *(const u32x2*)(GS + t * DM + c); const f32x4 w4 = *(const f32x4*)(nw + v);
            u32x2 o; o.x = pk2(acc[i][0] * rstd * w4[0] * bf_lo(gw.x), acc[i][1] * rstd * w4[1] * bf_hi(gw.x));
            o.y = pk2(acc[i][2] * rstd * w4[2] * bf_lo(gw.y), acc[i][3] * rstd * w4[3] * bf_hi(gw.y));
            *(u32x2*)(YIN + t * DM + c) = o; }
        __syncthreads();
    }
}


#define XB_TMO      128
#define XB_XCNT(j)  (256  + 64 * (j))
#define XB_XSUB(j)  (1280 + 64 * (j))
#define XB_XGEN(j)  (2304 + 64 * (j))
#define XB_TOP      3328
#define XB_TOPGEN   3392
#define XCD_BAR_WORDS 3456
#define XB_SPIN_CAP (1u << 22)
DEV unsigned xb_ld(unsigned* p)              { return __hip_atomic_load(p, __ATOMIC_RELAXED, __HIP_MEMORY_SCOPE_AGENT); }
DEV unsigned xb_add(unsigned* p, unsigned v) { return __hip_atomic_fetch_add(p, v, __ATOMIC_RELAXED, __HIP_MEMORY_SCOPE_AGENT); }
DEV unsigned xb_xcc_id() { return (unsigned)__builtin_amdgcn_s_getreg((3 << 11) | 20) & 0xFu; }
#define XB_SPIN(cond, bar) do { unsigned _sp = 0; while (cond) { __builtin_amdgcn_s_sleep(1); \
    if ((++_sp & 255u) == 0u) { if (xb_ld(&(bar)[XB_TMO])) break; if (_sp > XB_SPIN_CAP) { atomicAdd(&(bar)[XB_TMO], 1u); break; } } } } while (0)
DEV void xcd_barrier_complete(unsigned* bar, unsigned x, unsigned Gn, unsigned& nloc, unsigned& nx) {
    unsigned sum, cnt, mine, sp = 0u;
    for (;;) {
        sum = 0u; cnt = 0u; mine = 0u;
#pragma unroll
        for (unsigned j = 0; j < 16; ++j) { const unsigned c = xb_ld(&bar[XB_XCNT(j)]); sum += c; cnt += (c > 0u) ? 1u : 0u; mine = (j == x) ? c : mine; }
        if (sum == Gn) break;
        __builtin_amdgcn_s_sleep(1);
        if ((++sp & 255u) == 0u) { if (xb_ld(&bar[XB_TMO])) break; if (sp > XB_SPIN_CAP) { atomicAdd(&bar[XB_TMO], 1u); break; } }
    }
    nloc = mine > 0u ? mine : 1u; nx = cnt > 0u ? cnt : 1u;
}
DEV void xcd_barrier(unsigned* bar, unsigned x, volatile LAS unsigned* st, int tid, unsigned Gn) {
    asm volatile("s_waitcnt vmcnt(0)" ::: "memory");
    __syncthreads();
    if (tid == 0) {
        __builtin_amdgcn_s_waitcnt(0);
        unsigned nloc = st[0], nx = st[1];
        if (nloc == 0u) { xcd_barrier_complete(bar, x, Gn, nloc, nx); st[0] = nloc; st[1] = nx; }
        const unsigned old = xb_add(&bar[XB_XSUB(x)], 1u);
        const unsigned gen = old / nloc;
        if (old + 1u == (gen + 1u) * nloc) {
            __builtin_amdgcn_fence(__ATOMIC_RELEASE, "agent");
            asm volatile("s_waitcnt vmcnt(0)" ::: "memory");
            const unsigned og = xb_add(&bar[XB_TOP], 1u);
            const unsigned tg = og / nx;
            if (og + 1u == (tg + 1u) * nx) xb_add(&bar[XB_TOPGEN], 1u);
            else XB_SPIN(xb_ld(&bar[XB_TOPGEN]) == tg, bar);
            __builtin_amdgcn_fence(__ATOMIC_ACQUIRE, "agent");
            xb_add(&bar[XB_XGEN(x)], 1u);
            asm volatile("s_waitcnt vmcnt(0)" ::: "memory");
        } else {
            XB_SPIN(xb_ld(&bar[XB_XGEN(x)]) == gen, bar);
            __builtin_amdgcn_fence(__ATOMIC_ACQUIRE, "agent");
            asm volatile("s_waitcnt vmcnt(0)" ::: "memory");
        }
    }
    __syncthreads();
}

typedef const __attribute__((address_space(4))) Params* KParams;
DEV KParams kargs() { unsigned long long kp = (unsigned long long)__builtin_amdgcn_kernarg_segment_ptr(); asm volatile("" : "+s"(kp)); return (KParams)kp; }

__global__ void __launch_bounds__(NTHR, 2) mega_fwd(Params Parg, int pc_lo, int pc_hi, int coop, int pad_) {
    extern __shared__ __attribute__((aligned(16))) unsigned char smem[];
    cg::grid_group grid = cg::this_grid();
    if (coop) grid.sync();
    volatile LAS unsigned* xst = (volatile LAS unsigned*)((LAS unsigned char*)smem + 139264 - 16);
    const unsigned xcc = xb_xcc_id();
    if (threadIdx.x == 0) { xst[0] = 0u; xst[1] = 0u; (void)xb_add((unsigned*)(asglobal(kargs()->ws) + WS_BAR) + XB_XCNT(xcc), 1u); }
    __syncthreads();
    using pg8::Sched; using pg8::job_put;
    constexpr int PER_LAYER = 1 + 34 + 3, NPC = 2 * PER_LAYER + 1;
#pragma unroll 1
    for (int pc0 = pc_lo; pc0 < pc_hi; ++pc0) {
        int pc = pc0; asm volatile("" : "+s"(pc));
        int tid = threadIdx.x; asm volatile("" : "+v"(tid));
        const int lane = tid & 63, wave = __builtin_amdgcn_readfirstlane(tid >> 6);
        unsigned ldso = 0; asm volatile("" : "+s"(ldso));
        LAS unsigned char* lds = (LAS unsigned char*)smem + ldso;
        int bxv = blockIdx.x, gdv = gridDim.x; asm volatile("" : "+s"(bxv), "+s"(gdv));
        const int layer = pc / PER_LAYER; const int r = pc - layer * PER_LAYER;
        int ph, hf = 0;
        if (pc == NPC - 1) ph = 21; else if (r == 0) ph = 0; else if (r <= 34) { hf = (r - 1) / 17; ph = (r - 1) - hf * 17 + 1; } else ph = 18 + (r - 35);
        asm volatile("" : "+s"(ph), "+s"(hf));
#define P kargs()
#define ws asglobal(kargs()->ws)
#define INP(i) asglobal(kargs()->in[i])
#define OUTP asglobal(kargs()->out)
#define G gdv
#define bx bxv
#define gw (bx * NWAVES + wave)
#define NGW (G * NWAVES)
#define gtid (bx * NTHR + tid)
#define NT (G * NTHR)
#define WIN ((bf16_t*)(ws + WS_WIN))
#define HB ((bf16_t*)(ws + WS_HB))
#define MERGED ((float*)(ws + WS_MERGED))
#define GB ((bf16_t*)(ws + WS_G))
#define YIN ((bf16_t*)(ws + WS_YIN))
#define xsrc (((layer == 0) ? INP(0) : (const float*)OUTP) + (size_t)hf * HT * DM)
#define xdst (OUTP + (size_t)hf * HT * DM)

#define PROBE11 0
#define NOMIX 0
#define NOMLP 0
#ifndef SKIPMASK

#define SKIPMASK 0u
#endif
        if ((SKIPMASK >> ph) & 1u) ph = 99;
#ifdef DELAY_PROBE
        if (bxv == 3) { const unsigned long long t0 = __builtin_amdgcn_s_memrealtime(); while (__builtin_amdgcn_s_memrealtime() - t0 < 30000ull) __builtin_amdgcn_s_sleep(64); }
#endif
        switch (ph) {
        case 0:
            phase_weights(ws, INP(2) + (size_t)layer * 1024 * INW, INP(4) + (size_t)layer * 1048576, INP(11) + (size_t)layer * 1048576, INP(15) + (size_t)layer * 1048576,
                          INP(16) + (size_t)layer * 1048576, INP(18) + (size_t)layer * 4194304, INP(19) + (size_t)layer * 4194304, lds, gw, NGW, wave, lane);
            break;
        case 1:
            phase_rmsnorm_bf16(xsrc, INP(1) + layer * DM, HB, HT, gw, NGW, lane);
            if (DUP2) phase_rmsnorm_bf16(xsrc, INP(1) + layer * DM, HB, HT, gw, NGW, lane);
            break;
        case 2: {
            if (tid == 0) { job_put(lds, 0, HB, WIN, ws + RA_UA, nullptr, 64, 12, 3072, 0); job_put(lds, 1, HB, WIN + (size_t)9248 * DM, GB, nullptr, 64, 4, 1024, 1); }
            Sched S; S.init(lds, 2, G, bx, DM, tid);
            pg8::GEMM_BODY<3>(lds, DM, S, tid);
            phase_narrow(HB, WIN + (size_t)6144 * DM, WIN + (size_t)9232 * DM, (float*)(ws + WS_DTGK), gw, NGW, lane);
            break; }
        case 3:
            phase_conv_a((const bf16_t*)(ws + RA_UA), INP(3) + (size_t)layer * 3 * 1024, YIN, gtid, NT);
            if (DUP2) phase_conv_a((const bf16_t*)(ws + RA_UA), INP(3) + (size_t)layer * 3 * 1024, YIN, gtid, NT);
            break;
        case 4: {
            if (tid == 0) job_put(lds, 0, YIN, ws + WS_WOA, ws + WS_MERGED, GB, 64, 4, 1024, 4);
            Sched S; S.init(lds, 1, G, bx, DM, tid); pg8::GEMM_BODY<16>(lds, DM, S, tid);
            break; }
        case 5: {
            if (tid == 0) { job_put(lds, 0, HB, WIN + (size_t)3072 * DM, ws + RB_Z, nullptr, 64, 4, 1024, 2); job_put(lds, 1, WIN + (size_t)4096 * DM, HB, ws + RB_XST, nullptr, 4, 64, HT, 0);
                            job_put(lds, 2, HB, WIN + (size_t)5120 * DM, ws + RB_BC, nullptr, 64, 4, 1024, 0); job_put(lds, 3, HB, WIN + (size_t)10272 * DM, GB, nullptr, 64, 4, 1024, 1); }
            Sched S; S.init(lds, 4, G, bx, DM, tid); pg8::GEMM_BODY<7>(lds, DM, S, tid);
            break; }
        case 6:
            phase_ssd_prep(ws, INP(5) + (size_t)layer * 4 * 2048, INP(6) + (size_t)layer * 2048, INP(7) + layer * 16, INP(8) + layer * 16, gtid, NT, tid, G, bx);
            if (DUP2) phase_ssd_prep(ws, INP(5) + (size_t)layer * 4 * 2048, INP(6) + (size_t)layer * 2048, INP(7) + layer * 16, INP(8) + layer * 16, gtid, NT, tid, G, bx);
            break;
        case 7: phase_ssd_states(ws, lds, tid, wave, lane); if (DUP) { __syncthreads(); phase_ssd_states(ws, lds, tid, wave, lane); } break;
        case 8: phase_ssd_scan(ws, gtid, NT); break;
        case 9: phase_ssd_out(ws, INP(9) + layer * 16, INP(10) + layer * 1024, lds, tid, wave, lane); if (DUP) { __syncthreads(); phase_ssd_out(ws, INP(9) + layer * 16, INP(10) + layer * 1024, lds, tid, wave, lane); } break;
        case 10: {
            if (tid == 0) job_put(lds, 0, YIN, ws + WS_WOS, ws + WS_MERGED, GB, 64, 4, (int)((WS_MSUM - WS_MERGED) / 4), 5);
            Sched S; S.init(lds, 1, G, bx, DM, tid); pg8::GEMM_BODY<32>(lds, DM, S, tid);
            break; }
        case 11: {
#if PROBE11 == 1
            if (tid == 0) { job_put(lds, 0, HB, WIN + (size_t)11296 * DM, GB, nullptr, 64, 4, 1024, 1); }
            Sched S; S.init(lds, 1, G, bx, DM, tid); pg8::GEMM_BODY<7>(lds, DM, S, tid);
#elif PROBE11 == 2
            if (tid == 0) { job_put(lds, 1, HB, WIN + (size_t)3072 * DM, ws + RB_Z, nullptr, 64, 4, 1024, 2); job_put(lds, 2, WIN + (size_t)4096 * DM, HB, ws + RB_XST, nullptr, 4, 64, HT, 0);
                            job_put(lds, 3, HB, WIN + (size_t)5120 * DM, ws + RB_BC, nullptr, 64, 4, 1024, 0); job_put(lds, 0, HB, WIN + (size_t)10272 * DM, GB, nullptr, 64, 4, 1024, 1); }
            Sched S; S.init(lds, 4, G, bx, DM, tid); pg8::GEMM_BODY<7>(lds, DM, S, tid);
#else
            if (tid == 0) { job_put(lds, 0, HB, WIN + (size_t)6160 * DM, ws + RC_QK, nullptr, 64, 4, 1024, 0); job_put(lds, 1, WIN + (size_t)7184 * DM, HB, ws + RC_VT, nullptr, 4, 64, HT, 0);
                            job_put(lds, 2, HB, WIN + (size_t)8208 * DM, ws + RC_GS, nullptr, 64, 4, 1024, 2); job_put(lds, 3, HB, WIN + (size_t)11296 * DM, GB, nullptr, 64, 4, 1024, 1); }
            Sched S; S.init(lds, 4, G, bx, DM, tid); pg8::GEMM_BODY<7>(lds, DM, S, tid);
#endif
            break; }
        case 12: phase_gla_prep(ws, INP(12) + (size_t)layer * 16 * 512, INP(13) + layer * 512, gtid, NT); break;
        case 13: phase_gla_states(ws, lds, tid, wave, lane); if (DUP) { __syncthreads(); phase_gla_states(ws, lds, tid, wave, lane); } break;
        case 14: phase_gla_scan(ws, gtid, NT); break;
        case 15: phase_gla_out(ws, INP(14) + layer * 256, lds, tid, wave, lane); if (DUP) { __syncthreads(); phase_gla_out(ws, INP(14) + layer * 256, lds, tid, wave, lane); } break;
        case 16: {
            if (tid == 0) job_put(lds, 0, YIN, ws + WS_WOG, ws + WS_MSUM, GB, 64, 4, 1024, 6);
            Sched S; S.init(lds, 1, G, bx, DM, tid); pg8::GEMM_BODY<64>(lds, DM, S, tid);
            break; }
        case 17: {
            if (tid == 0) job_put(lds, 0, GB, ws + WS_WO, xdst, xsrc, 64, 4, NOMIX ? 0 : 1024, 7);
            Sched S; S.init(lds, 1, G, bx, DM, tid); pg8::GEMM_BODY<128>(lds, DM, S, tid);
            break; }
        case 18:
            phase_rmsnorm_bf16(OUTP, INP(17) + layer * DM, (bf16_t*)(ws + WS_MERGED), T_ALL, gw, NGW, lane);
            break;
        case 19: {
            if (tid == 0) job_put(lds, 0, ws + WS_MERGED, ws + WS_WUP, ws + WS_R, nullptr, 128, 16, DFF, 3);
            Sched S; S.init(lds, 1, G, bx, DM, tid); pg8::GEMM_BODY<8>(lds, DM, S, tid);
            break; }
        case 20: {
            if (tid == 0) job_put(lds, 0, ws + WS_R, ws + WS_WDN, OUTP, OUTP, 128, 4, NOMLP ? 0 : 1024, 7);
            Sched S; S.init(lds, 1, G, bx, DFF, tid); pg8::GEMM_BODY<128>(lds, DFF, S, tid);
            break; }
        case 99: {
#ifdef SPIN_PROBE
            if (pc == 6 || pc == 23) { const unsigned long long t0 = __builtin_amdgcn_s_memrealtime(); while (__builtin_amdgcn_s_memrealtime() - t0 < 500000ull) __builtin_amdgcn_s_sleep(64); }
#endif
            break; }
        default:
            phase_rmsnorm_f32(OUTP, INP(20), T_ALL, gw, NGW, lane);
            break;
        }
        if (pc0 != pc_hi - 1) {
            xcd_barrier((unsigned*)(ws + WS_BAR), xcc, xst, tid, (unsigned)gdv);
            if (BAR2) xcd_barrier((unsigned*)(ws + WS_BAR), xcc, xst, tid, (unsigned)gdv);
        }
    }
#undef P
#undef ws
#undef INP
#undef OUTP
#undef G
#undef bx
#undef gw
#undef NGW
#undef gtid
#undef NT
#undef WIN
#undef HB
#undef MERGED
#undef GB
#undef YIN
#undef xsrc
#undef xdst
}

extern "C" void kernel_launch(void* const* d_in, const int* in_sizes, int n_in, void* d_out, int out_size, void* d_ws, size_t ws_size, hipStream_t stream) {
    static int grid = 0;
    if (grid == 0) {
        if (n_in != 21 || out_size != T_ALL * DM || ws_size < WS_TOTAL) { fprintf(stderr, "kernel_launch: unexpected shapes (n_in %d out %d ws %zu need %zu)\n", n_in, out_size, ws_size, (size_t)WS_TOTAL); grid = -1; return; }
        int dev = 0, cus = 0, per_cu = 0;
        hipGetDevice(&dev);
        hipDeviceGetAttribute(&cus, hipDeviceAttributeMultiprocessorCount, dev);
        if (hipFuncSetAttribute((const void*)mega_fwd, hipFuncAttributeMaxDynamicSharedMemorySize, LDS_BYTES) != hipSuccess) { fprintf(stderr, "kernel_launch: hipFuncSetAttribute failed\n"); }
        if (hipOccupancyMaxActiveBlocksPerMultiprocessor(&per_cu, (const void*)mega_fwd, NTHR, LDS_BYTES) != hipSuccess || per_cu < 1) { fprintf(stderr, "kernel_launch: occupancy query says %d\n", per_cu); per_cu = 1; }
        (void)hipGetLastError();
        grid = cus > 0 ? cus : 256;
    }
    if (grid < 0) return;
    if (hipMemsetAsync((char*)d_ws + WS_BAR, 0, 16384, stream) != hipSuccess) { fprintf(stderr, "kernel_launch: memset failed\n"); return; }
    Params p{};
    for (int i = 0; i < 21; ++i) p.in[i] = (const float*)d_in[i];
    p.out = (float*)d_out; p.ws = (unsigned char*)d_ws;
#ifndef N_LAUNCH_SPLIT
#define N_LAUNCH_SPLIT 0
#endif
    constexpr int NPC_H = 2 * 38 + 1;
    if (N_LAUNCH_SPLIT) {
        for (int pc = 0; pc < NPC_H; ++pc) {
            hipLaunchKernelGGL(mega_fwd, dim3(grid), dim3(NTHR), LDS_BYTES, stream, p, pc, pc + 1, 0, 0);
        }
        hipError_t e = hipPeekAtLastError();
        if (e != hipSuccess) fprintf(stderr, "launch failed: %s (grid %d)\n", hipGetErrorString(e), grid);
    } else {
        int lo = 0, hi = NPC_H, coop = 1, pad = 0;
        void* args[] = {&p, &lo, &hi, &coop, &pad};
        hipError_t e = hipLaunchCooperativeKernel((const void*)mega_fwd, dim3(grid), dim3(NTHR), args, LDS_BYTES, stream);
        if (e != hipSuccess) fprintf(stderr, "cooperative launch failed: %s (grid %d)\n", hipGetErrorString(e), grid);
    }
}
```

```cpp
#include <hip/hip_runtime.h>
#include <hip/hip_cooperative_groups.h>
#include <cstdio>
namespace cg = cooperative_groups;

#define LAS __attribute__((address_space(3)))
#define DEV __device__ __forceinline__
typedef unsigned short bf16_t;
typedef short bf16x8 __attribute__((ext_vector_type(8)));
typedef float f32x4 __attribute__((ext_vector_type(4)));
typedef float f32x2 __attribute__((ext_vector_type(2)));
typedef unsigned u32x4 __attribute__((ext_vector_type(4)));
typedef unsigned u32x2 __attribute__((ext_vector_type(2)));

constexpr int T_ALL = 32768, HT = 16384, DM = 1024, SEQ = 8192, INW = 12320, DFF = 4096;
constexpr int NTHR = 512, NWAVES = 8;
constexpr int LDS_BYTES = 136 * 1024;
constexpr float EPS = 1e-6f;

constexpr size_t WS_WIN = 1048576;
constexpr size_t WS_WOA = WS_WIN + (size_t)INW * 1024 * 2 + 1048576;
constexpr size_t WS_WOS = WS_WOA + 2097152;
constexpr size_t WS_WOG = WS_WOS + 2097152;
constexpr size_t WS_WO = WS_WOG + 2097152;
constexpr size_t WS_WUP = WS_WO + 2097152;
constexpr size_t WS_WDN = WS_WUP + 8388608;
constexpr size_t WS_HB = WS_WDN + 8388608;
constexpr size_t WS_MERGED = WS_HB + (size_t)HT * 1024 * 2;
constexpr size_t WS_G = WS_MERGED + (size_t)HT * 1024 * 4;
constexpr size_t WS_YIN = WS_G + (size_t)HT * 1024 * 2;
constexpr size_t WS_DTGK = WS_YIN + (size_t)HT * 1024 * 2;
constexpr size_t WS_R = WS_DTGK + (size_t)HT * 32 * 4;
constexpr size_t RA_UA = WS_R;
constexpr size_t RB_Z = WS_R;
constexpr size_t RB_XST = RB_Z + 33554432;
constexpr size_t RB_BC = RB_XST + 33554432;
constexpr size_t RB_XSTC = RB_BC + 33554432;
constexpr size_t RB_BCC = RB_XSTC + 33554432;
constexpr size_t RB_BTC = RB_BCC + 33554432;
constexpr size_t RB_DT = RB_BTC + 16777216;
constexpr size_t RB_ACUM = RB_DT + 1048576;
constexpr size_t RB_ST = RB_ACUM + 1048576;
constexpr size_t RB_END = RB_ST + 67108864;
constexpr size_t RC_QK = WS_R;
constexpr size_t RC_KT = RC_QK + 33554432;
constexpr size_t RC_VT = RC_KT + 16777216;
constexpr size_t RC_GS = RC_VT + 33554432;
constexpr size_t RC_DEC = RC_GS + 33554432;
constexpr size_t RC_ST = RC_DEC + 524288;
constexpr size_t RC_END = RC_ST + 134217728;
constexpr size_t R_HID_END = WS_R + (size_t)T_ALL * DFF * 2;
constexpr size_t WS_END = (RB_END > RC_END ? (RB_END > R_HID_END ? RB_END : R_HID_END) : (RC_END > R_HID_END ? RC_END : R_HID_END));

constexpr size_t WS_MSUM = (WS_END + 255) & ~(size_t)255;
constexpr size_t WS_BAR = WS_MSUM + (size_t)HT * 1024 * 2;
constexpr size_t WS_DEC = WS_BAR + 16384;
constexpr size_t WS_TOTAL = WS_DEC + 524288;
struct Params { const float* in[21]; float* out; unsigned char* ws; };

DEV unsigned f2bf(float f) { unsigned u = __float_as_uint(f); return (u + 0x7fffu + ((u >> 16) & 1u)) >> 16; }
typedef __bf16 bf16x2_t __attribute__((ext_vector_type(2)));
DEV unsigned pk2(float lo, float hi) { const f32x2 v = {lo, hi}; const bf16x2_t r = __builtin_convertvector(v, bf16x2_t); return __builtin_bit_cast(unsigned, r); }
DEV float bf_lo(unsigned w) { return __uint_as_float(w << 16); }
DEV float bf_hi(unsigned w) { return __uint_as_float(w & 0xffff0000u); }
DEV float bf1(bf16_t h) { return __uint_as_float(((unsigned)h) << 16); }
DEV void unpack8(const u32x4 w, float (&f)[8]) {
    f[0] = bf_lo(w.x); f[1] = bf_hi(w.x); f[2] = bf_lo(w.y); f[3] = bf_hi(w.y);
    f[4] = bf_lo(w.z); f[5] = bf_hi(w.z); f[6] = bf_lo(w.w); f[7] = bf_hi(w.w);
}
DEV u32x4 pack8(const float (&f)[8]) { u32x4 w; w.x = pk2(f[0], f[1]); w.y = pk2(f[2], f[3]); w.z = pk2(f[4], f[5]); w.w = pk2(f[6], f[7]); return w; }
DEV float sigmoidf_(float x) { return __builtin_amdgcn_rcpf(1.0f + __expf(-x)); }
DEV float siluf_(float x) { return x * sigmoidf_(x); }
DEV float softplusf_(float x) { return x > 20.f ? x : (x < -15.f ? __expf(x) : __logf(1.0f + __expf(x))); }
DEV float logsigf_(float x) { const float e = __expf(-fabsf(x)); return fminf(x, 0.f) - (e < 1e-4f ? e : __logf(1.0f + e)); }
DEV float wave_sum(float v) {
#pragma unroll
    for (int o = 1; o < 64; o <<= 1) v += __shfl_xor(v, o);
    return v;
}
DEV f32x4 mma(bf16x8 x, bf16x8 y, f32x4 acc) { return __builtin_amdgcn_mfma_f32_16x16x32_bf16(x, y, acc, 0, 0, 0); }
DEV bf16x8 ldsfrag(const LAS unsigned char* p) { return *(const LAS bf16x8*)p; }
#define SCALE_A 1.f
#define SCALE_B 1.f
#define SCALE_C 1.f
#define DUP 0
#define DUP2 0
#define BAR2 0
#define GLA_NO_INTER 0
#define GLA_ZERO_DEC 0
#ifndef GEMM_BODY
#define GEMM_BODY gemm_phase
#endif
#define LDS_WAIT() asm volatile("s_waitcnt lgkmcnt(0)" ::: "memory")
#define GAS __attribute__((address_space(1)))
template <class T> DEV T* asglobal(T* p) { return (T*)(GAS T*)p; }

namespace pg8 {
constexpr int BM = 256, BK = 64, HALF = 128, HTB = HALF * BK * 2, STAGE_BYTES = 8 * HTB, NXCD = 8, WGM = 8;
DEV int lds_byte(int r, int c) { const int st = (r >> 4) * 2 + (c >> 5), rr = r & 15, cc = c & 31, ob = rr * 64 + cc * 2; return st * 1024 + (ob ^ (((ob >> 9) & 1) << 5)); }
DEV void stage_rc(int b, int& R, int& C) { const int st = b / 1024, sb = b % 1024, swz = sb ^ (((sb >> 9) & 1) << 5); R = (st >> 1) * 16 + swz / 64; C = (st & 1) * 32 + (swz % 64) / 2; }
DEV int perm32(int rho) { const int n = rho >> 4, i = rho & 15; return 8 * (i >> 2) + 4 * n + (i & 3); }

struct Job { const bf16_t* A; const bf16_t* B; void* out; const void* aux; int nM, nN, ldc, kind; };
struct Unit { const char* A; const char* B; int jid, pm, pn; };
constexpr int JT_OFF = 131072;
DEV int rfl(int v) { return __builtin_amdgcn_readfirstlane(v); }
DEV const char* rflp(const LAS int* p) { const unsigned lo = (unsigned)rfl(p[0]), hi = (unsigned)rfl(p[1]); return asglobal((const char*)(((unsigned long long)hi << 32) | lo)); }
DEV void job_put(LAS unsigned char* lds, int q, const void* A, const void* B, void* out, const void* aux, int nM, int nN, int ldc, int kind) {
    LAS int* jt = (LAS int*)(lds + JT_OFF) + q * 12;
    const unsigned long long a = (unsigned long long)A, b = (unsigned long long)B, o = (unsigned long long)out, x = (unsigned long long)aux;
    jt[0] = (int)(unsigned)a; jt[1] = (int)(unsigned)(a >> 32); jt[2] = (int)(unsigned)b; jt[3] = (int)(unsigned)(b >> 32);
    jt[4] = (int)(unsigned)o; jt[5] = (int)(unsigned)(o >> 32); jt[6] = (int)(unsigned)x; jt[7] = (int)(unsigned)(x >> 32);
    jt[8] = nM; jt[9] = nN; jt[10] = ldc; jt[11] = kind;
}
struct Sched {
    LAS unsigned char* lds; int nj, total, G, c; size_t tstep;
    DEV void init(LAS unsigned char* lds_, int nj_, int G_, int c_, int K, int tid_) {
        lds = lds_; nj = nj_; G = G_; c = c_; tstep = (size_t)BM * K * 2;
        __syncthreads();
        LAS int* jt = (LAS int*)(lds + JT_OFF);
        if (tid_ == 0) { int s = 0; for (int q = 0; q < nj; ++q) { jt[48 + q] = s; s += jt[q * 12 + 8] * jt[q * 12 + 9]; } for (int q = nj; q < 5; ++q) jt[48 + q] = s; }
        __syncthreads();
        total = rfl(jt[48 + 4]);
    }
    DEV bool next(int i, Unit& u) const {
        const int L = i * G + c; if (L >= total) return false;
        const LAS int* jt = (const LAS int*)(lds + JT_OFF);
        int jid = 0;
        for (int q = 1; q < nj; ++q) if (L >= rfl(jt[48 + q])) jid = q;
        const LAS int* J = jt + jid * 12;
        const int base = rfl(jt[48 + jid]), nM = rfl(J[8]), nN = rfl(J[9]);
        int wgid = L - base; const int nwg = nM * nN;
        { const int q = nwg / NXCD, r = nwg % NXCD, xcd = wgid % NXCD, off = wgid / NXCD; wgid = (xcd < r ? xcd * (q + 1) : r * (q + 1) + (xcd - r) * q) + off; }
        const int nig = WGM * nN, gid = wgid / nig, fm = gid * WGM, gsz = (nM - fm) < WGM ? (nM - fm) : WGM;
        u.pm = fm + ((wgid % nig) % gsz); u.pn = (wgid % nig) / gsz; u.jid = jid;
        u.A = rflp(J) + (size_t)u.pm * tstep; u.B = rflp(J + 2) + (size_t)u.pn * tstep;
        return true;
    }
};

DEV void st16_wt(GAS u32x4* p, u32x4 v) { asm volatile("global_store_dwordx4 %0, %1, off sc1" :: "v"(p), "v"(v) : "memory"); }
DEV void st16f_wt(GAS f32x4* p, f32x4 v) { asm volatile("global_store_dwordx4 %0, %1, off sc1" :: "v"(p), "v"(v) : "memory"); }
DEV unsigned cvt_pk_bf16(float lo, float hi) { return pk2(lo, hi); }

template <int KIND> DEV void epi_loop(const f32x4 (&acc)[2][2][4][2], const Job& J, const Unit& u, int wr, int wc, int fr, int fq) {
    const int row0 = u.pm * BM + wr * 64 + fr, col0 = u.pn * BM + wc * 32 + 8 * fq;
    GAS bf16_t* const outb = (GAS bf16_t*)J.out; GAS float* const outf = (GAS float*)J.out;
    const GAS float* const auxf = (const GAS float*)J.aux; GAS bf16_t* const auxb = (GAS bf16_t*)const_cast<void*>(J.aux);
#pragma unroll
    for (int ai = 0; ai < 2; ++ai)
#pragma unroll
        for (int m = 0; m < 4; ++m) {
            const size_t row = (size_t)(row0 + ai * HALF + m * 16);
#pragma unroll
            for (int bj = 0; bj < 2; ++bj) {
                const int col = col0 + bj * HALF;
                f32x4 v0 = acc[ai][bj][m][0], v1 = acc[ai][bj][m][1];
                if (KIND <= 3) {
                    if (KIND == 1) {
#pragma unroll
                        for (int e = 0; e < 4; ++e) { v0[e] = sigmoidf_(v0[e]); v1[e] = sigmoidf_(v1[e]); } }
                    if (KIND == 2) {
#pragma unroll
                        for (int e = 0; e < 4; ++e) { v0[e] = siluf_(v0[e]); v1[e] = siluf_(v1[e]); } }
                    if (KIND == 3) {
#pragma unroll
                        for (int e = 0; e < 4; ++e) { float a = fmaxf(v0[e], 0.f), b = fmaxf(v1[e], 0.f); v0[e] = a * a; v1[e] = b * b; } }
                    u32x4 w; w.x = cvt_pk_bf16(v0[0], v0[1]); w.y = cvt_pk_bf16(v0[2], v0[3]); w.z = cvt_pk_bf16(v1[0], v1[1]); w.w = cvt_pk_bf16(v1[2], v1[3]);
                    *(GAS u32x4*)(outb + row * J.ldc + col) = w;
                } else if (KIND == 7) {
                    const GAS float* xin = auxf + row * DM + col; GAS float* xo = outf + row * DM + col;
                    const f32x4 a = *(const GAS f32x4*)xin, b = *(const GAS f32x4*)(xin + 4);
                    const float sc = (J.ldc == 0) ? 0.f : 1.f; *(GAS f32x4*)xo = a + v0 * sc; *(GAS f32x4*)(xo + 4) = b + v1 * sc;
                } else if (KIND == 4) {
                    const u32x4 gw = *(const GAS u32x4*)(auxb + row * DM + col); float g[8]; unpack8(gw, g);
                    f32x4 r0, r1;
#pragma unroll
                    for (int e = 0; e < 4; ++e) { r0[e] = g[e] * v0[e] * SCALE_A; r1[e] = g[4 + e] * v1[e] * SCALE_A; }
                    GAS float* mo = outf + row * DM + col; *(GAS f32x4*)mo = r0; *(GAS f32x4*)(mo + 4) = r1;
                } else if (KIND == 5) {
                    const u32x4 gw = *(const GAS u32x4*)(auxb + row * DM + col); float g[8]; unpack8(gw, g);
                    const GAS float* mo = outf + row * DM + col; const f32x4 m0 = *(const GAS f32x4*)mo, m1 = *(const GAS f32x4*)(mo + 4);
#pragma unroll
                    for (int e = 0; e < 8; ++e) g[e] *= SCALE_B;
                    u32x4 w; w.x = cvt_pk_bf16(m0[0] + g[0] * v0[0], m0[1] + g[1] * v0[1]); w.y = cvt_pk_bf16(m0[2] + g[2] * v0[2], m0[3] + g[3] * v0[3]);
                    w.z = cvt_pk_bf16(m1[0] + g[4] * v1[0], m1[1] + g[5] * v1[1]); w.w = cvt_pk_bf16(m1[2] + g[6] * v1[2], m1[3] + g[7] * v1[3]);
                    *(GAS u32x4*)((GAS bf16_t*)(outf + (size_t)J.ldc) + row * DM + col) = w;
                } else {
                    GAS bf16_t* gp = auxb + row * DM + col;
                    const u32x4 gw = *(const GAS u32x4*)gp, aw = *(const GAS u32x4*)(outb + row * DM + col);
                    float g[8], a[8]; unpack8(gw, g); unpack8(aw, a);
#pragma unroll
                    for (int e = 0; e < 8; ++e) g[e] *= SCALE_C;
                    u32x4 w; w.x = cvt_pk_bf16(a[0] + g[0] * v0[0], a[1] + g[1] * v0[1]); w.y = cvt_pk_bf16(a[2] + g[2] * v0[2], a[3] + g[3] * v0[3]);
                    w.z = cvt_pk_bf16(a[4] + g[4] * v1[0], a[5] + g[5] * v1[1]); w.w = cvt_pk_bf16(a[6] + g[6] * v1[2], a[7] + g[7] * v1[3]);
                    *(GAS u32x4*)gp = w;
                }
            }
        }
}

template <int MASK> DEV void run_epi(const Sched& S, const Unit& u, const f32x4 (&acc)[2][2][4][2], int wr, int wc, int fr, int fq) {
    const LAS int* Jp = (const LAS int*)(S.lds + JT_OFF) + u.jid * 12;
    Job J; J.A = nullptr; J.B = nullptr; J.out = (void*)rflp(Jp + 4); J.aux = (const void*)rflp(Jp + 6); J.nM = 0; J.nN = 0; J.ldc = rfl(Jp[10]); J.kind = rfl(Jp[11]);
    const int k = J.kind;
    if ((MASK & 1) && k == 0) epi_loop<0>(acc, J, u, wr, wc, fr, fq);
    else if ((MASK & 2) && k == 1) epi_loop<1>(acc, J, u, wr, wc, fr, fq);
    else if ((MASK & 4) && k == 2) epi_loop<2>(acc, J, u, wr, wc, fr, fq);
    else if ((MASK & 8) && k == 3) epi_loop<3>(acc, J, u, wr, wc, fr, fq);
    else if ((MASK & 16) && k == 4) epi_loop<4>(acc, J, u, wr, wc, fr, fq);
    else if ((MASK & 32) && k == 5) epi_loop<5>(acc, J, u, wr, wc, fr, fq);
    else if ((MASK & 64) && k == 6) epi_loop<6>(acc, J, u, wr, wc, fr, fq);
    else if ((MASK & 128) && k == 7) epi_loop<7>(acc, J, u, wr, wc, fr, fq);
}

template <int MASK>
DEV void gemm_phase(LAS unsigned char* lds, const int K, const Sched& S, const int tid) {
    const int wid = __builtin_amdgcn_readfirstlane(tid >> 6), lane = tid & 63, wr = wid >> 2, wc = wid & 3, fr = lane & 15, fq = lane >> 4;
    const int nt = K / BK;
    unsigned voffA[2], voffB[2];
#pragma unroll
    for (int i = 0; i < 2; ++i) { int R, C; stage_rc(tid * 16 + i * 8192, R, C); const int Rb = (R & ~31) + perm32(R & 31);
        voffA[i] = (unsigned)(R * K + C) * 2u; voffB[i] = (unsigned)(Rb * K + C) * 2u; }
    const size_t kstep = (size_t)(BK * 2);
    const size_t hstep = (size_t)HALF * K * 2;
    const unsigned ldsw = (unsigned)wid * 1024u;
    const int aoff = lds_byte(wr * 64 + fr, fq * 8), boff = lds_byte(wc * 32 + fr, fq * 8);
#define PG8_SA(b, h) (((b) * 2 + (h)) * HTB)
#define PG8_SB(b, h) ((4 + (b) * 2 + (h)) * HTB)
#define PG8_STAGE(bufoff, gbase, voff) do { _Pragma("unroll") for (int _i = 0; _i < 2; ++_i) \
        __builtin_amdgcn_global_load_lds((const unsigned*)((const char*)(gbase) + (voff)[_i]), (LAS unsigned*)(lds + (bufoff) + ldsw + _i * 8192), 16, 0, 0); } while (0)
#define PG8_LDA(dst, b, h) do { _Pragma("unroll") for (int m = 0; m < 4; ++m) _Pragma("unroll") for (int k = 0; k < 2; ++k) dst[m][k] = *(const LAS bf16x8*)(lds + PG8_SA(b, h) + aoff + m * 2048 + k * 1024); } while (0)
#define PG8_LDB(dst, b, h) do { _Pragma("unroll") for (int n = 0; n < 2; ++n) _Pragma("unroll") for (int k = 0; k < 2; ++k) dst[n][k] = *(const LAS bf16x8*)(lds + PG8_SB(b, h) + boff + n * 2048 + k * 1024); } while (0)
#define PG8_MMA(ai, bj, At, Bt) do { __builtin_amdgcn_s_setprio(1); _Pragma("unroll") for (int m = 0; m < 4; ++m) _Pragma("unroll") for (int n = 0; n < 2; ++n) _Pragma("unroll") for (int k = 0; k < 2; ++k) \
        acc[ai][bj][m][n] = __builtin_amdgcn_mfma_f32_16x16x32_bf16(Bt[n][k], At[m][k], acc[ai][bj][m][n], 0, 0, 0); __builtin_amdgcn_s_setprio(0); } while (0)
#define PG8_WAIT_V(n) asm volatile("s_waitcnt vmcnt(" #n ")" ::: "memory")
#define PG8_WAIT_L(n) asm volatile("s_waitcnt lgkmcnt(" #n ")" ::: "memory")
#define PG8_BAR __builtin_amdgcn_s_barrier()
#define PG8_SCHED __builtin_amdgcn_sched_barrier(0)
    Unit cur, nxt; int ui = 0;
    if (!S.next(0, cur)) return;
    f32x4 acc[2][2][4][2];
#pragma unroll
    for (int a = 0; a < 2; ++a)
#pragma unroll
        for (int b = 0; b < 2; ++b)
#pragma unroll
            for (int m = 0; m < 4; ++m)
#pragma unroll
                for (int n = 0; n < 2; ++n) acc[a][b][m][n] = (f32x4){0.f, 0.f, 0.f, 0.f};
    bf16x8 At[4][2], B0[2][2], B1[2][2];
    const char* cA = cur.A; const char* cB = cur.B;
    PG8_STAGE(PG8_SB(0, 0), cB, voffB); PG8_STAGE(PG8_SA(0, 0), cA, voffA); PG8_STAGE(PG8_SB(0, 1), cB + hstep, voffB); PG8_STAGE(PG8_SA(0, 1), cA + hstep, voffA);
    if (wr == 1) PG8_BAR;
    PG8_WAIT_V(4); PG8_BAR;
    PG8_STAGE(PG8_SB(1, 0), cB + kstep, voffB); PG8_STAGE(PG8_SA(1, 0), cA + kstep, voffA); PG8_STAGE(PG8_SB(1, 1), cB + hstep + kstep, voffB);
    PG8_WAIT_V(6); PG8_BAR;
    for (;;) {
        const bool has_next = S.next(ui + 1, nxt);
        const char* nA = has_next ? nxt.A : cA; const char* nB = has_next ? nxt.B : cB;
        for (int t = 0; t < nt; t += 2) {
            const bool last = (t == nt - 2);
            const char* a1 = cA + (size_t)(t + 1) * kstep;
            const char* a2 = last ? nA : cA + (size_t)(t + 2) * kstep; const char* b2 = last ? nB : cB + (size_t)(t + 2) * kstep;
            const char* a3 = a2 + kstep; const char* b3 = b2 + kstep;
            PG8_LDB(B0, 0, 0); PG8_SCHED; PG8_LDA(At, 0, 0); PG8_STAGE(PG8_SA(1, 1), a1 + hstep, voffA);
            PG8_WAIT_L(8); PG8_BAR; PG8_WAIT_L(0); PG8_MMA(0, 0, At, B0); PG8_BAR; PG8_SCHED;
            PG8_LDB(B1, 0, 1); PG8_STAGE(PG8_SB(0, 0), b2, voffB);
            PG8_BAR; PG8_WAIT_L(0); PG8_MMA(0, 1, At, B1); PG8_BAR;
            PG8_LDA(At, 0, 1); PG8_STAGE(PG8_SA(0, 0), a2, voffA);
            PG8_BAR; PG8_WAIT_L(0); PG8_MMA(1, 0, At, B0); PG8_BAR; PG8_SCHED;
            PG8_STAGE(PG8_SB(0, 1), b2 + hstep, voffB);
            PG8_WAIT_V(6); PG8_BAR; PG8_MMA(1, 1, At, B1); PG8_BAR;
            PG8_LDB(B0, 1, 0); PG8_SCHED; PG8_LDA(At, 1, 0); PG8_STAGE(PG8_SA(0, 1), a2 + hstep, voffA);
            PG8_WAIT_L(8); PG8_BAR; PG8_WAIT_L(0); PG8_MMA(0, 0, At, B0); PG8_BAR; PG8_SCHED;
            PG8_LDB(B1, 1, 1); PG8_STAGE(PG8_SB(1, 0), b3, voffB);
            PG8_BAR; PG8_WAIT_L(0); PG8_MMA(0, 1, At, B1); PG8_BAR;
            PG8_LDA(At, 1, 1); PG8_STAGE(PG8_SA(1, 0), a3, voffA);
            PG8_BAR; PG8_WAIT_L(0); PG8_MMA(1, 0, At, B0); PG8_BAR; PG8_SCHED;
            PG8_STAGE(PG8_SB(1, 1), b3 + hstep, voffB);
            PG8_WAIT_V(6); PG8_BAR; PG8_MMA(1, 1, At, B1); PG8_BAR;
        }
        run_epi<MASK>(S, cur, acc, wr, wc, fr, fq);
        if (!has_next) break;
#pragma unroll
        for (int a = 0; a < 2; ++a)
#pragma unroll
            for (int b = 0; b < 2; ++b)
#pragma unroll
                for (int m = 0; m < 4; ++m)
#pragma unroll
                    for (int n = 0; n < 2; ++n) acc[a][b][m][n] = (f32x4){0.f, 0.f, 0.f, 0.f};
        cur = nxt; cA = nA; cB = nB; ++ui;
    }
    PG8_WAIT_V(0);
    if (wr == 0) PG8_BAR;
    PG8_BAR;
#undef PG8_SA
#undef PG8_SB
#undef PG8_STAGE
#undef PG8_LDA
#undef PG8_LDB
#undef PG8_MMA
#undef PG8_WAIT_V
#undef PG8_WAIT_L
#undef PG8_BAR
#undef PG8_SCHED
}

template <int MASK>
DEV void gemm_simple(LAS unsigned char* lds, const int K, const Sched& S, const int tid) {
    const int wid = __builtin_amdgcn_readfirstlane(tid >> 6), lane = tid & 63, wr = wid >> 2, wc = wid & 3, fr = lane & 15, fq = lane >> 4;
    const int nt = K / BK;
    unsigned voffA[2], voffB[2];
#pragma unroll
    for (int i = 0; i < 2; ++i) { int R, C; stage_rc(tid * 16 + i * 8192, R, C); const int Rb = (R & ~31) + perm32(R & 31);
        voffA[i] = (unsigned)(R * K + C) * 2u; voffB[i] = (unsigned)(Rb * K + C) * 2u; }
    const size_t kstep = (size_t)(BK * 2), hstep = (size_t)HALF * K * 2;
    const unsigned ldsl = (unsigned)wid * 1024u + (unsigned)lane * 16u;
    const int aoff = lds_byte(wr * 64 + fr, fq * 8), boff = lds_byte(wc * 32 + fr, fq * 8);
#define GS_SA(b, h) (((b) * 2 + (h)) * HTB)
#define GS_SB(b, h) ((4 + (b) * 2 + (h)) * HTB)
#define GS_LOAD(dst, pa, pb) do { _Pragma("unroll") for (int _i = 0; _i < 2; ++_i) { \
        dst[0][_i] = *(const GAS u32x4*)((const GAS char*)(pa) + voffA[_i]); dst[1][_i] = *(const GAS u32x4*)((const GAS char*)(pa) + hstep + voffA[_i]); \
        dst[2][_i] = *(const GAS u32x4*)((const GAS char*)(pb) + voffB[_i]); dst[3][_i] = *(const GAS u32x4*)((const GAS char*)(pb) + hstep + voffB[_i]); } } while (0)
#define GS_WRITE(b, src) do { _Pragma("unroll") for (int _i = 0; _i < 2; ++_i) { \
        *(LAS u32x4*)(lds + GS_SA(b, 0) + ldsl + _i * 8192) = src[0][_i]; *(LAS u32x4*)(lds + GS_SA(b, 1) + ldsl + _i * 8192) = src[1][_i]; \
        *(LAS u32x4*)(lds + GS_SB(b, 0) + ldsl + _i * 8192) = src[2][_i]; *(LAS u32x4*)(lds + GS_SB(b, 1) + ldsl + _i * 8192) = src[3][_i]; } } while (0)
    Unit cur; int ui = 0;
    while (S.next(ui, cur)) {
        f32x4 acc[2][2][4][2];
#pragma unroll
        for (int a = 0; a < 2; ++a)
#pragma unroll
            for (int b = 0; b < 2; ++b)
#pragma unroll
                for (int m = 0; m < 4; ++m)
#pragma unroll
                    for (int n = 0; n < 2; ++n) acc[a][b][m][n] = (f32x4){0.f, 0.f, 0.f, 0.f};
        const char* cA = cur.A; const char* cB = cur.B;
        u32x4 st[4][2];
        GS_LOAD(st, cA, cB);
        GS_WRITE(0, st);
        __syncthreads();
        for (int t = 0; t < nt; ++t) {
            const int b = t & 1;
            if (t + 1 < nt) GS_LOAD(st, cA + (size_t)(t + 1) * kstep, cB + (size_t)(t + 1) * kstep);
#pragma unroll
            for (int ai = 0; ai < 2; ++ai) {
                bf16x8 At[4][2];
#pragma unroll
                for (int m = 0; m < 4; ++m)
#pragma unroll
                    for (int k = 0; k < 2; ++k) At[m][k] = *(const LAS bf16x8*)(lds + (b ? GS_SA(1, 0) : GS_SA(0, 0)) + ai * HTB + aoff + m * 2048 + k * 1024);
#pragma unroll
                for (int bj = 0; bj < 2; ++bj) {
                    bf16x8 Bt[2][2];
#pragma unroll
                    for (int n = 0; n < 2; ++n)
#pragma unroll
                        for (int k = 0; k < 2; ++k) Bt[n][k] = *(const LAS bf16x8*)(lds + (b ? GS_SB(1, 0) : GS_SB(0, 0)) + bj * HTB + boff + n * 2048 + k * 1024);
#pragma unroll
                    for (int m = 0; m < 4; ++m)
#pragma unroll
                        for (int n = 0; n < 2; ++n)
#pragma unroll
                            for (int k = 0; k < 2; ++k) acc[ai][bj][m][n] = __builtin_amdgcn_mfma_f32_16x16x32_bf16(Bt[n][k], At[m][k], acc[ai][bj][m][n], 0, 0, 0);
                }
            }
            if (t + 1 < nt) { if (b) GS_WRITE(0, st); else GS_WRITE(1, st); }
            __syncthreads();
        }
        run_epi<MASK>(S, cur, acc, wr, wc, fr, fq);
        ++ui;
    }
    __syncthreads();
#undef GS_SA
#undef GS_SB
#undef GS_LOAD
#undef GS_WRITE
}
}

DEV void transpose_item(const float* W, int K, int N, bf16_t* WT, LAS float* scr, int item, int lane) {
    const int nblk = N / 32, kb = item / nblk, nb = item % nblk, k0 = 64 * kb, n0 = 32 * nb;
#pragma unroll 8
    for (int i = 0; i < 32; ++i) { const int kk = 2 * i + (lane >> 5); scr[kk * 33 + (lane & 31)] = W[(size_t)(k0 + kk) * N + n0 + (lane & 31)]; }
    LDS_WAIT();
    const int c = lane & 7;
#pragma unroll
    for (int jj = 0; jj < 4; ++jj) { const int n = (lane >> 3) + 8 * jj; const LAS float* s = scr + (8 * c) * 33 + n;
        u32x4 o; o.x = pk2(s[0 * 33], s[1 * 33]); o.y = pk2(s[2 * 33], s[3 * 33]); o.z = pk2(s[4 * 33], s[5 * 33]); o.w = pk2(s[6 * 33], s[7 * 33]);
        *(u32x4*)(WT + (size_t)(n0 + n) * K + k0 + 8 * c) = o; }
    LDS_WAIT();
}

DEV void phase_weights(unsigned char* ws, const float* w_in, const float* w_oa, const float* w_os, const float* w_og, const float* w_o, const float* w_up, const float* w_dn, LAS unsigned char* lds, int gw, int NGW, int wave, int lane) {
    LAS float* scr = (LAS float*)(lds + wave * 8704);
    constexpr int I_IN = 16 * (INW / 32), I_SQ = 16 * 32, I_UP = 16 * 128, I_DN = 64 * 32;
    constexpr int NIT = I_IN + 4 * I_SQ + I_UP + I_DN;
    for (int it = gw; it < NIT; it += NGW) {
        int r = it;
        if (r < I_IN) { transpose_item(w_in, 1024, INW, (bf16_t*)(ws + WS_WIN), scr, r, lane); continue; } r -= I_IN;
        if (r < I_SQ) { transpose_item(w_oa, 1024, 1024, (bf16_t*)(ws + WS_WOA), scr, r, lane); continue; } r -= I_SQ;
        if (r < I_SQ) { transpose_item(w_os, 1024, 1024, (bf16_t*)(ws + WS_WOS), scr, r, lane); continue; } r -= I_SQ;
        if (r < I_SQ) { transpose_item(w_og, 1024, 1024, (bf16_t*)(ws + WS_WOG), scr, r, lane); continue; } r -= I_SQ;
        if (r < I_SQ) { transpose_item(w_o, 1024, 1024, (bf16_t*)(ws + WS_WO), scr, r, lane); continue; } r -= I_SQ;
        if (r < I_UP) { transpose_item(w_up, 1024, 4096, (bf16_t*)(ws + WS_WUP), scr, r, lane); continue; } r -= I_UP;
        transpose_item(w_dn, 4096, 1024, (bf16_t*)(ws + WS_WDN), scr, r, lane);
    }
}

DEV void phase_rmsnorm_bf16(const float* x, const float* w, bf16_t* o, int nrows, int gw, int NGW, int lane) {
    for (int m = gw; m < nrows; m += NGW) {
        const f32x4* xr = (const f32x4*)(x + (size_t)m * DM) + lane;
        f32x4 v[4]; float s = 0.f;
#pragma unroll
        for (int j = 0; j < 4; ++j) { v[j] = xr[64 * j]; s += (v[j].x * v[j].x + v[j].y * v[j].y) + (v[j].z * v[j].z + v[j].w * v[j].w); }
        const float rstd = rsqrtf(wave_sum(s) * (1.f / DM) + EPS);
        u32x2* o8 = (u32x2*)(o + (size_t)m * DM) + lane;
#pragma unroll
        for (int j = 0; j < 4; ++j) { const f32x4 ww = ((const f32x4*)w)[lane + 64 * j]; u32x2 r; r.x = pk2(v[j].x * rstd * ww.x, v[j].y * rstd * ww.y); r.y = pk2(v[j].z * rstd * ww.z, v[j].w * rstd * ww.w); o8[64 * j] = r; }
    }
}
DEV void phase_rmsnorm_f32(float* x, const float* w, int nrows, int gw, int NGW, int lane) {
    for (int m = gw; m < nrows; m += NGW) {
        f32x4* xr = (f32x4*)(x + (size_t)m * DM) + lane;
        f32x4 v[4]; float s = 0.f;
#pragma unroll
        for (int j = 0; j < 4; ++j) { v[j] = xr[64 * j]; s += (v[j].x * v[j].x + v[j].y * v[j].y) + (v[j].z * v[j].z + v[j].w * v[j].w); }
        const float rstd = rsqrtf(wave_sum(s) * (1.f / DM) + EPS);
#pragma unroll
        for (int j = 0; j < 4; ++j) { const f32x4 ww = ((const f32x4*)w)[lane + 64 * j]; xr[64 * j] = v[j] * rstd * ww; }
    }
}

DEV void phase_narrow(const bf16_t* HB, const bf16_t* Wdt, const bf16_t* Wgk, float* DTGK, int gw, int NGW, int lane) {
    const int fr = lane & 15, fq = lane >> 4;
    for (int u = gw; u < HT / 16; u += NGW) {
        const int t0 = u * 16;
        f32x4 a0 = {0.f, 0.f, 0.f, 0.f}, a1 = {0.f, 0.f, 0.f, 0.f};
        const bf16_t* ap = HB + (size_t)(t0 + fr) * DM + fq * 8;
        const bf16_t* b0p = Wdt + (size_t)fr * DM + fq * 8;
        const bf16_t* b1p = Wgk + (size_t)fr * DM + fq * 8;
#pragma unroll 4
        for (int k = 0; k < DM; k += 32) {
            const bf16x8 a = *(const bf16x8*)(ap + k), b0 = *(const bf16x8*)(b0p + k), b1 = *(const bf16x8*)(b1p + k);
            a0 = mma(a, b0, a0); a1 = mma(a, b1, a1);
        }
#pragma unroll
        for (int j = 0; j < 4; ++j) { float* d = DTGK + (size_t)(t0 + 4 * fq + j) * 32; d[fr] = a0[j]; d[16 + fr] = a1[j]; }
    }
}

DEV void phase_conv_a(const bf16_t* __restrict__ UA, const float* __restrict__ cw, bf16_t* __restrict__ YIN, int gtid, int NT) {
    for (int u = gtid; u < (HT / 16) * 128; u += NT) {
        const int c0 = (u & 127) * 8, t0 = (u >> 7) * 16;
        float w0[8], w1[8], w2[8], p1[8], p2[8];
#pragma unroll
        for (int j = 0; j < 8; ++j) { w0[j] = cw[c0 + j]; w1[j] = cw[1024 + c0 + j]; w2[j] = cw[2048 + c0 + j]; p1[j] = 0.f; p2[j] = 0.f; }
        if ((t0 & (SEQ - 1)) != 0) {
            float ax[8], ac[8];
            unpack8(*(const u32x4*)(UA + (size_t)(t0 - 2) * 3072 + c0), ax); unpack8(*(const u32x4*)(UA + (size_t)(t0 - 2) * 3072 + 2048 + c0), ac);
#pragma unroll
            for (int j = 0; j < 8; ++j) p2[j] = ax[j] * ac[j];
            unpack8(*(const u32x4*)(UA + (size_t)(t0 - 1) * 3072 + c0), ax); unpack8(*(const u32x4*)(UA + (size_t)(t0 - 1) * 3072 + 2048 + c0), ac);
#pragma unroll
            for (int j = 0; j < 8; ++j) p1[j] = ax[j] * ac[j];
        }
#pragma unroll 4
        for (int i = 0; i < 16; ++i) {
            const bf16_t* rp = UA + (size_t)(t0 + i) * 3072 + c0;
            float ax[8], ab[8], ac[8], o[8];
            unpack8(*(const u32x4*)rp, ax); unpack8(*(const u32x4*)(rp + 1024), ab); unpack8(*(const u32x4*)(rp + 2048), ac);
#pragma unroll
            for (int j = 0; j < 8; ++j) { const float p0 = ax[j] * ac[j]; o[j] = ab[j] * (w0[j] * p2[j] + w1[j] * p1[j] + w2[j] * p0); p2[j] = p1[j]; p1[j] = p0; }
            *(u32x4*)(YIN + (size_t)(t0 + i) * DM + c0) = pack8(o);
        }
    }
}

DEV void phase_ssd_prep(unsigned char* ws, const float* cw, const float* cb, const float* dtb, const float* alog, int gtid, int NT, int tid, int nblk, int blk) {
    const bf16_t* __restrict__ XST = (const bf16_t*)(ws + RB_XST); bf16_t* __restrict__ XSTC = (bf16_t*)(ws + RB_XSTC);
    for (int u = gtid; u < 1024 * (HT / 8); u += NT) {
        const int tb = u & (HT / 8 - 1), c = u >> 11, t0 = tb * 8;
        float x[11], cur[8];
        unpack8(*(const u32x4*)(XST + (size_t)c * HT + t0), cur);
        if ((t0 & (SEQ - 1)) != 0) { float pv[8]; unpack8(*(const u32x4*)(XST + (size_t)c * HT + t0 - 8), pv); x[0] = pv[5]; x[1] = pv[6]; x[2] = pv[7]; }
        else { x[0] = 0.f; x[1] = 0.f; x[2] = 0.f; }
#pragma unroll
        for (int i = 0; i < 8; ++i) x[3 + i] = cur[i];
        const float w0 = cw[c], w1 = cw[2048 + c], w2 = cw[4096 + c], w3 = cw[6144 + c], b = cb[c];
        float y[8];
#pragma unroll
        for (int i = 0; i < 8; ++i) y[i] = siluf_(b + w0 * x[i] + w1 * x[i + 1] + w2 * x[i + 2] + w3 * x[i + 3]);
        *(u32x4*)(XSTC + (size_t)c * HT + t0) = pack8(y);
    }
    const bf16_t* __restrict__ BC = (const bf16_t*)(ws + RB_BC); bf16_t* __restrict__ BCC = (bf16_t*)(ws + RB_BCC); bf16_t* __restrict__ BTC = (bf16_t*)(ws + RB_BTC);
    for (int u = gtid; u < (HT / 8) * 128; u += NT) {
        const int cg8 = u & 127, c0 = cg8 * 8, t0 = (u >> 7) * 8, cc = 1024 + c0;
        float w0[8], w1[8], w2[8], w3[8], bb[8], x1[8], x2[8], x3[8];
#pragma unroll
        for (int j = 0; j < 8; ++j) { w0[j] = cw[cc + j]; w1[j] = cw[2048 + cc + j]; w2[j] = cw[4096 + cc + j]; w3[j] = cw[6144 + cc + j]; bb[j] = cb[cc + j]; x1[j] = 0.f; x2[j] = 0.f; x3[j] = 0.f; }
        if ((t0 & (SEQ - 1)) != 0) {
            unpack8(*(const u32x4*)(BC + (size_t)(t0 - 1) * DM + c0), x1); unpack8(*(const u32x4*)(BC + (size_t)(t0 - 2) * DM + c0), x2); unpack8(*(const u32x4*)(BC + (size_t)(t0 - 3) * DM + c0), x3);
        }
        unsigned tr[8][4];
#pragma unroll
        for (int i = 0; i < 8; ++i) {
            float x0[8], y[8];
            unpack8(*(const u32x4*)(BC + (size_t)(t0 + i) * DM + c0), x0);
#pragma unroll
            for (int j = 0; j < 8; ++j) { y[j] = siluf_(bb[j] + w3[j] * x0[j] + w2[j] * x1[j] + w1[j] * x2[j] + w0[j] * x3[j]); x3[j] = x2[j]; x2[j] = x1[j]; x1[j] = x0[j]; }
            *(u32x4*)(BCC + (size_t)(t0 + i) * DM + c0) = pack8(y);
#pragma unroll
            for (int j = 0; j < 8; ++j) { if (i & 1) tr[j][i >> 1] |= f2bf(y[j]) << 16; else tr[j][i >> 1] = f2bf(y[j]); }
        }
        if (cg8 < 64) {
#pragma unroll
            for (int j = 0; j < 8; ++j) *(u32x4*)(BTC + (size_t)(c0 + j) * HT + t0) = (u32x4){tr[j][0], tr[j][1], tr[j][2], tr[j][3]};
        }
    }
    const float* __restrict__ DTGK = (const float*)(ws + WS_DTGK); float* __restrict__ DT = (float*)(ws + RB_DT); float* __restrict__ AC = (float*)(ws + RB_ACUM);
    {
        const int lane_ = tid & 63, gw_ = blk * NWAVES + (tid >> 6), ngw_ = nblk * NWAVES;
        for (int ch = gw_; ch < HT / 128; ch += ngw_) {
            const size_t tA = (size_t)ch * 128 + 2 * lane_;
            float d0[16], d1[16];
#pragma unroll
            for (int q = 0; q < 4; ++q) { const f32x4 a = *(const f32x4*)(DTGK + tA * 32 + 4 * q), b = *(const f32x4*)(DTGK + (tA + 1) * 32 + 4 * q);
#pragma unroll
                for (int e = 0; e < 4; ++e) { d0[4 * q + e] = a[e]; d1[4 * q + e] = b[e]; } }
            float c0[16], c1[16];
#pragma unroll
            for (int h = 0; h < 16; ++h) {
                const float av = -__expf(alog[h]), bias = dtb[h];
                d0[h] = softplusf_(d0[h] + bias); d1[h] = softplusf_(d1[h] + bias);
                const float x0 = d0[h] * av, x1 = x0 + d1[h] * av;
                float s = x1;
#pragma unroll
                for (int off = 1; off < 64; off <<= 1) { const float y = __shfl_up(s, off); if (lane_ >= off) s += y; }
                const float pre = s - x1; c0[h] = pre + x0; c1[h] = pre + x1;
            }
#pragma unroll
            for (int q = 0; q < 4; ++q) {
                *(f32x4*)(DT + tA * 16 + 4 * q) = (f32x4){d0[4 * q], d0[4 * q + 1], d0[4 * q + 2], d0[4 * q + 3]};
                *(f32x4*)(DT + (tA + 1) * 16 + 4 * q) = (f32x4){d1[4 * q], d1[4 * q + 1], d1[4 * q + 2], d1[4 * q + 3]};
                *(f32x4*)(AC + tA * 16 + 4 * q) = (f32x4){c0[4 * q], c0[4 * q + 1], c0[4 * q + 2], c0[4 * q + 3]};
                *(f32x4*)(AC + (tA + 1) * 16 + 4 * q) = (f32x4){c1[4 * q], c1[4 * q + 1], c1[4 * q + 2], c1[4 * q + 3]};
            }
        }
    }
}

DEV void phase_ssd_states(unsigned char* ws, LAS unsigned char* lds, int tid, int wave, int lane) {
    const bf16_t* XSTC = (const bf16_t*)(ws + RB_XSTC); const bf16_t* BTC = (const bf16_t*)(ws + RB_BTC);
    const float* DT = (const float*)(ws + RB_DT); const float* AC = (const float*)(ws + RB_ACUM); bf16_t* ST = (bf16_t*)(ws + RB_ST);
    constexpr int BT_OFF = 0, XW_OFF = 34816, TAB_OFF = 34816 + 69632, RS = 272;
    LAS float* wt = (LAS float*)(lds + TAB_OFF);
    const int fr = lane & 15, fq = lane >> 4;
    for (int unit = blockIdx.x; unit < (HT / 128) * 4; unit += gridDim.x) {
        const int cidx = unit >> 2, g = unit & 3, t0 = cidx * 128;
        { const int r = tid >> 7, l = tid & 127, h = g * 4 + r;
          const float al = AC[(size_t)(t0 + 127) * 16 + h], a = AC[(size_t)(t0 + l) * 16 + h];
          wt[r * 128 + l] = DT[(size_t)(t0 + l) * 16 + h] * __expf(al - a); }
        for (int i = tid; i < 2048; i += NTHR) { const int row = i >> 4, ch = i & 15;
            *(LAS u32x4*)(lds + BT_OFF + row * RS + ch * 16) = *(const u32x4*)(BTC + (size_t)(g * 128 + row) * HT + t0 + ch * 8); }
        __syncthreads();
        for (int i = tid; i < 4096; i += NTHR) { const int row = i >> 4, ch = i & 15; float f[8];
            unpack8(*(const u32x4*)(XSTC + (size_t)(g * 256 + row) * HT + t0 + ch * 8), f);
            const LAS float* wp = wt + (row >> 6) * 128 + ch * 8;
#pragma unroll
            for (int e = 0; e < 8; ++e) f[e] *= wp[e];
            *(LAS u32x4*)(lds + XW_OFF + row * RS + ch * 16) = pack8(f); }
        __syncthreads();
        f32x4 acc[2][8];
#pragma unroll
        for (int a = 0; a < 2; ++a)
#pragma unroll
            for (int b = 0; b < 8; ++b) acc[a][b] = (f32x4){0.f, 0.f, 0.f, 0.f};
#pragma unroll
        for (int ks = 0; ks < 4; ++ks) {
            const bf16x8 y0 = ldsfrag(lds + XW_OFF + (wave * 32 + fr) * RS + ks * 64 + fq * 16), y1 = ldsfrag(lds + XW_OFF + (wave * 32 + 16 + fr) * RS + ks * 64 + fq * 16);
#pragma unroll
            for (int nt = 0; nt < 8; ++nt) { const bf16x8 x = ldsfrag(lds + BT_OFF + (nt * 16 + fr) * RS + ks * 64 + fq * 16); acc[0][nt] = mma(x, y0, acc[0][nt]); acc[1][nt] = mma(x, y1, acc[1][nt]); }
        }
#pragma unroll
        for (int yt = 0; yt < 2; ++yt) { const int pp = wave * 32 + yt * 16 + fr, h = g * 4 + (pp >> 6), p = pp & 63;
            bf16_t* d = ST + (((size_t)cidx * 16 + h) * 64 + p) * 128 + 4 * fq;
#pragma unroll
            for (int nt = 0; nt < 8; ++nt) { u32x2 w; w.x = pk2(acc[yt][nt][0], acc[yt][nt][1]); w.y = pk2(acc[yt][nt][2], acc[yt][nt][3]); *(u32x2*)(d + nt * 16) = w; } }
        __syncthreads();
    }
}

DEV void phase_ssd_scan(unsigned char* ws, int gtid, int NT) {
    unsigned* ST = (unsigned*)(ws + RB_ST); const float* AC = (const float*)(ws + RB_ACUM);
    for (int e = gtid; e < 2 * 65536; e += NT) {
        const int bl = e >> 16, rem = e & 65535, h = rem >> 12;
        f32x2 carry = {0.f, 0.f};
        for (int c0 = 0; c0 < 64; c0 += 8) {
            unsigned v[8]; float dec[8];
#pragma unroll
            for (int i = 0; i < 8; ++i) { const int cidx = bl * 64 + c0 + i; v[i] = ST[(size_t)cidx * 65536 + rem]; dec[i] = __expf(AC[((size_t)cidx * 128 + 127) * 16 + h]); }
#pragma unroll
            for (int i = 0; i < 8; ++i) { const int cidx = bl * 64 + c0 + i; ST[(size_t)cidx * 65536 + rem] = pk2(carry[0], carry[1]);
                carry[0] = carry[0] * dec[i] + bf_lo(v[i]); carry[1] = carry[1] * dec[i] + bf_hi(v[i]); }
        }
    }
}

DEV void phase_ssd_out(unsigned char* ws, const float* dsk, const float* nw, LAS unsigned char* lds, int tid, int wave, int lane) {
    const bf16_t* XSTC = (const bf16_t*)(ws + RB_XSTC); const bf16_t* BCC = (const bf16_t*)(ws + RB_BCC); const bf16_t* Z = (const bf16_t*)(ws + RB_Z);
    const float* DT = (const float*)(ws + RB_DT); const float* AC = (const float*)(ws + RB_ACUM); const bf16_t* ST = (const bf16_t*)(ws + RB_ST);
    bf16_t* YIN = (bf16_t*)(ws + WS_YIN);
    float* YT = (float*)(ws + RB_XST);
    constexpr int C_OFF = 0, B_OFF = 34816, PV_OFF = 34816, XS_OFF = 34816 + 17408, M_OFF = 69632, TAB_OFF = 104448, RS = 272;
    LAS float* tac = (LAS float*)(lds + TAB_OFF); LAS float* tdt = tac + 512;
    const int fr = lane & 15, fq = lane >> 4;
    LAS unsigned char* Mw = lds + M_OFF + wave * 4352;
    for (int unit = blockIdx.x; unit < (HT / 128) * 4; unit += gridDim.x) {
        const int cidx = unit >> 2, g = unit & 3, t0 = cidx * 128;
        for (int i = tid; i < 2048; i += NTHR) { const int row = i >> 4, ch = i & 15;
            *(LAS u32x4*)(lds + C_OFF + row * RS + ch * 16) = *(const u32x4*)(BCC + (size_t)(t0 + row) * DM + 512 + g * 128 + ch * 8);
            *(LAS u32x4*)(lds + B_OFF + row * RS + ch * 16) = *(const u32x4*)(BCC + (size_t)(t0 + row) * DM + g * 128 + ch * 8); }
        { const int r = tid >> 7, l = tid & 127, h = g * 4 + r; tac[tid] = AC[(size_t)(t0 + l) * 16 + h]; tdt[tid] = DT[(size_t)(t0 + l) * 16 + h]; }
        __syncthreads();
        f32x4 cb[8];
#pragma unroll
        for (int st = 0; st < 8; ++st) cb[st] = (f32x4){0.f, 0.f, 0.f, 0.f};
#pragma unroll
        for (int ks = 0; ks < 4; ++ks) {
            const bf16x8 y = ldsfrag(lds + C_OFF + (wave * 16 + fr) * RS + ks * 64 + fq * 16);
#pragma unroll
            for (int st = 0; st < 8; ++st) cb[st] = mma(ldsfrag(lds + B_OFF + (st * 16 + fr) * RS + ks * 64 + fq * 16), y, cb[st]);
        }
        __syncthreads();
        const int l = wave * 16 + fr;
        const size_t t = (size_t)(t0 + l);
        float ssq = 0.f;
#pragma unroll 1
        for (int r = 0; r < 4; ++r) {
            const int h = g * 4 + r;
            for (int i = tid; i < 1024; i += NTHR) { const int row = i >> 4, ch = i & 15;
                *(LAS u32x4*)(lds + PV_OFF + row * RS + ch * 16) = *(const u32x4*)(ST + (((size_t)cidx * 16 + h) * 64 + row) * 128 + ch * 8); }
            for (int i = tid; i < 1024; i += NTHR) { const int row = i >> 4, ch = i & 15;
                *(LAS u32x4*)(lds + XS_OFF + row * RS + ch * 16) = *(const u32x4*)(XSTC + (size_t)(h * 64 + row) * HT + t0 + ch * 8); }
            const float al = tac[r * 128 + l];
#pragma unroll
            for (int st = 0; st < 8; ++st) { float m[4];
#pragma unroll
                for (int j = 0; j < 4; ++j) { const int s = st * 16 + 4 * fq + j; const float d = fminf(al - tac[r * 128 + s], 0.f); m[j] = (s <= l) ? cb[st][j] * __expf(d) * tdt[r * 128 + s] : 0.f; }
                u32x2 w; w.x = pk2(m[0], m[1]); w.y = pk2(m[2], m[3]); *(LAS u32x2*)(Mw + fr * RS + (st * 16 + 4 * fq) * 2) = w; }
            __syncthreads();
            f32x4 acc[4];
#pragma unroll
            for (int pt = 0; pt < 4; ++pt) acc[pt] = (f32x4){0.f, 0.f, 0.f, 0.f};
#pragma unroll
            for (int ks = 0; ks < 4; ++ks) { const bf16x8 y = ldsfrag(lds + C_OFF + l * RS + ks * 64 + fq * 16);
#pragma unroll
                for (int pt = 0; pt < 4; ++pt) acc[pt] = mma(ldsfrag(lds + PV_OFF + (pt * 16 + fr) * RS + ks * 64 + fq * 16), y, acc[pt]); }
            const float el = __expf(al);
#pragma unroll
            for (int pt = 0; pt < 4; ++pt) acc[pt] *= el;
#pragma unroll
            for (int ks = 0; ks < 4; ++ks) { const bf16x8 y = ldsfrag(Mw + fr * RS + ks * 64 + fq * 16);
#pragma unroll
                for (int pt = 0; pt < 4; ++pt) acc[pt] = mma(ldsfrag(lds + XS_OFF + (pt * 16 + fr) * RS + ks * 64 + fq * 16), y, acc[pt]); }
            const float dh = dsk[h];
#pragma unroll
            for (int pt = 0; pt < 4; ++pt) {
#pragma unroll
                for (int j = 0; j < 4; ++j) { const bf16_t xv = *(const LAS bf16_t*)(lds + XS_OFF + (pt * 16 + 4 * fq + j) * RS + l * 2); acc[pt][j] += dh * bf1(xv); }
                const int c = g * 256 + r * 64 + pt * 16 + 4 * fq;
                const u32x2 zw = *(const u32x2*)(Z + t * DM + c);
                f32x4 v = acc[pt]; v[0] *= bf_lo(zw.x); v[1] *= bf_hi(zw.x); v[2] *= bf_lo(zw.y); v[3] *= bf_hi(zw.y);
                ssq += (v[0] * v[0] + v[1] * v[1]) + (v[2] * v[2] + v[3] * v[3]);
                *(f32x4*)(YT + t * DM + c) = v;
            }
            __syncthreads();
        }
        ssq += __shfl_xor(ssq, 16); ssq += __shfl_xor(ssq, 32);
        const float rstd = rsqrtf(ssq * (1.f / 256.f) + EPS);
#pragma unroll 4
        for (int q = 0; q < 16; ++q) { const int c = g * 256 + q * 16 + 4 * fq;
            const f32x4 w4 = *(const f32x4*)(nw + c); const f32x4 v = *(const f32x4*)(YT + t * DM + c);
            u32x2 o; o.x = pk2(v[0] * rstd * w4[0], v[1] * rstd * w4[1]); o.y = pk2(v[2] * rstd * w4[2], v[3] * rstd * w4[3]);
            *(u32x2*)(YIN + t * DM + c) = o; }
        __syncthreads();
    }
}

DEV float gla_gk(const float* DTGK, size_t t, const float (&w)[16], float b) {
    const f32x4* gl = (const f32x4*)(DTGK + t * 32 + 16);
    const f32x4 g0 = gl[0], g1 = gl[1], g2 = gl[2], g3 = gl[3];
    float z = b;
    z += g0[0] * w[0] + g0[1] * w[1] + g0[2] * w[2] + g0[3] * w[3];
    z += g1[0] * w[4] + g1[1] * w[5] + g1[2] * w[6] + g1[3] * w[7];
    z += g2[0] * w[8] + g2[1] * w[9] + g2[2] * w[10] + g2[3] * w[11];
    z += g3[0] * w[12] + g3[1] * w[13] + g3[2] * w[14] + g3[3] * w[15];
    return logsigf_(z) * (1.f / 16.f);
}
DEV void phase_gla_prep(unsigned char* ws, const float* w2, const float* bg, int gtid, int NT) {
    bf16_t* QK = (bf16_t*)(ws + RC_QK); bf16_t* __restrict__ KT = (bf16_t*)(ws + RC_KT); float* __restrict__ DEC = (float*)(ws + WS_DEC);
    const float* __restrict__ DTGK = (const float*)(ws + WS_DTGK);
    for (int e = gtid; e < (HT / 64) * 512; e += NT) {
        const int d = e & 511, ch = e >> 9, t0 = ch * 64;
        float w[16];
#pragma unroll
        for (int j = 0; j < 16; ++j) w[j] = w2[j * 512 + d];
        const float b = bg[d];
        float glast = 0.f;
#pragma unroll 4
        for (int i = 0; i < 64; ++i) glast += gla_gk(DTGK, (size_t)(t0 + i), w, b);
        float run = 0.f;
        bf16_t* kd = KT + (size_t)d * HT + t0;
#pragma unroll 1
        for (int m = 0; m < 8; ++m) {
            unsigned tr[4];
#pragma unroll
            for (int ii = 0; ii < 8; ++ii) {
                const int i = m * 8 + ii;
                run += gla_gk(DTGK, (size_t)(t0 + i), w, b);
                bf16_t* qp = QK + (size_t)(t0 + i) * DM + d;
                const float q = bf1(qp[0]), k = bf1(qp[512]);
                qp[0] = (bf16_t)f2bf(q * 0.08838834764831845f * __expf(run));
                qp[512] = (bf16_t)f2bf(k * __expf(-run));
                const unsigned ke = f2bf(k * __expf(glast - run));
                if (ii & 1) tr[ii >> 1] |= ke << 16; else tr[ii >> 1] = ke;
            }
            *(u32x4*)(kd + 8 * m) = (u32x4){tr[0], tr[1], tr[2], tr[3]};
        }
        DEC[(size_t)ch * 512 + d] = __expf(glast);
    }
}

DEV void phase_gla_states(unsigned char* ws, LAS unsigned char* lds, int tid, int wave, int lane) {
    const bf16_t* KT = (const bf16_t*)(ws + RC_KT); const bf16_t* VT = (const bf16_t*)(ws + RC_VT); bf16_t* ST = (bf16_t*)(ws + RC_ST);
    constexpr int V_OFF = 0, K_OFF = 36864, RS = 144;
    const int fr = lane & 15, fq = lane >> 4;
    for (int unit = blockIdx.x; unit < (HT / 64) * 4; unit += gridDim.x) {
        const int cidx = unit >> 2, h = unit & 3, t0 = cidx * 64;
        for (int i = tid; i < 2048; i += NTHR) { const int row = i >> 3, ch = i & 7;
            *(LAS u32x4*)(lds + V_OFF + row * RS + ch * 16) = *(const u32x4*)(VT + (size_t)(h * 256 + row) * HT + t0 + ch * 8); }
        for (int i = tid; i < 1024; i += NTHR) { const int row = i >> 3, ch = i & 7;
            *(LAS u32x4*)(lds + K_OFF + row * RS + ch * 16) = *(const u32x4*)(KT + (size_t)(h * 128 + row) * HT + t0 + ch * 8); }
        __syncthreads();
        f32x4 acc[2][8];
#pragma unroll
        for (int a = 0; a < 2; ++a)
#pragma unroll
            for (int b = 0; b < 8; ++b) acc[a][b] = (f32x4){0.f, 0.f, 0.f, 0.f};
#pragma unroll
        for (int ks = 0; ks < 2; ++ks) {
            const bf16x8 y0 = ldsfrag(lds + V_OFF + (wave * 32 + fr) * RS + ks * 64 + fq * 16), y1 = ldsfrag(lds + V_OFF + (wave * 32 + 16 + fr) * RS + ks * 64 + fq * 16);
#pragma unroll
            for (int dt = 0; dt < 8; ++dt) { const bf16x8 x = ldsfrag(lds + K_OFF + (dt * 16 + fr) * RS + ks * 64 + fq * 16); acc[0][dt] = mma(x, y0, acc[0][dt]); acc[1][dt] = mma(x, y1, acc[1][dt]); }
        }
#pragma unroll
        for (int yt = 0; yt < 2; ++yt) { const int v = wave * 32 + yt * 16 + fr;
            bf16_t* dp = ST + (((size_t)cidx * 4 + h) * 256 + v) * 128 + 4 * fq;
#pragma unroll
            for (int dt = 0; dt < 8; ++dt) { u32x2 w; w.x = pk2(acc[yt][dt][0], acc[yt][dt][1]); w.y = pk2(acc[yt][dt][2], acc[yt][dt][3]); *(u32x2*)(dp + dt * 16) = w; } }
        __syncthreads();
    }
}

DEV void phase_gla_scan(unsigned char* ws, int gtid, int NT) {
    unsigned* ST = (unsigned*)(ws + RC_ST); const float* DEC = (const float*)(ws + WS_DEC);
    for (int e = gtid; e < 2 * 65536; e += NT) {
        const int bl = e >> 16, rem = e & 65535, h = rem >> 14, d = (rem * 2) & 127;
        f32x2 carry = {0.f, 0.f};
        for (int c0 = 0; c0 < 128; c0 += 8) {
            unsigned v[8]; f32x2 dec[8];
#pragma unroll
            for (int i = 0; i < 8; ++i) { const int cidx = bl * 128 + c0 + i; v[i] = ST[(size_t)cidx * 65536 + rem]; dec[i] = *(const f32x2*)(DEC + (size_t)cidx * 512 + h * 128 + d); }
#pragma unroll
            for (int i = 0; i < 8; ++i) { const int cidx = bl * 128 + c0 + i; ST[(size_t)cidx * 65536 + rem] = pk2(carry[0], carry[1]);
                carry[0] = carry[0] * dec[i][0] + bf_lo(v[i]); carry[1] = carry[1] * dec[i][1] + bf_hi(v[i]); }
        }
    }
}

DEV void phase_gla_out(unsigned char* ws, const float* nw, LAS unsigned char* lds, int tid, int wave, int lane) {
    const bf16_t* QK = (const bf16_t*)(ws + RC_QK); const bf16_t* VT = (const bf16_t*)(ws + RC_VT); const bf16_t* GS = (const bf16_t*)(ws + RC_GS);
    const bf16_t* ST = (const bf16_t*)(ws + RC_ST); bf16_t* YIN = (bf16_t*)(ws + WS_YIN);
    constexpr int Q_OFF = 0, K_OFF = 17408, V_OFF = 34816, P_OFF = 71680, S_OFF = 80896, RSD = 272, RST = 144;
    LAS float* ssqt = (LAS float*)(lds + S_OFF);
    const int fr = lane & 15, fq = lane >> 4, lt = wave >> 1, vh = wave & 1;
    for (int unit = blockIdx.x; unit < (HT / 64) * 4; unit += gridDim.x) {
        const int cidx = unit >> 2, h = unit & 3, t0 = cidx * 64;
        for (int i = tid; i < 1024; i += NTHR) { const int row = i >> 4, ch = i & 15;
            *(LAS u32x4*)(lds + Q_OFF + row * RSD + ch * 16) = *(const u32x4*)(QK + (size_t)(t0 + row) * DM + h * 128 + ch * 8);
            *(LAS u32x4*)(lds + K_OFF + row * RSD + ch * 16) = *(const u32x4*)(QK + (size_t)(t0 + row) * DM + 512 + h * 128 + ch * 8); }
        for (int i = tid; i < 2048; i += NTHR) { const int row = i >> 3, ch = i & 7;
            *(LAS u32x4*)(lds + V_OFF + row * RST + ch * 16) = *(const u32x4*)(VT + (size_t)(h * 256 + row) * HT + t0 + ch * 8); }
        __syncthreads();
        const int l = lt * 16 + fr;
        {
            f32x4 sc[2] = {(f32x4){0.f, 0.f, 0.f, 0.f}, (f32x4){0.f, 0.f, 0.f, 0.f}};
#pragma unroll
            for (int ks = 0; ks < 4; ++ks) { const bf16x8 y = ldsfrag(lds + Q_OFF + l * RSD + ks * 64 + fq * 16);
#pragma unroll
                for (int i = 0; i < 2; ++i) sc[i] = mma(ldsfrag(lds + K_OFF + ((2 * vh + i) * 16 + fr) * RSD + ks * 64 + fq * 16), y, sc[i]); }
#pragma unroll
            for (int i = 0; i < 2; ++i) { const int s0 = (2 * vh + i) * 16 + 4 * fq; float m[4];
#pragma unroll
                for (int j = 0; j < 4; ++j) m[j] = (s0 + j <= l) ? sc[i][j] : 0.f;
                u32x2 w; w.x = pk2(m[0], m[1]); w.y = pk2(m[2], m[3]); *(LAS u32x2*)(lds + P_OFF + l * RST + s0 * 2) = w; }
        }
        __syncthreads();
        f32x4 acc[8];
#pragma unroll
        for (int i = 0; i < 8; ++i) acc[i] = (f32x4){0.f, 0.f, 0.f, 0.f};
#pragma unroll
        for (int ks = 0; ks < 2; ++ks) { const bf16x8 y = ldsfrag(lds + P_OFF + l * RST + ks * 64 + fq * 16);
#pragma unroll
            for (int i = 0; i < 8; ++i) acc[i] = mma(ldsfrag(lds + V_OFF + ((vh * 8 + i) * 16 + fr) * RST + ks * 64 + fq * 16), y, acc[i]); }
        const bf16_t* sp = ST + (((size_t)cidx * 4 + h) * 256 + vh * 128 + fr) * 128 + fq * 8;
#pragma unroll
        for (int ks = 0; ks < (GLA_NO_INTER ? 0 : 4); ++ks) { const bf16x8 y = ldsfrag(lds + Q_OFF + l * RSD + ks * 64 + fq * 16);
#pragma unroll
            for (int i = 0; i < 8; ++i) acc[i] = mma(*(const bf16x8*)(sp + (size_t)i * 16 * 128 + ks * 32), y, acc[i]); }
        float ssq = 0.f;
#pragma unroll
        for (int i = 0; i < 8; ++i) ssq += (acc[i][0] * acc[i][0] + acc[i][1] * acc[i][1]) + (acc[i][2] * acc[i][2] + acc[i][3] * acc[i][3]);
        ssq += __shfl_xor(ssq, 16); ssq += __shfl_xor(ssq, 32);
        if (fq == 0) ssqt[l * 2 + vh] = ssq;
        __syncthreads();
        const float rstd = rsqrtf((ssqt[l * 2] + ssqt[l * 2 + 1]) * (1.f / 256.f) + EPS);
        const size_t t = (size_t)(t0 + l);
#pragma unroll
        for (int i = 0; i < 8; ++i) { const int v = (vh * 8 + i) * 16 + 4 * fq, c = h * 256 + v;
            const u32x2 gw = *(const u32x2*)(GS + t * DM + c); const f32x4 w4 = *(const f32x4*)(nw + v);
            u32x2 o; o.x = pk2(acc[i][0] * rstd * w4[0] * bf_lo(gw.x), acc[i][1] * rstd * w4[1] * bf_hi(gw.x));
            o.y = pk2(acc[i][2] * rstd * w4[2] * bf_lo(gw.y), acc[i][3] * rstd * w4[3] * bf_hi(gw.y));
            *(u32x2*)(YIN + t * DM + c) = o; }
        __syncthreads();
    }
}


#define XB_TMO      128
#define XB_XCNT(j)  (256  + 64 * (j))
#define XB_XSUB(j)  (1280 + 64 * (j))
#define XB_XGEN(j)  (2304 + 64 * (j))
#define XB_TOP      3328
#define XB_TOPGEN   3392
#define XCD_BAR_WORDS 3456
#define XB_SPIN_CAP (1u << 22)
DEV unsigned xb_ld(unsigned* p)              { return __hip_atomic_load(p, __ATOMIC_RELAXED, __HIP_MEMORY_SCOPE_AGENT); }
DEV unsigned xb_add(unsigned* p, unsigned v) { return __hip_atomic_fetch_add(p, v, __ATOMIC_RELAXED, __HIP_MEMORY_SCOPE_AGENT); }
DEV unsigned xb_xcc_id() { return (unsigned)__builtin_amdgcn_s_getreg((3 << 11) | 20) & 0xFu; }
#define XB_SPIN(cond, bar) do { unsigned _sp = 0; while (cond) { __builtin_amdgcn_s_sleep(1); \
    if ((++_sp & 255u) == 0u) { if (xb_ld(&(bar)[XB_TMO])) break; if (_sp > XB_SPIN_CAP) { atomicAdd(&(bar)[XB_TMO], 1u); break; } } } } while (0)
DEV void xcd_barrier_complete(unsigned* bar, unsigned x, unsigned Gn, unsigned& nloc, unsigned& nx) {
    unsigned sum, cnt, mine, sp = 0u;
    for (;;) {
        sum = 0u; cnt = 0u; mine = 0u;
#pragma unroll
        for (unsigned j = 0; j < 16; ++j) { const unsigned c = xb_ld(&bar[XB_XCNT(j)]); sum += c; cnt += (c > 0u) ? 1u : 0u; mine = (j == x) ? c : mine; }
        if (sum == Gn) break;
        __builtin_amdgcn_s_sleep(1);
        if ((++sp & 255u) == 0u) { if (xb_ld(&bar[XB_TMO])) break; if (sp > XB_SPIN_CAP) { atomicAdd(&bar[XB_TMO], 1u); break; } }
    }
    nloc = mine > 0u ? mine : 1u; nx = cnt > 0u ? cnt : 1u;
}
DEV void xcd_barrier(unsigned* bar, unsigned x, volatile LAS unsigned* st, int tid, unsigned Gn) {
    asm volatile("s_waitcnt vmcnt(0)" ::: "memory");
    __syncthreads();
    if (tid == 0) {
        __builtin_amdgcn_s_waitcnt(0);
        unsigned nloc = st[0], nx = st[1];
        if (nloc == 0u) { xcd_barrier_complete(bar, x, Gn, nloc, nx); st[0] = nloc; st[1] = nx; }
        const unsigned old = xb_add(&bar[XB_XSUB(x)], 1u);
        const unsigned gen = old / nloc;
        if (old + 1u == (gen + 1u) * nloc) {
            __builtin_amdgcn_fence(__ATOMIC_RELEASE, "agent");
            asm volatile("s_waitcnt vmcnt(0)" ::: "memory");
            const unsigned og = xb_add(&bar[XB_TOP], 1u);
            const unsigned tg = og / nx;
            if (og + 1u == (tg + 1u) * nx) xb_add(&bar[XB_TOPGEN], 1u);
            else XB_SPIN(xb_ld(&bar[XB_TOPGEN]) == tg, bar);
            __builtin_amdgcn_fence(__ATOMIC_ACQUIRE, "agent");
            xb_add(&bar[XB_XGEN(x)], 1u);
            asm volatile("s_waitcnt vmcnt(0)" ::: "memory");
        } else {
            XB_SPIN(xb_ld(&bar[XB_XGEN(x)]) == gen, bar);
            __builtin_amdgcn_fence(__ATOMIC_ACQUIRE, "agent");
            asm volatile("s_waitcnt vmcnt(0)" ::: "memory");
        }
    }
    __syncthreads();
}

typedef const __attribute__((address_space(4))) Params* KParams;
DEV KParams kargs() { unsigned long long kp = (unsigned long long)__builtin_amdgcn_kernarg_segment_ptr(); asm volatile("" : "+s"(kp)); return (KParams)kp; }

__global__ void __launch_bounds__(NTHR, 2) mega_fwd(Params Parg, int pc_lo, int pc_hi, int coop, int pad_) {
    extern __shared__ __attribute__((aligned(16))) unsigned char smem[];
    cg::grid_group grid = cg::this_grid();
    if (coop) grid.sync();
    volatile LAS unsigned* xst = (volatile LAS unsigned*)((LAS unsigned char*)smem + 139264 - 16);
    const unsigned xcc = xb_xcc_id();
    if (threadIdx.x == 0) { xst[0] = 0u; xst[1] = 0u; (void)xb_add((unsigned*)(asglobal(kargs()->ws) + WS_BAR) + XB_XCNT(xcc), 1u); }
    __syncthreads();
    using pg8::Sched; using pg8::job_put;
    constexpr int PER_LAYER = 1 + 34 + 3, NPC = 2 * PER_LAYER + 1;
#pragma unroll 1
    for (int pc0 = pc_lo; pc0 < pc_hi; ++pc0) {
        int pc = pc0; asm volatile("" : "+s"(pc));
        int tid = threadIdx.x; asm volatile("" : "+v"(tid));
        const int lane = tid & 63, wave = __builtin_amdgcn_readfirstlane(tid >> 6);
        unsigned ldso = 0; asm volatile("" : "+s"(ldso));
        LAS unsigned char* lds = (LAS unsigned char*)smem + ldso;
        int bxv = blockIdx.x, gdv = gridDim.x; asm volatile("" : "+s"(bxv), "+s"(gdv));
        const int layer = pc / PER_LAYER; const int r = pc - layer * PER_LAYER;
        int ph, hf = 0;
        if (pc == NPC - 1) ph = 21; else if (r == 0) ph = 0; else if (r <= 34) { hf = (r - 1) / 17; ph = (r - 1) - hf * 17 + 1; } else ph = 18 + (r - 35);
        asm volatile("" : "+s"(ph), "+s"(hf));
#define P kargs()
#define ws asglobal(kargs()->ws)
#define INP(i) asglobal(kargs()->in[i])
#define OUTP asglobal(kargs()->out)
#define G gdv
#define bx bxv
#define gw (bx * NWAVES + wave)
#define NGW (G * NWAVES)
#define gtid (bx * NTHR + tid)
#define NT (G * NTHR)
#define WIN ((bf16_t*)(ws + WS_WIN))
#define HB ((bf16_t*)(ws + WS_HB))
#define MERGED ((float*)(ws + WS_MERGED))
#define GB ((bf16_t*)(ws + WS_G))
#define YIN ((bf16_t*)(ws + WS_YIN))
#define xsrc (((layer == 0) ? INP(0) : (const float*)OUTP) + (size_t)hf * HT * DM)
#define xdst (OUTP + (size_t)hf * HT * DM)

#define PROBE11 0
#define NOMIX 0
#define NOMLP 0
#ifndef SKIPMASK

#define SKIPMASK 0u
#endif
        if ((SKIPMASK >> ph) & 1u) ph = 99;
#ifdef DELAY_PROBE
        if (bxv == 3) { const unsigned long long t0 = __builtin_amdgcn_s_memrealtime(); while (__builtin_amdgcn_s_memrealtime() - t0 < 30000ull) __builtin_amdgcn_s_sleep(64); }
#endif
        switch (ph) {
        case 0:
            phase_weights(ws, INP(2) + (size_t)layer * 1024 * INW, INP(4) + (size_t)layer * 1048576, INP(11) + (size_t)layer * 1048576, INP(15) + (size_t)layer * 1048576,
                          INP(16) + (size_t)layer * 1048576, INP(18) + (size_t)layer * 4194304, INP(19) + (size_t)layer * 4194304, lds, gw, NGW, wave, lane);
            break;
        case 1:
            phase_rmsnorm_bf16(xsrc, INP(1) + layer * DM, HB, HT, gw, NGW, lane);
            if (DUP2) phase_rmsnorm_bf16(xsrc, INP(1) + layer * DM, HB, HT, gw, NGW, lane);
            break;
        case 2: {
            if (tid == 0) { job_put(lds, 0, HB, WIN, ws + RA_UA, nullptr, 64, 12, 3072, 0); job_put(lds, 1, HB, WIN + (size_t)9248 * DM, GB, nullptr, 64, 4, 1024, 1); }
            Sched S; S.init(lds, 2, G, bx, DM, tid);
            pg8::GEMM_BODY<3>(lds, DM, S, tid);
            phase_narrow(HB, WIN + (size_t)6144 * DM, WIN + (size_t)9232 * DM, (float*)(ws + WS_DTGK), gw, NGW, lane);
            break; }
        case 3:
            phase_conv_a((const bf16_t*)(ws + RA_UA), INP(3) + (size_t)layer * 3 * 1024, YIN, gtid, NT);
            if (DUP2) phase_conv_a((const bf16_t*)(ws + RA_UA), INP(3) + (size_t)layer * 3 * 1024, YIN, gtid, NT);
            break;
        case 4: {
            if (tid == 0) job_put(lds, 0, YIN, ws + WS_WOA, ws + WS_MERGED, GB, 64, 4, 1024, 4);
            Sched S; S.init(lds, 1, G, bx, DM, tid); pg8::GEMM_BODY<16>(lds, DM, S, tid);
            break; }
        case 5: {
            if (tid == 0) { job_put(lds, 0, HB, WIN + (size_t)3072 * DM, ws + RB_Z, nullptr, 64, 4, 1024, 2); job_put(lds, 1, WIN + (size_t)4096 * DM, HB, ws + RB_XST, nullptr, 4, 64, HT, 0);
                            job_put(lds, 2, HB, WIN + (size_t)5120 * DM, ws + RB_BC, nullptr, 64, 4, 1024, 0); job_put(lds, 3, HB, WIN + (size_t)10272 * DM, GB, nullptr, 64, 4, 1024, 1); }
            Sched S; S.init(lds, 4, G, bx, DM, tid); pg8::GEMM_BODY<7>(lds, DM, S, tid);
            break; }
        case 6:
            phase_ssd_prep(ws, INP(5) + (size_t)layer * 4 * 2048, INP(6) + (size_t)layer * 2048, INP(7) + layer * 16, INP(8) + layer * 16, gtid, NT, tid, G, bx);
            if (DUP2) phase_ssd_prep(ws, INP(5) + (size_t)layer * 4 * 2048, INP(6) + (size_t)layer * 2048, INP(7) + layer * 16, INP(8) + layer * 16, gtid, NT, tid, G, bx);
            break;
        case 7: phase_ssd_states(ws, lds, tid, wave, lane); if (DUP) { __syncthreads(); phase_ssd_states(ws, lds, tid, wave, lane); } break;
        case 8: phase_ssd_scan(ws, gtid, NT); break;
        case 9: phase_ssd_out(ws, INP(9) + layer * 16, INP(10) + layer * 1024, lds, tid, wave, lane); if (DUP) { __syncthreads(); phase_ssd_out(ws, INP(9) + layer * 16, INP(10) + layer * 1024, lds, tid, wave, lane); } break;
        case 10: {
            if (tid == 0) job_put(lds, 0, YIN, ws + WS_WOS, ws + WS_MERGED, GB, 64, 4, (int)((WS_MSUM - WS_MERGED) / 4), 5);
            Sched S; S.init(lds, 1, G, bx, DM, tid); pg8::GEMM_BODY<32>(lds, DM, S, tid);
            break; }
        case 11: {
#if PROBE11 == 1
            if (tid == 0) { job_put(lds, 0, HB, WIN + (size_t)11296 * DM, GB, nullptr, 64, 4, 1024, 1); }
            Sched S; S.init(lds, 1, G, bx, DM, tid); pg8::GEMM_BODY<7>(lds, DM, S, tid);
#elif PROBE11 == 2
            if (tid == 0) { job_put(lds, 1, HB, WIN + (size_t)3072 * DM, ws + RB_Z, nullptr, 64, 4, 1024, 2); job_put(lds, 2, WIN + (size_t)4096 * DM, HB, ws + RB_XST, nullptr, 4, 64, HT, 0);
                            job_put(lds, 3, HB, WIN + (size_t)5120 * DM, ws + RB_BC, nullptr, 64, 4, 1024, 0); job_put(lds, 0, HB, WIN + (size_t)10272 * DM, GB, nullptr, 64, 4, 1024, 1); }
            Sched S; S.init(lds, 4, G, bx, DM, tid); pg8::GEMM_BODY<7>(lds, DM, S, tid);
#else
            if (tid == 0) { job_put(lds, 0, HB, WIN + (size_t)6160 * DM, ws + RC_QK, nullptr, 64, 4, 1024, 0); job_put(lds, 1, WIN + (size_t)7184 * DM, HB, ws + RC_VT, nullptr, 4, 64, HT, 0);
                            job_put(lds, 2, HB, WIN + (size_t)8208 * DM, ws + RC_GS, nullptr, 64, 4, 1024, 2); job_put(lds, 3, HB, WIN + (size_t)11296 * DM, GB, nullptr, 64, 4, 1024, 1); }
            Sched S; S.init(lds, 4, G, bx, DM, tid); pg8::GEMM_BODY<7>(lds, DM, S, tid);
#endif
            break; }
        case 12: phase_gla_prep(ws, INP(12) + (size_t)layer * 16 * 512, INP(13) + layer * 512, gtid, NT); break;
        case 13: phase_gla_states(ws, lds, tid, wave, lane); if (DUP) { __syncthreads(); phase_gla_states(ws, lds, tid, wave, lane); } break;
        case 14: phase_gla_scan(ws, gtid, NT); break;
        case 15: phase_gla_out(ws, INP(14) + layer * 256, lds, tid, wave, lane); if (DUP) { __syncthreads(); phase_gla_out(ws, INP(14) + layer * 256, lds, tid, wave, lane); } break;
        case 16: {
            if (tid == 0) job_put(lds, 0, YIN, ws + WS_WOG, ws + WS_MSUM, GB, 64, 4, 1024, 6);
            Sched S; S.init(lds, 1, G, bx, DM, tid); pg8::GEMM_BODY<64>(lds, DM, S, tid);
            break; }
        case 17: {
            if (tid == 0) job_put(lds, 0, GB, ws + WS_WO, xdst, xsrc, 64, 4, NOMIX ? 0 : 1024, 7);
            Sched S; S.init(lds, 1, G, bx, DM, tid); pg8::GEMM_BODY<128>(lds, DM, S, tid);
            break; }
        case 18:
            phase_rmsnorm_bf16(OUTP, INP(17) + layer * DM, (bf16_t*)(ws + WS_MERGED), T_ALL, gw, NGW, lane);
            break;
        case 19: {
            if (tid == 0) job_put(lds, 0, ws + WS_MERGED, ws + WS_WUP, ws + WS_R, nullptr, 128, 16, DFF, 3);
            Sched S; S.init(lds, 1, G, bx, DM, tid); pg8::GEMM_BODY<8>(lds, DM, S, tid);
            break; }
        case 20: {
            if (tid == 0) job_put(lds, 0, ws + WS_R, ws + WS_WDN, OUTP, OUTP, 128, 4, NOMLP ? 0 : 1024, 7);
            Sched S; S.init(lds, 1, G, bx, DFF, tid); pg8::GEMM_BODY<128>(lds, DFF, S, tid);
            break; }
        case 99: {
#ifdef SPIN_PROBE
            if (pc == 6 || pc == 23) { const unsigned long long t0 = __builtin_amdgcn_s_memrealtime(); while (__builtin_amdgcn_s_memrealtime() - t0 < 500000ull) __builtin_amdgcn_s_sleep(64); }
#endif
            break; }
        default:
            phase_rmsnorm_f32(OUTP, INP(20), T_ALL, gw, NGW, lane);
            break;
        }
        if (pc0 != pc_hi - 1) {
            xcd_barrier((unsigned*)(ws + WS_BAR), xcc, xst, tid, (unsigned)gdv);
            if (BAR2) xcd_barrier((unsigned*)(ws + WS_BAR), xcc, xst, tid, (unsigned)gdv);
        }
    }
#undef P
#undef ws
#undef INP
#undef OUTP
#undef G
#undef bx
#undef gw
#undef NGW
#undef gtid
#undef NT
#undef WIN
#undef HB
#undef MERGED
#undef GB
#undef YIN
#undef xsrc
#undef xdst
}

extern "C" void kernel_launch(void* const* d_in, const int* in_sizes, int n_in, void* d_out, int out_size, void* d_ws, size_t ws_size, hipStream_t stream) {
    static int grid = 0;
    if (grid == 0) {
        if (n_in != 21 || out_size != T_ALL * DM || ws_size < WS_TOTAL) { fprintf(stderr, "kernel_launch: unexpected shapes (n_in %d out %d ws %zu need %zu)\n", n_in, out_size, ws_size, (size_t)WS_TOTAL); grid = -1; return; }
        int dev = 0, cus = 0, per_cu = 0;
        hipGetDevice(&dev);
        hipDeviceGetAttribute(&cus, hipDeviceAttributeMultiprocessorCount, dev);
        if (hipFuncSetAttribute((const void*)mega_fwd, hipFuncAttributeMaxDynamicSharedMemorySize, LDS_BYTES) != hipSuccess) { fprintf(stderr, "kernel_launch: hipFuncSetAttribute failed\n"); }
        if (hipOccupancyMaxActiveBlocksPerMultiprocessor(&per_cu, (const void*)mega_fwd, NTHR, LDS_BYTES) != hipSuccess || per_cu < 1) { fprintf(stderr, "kernel_launch: occupancy query says %d\n", per_cu); per_cu = 1; }
        (void)hipGetLastError();
        grid = cus > 0 ? cus : 256;
    }
    if (grid < 0) return;
    if (hipMemsetAsync((char*)d_ws + WS_BAR, 0, 16384, stream) != hipSuccess) { fprintf(stderr, "kernel_launch: memset failed\n"); return; }
    Params p{};
    for (int i = 0; i < 21; ++i) p.in[i] = (const float*)d_in[i];
    p.out = (float*)d_out; p.ws = (unsigned char*)d_ws;
#ifndef N_LAUNCH_SPLIT
#define N_LAUNCH_SPLIT 0
#endif
    constexpr int NPC_H = 2 * 38 + 1;
    if (N_LAUNCH_SPLIT) {
        for (int pc = 0; pc < NPC_H; ++pc) {
            hipLaunchKernelGGL(mega_fwd, dim3(grid), dim3(NTHR), LDS_BYTES, stream, p, pc, pc + 1, 0, 0);
        }
        hipError_t e = hipPeekAtLastError();
        if (e != hipSuccess) fprintf(stderr, "launch failed: %s (grid %d)\n", hipGetErrorString(e), grid);
    } else {
        int lo = 0, hi = NPC_H, coop = 1, pad = 0;
        void* args[] = {&p, &lo, &hi, &coop, &pad};
        hipError_t e = hipLaunchCooperativeKernel((const void*)mega_fwd, dim3(grid), dim3(NTHR), args, LDS_BYTES, stream);
        if (e != hipSuccess) fprintf(stderr, "cooperative launch failed: %s (grid %d)\n", hipGetErrorString(e), grid);
    }
}
```

```cpp
#include <hip/hip_runtime.h>
#include <hip/hip_cooperative_groups.h>
#include <cstdio>
namespace cg = cooperative_groups;

#define LAS __attribute__((address_space(3)))
#define DEV __device__ __forceinline__
typedef unsigned short bf16_t;
typedef short bf16x8 __attribute__((ext_vector_type(8)));
typedef float f32x4 __attribute__((ext_vector_type(4)));
typedef float f32x2 __attribute__((ext_vector_type(2)));
typedef unsigned u32x4 __attribute__((ext_vector_type(4)));
typedef unsigned u32x2 __attribute__((ext_vector_type(2)));

constexpr int T_ALL = 32768, HT = 16384, DM = 1024, SEQ = 8192, INW = 12320, DFF = 4096;
constexpr int NTHR = 512, NWAVES = 8;
constexpr int LDS_BYTES = 136 * 1024;
constexpr float EPS = 1e-6f;

constexpr size_t WS_WIN = 1048576;
constexpr size_t WS_WOA = WS_WIN + (size_t)INW * 1024 * 2 + 1048576;
constexpr size_t WS_WOS = WS_WOA + 2097152;
constexpr size_t WS_WOG = WS_WOS + 2097152;
constexpr size_t WS_WO = WS_WOG + 2097152;
constexpr size_t WS_WUP = WS_WO + 2097152;
constexpr size_t WS_WDN = WS_WUP + 8388608;
constexpr size_t WS_HB = WS_WDN + 8388608;
constexpr size_t WS_MERGED = WS_HB + (size_t)HT * 1024 * 2;
constexpr size_t WS_G = WS_MERGED + (size_t)HT * 1024 * 4;
constexpr size_t WS_YIN = WS_G + (size_t)HT * 1024 * 2;
constexpr size_t WS_DTGK = WS_YIN + (size_t)HT * 1024 * 2;
constexpr size_t WS_R = WS_DTGK + (size_t)HT * 32 * 4;
constexpr size_t RA_UA = WS_R;
constexpr size_t RB_Z = WS_R;
constexpr size_t RB_XST = RB_Z + 33554432;
constexpr size_t RB_BC = RB_XST + 33554432;
constexpr size_t RB_XSTC = RB_BC + 33554432;
constexpr size_t RB_BCC = RB_XSTC + 33554432;
constexpr size_t RB_BTC = RB_BCC + 33554432;
constexpr size_t RB_DT = RB_BTC + 16777216;
constexpr size_t RB_ACUM = RB_DT + 1048576;
constexpr size_t RB_ST = RB_ACUM + 1048576;
constexpr size_t RB_END = RB_ST + 67108864;
constexpr size_t RC_QK = WS_R;
constexpr size_t RC_KT = RC_QK + 33554432;
constexpr size_t RC_VT = RC_KT + 16777216;
constexpr size_t RC_GS = RC_VT + 33554432;
constexpr size_t RC_DEC = RC_GS + 33554432;
constexpr size_t RC_ST = RC_DEC + 524288;
constexpr size_t RC_END = RC_ST + 134217728;
constexpr size_t R_HID_END = WS_R + (size_t)T_ALL * DFF * 2;
constexpr size_t WS_END = (RB_END > RC_END ? (RB_END > R_HID_END ? RB_END : R_HID_END) : (RC_END > R_HID_END ? RC_END : R_HID_END));

constexpr size_t WS_MSUM = (WS_END + 255) & ~(size_t)255;
constexpr size_t WS_BAR = WS_MSUM + (size_t)HT * 1024 * 2;
constexpr size_t WS_DEC = WS_BAR + 16384;
constexpr size_t WS_TOTAL = WS_DEC + 524288;
struct Params { const float* in[21]; float* out; unsigned char* ws; };

DEV unsigned f2bf(float f) { unsigned u = __float_as_uint(f); return (u + 0x7fffu + ((u >> 16) & 1u)) >> 16; }
typedef __bf16 bf16x2_t __attribute__((ext_vector_type(2)));
DEV unsigned pk2(float lo, float hi) { const f32x2 v = {lo, hi}; const bf16x2_t r = __builtin_convertvector(v, bf16x2_t); return __builtin_bit_cast(unsigned, r); }
DEV float bf_lo(unsigned w) { return __uint_as_float(w << 16); }
DEV float bf_hi(unsigned w) { return __uint_as_float(w & 0xffff0000u); }
DEV float bf1(bf16_t h) { return __uint_as_float(((unsigned)h) << 16); }
DEV void unpack8(const u32x4 w, float (&f)[8]) {
    f[0] = bf_lo(w.x); f[1] = bf_hi(w.x); f[2] = bf_lo(w.y); f[3] = bf_hi(w.y);
    f[4] = bf_lo(w.z); f[5] = bf_hi(w.z); f[6] = bf_lo(w.w); f[7] = bf_hi(w.w);
}
DEV u32x4 pack8(const float (&f)[8]) { u32x4 w; w.x = pk2(f[0], f[1]); w.y = pk2(f[2], f[3]); w.z = pk2(f[4], f[5]); w.w = pk2(f[6], f[7]); return w; }
DEV float sigmoidf_(float x) { return __builtin_amdgcn_rcpf(1.0f + __expf(-x)); }
DEV float siluf_(float x) { return x * sigmoidf_(x); }
DEV float softplusf_(float x) { return x > 20.f ? x : (x < -15.f ? __expf(x) : __logf(1.0f + __expf(x))); }
DEV float logsigf_(float x) { const float e = __expf(-fabsf(x)); return fminf(x, 0.f) - (e < 1e-4f ? e : __logf(1.0f + e)); }
DEV float wave_sum(float v) {
#pragma unroll
    for (int o = 1; o < 64; o <<= 1) v += __shfl_xor(v, o);
    return v;
}
DEV f32x4 mma(bf16x8 x, bf16x8 y, f32x4 acc) { return __builtin_amdgcn_mfma_f32_16x16x32_bf16(x, y, acc, 0, 0, 0); }
DEV bf16x8 ldsfrag(const LAS unsigned char* p) { return *(const LAS bf16x8*)p; }
#define SCALE_A 1.f
#define SCALE_B 1.f
#define SCALE_C 1.f
#define DUP 0
#define DUP2 0
#define BAR2 0
#define GLA_NO_INTER 0
#define GLA_ZERO_DEC 0
#ifndef GEMM_BODY
#define GEMM_BODY gemm_phase
#endif
#define LDS_WAIT() asm volatile("s_waitcnt lgkmcnt(0)" ::: "memory")
#define GAS __attribute__((address_space(1)))
template <class T> DEV T* asglobal(T* p) { return (T*)(GAS T*)p; }

namespace pg8 {
constexpr int BM = 256, BK = 64, HALF = 128, HTB = HALF * BK * 2, STAGE_BYTES = 8 * HTB, NXCD = 8, WGM = 8;
DEV int lds_byte(int r, int c) { const int st = (r >> 4) * 2 + (c >> 5), rr = r & 15, cc = c & 31, ob = rr * 64 + cc * 2; return st * 1024 + (ob ^ (((ob >> 9) & 1) << 5)); }
DEV void stage_rc(int b, int& R, int& C) { const int st = b / 1024, sb = b % 1024, swz = sb ^ (((sb >> 9) & 1) << 5); R = (st >> 1) * 16 + swz / 64; C = (st & 1) * 32 + (swz % 64) / 2; }
DEV int perm32(int rho) { const int n = rho >> 4, i = rho & 15; return 8 * (i >> 2) + 4 * n + (i & 3); }

struct Job { const bf16_t* A; const bf16_t* B; void* out; const void* aux; int nM, nN, ldc, kind; };
struct Unit { const char* A; const char* B; int jid, pm, pn; };
constexpr int JT_OFF = 131072;
DEV int rfl(int v) { return __builtin_amdgcn_readfirstlane(v); }
DEV const char* rflp(const LAS int* p) { const unsigned lo = (unsigned)rfl(p[0]), hi = (unsigned)rfl(p[1]); return asglobal((const char*)(((unsigned long long)hi << 32) | lo)); }
DEV void job_put(LAS unsigned char* lds, int q, const void* A, const void* B, void* out, const void* aux, int nM, int nN, int ldc, int kind) {
    LAS int* jt = (LAS int*)(lds + JT_OFF) + q * 12;
    const unsigned long long a = (unsigned long long)A, b = (unsigned long long)B, o = (unsigned long long)out, x = (unsigned long long)aux;
    jt[0] = (int)(unsigned)a; jt[1] = (int)(unsigned)(a >> 32); jt[2] = (int)(unsigned)b; jt[3] = (int)(unsigned)(b >> 32);
    jt[4] = (int)(unsigned)o; jt[5] = (int)(unsigned)(o >> 32); jt[6] = (int)(unsigned)x; jt[7] = (int)(unsigned)(x >> 32);
    jt[8] = nM; jt[9] = nN; jt[10] = ldc; jt[11] = kind;
}
struct Sched {
    LAS unsigned char* lds; int nj, total, G, c; size_t tstep;
    DEV void init(LAS unsigned char* lds_, int nj_, int G_, int c_, int K, int tid_) {
        lds = lds_; nj = nj_; G = G_; c = c_; tstep = (size_t)BM * K * 2;
        __syncthreads();
        LAS int* jt = (LAS int*)(lds + JT_OFF);
        if (tid_ == 0) { int s = 0; for (int q = 0; q < nj; ++q) { jt[48 + q] = s; s += jt[q * 12 + 8] * jt[q * 12 + 9]; } for (int q = nj; q < 5; ++q) jt[48 + q] = s; }
        __syncthreads();
        total = rfl(jt[48 + 4]);
    }
    DEV bool next(int i, Unit& u) const {
        const int L = i * G + c; if (L >= total) return false;
        const LAS int* jt = (const LAS int*)(lds + JT_OFF);
        int jid = 0;
        for (int q = 1; q < nj; ++q) if (L >= rfl(jt[48 + q])) jid = q;
        const LAS int* J = jt + jid * 12;
        const int base = rfl(jt[48 + jid]), nM = rfl(J[8]), nN = rfl(J[9]);
        int wgid = L - base; const int nwg = nM * nN;
        { const int q = nwg / NXCD, r = nwg % NXCD, xcd = wgid % NXCD, off = wgid / NXCD; wgid = (xcd < r ? xcd * (q + 1) : r * (q + 1) + (xcd - r) * q) + off; }
        const int nig = WGM * nN, gid = wgid / nig, fm = gid * WGM, gsz = (nM - fm) < WGM ? (nM - fm) : WGM;
        u.pm = fm + ((wgid % nig) % gsz); u.pn = (wgid % nig) / gsz; u.jid = jid;
        u.A = rflp(J) + (size_t)u.pm * tstep; u.B = rflp(J + 2) + (size_t)u.pn * tstep;
        return true;
    }
};

DEV void st16_wt(GAS u32x4* p, u32x4 v) { asm volatile("global_store_dwordx4 %0, %1, off sc1" :: "v"(p), "v"(v) : "memory"); }
DEV void st16f_wt(GAS f32x4* p, f32x4 v) { asm volatile("global_store_dwordx4 %0, %1, off sc1" :: "v"(p), "v"(v) : "memory"); }
DEV unsigned cvt_pk_bf16(float lo, float hi) { return pk2(lo, hi); }

template <int KIND> DEV void epi_loop(const f32x4 (&acc)[2][2][4][2], const Job& J, const Unit& u, int wr, int wc, int fr, int fq) {
    const int row0 = u.pm * BM + wr * 64 + fr, col0 = u.pn * BM + wc * 32 + 8 * fq;
    GAS bf16_t* const outb = (GAS bf16_t*)J.out; GAS float* const outf = (GAS float*)J.out;
    const GAS float* const auxf = (const GAS float*)J.aux; GAS bf16_t* const auxb = (GAS bf16_t*)const_cast<void*>(J.aux);
#pragma unroll
    for (int ai = 0; ai < 2; ++ai)
#pragma unroll
        for (int m = 0; m < 4; ++m) {
            const size_t row = (size_t)(row0 + ai * HALF + m * 16);
#pragma unroll
            for (int bj = 0; bj < 2; ++bj) {
                const int col = col0 + bj * HALF;
                f32x4 v0 = acc[ai][bj][m][0], v1 = acc[ai][bj][m][1];
                if (KIND <= 3) {
                    if (KIND == 1) {
#pragma unroll
                        for (int e = 0; e < 4; ++e) { v0[e] = sigmoidf_(v0[e]); v1[e] = sigmoidf_(v1[e]); } }
                    if (KIND == 2) {
#pragma unroll
                        for (int e = 0; e < 4; ++e) { v0[e] = siluf_(v0[e]); v1[e] = siluf_(v1[e]); } }
                    if (KIND == 3) {
#pragma unroll
                        for (int e = 0; e < 4; ++e) { float a = fmaxf(v0[e], 0.f), b = fmaxf(v1[e], 0.f); v0[e] = a * a; v1[e] = b * b; } }
                    u32x4 w; w.x = cvt_pk_bf16(v0[0], v0[1]); w.y = cvt_pk_bf16(v0[2], v0[3]); w.z = cvt_pk_bf16(v1[0], v1[1]); w.w = cvt_pk_bf16(v1[2], v1[3]);
                    *(GAS u32x4*)(outb + row * J.ldc + col) = w;
                } else if (KIND == 7) {
                    const GAS float* xin = auxf + row * DM + col; GAS float* xo = outf + row * DM + col;
                    const f32x4 a = *(const GAS f32x4*)xin, b = *(const GAS f32x4*)(xin + 4);
                    const float sc = (J.ldc == 0) ? 0.f : 1.f; *(GAS f32x4*)xo = a + v0 * sc; *(GAS f32x4*)(xo + 4) = b + v1 * sc;
                } else if (KIND == 4) {
                    const u32x4 gw = *(const GAS u32x4*)(auxb + row * DM + col); float g[8]; unpack8(gw, g);
                    f32x4 r0, r1;
#pragma unroll
                    for (int e = 0; e < 4; ++e) { r0[e] = g[e] * v0[e] * SCALE_A; r1[e] = g[4 + e] * v1[e] * SCALE_A; }
                    GAS float* mo = outf + row * DM + col; *(GAS f32x4*)mo = r0; *(GAS f32x4*)(mo + 4) = r1;
                } else if (KIND == 5) {
                    const u32x4 gw = *(const GAS u32x4*)(auxb + row * DM + col); float g[8]; unpack8(gw, g);
                    const GAS float* mo = outf + row * DM + col; const f32x4 m0 = *(const GAS f32x4*)mo, m1 = *(const GAS f32x4*)(mo + 4);
#pragma unroll
                    for (int e = 0; e < 8; ++e) g[e] *= SCALE_B;
                    u32x4 w; w.x = cvt_pk_bf16(m0[0] + g[0] * v0[0], m0[1] + g[1] * v0[1]); w.y = cvt_pk_bf16(m0[2] + g[2] * v0[2], m0[3] + g[3] * v0[3]);
                    w.z = cvt_pk_bf16(m1[0] + g[4] * v1[0], m1[1] + g[5] * v1[1]); w.w = cvt_pk_bf16(m1[2] + g[6] * v1[2], m1[3] + g[7] * v1[3]);
                    *(GAS u32x4*)((GAS bf16_t*)(outf + (size_t)J.ldc) + row * DM + col) = w;
                } else {
                    GAS bf16_t* gp = auxb + row * DM + col;
                    const u32x4 gw = *(const GAS u32x4*)gp, aw = *(const GAS u32x4*)(outb + row * DM + col);
                    float g[8], a[8]; unpack8(gw, g); unpack8(aw, a);
#pragma unroll
                    for (int e = 0; e < 8; ++e) g[e] *= SCALE_C;
                    u32x4 w; w.x = cvt_pk_bf16(a[0] + g[0] * v0[0], a[1] + g[1] * v0[1]); w.y = cvt_pk_bf16(a[2] + g[2] * v0[2], a[3] + g[3] * v0[3]);
                    w.z = cvt_pk_bf16(a[4] + g[4] * v1[0], a[5] + g[5] * v1[1]); w.w = cvt_pk_bf16(a[6] + g[6] * v1[2], a[7] + g[7] * v1[3]);
                    *(GAS u32x4*)gp = w;
                }
            }
        }
}

template <int MASK> DEV void run_epi(const Sched& S, const Unit& u, const f32x4 (&acc)[2][2][4][2], int wr, int wc, int fr, int fq) {
    const LAS int* Jp = (const LAS int*)(S.lds + JT_OFF) + u.jid * 12;
    Job J; J.A = nullptr; J.B = nullptr; J.out = (void*)rflp(Jp + 4); J.aux = (const void*)rflp(Jp + 6); J.nM = 0; J.nN = 0; J.ldc = rfl(Jp[10]); J.kind = rfl(Jp[11]);
    const int k = J.kind;
    if ((MASK & 1) && k == 0) epi_loop<0>(acc, J, u, wr, wc, fr, fq);
    else if ((MASK & 2) && k == 1) epi_loop<1>(acc, J, u, wr, wc, fr, fq);
    else if ((MASK & 4) && k == 2) epi_loop<2>(acc, J, u, wr, wc, fr, fq);
    else if ((MASK & 8) && k == 3) epi_loop<3>(acc, J, u, wr, wc, fr, fq);
    else if ((MASK & 16) && k == 4) epi_loop<4>(acc, J, u, wr, wc, fr, fq);
    else if ((MASK & 32) && k == 5) epi_loop<5>(acc, J, u, wr, wc, fr, fq);
    else if ((MASK & 64) && k == 6) epi_loop<6>(acc, J, u, wr, wc, fr, fq);
    else if ((MASK & 128) && k == 7) epi_loop<7>(acc, J, u, wr, wc, fr, fq);
}

template <int MASK>
DEV void gemm_phase(LAS unsigned char* lds, const int K, const Sched& S, const int tid) {
    const int wid = __builtin_amdgcn_readfirstlane(tid >> 6), lane = tid & 63, wr = wid >> 2, wc = wid & 3, fr = lane & 15, fq = lane >> 4;
    const int nt = K / BK;
    unsigned voffA[2], voffB[2];
#pragma unroll
    for (int i = 0; i < 2; ++i) { int R, C; stage_rc(tid * 16 + i * 8192, R, C); const int Rb = (R & ~31) + perm32(R & 31);
        voffA[i] = (unsigned)(R * K + C) * 2u; voffB[i] = (unsigned)(Rb * K + C) * 2u; }
    const size_t kstep = (size_t)(BK * 2);
    const size_t hstep = (size_t)HALF * K * 2;
    const unsigned ldsw = (unsigned)wid * 1024u;
    const int aoff = lds_byte(wr * 64 + fr, fq * 8), boff = lds_byte(wc * 32 + fr, fq * 8);
#define PG8_SA(b, h) (((b) * 2 + (h)) * HTB)
#define PG8_SB(b, h) ((4 + (b) * 2 + (h)) * HTB)
#define PG8_STAGE(bufoff, gbase, voff) do { _Pragma("unroll") for (int _i = 0; _i < 2; ++_i) \
        __builtin_amdgcn_global_load_lds((const unsigned*)((const char*)(gbase) + (voff)[_i]), (LAS unsigned*)(lds + (bufoff) + ldsw + _i * 8192), 16, 0, 0); } while (0)
#define PG8_LDA(dst, b, h) do { _Pragma("unroll") for (int m = 0; m < 4; ++m) _Pragma("unroll") for (int k = 0; k < 2; ++k) dst[m][k] = *(const LAS bf16x8*)(lds + PG8_SA(b, h) + aoff + m * 2048 + k * 1024); } while (0)
#define PG8_LDB(dst, b, h) do { _Pragma("unroll") for (int n = 0; n < 2; ++n) _Pragma("unroll") for (int k = 0; k < 2; ++k) dst[n][k] = *(const LAS bf16x8*)(lds + PG8_SB(b, h) + boff + n * 2048 + k * 1024); } while (0)
#define PG8_MMA(ai, bj, At, Bt) do { __builtin_amdgcn_s_setprio(1); _Pragma("unroll") for (int m = 0; m < 4; ++m) _Pragma("unroll") for (int n = 0; n < 2; ++n) _Pragma("unroll") for (int k = 0; k < 2; ++k) \
        acc[ai][bj][m][n] = __builtin_amdgcn_mfma_f32_16x16x32_bf16(Bt[n][k], At[m][k], acc[ai][bj][m][n], 0, 0, 0); __builtin_amdgcn_s_setprio(0); } while (0)
#define PG8_WAIT_V(n) asm volatile("s_waitcnt vmcnt(" #n ")" ::: "memory")
#define PG8_WAIT_L(n) asm volatile("s_waitcnt lgkmcnt(" #n ")" ::: "memory")
#define PG8_BAR __builtin_amdgcn_s_barrier()
#define PG8_SCHED __builtin_amdgcn_sched_barrier(0)
    Unit cur, nxt; int ui = 0;
    if (!S.next(0, cur)) return;
    f32x4 acc[2][2][4][2];
#pragma unroll
    for (int a = 0; a < 2; ++a)
#pragma unroll
        for (int b = 0; b < 2; ++b)
#pragma unroll
            for (int m = 0; m < 4; ++m)
#pragma unroll
                for (int n = 0; n < 2; ++n) acc[a][b][m][n] = (f32x4){0.f, 0.f, 0.f, 0.f};
    bf16x8 At[4][2], B0[2][2], B1[2][2];
    const char* cA = cur.A; const char* cB = cur.B;
    PG8_STAGE(PG8_SB(0, 0), cB, voffB); PG8_STAGE(PG8_SA(0, 0), cA, voffA); PG8_STAGE(PG8_SB(0, 1), cB + hstep, voffB); PG8_STAGE(PG8_SA(0, 1), cA + hstep, voffA);
    if (wr == 1) PG8_BAR;
    PG8_WAIT_V(4); PG8_BAR;
    PG8_STAGE(PG8_SB(1, 0), cB + kstep, voffB); PG8_STAGE(PG8_SA(1, 0), cA + kstep, voffA); PG8_STAGE(PG8_SB(1, 1), cB + hstep + kstep, voffB);
    PG8_WAIT_V(6); PG8_BAR;
    for (;;) {
        const bool has_next = S.next(ui + 1, nxt);
        const char* nA = has_next ? nxt.A : cA; const char* nB = has_next ? nxt.B : cB;
        for (int t = 0; t < nt; t += 2) {
            const bool last = (t == nt - 2);
            const char* a1 = cA + (size_t)(t + 1) * kstep;
            const char* a2 = last ? nA : cA + (size_t)(t + 2) * kstep; const char* b2 = last ? nB : cB + (size_t)(t + 2) * kstep;
            const char* a3 = a2 + kstep; const char* b3 = b2 + kstep;
            PG8_LDB(B0, 0, 0); PG8_SCHED; PG8_LDA(At, 0, 0); PG8_STAGE(PG8_SA(1, 1), a1 + hstep, voffA);
            PG8_WAIT_L(8); PG8_BAR; PG8_WAIT_L(0); PG8_MMA(0, 0, At, B0); PG8_BAR; PG8_SCHED;
            PG8_LDB(B1, 0, 1); PG8_STAGE(PG8_SB(0, 0), b2, voffB);
            PG8_BAR; PG8_WAIT_L(0); PG8_MMA(0, 1, At, B1); PG8_BAR;
            PG8_LDA(At, 0, 1); PG8_STAGE(PG8_SA(0, 0), a2, voffA);
            PG8_BAR; PG8_WAIT_L(0); PG8_MMA(1, 0, At, B0); PG8_BAR; PG8_SCHED;
            PG8_STAGE(PG8_SB(0, 1), b2 + hstep, voffB);
            PG8_WAIT_V(6); PG8_BAR; PG8_MMA(1, 1, At, B1); PG8_BAR;
            PG8_LDB(B0, 1, 0); PG8_SCHED; PG8_LDA(At, 1, 0); PG8_STAGE(PG8_SA(0, 1), a2 + hstep, voffA);
            PG8_WAIT_L(8); PG8_BAR; PG8_WAIT_L(0); PG8_MMA(0, 0, At, B0); PG8_BAR; PG8_SCHED;
            PG8_LDB(B1, 1, 1); PG8_STAGE(PG8_SB(1, 0), b3, voffB);
            PG8_BAR; PG8_WAIT_L(0); PG8_MMA(0, 1, At, B1); PG8_BAR;
            PG8_LDA(At, 1, 1); PG8_STAGE(PG8_SA(1, 0), a3, voffA);
            PG8_BAR; PG8_WAIT_L(0); PG8_MMA(1, 0, At, B0); PG8_BAR; PG8_SCHED;
            PG8_STAGE(PG8_SB(1, 1), b3 + hstep, voffB);
            PG8_WAIT_V(6); PG8_BAR; PG8_MMA(1, 1, At, B1); PG8_BAR;
        }
        run_epi<MASK>(S, cur, acc, wr, wc, fr, fq);
        if (!has_next) break;
#pragma unroll
        for (int a = 0; a < 2; ++a)
#pragma unroll
            for (int b = 0; b < 2; ++b)
#pragma unroll
                for (int m = 0; m < 4; ++m)
#pragma unroll
                    for (int n = 0; n < 2; ++n) acc[a][b][m][n] = (f32x4){0.f, 0.f, 0.f, 0.f};
        cur = nxt; cA = nA; cB = nB; ++ui;
    }
    PG8_WAIT_V(0);
    if (wr == 0) PG8_BAR;
    PG8_BAR;
#undef PG8_SA
#undef PG8_SB
#undef PG8_STAGE
#undef PG8_LDA
#undef PG8_LDB
#undef PG8_MMA
#undef PG8_WAIT_V
#undef PG8_WAIT_L
#undef PG8_BAR
#undef PG8_SCHED
}

template <int MASK>
DEV void gemm_simple(LAS unsigned char* lds, const int K, const Sched& S, const int tid) {
    const int wid = __builtin_amdgcn_readfirstlane(tid >> 6), lane = tid & 63, wr = wid >> 2, wc = wid & 3, fr = lane & 15, fq = lane >> 4;
    const int nt = K / BK;
    unsigned voffA[2], voffB[2];
#pragma unroll
    for (int i = 0; i < 2; ++i) { int R, C; stage_rc(tid * 16 + i * 8192, R, C); const int Rb = (R & ~31) + perm32(R & 31);
        voffA[i] = (unsigned)(R * K + C) * 2u; voffB[i] = (unsigned)(Rb * K + C) * 2u; }
    const size_t kstep = (size_t)(BK * 2), hstep = (size_t)HALF * K * 2;
    const unsigned ldsl = (unsigned)wid * 1024u + (unsigned)lane * 16u;
    const int aoff = lds_byte(wr * 64 + fr, fq * 8), boff = lds_byte(wc * 32 + fr, fq * 8);
#define GS_SA(b, h) (((b) * 2 + (h)) * HTB)
#define GS_SB(b, h) ((4 + (b) * 2 + (h)) * HTB)
#define GS_LOAD(dst, pa, pb) do { _Pragma("unroll") for (int _i = 0; _i < 2; ++_i) { \
        dst[0][_i] = *(const GAS u32x4*)((const GAS char*)(pa) + voffA[_i]); dst[1][_i] = *(const GAS u32x4*)((const GAS char*)(pa) + hstep + voffA[_i]); \
        dst[2][_i] = *(const GAS u32x4*)((const GAS char*)(pb) + voffB[_i]); dst[3][_i] = *(const GAS u32x4*)((const GAS char*)(pb) + hstep + voffB[_i]); } } while (0)
#define GS_WRITE(b, src) do { _Pragma("unroll") for (int _i = 0; _i < 2; ++_i) { \
        *(LAS u32x4*)(lds + GS_SA(b, 0) + ldsl + _i * 8192) = src[0][_i]; *(LAS u32x4*)(lds + GS_SA(b, 1) + ldsl + _i * 8192) = src[1][_i]; \
        *(LAS u32x4*)(lds + GS_SB(b, 0) + ldsl + _i * 8192) = src[2][_i]; *(LAS u32x4*)(lds + GS_SB(b, 1) + ldsl + _i * 8192) = src[3][_i]; } } while (0)
    Unit cur; int ui = 0;
    while (S.next(ui, cur)) {
        f32x4 acc[2][2][4][2];
#pragma unroll
        for (int a = 0; a < 2; ++a)
#pragma unroll
            for (int b = 0; b < 2; ++b)
#pragma unroll
                for (int m = 0; m < 4; ++m)
#pragma unroll
                    for (int n = 0; n < 2; ++n) acc[a][b][m][n] = (f32x4){0.f, 0.f, 0.f, 0.f};
        const char* cA = cur.A; const char* cB = cur.B;
        u32x4 st[4][2];
        GS_LOAD(st, cA, cB);
        GS_WRITE(0, st);
        __syncthreads();
        for (int t = 0; t < nt; ++t) {
            const int b = t & 1;
            if (t + 1 < nt) GS_LOAD(st, cA + (size_t)(t + 1) * kstep, cB + (size_t)(t + 1) * kstep);
#pragma unroll
            for (int ai = 0; ai < 2; ++ai) {
                bf16x8 At[4][2];
#pragma unroll
                for (int m = 0; m < 4; ++m)
#pragma unroll
                    for (int k = 0; k < 2; ++k) At[m][k] = *(const LAS bf16x8*)(lds + (b ? GS_SA(1, 0) : GS_SA(0, 0)) + ai * HTB + aoff + m * 2048 + k * 1024);
#pragma unroll
                for (int bj = 0; bj < 2; ++bj) {
                    bf16x8 Bt[2][2];
#pragma unroll
                    for (int n = 0; n < 2; ++n)
#pragma unroll
                        for (int k = 0; k < 2; ++k) Bt[n][k] = *(const LAS bf16x8*)(lds + (b ? GS_SB(1, 0) : GS_SB(0, 0)) + bj * HTB + boff + n * 2048 + k * 1024);
#pragma unroll
                    for (int m = 0; m < 4; ++m)
#pragma unroll
                        for (int n = 0; n < 2; ++n)
#pragma unroll
                            for (int k = 0; k < 2; ++k) acc[ai][bj][m][n] = __builtin_amdgcn_mfma_f32_16x16x32_bf16(Bt[n][k], At[m][k], acc[ai][bj][m][n], 0, 0, 0);
                }
            }
            if (t + 1 < nt) { if (b) GS_WRITE(0, st); else GS_WRITE(1, st); }
            __syncthreads();
        }
        run_epi<MASK>(S, cur, acc, wr, wc, fr, fq);
        ++ui;
    }
    __syncthreads();
#undef GS_SA
#undef GS_SB
#undef GS_LOAD
#undef GS_WRITE
}
}

DEV void transpose_item(const float* W, int K, int N, bf16_t* WT, LAS float* scr, int item, int lane) {
    const int nblk = N / 32, kb = item / nblk, nb = item % nblk, k0 = 64 * kb, n0 = 32 * nb;
#pragma unroll 8
    for (int i = 0; i < 32; ++i) { const int kk = 2 * i + (lane >> 5); scr[kk * 33 + (lane & 31)] = W[(size_t)(k0 + kk) * N + n0 + (lane & 31)]; }
    LDS_WAIT();
    const int c = lane & 7;
#pragma unroll
    for (int jj = 0; jj < 4; ++jj) { const int n = (lane >> 3) + 8 * jj; const LAS float* s = scr + (8 * c) * 33 + n;
        u32x4 o; o.x = pk2(s[0 * 33], s[1 * 33]); o.y = pk2(s[2 * 33], s[3 * 33]); o.z = pk2(s[4 * 33], s[5 * 33]); o.w = pk2(s[6 * 33], s[7 * 33]);
        *(u32x4*)(WT + (size_t)(n0 + n) * K + k0 + 8 * c) = o; }
    LDS_WAIT();
}

DEV void phase_weights(unsigned char* ws, const float* w_in, const float* w_oa, const float* w_os, const float* w_og, const float* w_o, const float* w_up, const float* w_dn, LAS unsigned char* lds, int gw, int NGW, int wave, int lane) {
    LAS float* scr = (LAS float*)(lds + wave * 8704);
    constexpr int I_IN = 16 * (INW / 32), I_SQ = 16 * 32, I_UP = 16 * 128, I_DN = 64 * 32;
    constexpr int NIT = I_IN + 4 * I_SQ + I_UP + I_DN;
    for (int it = gw; it < NIT; it += NGW) {
        int r = it;
        if (r < I_IN) { transpose_item(w_in, 1024, INW, (bf16_t*)(ws + WS_WIN), scr, r, lane); continue; } r -= I_IN;
        if (r < I_SQ) { transpose_item(w_oa, 1024, 1024, (bf16_t*)(ws + WS_WOA), scr, r, lane); continue; } r -= I_SQ;
        if (r < I_SQ) { transpose_item(w_os, 1024, 1024, (bf16_t*)(ws + WS_WOS), scr, r, lane); continue; } r -= I_SQ;
        if (r < I_SQ) { transpose_item(w_og, 1024, 1024, (bf16_t*)(ws + WS_WOG), scr, r, lane); continue; } r -= I_SQ;
        if (r < I_SQ) { transpose_item(w_o, 1024, 1024, (bf16_t*)(ws + WS_WO), scr, r, lane); continue; } r -= I_SQ;
        if (r < I_UP) { transpose_item(w_up, 1024, 4096, (bf16_t*)(ws + WS_WUP), scr, r, lane); continue; } r -= I_UP;
        transpose_item(w_dn, 4096, 1024, (bf16_t*)(ws + WS_WDN), scr, r, lane);
    }
}

DEV void phase_rmsnorm_bf16(const float* x, const float* w, bf16_t* o, int nrows, int gw, int NGW, int lane) {
    for (int m = gw; m < nrows; m += NGW) {
        const f32x4* xr = (const f32x4*)(x + (size_t)m * DM) + lane;
        f32x4 v[4]; float s = 0.f;
#pragma unroll
        for (int j = 0; j < 4; ++j) { v[j] = xr[64 * j]; s += (v[j].x * v[j].x + v[j].y * v[j].y) + (v[j].z * v[j].z + v[j].w * v[j].w); }
        const float rstd = rsqrtf(wave_sum(s) * (1.f / DM) + EPS);
        u32x2* o8 = (u32x2*)(o + (size_t)m * DM) + lane;
#pragma unroll
        for (int j = 0; j < 4; ++j) { const f32x4 ww = ((const f32x4*)w)[lane + 64 * j]; u32x2 r; r.x = pk2(v[j].x * rstd * ww.x, v[j].y * rstd * ww.y); r.y = pk2(v[j].z * rstd * ww.z, v[j].w * rstd * ww.w); o8[64 * j] = r; }
    }
}
DEV void phase_rmsnorm_f32(float* x, const float* w, int nrows, int gw, int NGW, int lane) {
    for (int m = gw; m < nrows; m += NGW) {
        f32x4* xr = (f32x4*)(x + (size_t)m * DM) + lane;
        f32x4 v[4]; float s = 0.f;
#pragma unroll
        for (int j = 0; j < 4; ++j) { v[j] = xr[64 * j]; s += (v[j].x * v[j].x + v[j].y * v[j].y) + (v[j].z * v[j].z + v[j].w * v[j].w); }
        const float rstd = rsqrtf(wave_sum(s) * (1.f / DM) + EPS);
#pragma unroll
        for (int j = 0; j < 4; ++j) { const f32x4 ww = ((const f32x4*)w)[lane + 64 * j]; xr[64 * j] = v[j] * rstd * ww; }
    }
}

DEV void phase_narrow(const bf16_t* HB, const bf16_t* Wdt, const bf16_t* Wgk, float* DTGK, int gw, int NGW, int lane) {
    const int fr = lane & 15, fq = lane >> 4;
    for (int u = gw; u < HT / 16; u += NGW) {
        const int t0 = u * 16;
        f32x4 a0 = {0.f, 0.f, 0.f, 0.f}, a1 = {0.f, 0.f, 0.f, 0.f};
        const bf16_t* ap = HB + (size_t)(t0 + fr) * DM + fq * 8;
        const bf16_t* b0p = Wdt + (size_t)fr * DM + fq * 8;
        const bf16_t* b1p = Wgk + (size_t)fr * DM + fq * 8;
#pragma unroll 4
        for (int k = 0; k < DM; k += 32) {
            const bf16x8 a = *(const bf16x8*)(ap + k), b0 = *(const bf16x8*)(b0p + k), b1 = *(const bf16x8*)(b1p + k);
            a0 = mma(a, b0, a0); a1 = mma(a, b1, a1);
        }
#pragma unroll
        for (int j = 0; j < 4; ++j) { float* d = DTGK + (size_t)(t0 + 4 * fq + j) * 32; d[fr] = a0[j]; d[16 + fr] = a1[j]; }
    }
}

DEV void phase_conv_a(const bf16_t* __restrict__ UA, const float* __restrict__ cw, bf16_t* __restrict__ YIN, int gtid, int NT) {
    for (int u = gtid; u < (HT / 16) * 128; u += NT) {
        const int c0 = (u & 127) * 8, t0 = (u >> 7) * 16;
        float w0[8], w1[8], w2[8], p1[8], p2[8];
#pragma unroll
        for (int j = 0; j < 8; ++j) { w0[j] = cw[c0 + j]; w1[j] = cw[1024 + c0 + j]; w2[j] = cw[2048 + c0 + j]; p1[j] = 0.f; p2[j] = 0.f; }
        if ((t0 & (SEQ - 1)) != 0) {
            float ax[8], ac[8];
            unpack8(*(const u32x4*)(UA + (size_t)(t0 - 2) * 3072 + c0), ax); unpack8(*(const u32x4*)(UA + (size_t)(t0 - 2) * 3072 + 2048 + c0), ac);
#pragma unroll
            for (int j = 0; j < 8; ++j) p2[j] = ax[j] * ac[j];
            unpack8(*(const u32x4*)(UA + (size_t)(t0 - 1) * 3072 + c0), ax); unpack8(*(const u32x4*)(UA + (size_t)(t0 - 1) * 3072 + 2048 + c0), ac);
#pragma unroll
            for (int j = 0; j < 8; ++j) p1[j] = ax[j] * ac[j];
        }
#pragma unroll 4
        for (int i = 0; i < 16; ++i) {
            const bf16_t* rp = UA + (size_t)(t0 + i) * 3072 + c0;
            float ax[8], ab[8], ac[8], o[8];
            unpack8(*(const u32x4*)rp, ax); unpack8(*(const u32x4*)(rp + 1024), ab); unpack8(*(const u32x4*)(rp + 2048), ac);
#pragma unroll
            for (int j = 0; j < 8; ++j) { const float p0 = ax[j] * ac[j]; o[j] = ab[j] * (w0[j] * p2[j] + w1[j] * p1[j] + w2[j] * p0); p2[j] = p1[j]; p1[j] = p0; }
            *(u32x4*)(YIN + (size_t)(t0 + i) * DM + c0) = pack8(o);
        }
    }
}

DEV void phase_ssd_prep(unsigned char* ws, const float* cw, const float* cb, const float* dtb, const float* alog, int gtid, int NT, int tid, int nblk, int blk) {
    const bf16_t* __restrict__ XST = (const bf16_t*)(ws + RB_XST); bf16_t* __restrict__ XSTC = (bf16_t*)(ws + RB_XSTC);
    for (int u = gtid; u < 1024 * (HT / 8); u += NT) {
        const int tb = u & (HT / 8 - 1), c = u >> 11, t0 = tb * 8;
        float x[11], cur[8];
        unpack8(*(const u32x4*)(XST + (size_t)c * HT + t0), cur);
        if ((t0 & (SEQ - 1)) != 0) { float pv[8]; unpack8(*(const u32x4*)(XST + (size_t)c * HT + t0 - 8), pv); x[0] = pv[5]; x[1] = pv[6]; x[2] = pv[7]; }
        else { x[0] = 0.f; x[1] = 0.f; x[2] = 0.f; }
#pragma unroll
        for (int i = 0; i < 8; ++i) x[3 + i] = cur[i];
        const float w0 = cw[c], w1 = cw[2048 + c], w2 = cw[4096 + c], w3 = cw[6144 + c], b = cb[c];
        float y[8];
#pragma unroll
        for (int i = 0; i < 8; ++i) y[i] = siluf_(b + w0 * x[i] + w1 * x[i + 1] + w2 * x[i + 2] + w3 * x[i + 3]);
        *(u32x4*)(XSTC + (size_t)c * HT + t0) = pack8(y);
    }
    const bf16_t* __restrict__ BC = (const bf16_t*)(ws + RB_BC); bf16_t* __restrict__ BCC = (bf16_t*)(ws + RB_BCC); bf16_t* __restrict__ BTC = (bf16_t*)(ws + RB_BTC);
    for (int u = gtid; u < (HT / 8) * 128; u += NT) {
        const int cg8 = u & 127, c0 = cg8 * 8, t0 = (u >> 7) * 8, cc = 1024 + c0;
        float w0[8], w1[8], w2[8], w3[8], bb[8], x1[8], x2[8], x3[8];
#pragma unroll
        for (int j = 0; j < 8; ++j) { w0[j] = cw[cc + j]; w1[j] = cw[2048 + cc + j]; w2[j] = cw[4096 + cc + j]; w3[j] = cw[6144 + cc + j]; bb[j] = cb[cc + j]; x1[j] = 0.f; x2[j] = 0.f; x3[j] = 0.f; }
        if ((t0 & (SEQ - 1)) != 0) {
            unpack8(*(const u32x4*)(BC + (size_t)(t0 - 1) * DM + c0), x1); unpack8(*(const u32x4*)(BC + (size_t)(t0 - 2) * DM + c0), x2); unpack8(*(const u32x4*)(BC + (size_t)(t0 - 3) * DM + c0), x3);
        }
        unsigned tr[8][4];
#pragma unroll
        for (int i = 0; i < 8; ++i) {
            float x0[8], y[8];
            unpack8(*(const u32x4*)(BC + (size_t)(t0 + i) * DM + c0), x0);
#pragma unroll
            for (int j = 0; j < 8; ++j) { y[j] = siluf_(bb[j] + w3[j] * x0[j] + w2[j] * x1[j] + w1[j] * x2[j] + w0[j] * x3[j]); x3[j] = x2[j]; x2[j] = x1[j]; x1[j] = x0[j]; }
            *(u32x4*)(BCC + (size_t)(t0 + i) * DM + c0) = pack8(y);
#pragma unroll
            for (int j = 0; j < 8; ++j) { if (i & 1) tr[j][i >> 1] |= f2bf(y[j]) << 16; else tr[j][i >> 1] = f2bf(y[j]); }
        }
        if (cg8 < 64) {
#pragma unroll
            for (int j = 0; j < 8; ++j) *(u32x4*)(BTC + (size_t)(c0 + j) * HT + t0) = (u32x4){tr[j][0], tr[j][1], tr[j][2], tr[j][3]};
        }
    }
    const float* __restrict__ DTGK = (const float*)(ws + WS_DTGK); float* __restrict__ DT = (float*)(ws + RB_DT); float* __restrict__ AC = (float*)(ws + RB_ACUM);
    {
        const int lane_ = tid & 63, gw_ = blk * NWAVES + (tid >> 6), ngw_ = nblk * NWAVES;
        for (int ch = gw_; ch < HT / 128; ch += ngw_) {
            const size_t tA = (size_t)ch * 128 + 2 * lane_;
            float d0[16], d1[16];
#pragma unroll
            for (int q = 0; q < 4; ++q) { const f32x4 a = *(const f32x4*)(DTGK + tA * 32 + 4 * q), b = *(const f32x4*)(DTGK + (tA + 1) * 32 + 4 * q);
#pragma unroll
                for (int e = 0; e < 4; ++e) { d0[4 * q + e] = a[e]; d1[4 * q + e] = b[e]; } }
            float c0[16], c1[16];
#pragma unroll
            for (int h = 0; h < 16; ++h) {
                const float av = -__expf(alog[h]), bias = dtb[h];
                d0[h] = softplusf_(d0[h] + bias); d1[h] = softplusf_(d1[h] + bias);
                const float x0 = d0[h] * av, x1 = x0 + d1[h] * av;
                float s = x1;
#pragma unroll
                for (int off = 1; off < 64; off <<= 1) { const float y = __shfl_up(s, off); if (lane_ >= off) s += y; }
                const float pre = s - x1; c0[h] = pre + x0; c1[h] = pre + x1;
            }
#pragma unroll
            for (int q = 0; q < 4; ++q) {
                *(f32x4*)(DT + tA * 16 + 4 * q) = (f32x4){d0[4 * q], d0[4 * q + 1], d0[4 * q + 2], d0[4 * q + 3]};
                *(f32x4*)(DT + (tA + 1) * 16 + 4 * q) = (f32x4){d1[4 * q], d1[4 * q + 1], d1[4 * q + 2], d1[4 * q + 3]};
                *(f32x4*)(AC + tA * 16 + 4 * q) = (f32x4){c0[4 * q], c0[4 * q + 1], c0[4 * q + 2], c0[4 * q + 3]};
                *(f32x4*)(AC + (tA + 1) * 16 + 4 * q) = (f32x4){c1[4 * q], c1[4 * q + 1], c1[4 * q + 2], c1[4 * q + 3]};
            }
        }
    }
}

DEV void phase_ssd_states(unsigned char* ws, LAS unsigned char* lds, int tid, int wave, int lane) {
    const bf16_t* XSTC = (const bf16_t*)(ws + RB_XSTC); const bf16_t* BTC = (const bf16_t*)(ws + RB_BTC);
    const float* DT = (const float*)(ws + RB_DT); const float* AC = (const float*)(ws + RB_ACUM); bf16_t* ST = (bf16_t*)(ws + RB_ST);
    constexpr int BT_OFF = 0, XW_OFF = 34816, TAB_OFF = 34816 + 69632, RS = 272;
    LAS float* wt = (LAS float*)(lds + TAB_OFF);
    const int fr = lane & 15, fq = lane >> 4;
    for (int unit = blockIdx.x; unit < (HT / 128) * 4; unit += gridDim.x) {
        const int cidx = unit >> 2, g = unit & 3, t0 = cidx * 128;
        { const int r = tid >> 7, l = tid & 127, h = g * 4 + r;
          const float al = AC[(size_t)(t0 + 127) * 16 + h], a = AC[(size_t)(t0 + l) * 16 + h];
          wt[r * 128 + l] = DT[(size_t)(t0 + l) * 16 + h] * __expf(al - a); }
        for (int i = tid; i < 2048; i += NTHR) { const int row = i >> 4, ch = i & 15;
            *(LAS u32x4*)(lds + BT_OFF + row * RS + ch * 16) = *(const u32x4*)(BTC + (size_t)(g * 128 + row) * HT + t0 + ch * 8); }
        __syncthreads();
        for (int i = tid; i < 4096; i += NTHR) { const int row = i >> 4, ch = i & 15; float f[8];
            unpack8(*(const u32x4*)(XSTC + (size_t)(g * 256 + row) * HT + t0 + ch * 8), f);
            const LAS float* wp = wt + (row >> 6) * 128 + ch * 8;
#pragma unroll
            for (int e = 0; e < 8; ++e) f[e] *= wp[e];
            *(LAS u32x4*)(lds + XW_OFF + row * RS + ch * 16) = pack8(f); }
        __syncthreads();
        f32x4 acc[2][8];
#pragma unroll
        for (int a = 0; a < 2; ++a)
#pragma unroll
            for (int b = 0; b < 8; ++b) acc[a][b] = (f32x4){0.f, 0.f, 0.f, 0.f};
#pragma unroll
        for (int ks = 0; ks < 4; ++ks) {
            const bf16x8 y0 = ldsfrag(lds + XW_OFF + (wave * 32 + fr) * RS + ks * 64 + fq * 16), y1 = ldsfrag(lds + XW_OFF + (wave * 32 + 16 + fr) * RS + ks * 64 + fq * 16);
#pragma unroll
            for (int nt = 0; nt < 8; ++nt) { const bf16x8 x = ldsfrag(lds + BT_OFF + (nt * 16 + fr) * RS + ks * 64 + fq * 16); acc[0][nt] = mma(x, y0, acc[0][nt]); acc[1][nt] = mma(x, y1, acc[1][nt]); }
        }
#pragma unroll
        for (int yt = 0; yt < 2; ++yt) { const int pp = wave * 32 + yt * 16 + fr, h = g * 4 + (pp >> 6), p = pp & 63;
            bf16_t* d = ST + (((size_t)cidx * 16 + h) * 64 + p) * 128 + 4 * fq;
#pragma unroll
            for (int nt = 0; nt < 8; ++nt) { u32x2 w; w.x = pk2(acc[yt][nt][0], acc[yt][nt][1]); w.y = pk2(acc[yt][nt][2], acc[yt][nt][3]); *(u32x2*)(d + nt * 16) = w; } }
        __syncthreads();
    }
}

DEV void phase_ssd_scan(unsigned char* ws, int gtid, int NT) {
    unsigned* ST = (unsigned*)(ws + RB_ST); const float* AC = (const float*)(ws + RB_ACUM);
    for (int e = gtid; e < 2 * 65536; e += NT) {
        const int bl = e >> 16, rem = e & 65535, h = rem >> 12;
        f32x2 carry = {0.f, 0.f};
        for (int c0 = 0; c0 < 64; c0 += 8) {
            unsigned v[8]; float dec[8];
#pragma unroll
            for (int i = 0; i < 8; ++i) { const int cidx = bl * 64 + c0 + i; v[i] = ST[(size_t)cidx * 65536 + rem]; dec[i] = __expf(AC[((size_t)cidx * 128 + 127) * 16 + h]); }
#pragma unroll
            for (int i = 0; i < 8; ++i) { const int cidx = bl * 64 + c0 + i; ST[(size_t)cidx * 65536 + rem] = pk2(carry[0], carry[1]);
                carry[0] = carry[0] * dec[i] + bf_lo(v[i]); carry[1] = carry[1] * dec[i] + bf_hi(v[i]); }
        }
    }
}

DEV void phase_ssd_out(unsigned char* ws, const float* dsk, const float* nw, LAS unsigned char* lds, int tid, int wave, int lane) {
    const bf16_t* XSTC = (const bf16_t*)(ws + RB_XSTC); const bf16_t* BCC = (const bf16_t*)(ws + RB_BCC); const bf16_t* Z = (const bf16_t*)(ws + RB_Z);
    const float* DT = (const float*)(ws + RB_DT); const float* AC = (const float*)(ws + RB_ACUM); const bf16_t* ST = (const bf16_t*)(ws + RB_ST);
    bf16_t* YIN = (bf16_t*)(ws + WS_YIN);
    float* YT = (float*)(ws + RB_XST);
    constexpr int C_OFF = 0, B_OFF = 34816, PV_OFF = 34816, XS_OFF = 34816 + 17408, M_OFF = 69632, TAB_OFF = 104448, RS = 272;
    LAS float* tac = (LAS float*)(lds + TAB_OFF); LAS float* tdt = tac + 512;
    const int fr = lane & 15, fq = lane >> 4;
    LAS unsigned char* Mw = lds + M_OFF + wave * 4352;
    for (int unit = blockIdx.x; unit < (HT / 128) * 4; unit += gridDim.x) {
        const int cidx = unit >> 2, g = unit & 3, t0 = cidx * 128;
        for (int i = tid; i < 2048; i += NTHR) { const int row = i >> 4, ch = i & 15;
            *(LAS u32x4*)(lds + C_OFF + row * RS + ch * 16) = *(const u32x4*)(BCC + (size_t)(t0 + row) * DM + 512 + g * 128 + ch * 8);
            *(LAS u32x4*)(lds + B_OFF + row * RS + ch * 16) = *(const u32x4*)(BCC + (size_t)(t0 + row) * DM + g * 128 + ch * 8); }
        { const int r = tid >> 7, l = tid & 127, h = g * 4 + r; tac[tid] = AC[(size_t)(t0 + l) * 16 + h]; tdt[tid] = DT[(size_t)(t0 + l) * 16 + h]; }
        __syncthreads();
        f32x4 cb[8];
#pragma unroll
        for (int st = 0; st < 8; ++st) cb[st] = (f32x4){0.f, 0.f, 0.f, 0.f};
#pragma unroll
        for (int ks = 0; ks < 4; ++ks) {
            const bf16x8 y = ldsfrag(lds + C_OFF + (wave * 16 + fr) * RS + ks * 64 + fq * 16);
#pragma unroll
            for (int st = 0; st < 8; ++st) cb[st] = mma(ldsfrag(lds + B_OFF + (st * 16 + fr) * RS + ks * 64 + fq * 16), y, cb[st]);
        }
        __syncthreads();
        const int l = wave * 16 + fr;
        const size_t t = (size_t)(t0 + l);
        float ssq = 0.f;
#pragma unroll 1
        for (int r = 0; r < 4; ++r) {
            const int h = g * 4 + r;
            for (int i = tid; i < 1024; i += NTHR) { const int row = i >> 4, ch = i & 15;
                *(LAS u32x4*)(lds + PV_OFF + row * RS + ch * 16) = *(const u32x4*)(ST + (((size_t)cidx * 16 + h) * 64 + row) * 128 + ch * 8); }
            for (int i = tid; i < 1024; i += NTHR) { const int row = i >> 4, ch = i & 15;
                *(LAS u32x4*)(lds + XS_OFF + row * RS + ch * 16) = *(const u32x4*)(XSTC + (size_t)(h * 64 + row) * HT + t0 + ch * 8); }
            const float al = tac[r * 128 + l];
#pragma unroll
            for (int st = 0; st < 8; ++st) { float m[4];
#pragma unroll
                for (int j = 0; j < 4; ++j) { const int s = st * 16 + 4 * fq + j; const float d = fminf(al - tac[r * 128 + s], 0.f); m[j] = (s <= l) ? cb[st][j] * __expf(d) * tdt[r * 128 + s] : 0.f; }
                u32x2 w; w.x = pk2(m[0], m[1]); w.y = pk2(m[2], m[3]); *(LAS u32x2*)(Mw + fr * RS + (st * 16 + 4 * fq) * 2) = w; }
            __syncthreads();
            f32x4 acc[4];
#pragma unroll
            for (int pt = 0; pt < 4; ++pt) acc[pt] = (f32x4){0.f, 0.f, 0.f, 0.f};
#pragma unroll
            for (int ks = 0; ks < 4; ++ks) { const bf16x8 y = ldsfrag(lds + C_OFF + l * RS + ks * 64 + fq * 16);
#pragma unroll
                for (int pt = 0; pt < 4; ++pt) acc[pt] = mma(ldsfrag(lds + PV_OFF + (pt * 16 + fr) * RS + ks * 64 + fq * 16), y, acc[pt]); }
            const float el = __expf(al);
#pragma unroll
            for (int pt = 0; pt < 4; ++pt) acc[pt] *= el;
#pragma unroll
            for (int ks = 0; ks < 4; ++ks) { const bf16x8 y = ldsfrag(Mw + fr * RS + ks * 64 + fq * 16);
#pragma unroll
                for (int pt = 0; pt < 4; ++pt) acc[pt] = mma(ldsfrag(lds + XS_OFF + (pt * 16 + fr) * RS + ks * 64 + fq * 16), y, acc[pt]); }
            const float dh = dsk[h];
#pragma unroll
            for (int pt = 0; pt < 4; ++pt) {
#pragma unroll
                for (int j = 0; j < 4; ++j) { const bf16_t xv = *(const LAS bf16_t*)(lds + XS_OFF + (pt * 16 + 4 * fq + j) * RS + l * 2); acc[pt][j] += dh * bf1(xv); }
                const int c = g * 256 + r * 64 + pt * 16 + 4 * fq;
                const u32x2 zw = *(const u32x2*)(Z + t * DM + c);
                f32x4 v = acc[pt]; v[0] *= bf_lo(zw.x); v[1] *= bf_hi(zw.x); v[2] *= bf_lo(zw.y); v[3] *= bf_hi(zw.y);
                ssq += (v[0] * v[0] + v[1] * v[1]) + (v[2] * v[2] + v[3] * v[3]);
                *(f32x4*)(YT + t * DM + c) = v;
            }
            __syncthreads();
        }
        ssq += __shfl_xor(ssq, 16); ssq += __shfl_xor(ssq, 32);
        const float rstd = rsqrtf(ssq * (1.f / 256.f) + EPS);
#pragma unroll 4
        for (int q = 0; q < 16; ++q) { const int c = g * 256 + q * 16 + 4 * fq;
            const f32x4 w4 = *(const f32x4*)(nw + c); const f32x4 v = *(const f32x4*)(YT + t * DM + c);
            u32x2 o; o.x = pk2(v[0] * rstd * w4[0], v[1] * rstd * w4[1]); o.y = pk2(v[2] * rstd * w4[2], v[3] * rstd * w4[3]);
            *(u32x2*)(YIN + t * DM + c) = o; }
        __syncthreads();
    }
}

DEV float gla_gk(const float* DTGK, size_t t, const float (&w)[16], float b) {
    const f32x4* gl = (const f32x4*)(DTGK + t * 32 + 16);
    const f32x4 g0 = gl[0], g1 = gl[1], g2 = gl[2], g3 = gl[3];
    float z = b;
    z += g0[0] * w[0] + g0[1] * w[1] + g0[2] * w[2] + g0[3] * w[3];
    z += g1[0] * w[4] + g1[1] * w[5] + g1[2] * w[6] + g1[3] * w[7];
    z += g2[0] * w[8] + g2[1] * w[9] + g2[2] * w[10] + g2[3] * w[11];
    z += g3[0] * w[12] + g3[1] * w[13] + g3[2] * w[14] + g3[3] * w[15];
    return logsigf_(z) * (1.f / 16.f);
}
DEV void phase_gla_prep(unsigned char* ws, const float* w2, const float* bg, int gtid, int NT) {
    bf16_t* QK = (bf16_t*)(ws + RC_QK); bf16_t* __restrict__ KT = (bf16_t*)(ws + RC_KT); float* __restrict__ DEC = (float*)(ws + WS_DEC);
    const float* __restrict__ DTGK = (const float*)(ws + WS_DTGK);
    for (int e = gtid; e < (HT / 64) * 512; e += NT) {
        const int d = e & 511, ch = e >> 9, t0 = ch * 64;
        float w[16];
#pragma unroll
        for (int j = 0; j < 16; ++j) w[j] = w2[j * 512 + d];
        const float b = bg[d];
        float glast = 0.f;
#pragma unroll 4
        for (int i = 0; i < 64; ++i) glast += gla_gk(DTGK, (size_t)(t0 + i), w, b);
        float run = 0.f;
        bf16_t* kd = KT + (size_t)d * HT + t0;
#pragma unroll 1
        for (int m = 0; m < 8; ++m) {
            float qv[8], kv[8], gv[8];
#pragma unroll
            for (int ii = 0; ii < 8; ++ii) { const bf16_t* qp = QK + (size_t)(t0 + m * 8 + ii) * DM + d; qv[ii] = bf1(qp[0]); kv[ii] = bf1(qp[512]); gv[ii] = gla_gk(DTGK, (size_t)(t0 + m * 8 + ii), w, b); }
            unsigned tr[4];
#pragma unroll
            for (int ii = 0; ii < 8; ++ii) {
                run += gv[ii];
                bf16_t* qp = QK + (size_t)(t0 + m * 8 + ii) * DM + d;
                qp[0] = (bf16_t)f2bf(qv[ii] * 0.08838834764831845f * __expf(run));
                qp[512] = (bf16_t)f2bf(kv[ii] * __expf(-run));
                const unsigned ke = f2bf(kv[ii] * __expf(glast - run));
                if (ii & 1) tr[ii >> 1] |= ke << 16; else tr[ii >> 1] = ke;
            }
            *(u32x4*)(kd + 8 * m) = (u32x4){tr[0], tr[1], tr[2], tr[3]};
        }
        DEC[(size_t)ch * 512 + d] = __expf(glast);
    }
}

DEV void phase_gla_states(unsigned char* ws, LAS unsigned char* lds, int tid, int wave, int lane) {
    const bf16_t* KT = (const bf16_t*)(ws + RC_KT); const bf16_t* VT = (const bf16_t*)(ws + RC_VT); bf16_t* ST = (bf16_t*)(ws + RC_ST);
    constexpr int V_OFF = 0, K_OFF = 36864, RS = 144;
    const int fr = lane & 15, fq = lane >> 4;
    for (int unit = blockIdx.x; unit < (HT / 64) * 4; unit += gridDim.x) {
        const int cidx = unit >> 2, h = unit & 3, t0 = cidx * 64;
        for (int i = tid; i < 2048; i += NTHR) { const int row = i >> 3, ch = i & 7;
            *(LAS u32x4*)(lds + V_OFF + row * RS + ch * 16) = *(const u32x4*)(VT + (size_t)(h * 256 + row) * HT + t0 + ch * 8); }
        for (int i = tid; i < 1024; i += NTHR) { const int row = i >> 3, ch = i & 7;
            *(LAS u32x4*)(lds + K_OFF + row * RS + ch * 16) = *(const u32x4*)(KT + (size_t)(h * 128 + row) * HT + t0 + ch * 8); }
        __syncthreads();
        f32x4 acc[2][8];
#pragma unroll
        for (int a = 0; a < 2; ++a)
#pragma unroll
            for (int b = 0; b < 8; ++b) acc[a][b] = (f32x4){0.f, 0.f, 0.f, 0.f};
#pragma unroll
        for (int ks = 0; ks < 2; ++ks) {
            const bf16x8 y0 = ldsfrag(lds + V_OFF + (wave * 32 + fr) * RS + ks * 64 + fq * 16), y1 = ldsfrag(lds + V_OFF + (wave * 32 + 16 + fr) * RS + ks * 64 + fq * 16);
#pragma unroll
            for (int dt = 0; dt < 8; ++dt) { const bf16x8 x = ldsfrag(lds + K_OFF + (dt * 16 + fr) * RS + ks * 64 + fq * 16); acc[0][dt] = mma(x, y0, acc[0][dt]); acc[1][dt] = mma(x, y1, acc[1][dt]); }
        }
#pragma unroll
        for (int yt = 0; yt < 2; ++yt) { const int v = wave * 32 + yt * 16 + fr;
            bf16_t* dp = ST + (((size_t)cidx * 4 + h) * 256 + v) * 128 + 4 * fq;
#pragma unroll
            for (int dt = 0; dt < 8; ++dt) { u32x2 w; w.x = pk2(acc[yt][dt][0], acc[yt][dt][1]); w.y = pk2(acc[yt][dt][2], acc[yt][dt][3]); *(u32x2*)(dp + dt * 16) = w; } }
        __syncthreads();
    }
}

DEV void phase_gla_scan(unsigned char* ws, int gtid, int NT) {
    unsigned* ST = (unsigned*)(ws + RC_ST); const float* DEC = (const float*)(ws + WS_DEC);
    for (int e = gtid; e < 2 * 65536; e += NT) {
        const int bl = e >> 16, rem = e & 65535, h = rem >> 14, d = (rem * 2) & 127;
        f32x2 carry = {0.f, 0.f};
        for (int c0 = 0; c0 < 128; c0 += 8) {
            unsigned v[8]; f32x2 dec[8];
#pragma unroll
            for (int i = 0; i < 8; ++i) { const int cidx = bl * 128 + c0 + i; v[i] = ST[(size_t)cidx * 65536 + rem]; dec[i] = *(const f32x2*)(DEC + (size_t)cidx * 512 + h * 128 + d); }
#pragma unroll
            for (int i = 0; i < 8; ++i) { const int cidx = bl * 128 + c0 + i; ST[(size_t)cidx * 65536 + rem] = pk2(carry[0], carry[1]);
                carry[0] = carry[0] * dec[i][0] + bf_lo(v[i]); carry[1] = carry[1] * dec[i][1] + bf_hi(v[i]); }
        }
    }
}

DEV void phase_gla_out(unsigned char* ws, const float* nw, LAS unsigned char* lds, int tid, int wave, int lane) {
    const bf16_t* QK = (const bf16_t*)(ws + RC_QK); const bf16_t* VT = (const bf16_t*)(ws + RC_VT); const bf16_t* GS = (const bf16_t*)(ws + RC_GS);
    const bf16_t* ST = (const bf16_t*)(ws + RC_ST); bf16_t* YIN = (bf16_t*)(ws + WS_YIN);
    constexpr int Q_OFF = 0, K_OFF = 17408, V_OFF = 34816, P_OFF = 71680, S_OFF = 80896, RSD = 272, RST = 144;
    LAS float* ssqt = (LAS float*)(lds + S_OFF);
    const int fr = lane & 15, fq = lane >> 4, lt = wave >> 1, vh = wave & 1;
    for (int unit = blockIdx.x; unit < (HT / 64) * 4; unit += gridDim.x) {
        const int cidx = unit >> 2, h = unit & 3, t0 = cidx * 64;
        for (int i = tid; i < 1024; i += NTHR) { const int row = i >> 4, ch = i & 15;
            *(LAS u32x4*)(lds + Q_OFF + row * RSD + ch * 16) = *(const u32x4*)(QK + (size_t)(t0 + row) * DM + h * 128 + ch * 8);
            *(LAS u32x4*)(lds + K_OFF + row * RSD + ch * 16) = *(const u32x4*)(QK + (size_t)(t0 + row) * DM + 512 + h * 128 + ch * 8); }
        for (int i = tid; i < 2048; i += NTHR) { const int row = i >> 3, ch = i & 7;
            *(LAS u32x4*)(lds + V_OFF + row * RST + ch * 16) = *(const u32x4*)(VT + (size_t)(h * 256 + row) * HT + t0 + ch * 8); }
        __syncthreads();
        const int l = lt * 16 + fr;
        {
            f32x4 sc[2] = {(f32x4){0.f, 0.f, 0.f, 0.f}, (f32x4){0.f, 0.f, 0.f, 0.f}};
#pragma unroll
            for (int ks = 0; ks < 4; ++ks) { const bf16x8 y = ldsfrag(lds + Q_OFF + l * RSD + ks * 64 + fq * 16);
#pragma unroll
                for (int i = 0; i < 2; ++i) sc[i] = mma(ldsfrag(lds + K_OFF + ((2 * vh + i) * 16 + fr) * RSD + ks * 64 + fq * 16), y, sc[i]); }
#pragma unroll
            for (int i = 0; i < 2; ++i) { const int s0 = (2 * vh + i) * 16 + 4 * fq; float m[4];
#pragma unroll
                for (int j = 0; j < 4; ++j) m[j] = (s0 + j <= l) ? sc[i][j] : 0.f;
                u32x2 w; w.x = pk2(m[0], m[1]); w.y = pk2(m[2], m[3]); *(LAS u32x2*)(lds + P_OFF + l * RST + s0 * 2) = w; }
        }
        __syncthreads();
        f32x4 acc[8];
#pragma unroll
        for (int i = 0; i < 8; ++i) acc[i] = (f32x4){0.f, 0.f, 0.f, 0.f};
#pragma unroll
        for (int ks = 0; ks < 2; ++ks) { const bf16x8 y = ldsfrag(lds + P_OFF + l * RST + ks * 64 + fq * 16);
#pragma unroll
            for (int i = 0; i < 8; ++i) acc[i] = mma(ldsfrag(lds + V_OFF + ((vh * 8 + i) * 16 + fr) * RST + ks * 64 + fq * 16), y, acc[i]); }
        const bf16_t* sp = ST + (((size_t)cidx * 4 + h) * 256 + vh * 128 + fr) * 128 + fq * 8;
#pragma unroll
        for (int ks = 0; ks < (GLA_NO_INTER ? 0 : 4); ++ks) { const bf16x8 y = ldsfrag(lds + Q_OFF + l * RSD + ks * 64 + fq * 16);
#pragma unroll
            for (int i = 0; i < 8; ++i) acc[i] = mma(*(const bf16x8*)(sp + (size_t)i * 16 * 128 + ks * 32), y, acc[i]); }
        float ssq = 0.f;
#pragma unroll
        for (int i = 0; i < 8; ++i) ssq += (acc[i][0] * acc[i][0] + acc[i][1] * acc[i][1]) + (acc[i][2] * acc[i][2] + acc[i][3] * acc[i][3]);
        ssq += __shfl_xor(ssq, 16); ssq += __shfl_xor(ssq, 32);
        if (fq == 0) ssqt[l * 2 + vh] = ssq;
        __syncthreads();
        const float rstd = rsqrtf((ssqt[l * 2] + ssqt[l * 2 + 1]) * (1.f / 256.f) + EPS);
        const size_t t = (size_t)(t0 + l);
#pragma unroll
        for (int i = 0; i < 8; ++i) { const int v = (vh * 8 + i) * 16 + 4 * fq, c = h * 256 + v;
            const u32x2 gw = *(const u32x2*)(GS + t * DM + c); const f32x4 w4 = *(const f32x4*)(nw + v);
            u32x2 o; o.x = pk2(acc[i][0] * rstd * w4[0] * bf_lo(gw.x), acc[i][1] * rstd * w4[1] * bf_hi(gw.x));
            o.y = pk2(acc[i][2] * rstd * w4[2] * bf_lo(gw.y), acc[i][3] * rstd * w4[3] * bf_hi(gw.y));
            *(u32x2*)(YIN + t * DM + c) = o; }
        __syncthreads();
    }
}


#define XB_TMO      128
#define XB_XCNT(j)  (256  + 64 * (j))
#define XB_XSUB(j)  (1280 + 64 * (j))
#define XB_XGEN(j)  (2304 + 64 * (j))
#define XB_TOP      3328
#define XB_TOPGEN   3392
#define XCD_BAR_WORDS 3456
#define XB_SPIN_CAP (1u << 22)
DEV unsigned xb_ld(unsigned* p)              { return __hip_atomic_load(p, __ATOMIC_RELAXED, __HIP_MEMORY_SCOPE_AGENT); }
DEV unsigned xb_add(unsigned* p, unsigned v) { return __hip_atomic_fetch_add(p, v, __ATOMIC_RELAXED, __HIP_MEMORY_SCOPE_AGENT); }
DEV unsigned xb_xcc_id() { return (unsigned)__builtin_amdgcn_s_getreg((3 << 11) | 20) & 0xFu; }
#define XB_SPIN(cond, bar) do { unsigned _sp = 0; while (cond) { __builtin_amdgcn_s_sleep(1); \
    if ((++_sp & 255u) == 0u) { if (xb_ld(&(bar)[XB_TMO])) break; if (_sp > XB_SPIN_CAP) { atomicAdd(&(bar)[XB_TMO], 1u); break; } } } } while (0)
DEV void xcd_barrier_complete(unsigned* bar, unsigned x, unsigned Gn, unsigned& nloc, unsigned& nx) {
    unsigned sum, cnt, mine, sp = 0u;
    for (;;) {
        sum = 0u; cnt = 0u; mine = 0u;
#pragma unroll
        for (unsigned j = 0; j < 16; ++j) { const unsigned c = xb_ld(&bar[XB_XCNT(j)]); sum += c; cnt += (c > 0u) ? 1u : 0u; mine = (j == x) ? c : mine; }
        if (sum == Gn) break;
        __builtin_amdgcn_s_sleep(1);
        if ((++sp & 255u) == 0u) { if (xb_ld(&bar[XB_TMO])) break; if (sp > XB_SPIN_CAP) { atomicAdd(&bar[XB_TMO], 1u); break; } }
    }
    nloc = mine > 0u ? mine : 1u; nx = cnt > 0u ? cnt : 1u;
}
DEV void xcd_barrier(unsigned* bar, unsigned x, volatile LAS unsigned* st, int tid, unsigned Gn) {
    asm volatile("s_waitcnt vmcnt(0)" ::: "memory");
    __syncthreads();
    if (tid == 0) {
        __builtin_amdgcn_s_waitcnt(0);
        unsigned nloc = st[0], nx = st[1];
        if (nloc == 0u) { xcd_barrier_complete(bar, x, Gn, nloc, nx); st[0] = nloc; st[1] = nx; }
        const unsigned old = xb_add(&bar[XB_XSUB(x)], 1u);
        const unsigned gen = old / nloc;
        if (old + 1u == (gen + 1u) * nloc) {
            __builtin_amdgcn_fence(__ATOMIC_RELEASE, "agent");
            asm volatile("s_waitcnt vmcnt(0)" ::: "memory");
            const unsigned og = xb_add(&bar[XB_TOP], 1u);
            const unsigned tg = og / nx;
            if (og + 1u == (tg + 1u) * nx) xb_add(&bar[XB_TOPGEN], 1u);
            else XB_SPIN(xb_ld(&bar[XB_TOPGEN]) == tg, bar);
            __builtin_amdgcn_fence(__ATOMIC_ACQUIRE, "agent");
            xb_add(&bar[XB_XGEN(x)], 1u);
            asm volatile("s_waitcnt vmcnt(0)" ::: "memory");
        } else {
            XB_SPIN(xb_ld(&bar[XB_XGEN(x)]) == gen, bar);
            __builtin_amdgcn_fence(__ATOMIC_ACQUIRE, "agent");
            asm volatile("s_waitcnt vmcnt(0)" ::: "memory");
        }
    }
    __syncthreads();
}

typedef const __attribute__((address_space(4))) Params* KParams;
DEV KParams kargs() { unsigned long long kp = (unsigned long long)__builtin_amdgcn_kernarg_segment_ptr(); asm volatile("" : "+s"(kp)); return (KParams)kp; }

__global__ void __launch_bounds__(NTHR, 2) mega_fwd(Params Parg, int pc_lo, int pc_hi, int coop, int pad_) {
    extern __shared__ __attribute__((aligned(16))) unsigned char smem[];
    cg::grid_group grid = cg::this_grid();
    if (coop) grid.sync();
    volatile LAS unsigned* xst = (volatile LAS unsigned*)((LAS unsigned char*)smem + 139264 - 16);
    const unsigned xcc = xb_xcc_id();
    if (threadIdx.x == 0) { xst[0] = 0u; xst[1] = 0u; (void)xb_add((unsigned*)(asglobal(kargs()->ws) + WS_BAR) + XB_XCNT(xcc), 1u); }
    __syncthreads();
    using pg8::Sched; using pg8::job_put;
    constexpr int PER_LAYER = 1 + 34 + 3, NPC = 2 * PER_LAYER + 1;
#pragma unroll 1
    for (int pc0 = pc_lo; pc0 < pc_hi; ++pc0) {
        int pc = pc0; asm volatile("" : "+s"(pc));
        int tid = threadIdx.x; asm volatile("" : "+v"(tid));
        const int lane = tid & 63, wave = __builtin_amdgcn_readfirstlane(tid >> 6);
        unsigned ldso = 0; asm volatile("" : "+s"(ldso));
        LAS unsigned char* lds = (LAS unsigned char*)smem + ldso;
        int bxv = blockIdx.x, gdv = gridDim.x; asm volatile("" : "+s"(bxv), "+s"(gdv));
        const int layer = pc / PER_LAYER; const int r = pc - layer * PER_LAYER;
        int ph, hf = 0;
        if (pc == NPC - 1) ph = 21; else if (r == 0) ph = 0; else if (r <= 34) { hf = (r - 1) / 17; ph = (r - 1) - hf * 17 + 1; } else ph = 18 + (r - 35);
        asm volatile("" : "+s"(ph), "+s"(hf));
#define P kargs()
#define ws asglobal(kargs()->ws)
#define INP(i) asglobal(kargs()->in[i])
#define OUTP asglobal(kargs()->out)
#define G gdv
#define bx bxv
#define gw (bx * NWAVES + wave)
#define NGW (G * NWAVES)
#define gtid (bx * NTHR + tid)
#define NT (G * NTHR)
#define WIN ((bf16_t*)(ws + WS_WIN))
#define HB ((bf16_t*)(ws + WS_HB))
#define MERGED ((float*)(ws + WS_MERGED))
#define GB ((bf16_t*)(ws + WS_G))
#define YIN ((bf16_t*)(ws + WS_YIN))
#define xsrc (((layer == 0) ? INP(0) : (const float*)OUTP) + (size_t)hf * HT * DM)
#define xdst (OUTP + (size_t)hf * HT * DM)

#define PROBE11 0
#define NOMIX 0
#define NOMLP 0
#ifndef SKIPMASK

#define SKIPMASK 0u
#endif
        if ((SKIPMASK >> ph) & 1u) ph = 99;
#ifdef DELAY_PROBE
        if (bxv == 3) { const unsigned long long t0 = __builtin_amdgcn_s_memrealtime(); while (__builtin_amdgcn_s_memrealtime() - t0 < 30000ull) __builtin_amdgcn_s_sleep(64); }
#endif
        switch (ph) {
        case 0:
            phase_weights(ws, INP(2) + (size_t)layer * 1024 * INW, INP(4) + (size_t)layer * 1048576, INP(11) + (size_t)layer * 1048576, INP(15) + (size_t)layer * 1048576,
                          INP(16) + (size_t)layer * 1048576, INP(18) + (size_t)layer * 4194304, INP(19) + (size_t)layer * 4194304, lds, gw, NGW, wave, lane);
            break;
        case 1:
            phase_rmsnorm_bf16(xsrc, INP(1) + layer * DM, HB, HT, gw, NGW, lane);
            if (DUP2) phase_rmsnorm_bf16(xsrc, INP(1) + layer * DM, HB, HT, gw, NGW, lane);
            break;
        case 2: {
            if (tid == 0) { job_put(lds, 0, HB, WIN, ws + RA_UA, nullptr, 64, 12, 3072, 0); job_put(lds, 1, HB, WIN + (size_t)9248 * DM, GB, nullptr, 64, 4, 1024, 1); }
            Sched S; S.init(lds, 2, G, bx, DM, tid);
            pg8::GEMM_BODY<3>(lds, DM, S, tid);
            phase_narrow(HB, WIN + (size_t)6144 * DM, WIN + (size_t)9232 * DM, (float*)(ws + WS_DTGK), gw, NGW, lane);
            break; }
        case 3:
            phase_conv_a((const bf16_t*)(ws + RA_UA), INP(3) + (size_t)layer * 3 * 1024, YIN, gtid, NT);
            if (DUP2) phase_conv_a((const bf16_t*)(ws + RA_UA), INP(3) + (size_t)layer * 3 * 1024, YIN, gtid, NT);
            break;
        case 4: {
            if (tid == 0) job_put(lds, 0, YIN, ws + WS_WOA, ws + WS_MERGED, GB, 64, 4, 1024, 4);
            Sched S; S.init(lds, 1, G, bx, DM, tid); pg8::GEMM_BODY<16>(lds, DM, S, tid);
            break; }
        case 5: {
            if (tid == 0) { job_put(lds, 0, HB, WIN + (size_t)3072 * DM, ws + RB_Z, nullptr, 64, 4, 1024, 2); job_put(lds, 1, WIN + (size_t)4096 * DM, HB, ws + RB_XST, nullptr, 4, 64, HT, 0);
                            job_put(lds, 2, HB, WIN + (size_t)5120 * DM, ws + RB_BC, nullptr, 64, 4, 1024, 0); job_put(lds, 3, HB, WIN + (size_t)10272 * DM, GB, nullptr, 64, 4, 1024, 1); }
            Sched S; S.init(lds, 4, G, bx, DM, tid); pg8::GEMM_BODY<7>(lds, DM, S, tid);
            break; }
        case 6:
            phase_ssd_prep(ws, INP(5) + (size_t)layer * 4 * 2048, INP(6) + (size_t)layer * 2048, INP(7) + layer * 16, INP(8) + layer * 16, gtid, NT, tid, G, bx);
            if (DUP2) phase_ssd_prep(ws, INP(5) + (size_t)layer * 4 * 2048, INP(6) + (size_t)layer * 2048, INP(7) + layer * 16, INP(8) + layer * 16, gtid, NT, tid, G, bx);
            break;
        case 7: phase_ssd_states(ws, lds, tid, wave, lane); if (DUP) { __syncthreads(); phase_ssd_states(ws, lds, tid, wave, lane); } break;
        case 8: phase_ssd_scan(ws, gtid, NT); break;
        case 9: phase_ssd_out(ws, INP(9) + layer * 16, INP(10) + layer * 1024, lds, tid, wave, lane); if (DUP) { __syncthreads(); phase_ssd_out(ws, INP(9) + layer * 16, INP(10) + layer * 1024, lds, tid, wave, lane); } break;
        case 10: {
            if (tid == 0) job_put(lds, 0, YIN, ws + WS_WOS, ws + WS_MERGED, GB, 64, 4, (int)((WS_MSUM - WS_MERGED) / 4), 5);
            Sched S; S.init(lds, 1, G, bx, DM, tid); pg8::GEMM_BODY<32>(lds, DM, S, tid);
            break; }
        case 11: {
#if PROBE11 == 1
            if (tid == 0) { job_put(lds, 0, HB, WIN + (size_t)11296 * DM, GB, nullptr, 64, 4, 1024, 1); }
            Sched S; S.init(lds, 1, G, bx, DM, tid); pg8::GEMM_BODY<7>(lds, DM, S, tid);
#elif PROBE11 == 2
            if (tid == 0) { job_put(lds, 1, HB, WIN + (size_t)3072 * DM, ws + RB_Z, nullptr, 64, 4, 1024, 2); job_put(lds, 2, WIN + (size_t)4096 * DM, HB, ws + RB_XST, nullptr, 4, 64, HT, 0);
                            job_put(lds, 3, HB, WIN + (size_t)5120 * DM, ws + RB_BC, nullptr, 64, 4, 1024, 0); job_put(lds, 0, HB, WIN + (size_t)10272 * DM, GB, nullptr, 64, 4, 1024, 1); }
            Sched S; S.init(lds, 4, G, bx, DM, tid); pg8::GEMM_BODY<7>(lds, DM, S, tid);
#else
            if (tid == 0) { job_put(lds, 0, HB, WIN + (size_t)6160 * DM, ws + RC_QK, nullptr, 64, 4, 1024, 0); job_put(lds, 1, WIN + (size_t)7184 * DM, HB, ws + RC_VT, nullptr, 4, 64, HT, 0);
                            job_put(lds, 2, HB, WIN + (size_t)8208 * DM, ws + RC_GS, nullptr, 64, 4, 1024, 2); job_put(lds, 3, HB, WIN + (size_t)11296 * DM, GB, nullptr, 64, 4, 1024, 1); }
            Sched S; S.init(lds, 4, G, bx, DM, tid); pg8::GEMM_BODY<7>(lds, DM, S, tid);
#endif
            break; }
        case 12: phase_gla_prep(ws, INP(12) + (size_t)layer * 16 * 512, INP(13) + layer * 512, gtid, NT); break;
        case 13: phase_gla_states(ws, lds, tid, wave, lane); if (DUP) { __syncthreads(); phase_gla_states(ws, lds, tid, wave, lane); } break;
        case 14: phase_gla_scan(ws, gtid, NT); break;
        case 15: phase_gla_out(ws, INP(14) + layer * 256, lds, tid, wave, lane); if (DUP) { __syncthreads(); phase_gla_out(ws, INP(14) + layer * 256, lds, tid, wave, lane); } break;
        case 16: {
            if (tid == 0) job_put(lds, 0, YIN, ws + WS_WOG, ws + WS_MSUM, GB, 64, 4, 1024, 6);
            Sched S; S.init(lds, 1, G, bx, DM, tid); pg8::GEMM_BODY<64>(lds, DM, S, tid);
            break; }
        case 17: {
            if (tid == 0) job_put(lds, 0, GB, ws + WS_WO, xdst, xsrc, 64, 4, NOMIX ? 0 : 1024, 7);
            Sched S; S.init(lds, 1, G, bx, DM, tid); pg8::GEMM_BODY<128>(lds, DM, S, tid);
            break; }
        case 18:
            phase_rmsnorm_bf16(OUTP, INP(17) + layer * DM, (bf16_t*)(ws + WS_MERGED), T_ALL, gw, NGW, lane);
            break;
        case 19: {
            if (tid == 0) job_put(lds, 0, ws + WS_MERGED, ws + WS_WUP, ws + WS_R, nullptr, 128, 16, DFF, 3);
            Sched S; S.init(lds, 1, G, bx, DM, tid); pg8::GEMM_BODY<8>(lds, DM, S, tid);
            break; }
        case 20: {
            if (tid == 0) job_put(lds, 0, ws + WS_R, ws + WS_WDN, OUTP, OUTP, 128, 4, NOMLP ? 0 : 1024, 7);
            Sched S; S.init(lds, 1, G, bx, DFF, tid); pg8::GEMM_BODY<128>(lds, DFF, S, tid);
            break; }
        case 99: {
#ifdef SPIN_PROBE
            if (pc == 6 || pc == 23) { const unsigned long long t0 = __builtin_amdgcn_s_memrealtime(); while (__builtin_amdgcn_s_memrealtime() - t0 < 500000ull) __builtin_amdgcn_s_sleep(64); }
#endif
            break; }
        default:
            phase_rmsnorm_f32(OUTP, INP(20), T_ALL, gw, NGW, lane);
            break;
        }
        if (pc0 != pc_hi - 1) {
            xcd_barrier((unsigned*)(ws + WS_BAR), xcc, xst, tid, (unsigned)gdv);
            if (BAR2) xcd_barrier((unsigned*)(ws + WS_BAR), xcc, xst, tid, (unsigned)gdv);
        }
    }
#undef P
#undef ws
#undef INP
#undef OUTP
#undef G
#undef bx
#undef gw
#undef NGW
#undef gtid
#undef NT
#undef WIN
#undef HB
#undef MERGED
#undef GB
#undef YIN
#undef xsrc
#undef xdst
}

extern "C" void kernel_launch(void* const* d_in, const int* in_sizes, int n_in, void* d_out, int out_size, void* d_ws, size_t ws_size, hipStream_t stream) {
    static int grid = 0;
    if (grid == 0) {
        if (n_in != 21 || out_size != T_ALL * DM || ws_size < WS_TOTAL) { fprintf(stderr, "kernel_launch: unexpected shapes (n_in %d out %d ws %zu need %zu)\n", n_in, out_size, ws_size, (size_t)WS_TOTAL); grid = -1; return; }
        int dev = 0, cus = 0, per_cu = 0;
        hipGetDevice(&dev);
        hipDeviceGetAttribute(&cus, hipDeviceAttributeMultiprocessorCount, dev);
        if (hipFuncSetAttribute((const void*)mega_fwd, hipFuncAttributeMaxDynamicSharedMemorySize, LDS_BYTES) != hipSuccess) { fprintf(stderr, "kernel_launch: hipFuncSetAttribute failed\n"); }
        if (hipOccupancyMaxActiveBlocksPerMultiprocessor(&per_cu, (const void*)mega_fwd, NTHR, LDS_BYTES) != hipSuccess || per_cu < 1) { fprintf(stderr, "kernel_launch: occupancy query says %d\n", per_cu); per_cu = 1; }
        (void)hipGetLastError();
        grid = cus > 0 ? cus : 256;
    }
    if (grid < 0) return;
    if (hipMemsetAsync((char*)d_ws + WS_BAR, 0, 16384, stream) != hipSuccess) { fprintf(stderr, "kernel_launch: memset failed\n"); return; }
    Params p{};
    for (int i = 0; i < 21; ++i) p.in[i] = (const float*)d_in[i];
    p.out = (float*)d_out; p.ws = (unsigned char*)d_ws;
#ifndef N_LAUNCH_SPLIT
#define N_LAUNCH_SPLIT 0
#endif
    constexpr int NPC_H = 2 * 38 + 1;
    if (N_LAUNCH_SPLIT) {
        for (int pc = 0; pc < NPC_H; ++pc) {
            hipLaunchKernelGGL(mega_fwd, dim3(grid), dim3(NTHR), LDS_BYTES, stream, p, pc, pc + 1, 0, 0);
        }
        hipError_t e = hipPeekAtLastError();
        if (e != hipSuccess) fprintf(stderr, "launch failed: %s (grid %d)\n", hipGetErrorString(e), grid);
    } else {
        int lo = 0, hi = NPC_H, coop = 1, pad = 0;
        void* args[] = {&p, &lo, &hi, &coop, &pad};
        hipError_t e = hipLaunchCooperativeKernel((const void*)mega_fwd, dim3(grid), dim3(NTHR), args, LDS_BYTES, stream);
        if (e != hipSuccess) fprintf(stderr, "cooperative launch failed: %s (grid %d)\n", hipGetErrorString(e), grid);
    }
}
```

```cpp
#include <hip/hip_runtime.h>
#include <hip/hip_cooperative_groups.h>
#include <cstdio>
namespace cg = cooperative_groups;

#define LAS __attribute__((address_space(3)))
#define DEV __device__ __forceinline__
typedef unsigned short bf16_t;
typedef short bf16x8 __attribute__((ext_vector_type(8)));
typedef float f32x4 __attribute__((ext_vector_type(4)));
typedef float f32x2 __attribute__((ext_vector_type(2)));
typedef unsigned u32x4 __attribute__((ext_vector_type(4)));
typedef unsigned u32x2 __attribute__((ext_vector_type(2)));

constexpr int T_ALL = 32768, HT = 16384, DM = 1024, SEQ = 8192, INW = 12320, DFF = 4096;
constexpr int NTHR = 512, NWAVES = 8;
constexpr int LDS_BYTES = 136 * 1024;
constexpr float EPS = 1e-6f;

constexpr size_t WS_WIN = 1048576;
constexpr size_t WS_WOA = WS_WIN + (size_t)INW * 1024 * 2 + 1048576;
constexpr size_t WS_WOS = WS_WOA + 2097152;
constexpr size_t WS_WOG = WS_WOS + 2097152;
constexpr size_t WS_WO = WS_WOG + 2097152;
constexpr size_t WS_WUP = WS_WO + 2097152;
constexpr size_t WS_WDN = WS_WUP + 8388608;
constexpr size_t WS_HB = WS_WDN + 8388608;
constexpr size_t WS_MERGED = WS_HB + (size_t)HT * 1024 * 2;
constexpr size_t WS_G = WS_MERGED + (size_t)HT * 1024 * 4;
constexpr size_t WS_YIN = WS_G + (size_t)HT * 1024 * 2;
constexpr size_t WS_DTGK = WS_YIN + (size_t)HT * 1024 * 2;
constexpr size_t WS_R = WS_DTGK + (size_t)HT * 32 * 4;
constexpr size_t RA_UA = WS_R;
constexpr size_t RB_Z = WS_R;
constexpr size_t RB_XST = RB_Z + 33554432;
constexpr size_t RB_BC = RB_XST + 33554432;
constexpr size_t RB_XSTC = RB_BC + 33554432;
constexpr size_t RB_BCC = RB_XSTC + 33554432;
constexpr size_t RB_BTC = RB_BCC + 33554432;
constexpr size_t RB_DT = RB_BTC + 16777216;
constexpr size_t RB_ACUM = RB_DT + 1048576;
constexpr size_t RB_ST = RB_ACUM + 1048576;
constexpr size_t RB_END = RB_ST + 67108864;
constexpr size_t RC_QK = WS_R;
constexpr size_t RC_KT = RC_QK + 33554432;
constexpr size_t RC_VT = RC_KT + 16777216;
constexpr size_t RC_GS = RC_VT + 33554432;
constexpr size_t RC_DEC = RC_GS + 33554432;
constexpr size_t RC_ST = RC_DEC + 524288;
constexpr size_t RC_END = RC_ST + 134217728;
constexpr size_t R_HID_END = WS_R + (size_t)T_ALL * DFF * 2;
constexpr size_t WS_END = (RB_END > RC_END ? (RB_END > R_HID_END ? RB_END : R_HID_END) : (RC_END > R_HID_END ? RC_END : R_HID_END));

constexpr size_t WS_MSUM = (WS_END + 255) & ~(size_t)255;
constexpr size_t WS_BAR = WS_MSUM + (size_t)HT * 1024 * 2;
constexpr size_t WS_DEC = WS_BAR + 16384;
constexpr size_t WS_TOTAL = WS_DEC + 524288;
struct Params { const float* in[21]; float* out; unsigned char* ws; };

DEV unsigned f2bf(float f) { unsigned u = __float_as_uint(f); return (u + 0x7fffu + ((u >> 16) & 1u)) >> 16; }
typedef __bf16 bf16x2_t __attribute__((ext_vector_type(2)));
DEV unsigned pk2(float lo, float hi) { const f32x2 v = {lo, hi}; const bf16x2_t r = __builtin_convertvector(v, bf16x2_t); return __builtin_bit_cast(unsigned, r); }
DEV float bf_lo(unsigned w) { return __uint_as_float(w << 16); }
DEV float bf_hi(unsigned w) { return __uint_as_float(w & 0xffff0000u); }
DEV float bf1(bf16_t h) { return __uint_as_float(((unsigned)h) << 16); }
DEV void unpack8(const u32x4 w, float (&f)[8]) {
    f[0] = bf_lo(w.x); f[1] = bf_hi(w.x); f[2] = bf_lo(w.y); f[3] = bf_hi(w.y);
    f[4] = bf_lo(w.z); f[5] = bf_hi(w.z); f[6] = bf_lo(w.w); f[7] = bf_hi(w.w);
}
DEV u32x4 pack8(const float (&f)[8]) { u32x4 w; w.x = pk2(f[0], f[1]); w.y = pk2(f[2], f[3]); w.z = pk2(f[4], f[5]); w.w = pk2(f[6], f[7]); return w; }
DEV float sigmoidf_(float x) { return __builtin_amdgcn_rcpf(1.0f + __expf(-x)); }
DEV float siluf_(float x) { return x * sigmoidf_(x); }
DEV float softplusf_(float x) { return x > 20.f ? x : (x < -15.f ? __expf(x) : __logf(1.0f + __expf(x))); }
DEV float logsigf_(float x) { const float e = __expf(-fabsf(x)); return fminf(x, 0.f) - (e < 1e-4f ? e : __logf(1.0f + e)); }
DEV float wave_sum(float v) {
#pragma unroll
    for (int o = 1; o < 64; o <<= 1) v += __shfl_xor(v, o);
    return v;
}
DEV f32x4 mma(bf16x8 x, bf16x8 y, f32x4 acc) { return __builtin_amdgcn_mfma_f32_16x16x32_bf16(x, y, acc, 0, 0, 0); }
DEV bf16x8 ldsfrag(const LAS unsigned char* p) { return *(const LAS bf16x8*)p; }
#define SCALE_A 1.f
#define SCALE_B 1.f
#define SCALE_C 1.f
#define DUP 0
#define DUP2 0
#define BAR2 0
#define GLA_NO_INTER 0
#define GLA_ZERO_DEC 0
#ifndef GEMM_BODY
#define GEMM_BODY gemm_phase
#endif
#define LDS_WAIT() asm volatile("s_waitcnt lgkmcnt(0)" ::: "memory")
#define GAS __attribute__((address_space(1)))
template <class T> DEV T* asglobal(T* p) { return (T*)(GAS T*)p; }

namespace pg8 {
constexpr int BM = 256, BK = 64, HALF = 128, HTB = HALF * BK * 2, STAGE_BYTES = 8 * HTB, NXCD = 8, WGM = 8;
DEV int lds_byte(int r, int c) { const int st = (r >> 4) * 2 + (c >> 5), rr = r & 15, cc = c & 31, ob = rr * 64 + cc * 2; return st * 1024 + (ob ^ (((ob >> 9) & 1) << 5)); }
DEV void stage_rc(int b, int& R, int& C) { const int st = b / 1024, sb = b % 1024, swz = sb ^ (((sb >> 9) & 1) << 5); R = (st >> 1) * 16 + swz / 64; C = (st & 1) * 32 + (swz % 64) / 2; }
DEV int perm32(int rho) { const int n = rho >> 4, i = rho & 15; return 8 * (i >> 2) + 4 * n + (i & 3); }

struct Job { const bf16_t* A; const bf16_t* B; void* out; const void* aux; int nM, nN, ldc, kind; };
struct Unit { const char* A; const char* B; int jid, pm, pn; };
constexpr int JT_OFF = 131072;
DEV int rfl(int v) { return __builtin_amdgcn_readfirstlane(v); }
DEV const char* rflp(const LAS int* p) { const unsigned lo = (unsigned)rfl(p[0]), hi = (unsigned)rfl(p[1]); return asglobal((const char*)(((unsigned long long)hi << 32) | lo)); }
DEV void job_put(LAS unsigned char* lds, int q, const void* A, const void* B, void* out, const void* aux, int nM, int nN, int ldc, int kind) {
    LAS int* jt = (LAS int*)(lds + JT_OFF) + q * 12;
    const unsigned long long a = (unsigned long long)A, b = (unsigned long long)B, o = (unsigned long long)out, x = (unsigned long long)aux;
    jt[0] = (int)(unsigned)a; jt[1] = (int)(unsigned)(a >> 32); jt[2] = (int)(unsigned)b; jt[3] = (int)(unsigned)(b >> 32);
    jt[4] = (int)(unsigned)o; jt[5] = (int)(unsigned)(o >> 32); jt[6] = (int)(unsigned)x; jt[7] = (int)(unsigned)(x >> 32);
    jt[8] = nM; jt[9] = nN; jt[10] = ldc; jt[11] = kind;
}
struct Sched {
    LAS unsigned char* lds; int nj, total, G, c; size_t tstep;
    DEV void init(LAS unsigned char* lds_, int nj_, int G_, int c_, int K, int tid_) {
        lds = lds_; nj = nj_; G = G_; c = c_; tstep = (size_t)BM * K * 2;
        __syncthreads();
        LAS int* jt = (LAS int*)(lds + JT_OFF);
        if (tid_ == 0) { int s = 0; for (int q = 0; q < nj; ++q) { jt[72 + q] = s; s += jt[q * 12 + 8] * jt[q * 12 + 9]; } for (int q = nj; q < 7; ++q) jt[72 + q] = s; }
        __syncthreads();
        total = rfl(jt[72 + 6]);
    }
    DEV bool next(int i, Unit& u) const {
        const int L = i * G + c; if (L >= total) return false;
        const LAS int* jt = (const LAS int*)(lds + JT_OFF);
        int jid = 0;
        for (int q = 1; q < nj; ++q) if (L >= rfl(jt[72 + q])) jid = q;
        const LAS int* J = jt + jid * 12;
        const int base = rfl(jt[72 + jid]), nM = rfl(J[8]), nN = rfl(J[9]);
        int wgid = L - base; const int nwg = nM * nN;
        { const int q = nwg / NXCD, r = nwg % NXCD, xcd = wgid % NXCD, off = wgid / NXCD; wgid = (xcd < r ? xcd * (q + 1) : r * (q + 1) + (xcd - r) * q) + off; }
        const int nig = WGM * nN, gid = wgid / nig, fm = gid * WGM, gsz = (nM - fm) < WGM ? (nM - fm) : WGM;
        u.pm = fm + ((wgid % nig) % gsz); u.pn = (wgid % nig) / gsz; u.jid = jid;
        u.A = rflp(J) + (size_t)u.pm * tstep; u.B = rflp(J + 2) + (size_t)u.pn * tstep;
        return true;
    }
};

DEV void st16_wt(GAS u32x4* p, u32x4 v) { asm volatile("global_store_dwordx4 %0, %1, off sc1" :: "v"(p), "v"(v) : "memory"); }
DEV void st16f_wt(GAS f32x4* p, f32x4 v) { asm volatile("global_store_dwordx4 %0, %1, off sc1" :: "v"(p), "v"(v) : "memory"); }
DEV unsigned cvt_pk_bf16(float lo, float hi) { return pk2(lo, hi); }

template <int KIND> DEV void epi_loop(const f32x4 (&acc)[2][2][4][2], const Job& J, const Unit& u, int wr, int wc, int fr, int fq) {
    const int row0 = u.pm * BM + wr * 64 + fr, col0 = u.pn * BM + wc * 32 + 8 * fq;
    GAS bf16_t* const outb = (GAS bf16_t*)J.out; GAS float* const outf = (GAS float*)J.out;
    const GAS float* const auxf = (const GAS float*)J.aux; GAS bf16_t* const auxb = (GAS bf16_t*)const_cast<void*>(J.aux);
#pragma unroll
    for (int ai = 0; ai < 2; ++ai)
#pragma unroll
        for (int m = 0; m < 4; ++m) {
            const size_t row = (size_t)(row0 + ai * HALF + m * 16);
#pragma unroll
            for (int bj = 0; bj < 2; ++bj) {
                const int col = col0 + bj * HALF;
                f32x4 v0 = acc[ai][bj][m][0], v1 = acc[ai][bj][m][1];
                if (KIND <= 3) {
                    if (KIND == 1) {
#pragma unroll
                        for (int e = 0; e < 4; ++e) { v0[e] = sigmoidf_(v0[e]); v1[e] = sigmoidf_(v1[e]); } }
                    if (KIND == 2) {
#pragma unroll
                        for (int e = 0; e < 4; ++e) { v0[e] = siluf_(v0[e]); v1[e] = siluf_(v1[e]); } }
                    if (KIND == 3) {
#pragma unroll
                        for (int e = 0; e < 4; ++e) { float a = fmaxf(v0[e], 0.f), b = fmaxf(v1[e], 0.f); v0[e] = a * a; v1[e] = b * b; } }
                    u32x4 w; w.x = cvt_pk_bf16(v0[0], v0[1]); w.y = cvt_pk_bf16(v0[2], v0[3]); w.z = cvt_pk_bf16(v1[0], v1[1]); w.w = cvt_pk_bf16(v1[2], v1[3]);
                    *(GAS u32x4*)(outb + row * J.ldc + col) = w;
                } else if (KIND == 7) {
                    const GAS float* xin = auxf + row * DM + col; GAS float* xo = outf + row * DM + col;
                    const f32x4 a = *(const GAS f32x4*)xin, b = *(const GAS f32x4*)(xin + 4);
                    const float sc = (J.ldc == 0) ? 0.f : 1.f; *(GAS f32x4*)xo = a + v0 * sc; *(GAS f32x4*)(xo + 4) = b + v1 * sc;
                } else if (KIND == 4) {
                    const u32x4 gw = *(const GAS u32x4*)(auxb + row * DM + col); float g[8]; unpack8(gw, g);
                    f32x4 r0, r1;
#pragma unroll
                    for (int e = 0; e < 4; ++e) { r0[e] = g[e] * v0[e] * SCALE_A; r1[e] = g[4 + e] * v1[e] * SCALE_A; }
                    GAS float* mo = outf + row * DM + col; *(GAS f32x4*)mo = r0; *(GAS f32x4*)(mo + 4) = r1;
                } else if (KIND == 5) {
                    GAS bf16_t* gp = auxb + row * DM + col;
                    const u32x4 gw = *(const GAS u32x4*)gp; float g[8]; unpack8(gw, g);
#pragma unroll
                    for (int e = 0; e < 8; ++e) g[e] *= SCALE_B;
                    const GAS float* mo = outf + row * DM + col; const f32x4 m0 = *(const GAS f32x4*)mo, m1 = *(const GAS f32x4*)(mo + 4);
                    u32x4 w; w.x = cvt_pk_bf16(m0[0] + g[0] * v0[0], m0[1] + g[1] * v0[1]); w.y = cvt_pk_bf16(m0[2] + g[2] * v0[2], m0[3] + g[3] * v0[3]);
                    w.z = cvt_pk_bf16(m1[0] + g[4] * v1[0], m1[1] + g[5] * v1[1]); w.w = cvt_pk_bf16(m1[2] + g[6] * v1[2], m1[3] + g[7] * v1[3]);
                    *(GAS u32x4*)gp = w;
                } else {
                    GAS bf16_t* gp = auxb + row * DM + col;
                    const u32x4 gw = *(const GAS u32x4*)gp, aw = *(const GAS u32x4*)(outb + row * DM + col);
                    float g[8], a[8]; unpack8(gw, g); unpack8(aw, a);
#pragma unroll
                    for (int e = 0; e < 8; ++e) g[e] *= SCALE_C;
                    u32x4 w; w.x = cvt_pk_bf16(a[0] + g[0] * v0[0], a[1] + g[1] * v0[1]); w.y = cvt_pk_bf16(a[2] + g[2] * v0[2], a[3] + g[3] * v0[3]);
                    w.z = cvt_pk_bf16(a[4] + g[4] * v1[0], a[5] + g[5] * v1[1]); w.w = cvt_pk_bf16(a[6] + g[6] * v1[2], a[7] + g[7] * v1[3]);
                    *(GAS u32x4*)gp = w;
                }
            }
        }
}

template <int MASK> DEV void run_epi(const Sched& S, const Unit& u, const f32x4 (&acc)[2][2][4][2], int wr, int wc, int fr, int fq) {
    const LAS int* Jp = (const LAS int*)(S.lds + JT_OFF) + u.jid * 12;
    Job J; J.A = nullptr; J.B = nullptr; J.out = (void*)rflp(Jp + 4); J.aux = (const void*)rflp(Jp + 6); J.nM = 0; J.nN = 0; J.ldc = rfl(Jp[10]); J.kind = rfl(Jp[11]);
    const int k = J.kind;
    if ((MASK & 1) && k == 0) epi_loop<0>(acc, J, u, wr, wc, fr, fq);
    else if ((MASK & 2) && k == 1) epi_loop<1>(acc, J, u, wr, wc, fr, fq);
    else if ((MASK & 4) && k == 2) epi_loop<2>(acc, J, u, wr, wc, fr, fq);
    else if ((MASK & 8) && k == 3) epi_loop<3>(acc, J, u, wr, wc, fr, fq);
    else if ((MASK & 16) && k == 4) epi_loop<4>(acc, J, u, wr, wc, fr, fq);
    else if ((MASK & 32) && k == 5) epi_loop<5>(acc, J, u, wr, wc, fr, fq);
    else if ((MASK & 64) && k == 6) epi_loop<6>(acc, J, u, wr, wc, fr, fq);
    else if ((MASK & 128) && k == 7) epi_loop<7>(acc, J, u, wr, wc, fr, fq);
}

template <int MASK>
DEV void gemm_phase(LAS unsigned char* lds, const int K, const Sched& S, const int tid) {
    const int wid = __builtin_amdgcn_readfirstlane(tid >> 6), lane = tid & 63, wr = wid >> 2, wc = wid & 3, fr = lane & 15, fq = lane >> 4;
    const int nt = K / BK;
    unsigned voffA[2], voffB[2];
#pragma unroll
    for (int i = 0; i < 2; ++i) { int R, C; stage_rc(tid * 16 + i * 8192, R, C); const int Rb = (R & ~31) + perm32(R & 31);
        voffA[i] = (unsigned)(R * K + C) * 2u; voffB[i] = (unsigned)(Rb * K + C) * 2u; }
    const size_t kstep = (size_t)(BK * 2);
    const size_t hstep = (size_t)HALF * K * 2;
    const unsigned ldsw = (unsigned)wid * 1024u;
    const int aoff = lds_byte(wr * 64 + fr, fq * 8), boff = lds_byte(wc * 32 + fr, fq * 8);
#define PG8_SA(b, h) (((b) * 2 + (h)) * HTB)
#define PG8_SB(b, h) ((4 + (b) * 2 + (h)) * HTB)
#define PG8_STAGE(bufoff, gbase, voff) do { _Pragma("unroll") for (int _i = 0; _i < 2; ++_i) \
        __builtin_amdgcn_global_load_lds((const unsigned*)((const char*)(gbase) + (voff)[_i]), (LAS unsigned*)(lds + (bufoff) + ldsw + _i * 8192), 16, 0, 0); } while (0)
#define PG8_LDA(dst, b, h) do { _Pragma("unroll") for (int m = 0; m < 4; ++m) _Pragma("unroll") for (int k = 0; k < 2; ++k) dst[m][k] = *(const LAS bf16x8*)(lds + PG8_SA(b, h) + aoff + m * 2048 + k * 1024); } while (0)
#define PG8_LDB(dst, b, h) do { _Pragma("unroll") for (int n = 0; n < 2; ++n) _Pragma("unroll") for (int k = 0; k < 2; ++k) dst[n][k] = *(const LAS bf16x8*)(lds + PG8_SB(b, h) + boff + n * 2048 + k * 1024); } while (0)
#define PG8_MMA(ai, bj, At, Bt) do { __builtin_amdgcn_s_setprio(1); _Pragma("unroll") for (int m = 0; m < 4; ++m) _Pragma("unroll") for (int n = 0; n < 2; ++n) _Pragma("unroll") for (int k = 0; k < 2; ++k) \
        acc[ai][bj][m][n] = __builtin_amdgcn_mfma_f32_16x16x32_bf16(Bt[n][k], At[m][k], acc[ai][bj][m][n], 0, 0, 0); __builtin_amdgcn_s_setprio(0); } while (0)
#define PG8_WAIT_V(n) asm volatile("s_waitcnt vmcnt(" #n ")" ::: "memory")
#define PG8_WAIT_L(n) asm volatile("s_waitcnt lgkmcnt(" #n ")" ::: "memory")
#define PG8_BAR __builtin_amdgcn_s_barrier()
#define PG8_SCHED __builtin_amdgcn_sched_barrier(0)
    Unit cur, nxt; int ui = 0;
    if (!S.next(0, cur)) return;
    f32x4 acc[2][2][4][2];
#pragma unroll
    for (int a = 0; a < 2; ++a)
#pragma unroll
        for (int b = 0; b < 2; ++b)
#pragma unroll
            for (int m = 0; m < 4; ++m)
#pragma unroll
                for (int n = 0; n < 2; ++n) acc[a][b][m][n] = (f32x4){0.f, 0.f, 0.f, 0.f};
    bf16x8 At[4][2], B0[2][2], B1[2][2];
    const char* cA = cur.A; const char* cB = cur.B;
    PG8_STAGE(PG8_SB(0, 0), cB, voffB); PG8_STAGE(PG8_SA(0, 0), cA, voffA); PG8_STAGE(PG8_SB(0, 1), cB + hstep, voffB); PG8_STAGE(PG8_SA(0, 1), cA + hstep, voffA);
    if (wr == 1) PG8_BAR;
    PG8_WAIT_V(4); PG8_BAR;
    PG8_STAGE(PG8_SB(1, 0), cB + kstep, voffB); PG8_STAGE(PG8_SA(1, 0), cA + kstep, voffA); PG8_STAGE(PG8_SB(1, 1), cB + hstep + kstep, voffB);
    PG8_WAIT_V(6); PG8_BAR;
    for (;;) {
        const bool has_next = S.next(ui + 1, nxt);
        const char* nA = has_next ? nxt.A : cA; const char* nB = has_next ? nxt.B : cB;
        for (int t = 0; t < nt; t += 2) {
            const bool last = (t == nt - 2);
            const char* a1 = cA + (size_t)(t + 1) * kstep;
            const char* a2 = last ? nA : cA + (size_t)(t + 2) * kstep; const char* b2 = last ? nB : cB + (size_t)(t + 2) * kstep;
            const char* a3 = a2 + kstep; const char* b3 = b2 + kstep;
            PG8_LDB(B0, 0, 0); PG8_SCHED; PG8_LDA(At, 0, 0); PG8_STAGE(PG8_SA(1, 1), a1 + hstep, voffA);
            PG8_WAIT_L(8); PG8_BAR; PG8_WAIT_L(0); PG8_MMA(0, 0, At, B0); PG8_BAR; PG8_SCHED;
            PG8_LDB(B1, 0, 1); PG8_STAGE(PG8_SB(0, 0), b2, voffB);
            PG8_BAR; PG8_WAIT_L(0); PG8_MMA(0, 1, At, B1); PG8_BAR;
            PG8_LDA(At, 0, 1); PG8_STAGE(PG8_SA(0, 0), a2, voffA);
            PG8_BAR; PG8_WAIT_L(0); PG8_MMA(1, 0, At, B0); PG8_BAR; PG8_SCHED;
            PG8_STAGE(PG8_SB(0, 1), b2 + hstep, voffB);
            PG8_WAIT_V(6); PG8_BAR; PG8_MMA(1, 1, At, B1); PG8_BAR;
            PG8_LDB(B0, 1, 0); PG8_SCHED; PG8_LDA(At, 1, 0); PG8_STAGE(PG8_SA(0, 1), a2 + hstep, voffA);
            PG8_WAIT_L(8); PG8_BAR; PG8_WAIT_L(0); PG8_MMA(0, 0, At, B0); PG8_BAR; PG8_SCHED;
            PG8_LDB(B1, 1, 1); PG8_STAGE(PG8_SB(1, 0), b3, voffB);
            PG8_BAR; PG8_WAIT_L(0); PG8_MMA(0, 1, At, B1); PG8_BAR;
            PG8_LDA(At, 1, 1); PG8_STAGE(PG8_SA(1, 0), a3, voffA);
            PG8_BAR; PG8_WAIT_L(0); PG8_MMA(1, 0, At, B0); PG8_BAR; PG8_SCHED;
            PG8_STAGE(PG8_SB(1, 1), b3 + hstep, voffB);
            PG8_WAIT_V(6); PG8_BAR; PG8_MMA(1, 1, At, B1); PG8_BAR;
        }
        run_epi<MASK>(S, cur, acc, wr, wc, fr, fq);
        if (!has_next) break;
#pragma unroll
        for (int a = 0; a < 2; ++a)
#pragma unroll
            for (int b = 0; b < 2; ++b)
#pragma unroll
                for (int m = 0; m < 4; ++m)
#pragma unroll
                    for (int n = 0; n < 2; ++n) acc[a][b][m][n] = (f32x4){0.f, 0.f, 0.f, 0.f};
        cur = nxt; cA = nA; cB = nB; ++ui;
    }
    PG8_WAIT_V(0);
    if (wr == 0) PG8_BAR;
    PG8_BAR;
#undef PG8_SA
#undef PG8_SB
#undef PG8_STAGE
#undef PG8_LDA
#undef PG8_LDB
#undef PG8_MMA
#undef PG8_WAIT_V
#undef PG8_WAIT_L
#undef PG8_BAR
#undef PG8_SCHED
}

template <int MASK>
DEV void gemm_simple(LAS unsigned char* lds, const int K, const Sched& S, const int tid) {
    const int wid = __builtin_amdgcn_readfirstlane(tid >> 6), lane = tid & 63, wr = wid >> 2, wc = wid & 3, fr = lane & 15, fq = lane >> 4;
    const int nt = K / BK;
    unsigned voffA[2], voffB[2];
#pragma unroll
    for (int i = 0; i < 2; ++i) { int R, C; stage_rc(tid * 16 + i * 8192, R, C); const int Rb = (R & ~31) + perm32(R & 31);
        voffA[i] = (unsigned)(R * K + C) * 2u; voffB[i] = (unsigned)(Rb * K + C) * 2u; }
    const size_t kstep = (size_t)(BK * 2), hstep = (size_t)HALF * K * 2;
    const unsigned ldsl = (unsigned)wid * 1024u + (unsigned)lane * 16u;
    const int aoff = lds_byte(wr * 64 + fr, fq * 8), boff = lds_byte(wc * 32 + fr, fq * 8);
#define GS_SA(b, h) (((b) * 2 + (h)) * HTB)
#define GS_SB(b, h) ((4 + (b) * 2 + (h)) * HTB)
#define GS_LOAD(dst, pa, pb) do { _Pragma("unroll") for (int _i = 0; _i < 2; ++_i) { \
        dst[0][_i] = *(const GAS u32x4*)((const GAS char*)(pa) + voffA[_i]); dst[1][_i] = *(const GAS u32x4*)((const GAS char*)(pa) + hstep + voffA[_i]); \
        dst[2][_i] = *(const GAS u32x4*)((const GAS char*)(pb) + voffB[_i]); dst[3][_i] = *(const GAS u32x4*)((const GAS char*)(pb) + hstep + voffB[_i]); } } while (0)
#define GS_WRITE(b, src) do { _Pragma("unroll") for (int _i = 0; _i < 2; ++_i) { \
        *(LAS u32x4*)(lds + GS_SA(b, 0) + ldsl + _i * 8192) = src[0][_i]; *(LAS u32x4*)(lds + GS_SA(b, 1) + ldsl + _i * 8192) = src[1][_i]; \
        *(LAS u32x4*)(lds + GS_SB(b, 0) + ldsl + _i * 8192) = src[2][_i]; *(LAS u32x4*)(lds + GS_SB(b, 1) + ldsl + _i * 8192) = src[3][_i]; } } while (0)
    Unit cur; int ui = 0;
    while (S.next(ui, cur)) {
        f32x4 acc[2][2][4][2];
#pragma unroll
        for (int a = 0; a < 2; ++a)
#pragma unroll
            for (int b = 0; b < 2; ++b)
#pragma unroll
                for (int m = 0; m < 4; ++m)
#pragma unroll
                    for (int n = 0; n < 2; ++n) acc[a][b][m][n] = (f32x4){0.f, 0.f, 0.f, 0.f};
        const char* cA = cur.A; const char* cB = cur.B;
        u32x4 st[4][2];
        GS_LOAD(st, cA, cB);
        GS_WRITE(0, st);
        __syncthreads();
        for (int t = 0; t < nt; ++t) {
            const int b = t & 1;
            if (t + 1 < nt) GS_LOAD(st, cA + (size_t)(t + 1) * kstep, cB + (size_t)(t + 1) * kstep);
#pragma unroll
            for (int ai = 0; ai < 2; ++ai) {
                bf16x8 At[4][2];
#pragma unroll
                for (int m = 0; m < 4; ++m)
#pragma unroll
                    for (int k = 0; k < 2; ++k) At[m][k] = *(const LAS bf16x8*)(lds + (b ? GS_SA(1, 0) : GS_SA(0, 0)) + ai * HTB + aoff + m * 2048 + k * 1024);
#pragma unroll
                for (int bj = 0; bj < 2; ++bj) {
                    bf16x8 Bt[2][2];
#pragma unroll
                    for (int n = 0; n < 2; ++n)
#pragma unroll
                        for (int k = 0; k < 2; ++k) Bt[n][k] = *(const LAS bf16x8*)(lds + (b ? GS_SB(1, 0) : GS_SB(0, 0)) + bj * HTB + boff + n * 2048 + k * 1024);
#pragma unroll
                    for (int m = 0; m < 4; ++m)
#pragma unroll
                        for (int n = 0; n < 2; ++n)
#pragma unroll
                            for (int k = 0; k < 2; ++k) acc[ai][bj][m][n] = __builtin_amdgcn_mfma_f32_16x16x32_bf16(Bt[n][k], At[m][k], acc[ai][bj][m][n], 0, 0, 0);
                }
            }
            if (t + 1 < nt) { if (b) GS_WRITE(0, st); else GS_WRITE(1, st); }
            __syncthreads();
        }
        run_epi<MASK>(S, cur, acc, wr, wc, fr, fq);
        ++ui;
    }
    __syncthreads();
#undef GS_SA
#undef GS_SB
#undef GS_LOAD
#undef GS_WRITE
}
}

DEV void transpose_item(const float* W, int K, int N, bf16_t* WT, LAS float* scr, int item, int lane) {
    const int nblk = N / 32, kb = item / nblk, nb = item % nblk, k0 = 64 * kb, n0 = 32 * nb;
#pragma unroll 8
    for (int i = 0; i < 32; ++i) { const int kk = 2 * i + (lane >> 5); scr[kk * 33 + (lane & 31)] = W[(size_t)(k0 + kk) * N + n0 + (lane & 31)]; }
    LDS_WAIT();
    const int c = lane & 7;
#pragma unroll
    for (int jj = 0; jj < 4; ++jj) { const int n = (lane >> 3) + 8 * jj; const LAS float* s = scr + (8 * c) * 33 + n;
        u32x4 o; o.x = pk2(s[0 * 33], s[1 * 33]); o.y = pk2(s[2 * 33], s[3 * 33]); o.z = pk2(s[4 * 33], s[5 * 33]); o.w = pk2(s[6 * 33], s[7 * 33]);
        *(u32x4*)(WT + (size_t)(n0 + n) * K + k0 + 8 * c) = o; }
    LDS_WAIT();
}

DEV void phase_weights(unsigned char* ws, const float* w_in, const float* w_oa, const float* w_os, const float* w_og, const float* w_o, const float* w_up, const float* w_dn, LAS unsigned char* lds, int gw, int NGW, int wave, int lane) {
    LAS float* scr = (LAS float*)(lds + wave * 8704);
    constexpr int I_IN = 16 * (INW / 32), I_SQ = 16 * 32, I_UP = 16 * 128, I_DN = 64 * 32;
    constexpr int NIT = I_IN + 4 * I_SQ + I_UP + I_DN;
    for (int it = gw; it < NIT; it += NGW) {
        int r = it;
        if (r < I_IN) { transpose_item(w_in, 1024, INW, (bf16_t*)(ws + WS_WIN), scr, r, lane); continue; } r -= I_IN;
        if (r < I_SQ) { transpose_item(w_oa, 1024, 1024, (bf16_t*)(ws + WS_WOA), scr, r, lane); continue; } r -= I_SQ;
        if (r < I_SQ) { transpose_item(w_os, 1024, 1024, (bf16_t*)(ws + WS_WOS), scr, r, lane); continue; } r -= I_SQ;
        if (r < I_SQ) { transpose_item(w_og, 1024, 1024, (bf16_t*)(ws + WS_WOG), scr, r, lane); continue; } r -= I_SQ;
        if (r < I_SQ) { transpose_item(w_o, 1024, 1024, (bf16_t*)(ws + WS_WO), scr, r, lane); continue; } r -= I_SQ;
        if (r < I_UP) { transpose_item(w_up, 1024, 4096, (bf16_t*)(ws + WS_WUP), scr, r, lane); continue; } r -= I_UP;
        transpose_item(w_dn, 4096, 1024, (bf16_t*)(ws + WS_WDN), scr, r, lane);
    }
}

DEV void phase_rmsnorm_bf16(const float* x, const float* w, bf16_t* o, int nrows, int gw, int NGW, int lane) {
    for (int m = gw; m < nrows; m += NGW) {
        const f32x4* xr = (const f32x4*)(x + (size_t)m * DM) + lane;
        f32x4 v[4]; float s = 0.f;
#pragma unroll
        for (int j = 0; j < 4; ++j) { v[j] = xr[64 * j]; s += (v[j].x * v[j].x + v[j].y * v[j].y) + (v[j].z * v[j].z + v[j].w * v[j].w); }
        const float rstd = rsqrtf(wave_sum(s) * (1.f / DM) + EPS);
        u32x2* o8 = (u32x2*)(o + (size_t)m * DM) + lane;
#pragma unroll
        for (int j = 0; j < 4; ++j) { const f32x4 ww = ((const f32x4*)w)[lane + 64 * j]; u32x2 r; r.x = pk2(v[j].x * rstd * ww.x, v[j].y * rstd * ww.y); r.y = pk2(v[j].z * rstd * ww.z, v[j].w * rstd * ww.w); o8[64 * j] = r; }
    }
}
DEV void phase_rmsnorm_f32(float* x, const float* w, int nrows, int gw, int NGW, int lane) {
    for (int m = gw; m < nrows; m += NGW) {
        f32x4* xr = (f32x4*)(x + (size_t)m * DM) + lane;
        f32x4 v[4]; float s = 0.f;
#pragma unroll
        for (int j = 0; j < 4; ++j) { v[j] = xr[64 * j]; s += (v[j].x * v[j].x + v[j].y * v[j].y) + (v[j].z * v[j].z + v[j].w * v[j].w); }
        const float rstd = rsqrtf(wave_sum(s) * (1.f / DM) + EPS);
#pragma unroll
        for (int j = 0; j < 4; ++j) { const f32x4 ww = ((const f32x4*)w)[lane + 64 * j]; xr[64 * j] = v[j] * rstd * ww; }
    }
}

DEV void phase_narrow(const bf16_t* HB, const bf16_t* Wdt, const bf16_t* Wgk, float* DTGK, int gw, int NGW, int lane) {
    const int fr = lane & 15, fq = lane >> 4;
    for (int u = gw; u < HT / 16; u += NGW) {
        const int t0 = u * 16;
        f32x4 a0 = {0.f, 0.f, 0.f, 0.f}, a1 = {0.f, 0.f, 0.f, 0.f};
        const bf16_t* ap = HB + (size_t)(t0 + fr) * DM + fq * 8;
        const bf16_t* b0p = Wdt + (size_t)fr * DM + fq * 8;
        const bf16_t* b1p = Wgk + (size_t)fr * DM + fq * 8;
#pragma unroll 4
        for (int k = 0; k < DM; k += 32) {
            const bf16x8 a = *(const bf16x8*)(ap + k), b0 = *(const bf16x8*)(b0p + k), b1 = *(const bf16x8*)(b1p + k);
            a0 = mma(a, b0, a0); a1 = mma(a, b1, a1);
        }
#pragma unroll
        for (int j = 0; j < 4; ++j) { float* d = DTGK + (size_t)(t0 + 4 * fq + j) * 32; d[fr] = a0[j]; d[16 + fr] = a1[j]; }
    }
}

DEV void phase_conv_a(const bf16_t* __restrict__ UA, const float* __restrict__ cw, bf16_t* __restrict__ YIN, int gtid, int NT) {
    for (int u = gtid; u < (HT / 16) * 128; u += NT) {
        const int c0 = (u & 127) * 8, t0 = (u >> 7) * 16;
        float w0[8], w1[8], w2[8], p1[8], p2[8];
#pragma unroll
        for (int j = 0; j < 8; ++j) { w0[j] = cw[c0 + j]; w1[j] = cw[1024 + c0 + j]; w2[j] = cw[2048 + c0 + j]; p1[j] = 0.f; p2[j] = 0.f; }
        if ((t0 & (SEQ - 1)) != 0) {
            float ax[8], ac[8];
            unpack8(*(const u32x4*)(UA + (size_t)(t0 - 2) * 3072 + c0), ax); unpack8(*(const u32x4*)(UA + (size_t)(t0 - 2) * 3072 + 2048 + c0), ac);
#pragma unroll
            for (int j = 0; j < 8; ++j) p2[j] = ax[j] * ac[j];
            unpack8(*(const u32x4*)(UA + (size_t)(t0 - 1) * 3072 + c0), ax); unpack8(*(const u32x4*)(UA + (size_t)(t0 - 1) * 3072 + 2048 + c0), ac);
#pragma unroll
            for (int j = 0; j < 8; ++j) p1[j] = ax[j] * ac[j];
        }
#pragma unroll 4
        for (int i = 0; i < 16; ++i) {
            const bf16_t* rp = UA + (size_t)(t0 + i) * 3072 + c0;
            float ax[8], ab[8], ac[8], o[8];
            unpack8(*(const u32x4*)rp, ax); unpack8(*(const u32x4*)(rp + 1024), ab); unpack8(*(const u32x4*)(rp + 2048), ac);
#pragma unroll
            for (int j = 0; j < 8; ++j) { const float p0 = ax[j] * ac[j]; o[j] = ab[j] * (w0[j] * p2[j] + w1[j] * p1[j] + w2[j] * p0); p2[j] = p1[j]; p1[j] = p0; }
            *(u32x4*)(YIN + (size_t)(t0 + i) * DM + c0) = pack8(o);
        }
    }
}

DEV void phase_ssd_prep(unsigned char* ws, const float* cw, const float* cb, const float* dtb, const float* alog, int gtid, int NT, int tid, int nblk, int blk) {
    const bf16_t* __restrict__ XST = (const bf16_t*)(ws + RB_XST); bf16_t* __restrict__ XSTC = (bf16_t*)(ws + RB_XSTC);
    for (int u = gtid; u < 1024 * (HT / 8); u += NT) {
        const int tb = u & (HT / 8 - 1), c = u >> 11, t0 = tb * 8;
        float x[11], cur[8];
        unpack8(*(const u32x4*)(XST + (size_t)c * HT + t0), cur);
        if ((t0 & (SEQ - 1)) != 0) { float pv[8]; unpack8(*(const u32x4*)(XST + (size_t)c * HT + t0 - 8), pv); x[0] = pv[5]; x[1] = pv[6]; x[2] = pv[7]; }
        else { x[0] = 0.f; x[1] = 0.f; x[2] = 0.f; }
#pragma unroll
        for (int i = 0; i < 8; ++i) x[3 + i] = cur[i];
        const float w0 = cw[c], w1 = cw[2048 + c], w2 = cw[4096 + c], w3 = cw[6144 + c], b = cb[c];
        float y[8];
#pragma unroll
        for (int i = 0; i < 8; ++i) y[i] = siluf_(b + w0 * x[i] + w1 * x[i + 1] + w2 * x[i + 2] + w3 * x[i + 3]);
        *(u32x4*)(XSTC + (size_t)c * HT + t0) = pack8(y);
    }
    const bf16_t* __restrict__ BC = (const bf16_t*)(ws + RB_BC); bf16_t* __restrict__ BCC = (bf16_t*)(ws + RB_BCC); bf16_t* __restrict__ BTC = (bf16_t*)(ws + RB_BTC);
    for (int u = gtid; u < (HT / 8) * 128; u += NT) {
        const int cg8 = u & 127, c0 = cg8 * 8, t0 = (u >> 7) * 8, cc = 1024 + c0;
        float w0[8], w1[8], w2[8], w3[8], bb[8], x1[8], x2[8], x3[8];
#pragma unroll
        for (int j = 0; j < 8; ++j) { w0[j] = cw[cc + j]; w1[j] = cw[2048 + cc + j]; w2[j] = cw[4096 + cc + j]; w3[j] = cw[6144 + cc + j]; bb[j] = cb[cc + j]; x1[j] = 0.f; x2[j] = 0.f; x3[j] = 0.f; }
        if ((t0 & (SEQ - 1)) != 0) {
            unpack8(*(const u32x4*)(BC + (size_t)(t0 - 1) * DM + c0), x1); unpack8(*(const u32x4*)(BC + (size_t)(t0 - 2) * DM + c0), x2); unpack8(*(const u32x4*)(BC + (size_t)(t0 - 3) * DM + c0), x3);
        }
        unsigned tr[8][4];
#pragma unroll
        for (int i = 0; i < 8; ++i) {
            float x0[8], y[8];
            unpack8(*(const u32x4*)(BC + (size_t)(t0 + i) * DM + c0), x0);
#pragma unroll
            for (int j = 0; j < 8; ++j) { y[j] = siluf_(bb[j] + w3[j] * x0[j] + w2[j] * x1[j] + w1[j] * x2[j] + w0[j] * x3[j]); x3[j] = x2[j]; x2[j] = x1[j]; x1[j] = x0[j]; }
            *(u32x4*)(BCC + (size_t)(t0 + i) * DM + c0) = pack8(y);
#pragma unroll
            for (int j = 0; j < 8; ++j) { if (i & 1) tr[j][i >> 1] |= f2bf(y[j]) << 16; else tr[j][i >> 1] = f2bf(y[j]); }
        }
        if (cg8 < 64) {
#pragma unroll
            for (int j = 0; j < 8; ++j) *(u32x4*)(BTC + (size_t)(c0 + j) * HT + t0) = (u32x4){tr[j][0], tr[j][1], tr[j][2], tr[j][3]};
        }
    }
    const float* __restrict__ DTGK = (const float*)(ws + WS_DTGK); float* __restrict__ DT = (float*)(ws + RB_DT); float* __restrict__ AC = (float*)(ws + RB_ACUM);
    {
        const int lane_ = tid & 63, gw_ = blk * NWAVES + (tid >> 6), ngw_ = nblk * NWAVES;
        for (int ch = gw_; ch < HT / 128; ch += ngw_) {
            const size_t tA = (size_t)ch * 128 + 2 * lane_;
            float d0[16], d1[16];
#pragma unroll
            for (int q = 0; q < 4; ++q) { const f32x4 a = *(const f32x4*)(DTGK + tA * 32 + 4 * q), b = *(const f32x4*)(DTGK + (tA + 1) * 32 + 4 * q);
#pragma unroll
                for (int e = 0; e < 4; ++e) { d0[4 * q + e] = a[e]; d1[4 * q + e] = b[e]; } }
            float c0[16], c1[16];
#pragma unroll
            for (int h = 0; h < 16; ++h) {
                const float av = -__expf(alog[h]), bias = dtb[h];
                d0[h] = softplusf_(d0[h] + bias); d1[h] = softplusf_(d1[h] + bias);
                const float x0 = d0[h] * av, x1 = x0 + d1[h] * av;
                float s = x1;
#pragma unroll
                for (int off = 1; off < 64; off <<= 1) { const float y = __shfl_up(s, off); if (lane_ >= off) s += y; }
                const float pre = s - x1; c0[h] = pre + x0; c1[h] = pre + x1;
            }
#pragma unroll
            for (int q = 0; q < 4; ++q) {
                *(f32x4*)(DT + tA * 16 + 4 * q) = (f32x4){d0[4 * q], d0[4 * q + 1], d0[4 * q + 2], d0[4 * q + 3]};
                *(f32x4*)(DT + (tA + 1) * 16 + 4 * q) = (f32x4){d1[4 * q], d1[4 * q + 1], d1[4 * q + 2], d1[4 * q + 3]};
                *(f32x4*)(AC + tA * 16 + 4 * q) = (f32x4){c0[4 * q], c0[4 * q + 1], c0[4 * q + 2], c0[4 * q + 3]};
                *(f32x4*)(AC + (tA + 1) * 16 + 4 * q) = (f32x4){c1[4 * q], c1[4 * q + 1], c1[4 * q + 2], c1[4 * q + 3]};
            }
        }
    }
}

DEV void phase_ssd_states(unsigned char* ws, LAS unsigned char* lds, int tid, int wave, int lane) {
    const bf16_t* XSTC = (const bf16_t*)(ws + RB_XSTC); const bf16_t* BTC = (const bf16_t*)(ws + RB_BTC);
    const float* DT = (const float*)(ws + RB_DT); const float* AC = (const float*)(ws + RB_ACUM); bf16_t* ST = (bf16_t*)(ws + RB_ST);
    constexpr int BT_OFF = 0, XW_OFF = 34816, TAB_OFF = 34816 + 69632, RS = 272;
    LAS float* wt = (LAS float*)(lds + TAB_OFF);
    const int fr = lane & 15, fq = lane >> 4;
    for (int unit = blockIdx.x; unit < (HT / 128) * 4; unit += gridDim.x) {
        const int cidx = unit >> 2, g = unit & 3, t0 = cidx * 128;
        { const int r = tid >> 7, l = tid & 127, h = g * 4 + r;
          const float al = AC[(size_t)(t0 + 127) * 16 + h], a = AC[(size_t)(t0 + l) * 16 + h];
          wt[r * 128 + l] = DT[(size_t)(t0 + l) * 16 + h] * __expf(al - a); }
        for (int i = tid; i < 2048; i += NTHR) { const int row = i >> 4, ch = i & 15;
            *(LAS u32x4*)(lds + BT_OFF + row * RS + ch * 16) = *(const u32x4*)(BTC + (size_t)(g * 128 + row) * HT + t0 + ch * 8); }
        __syncthreads();
        for (int i = tid; i < 4096; i += NTHR) { const int row = i >> 4, ch = i & 15; float f[8];
            unpack8(*(const u32x4*)(XSTC + (size_t)(g * 256 + row) * HT + t0 + ch * 8), f);
            const LAS float* wp = wt + (row >> 6) * 128 + ch * 8;
#pragma unroll
            for (int e = 0; e < 8; ++e) f[e] *= wp[e];
            *(LAS u32x4*)(lds + XW_OFF + row * RS + ch * 16) = pack8(f); }
        __syncthreads();
        f32x4 acc[2][8];
#pragma unroll
        for (int a = 0; a < 2; ++a)
#pragma unroll
            for (int b = 0; b < 8; ++b) acc[a][b] = (f32x4){0.f, 0.f, 0.f, 0.f};
#pragma unroll
        for (int ks = 0; ks < 4; ++ks) {
            const bf16x8 y0 = ldsfrag(lds + XW_OFF + (wave * 32 + fr) * RS + ks * 64 + fq * 16), y1 = ldsfrag(lds + XW_OFF + (wave * 32 + 16 + fr) * RS + ks * 64 + fq * 16);
#pragma unroll
            for (int nt = 0; nt < 8; ++nt) { const bf16x8 x = ldsfrag(lds + BT_OFF + (nt * 16 + fr) * RS + ks * 64 + fq * 16); acc[0][nt] = mma(x, y0, acc[0][nt]); acc[1][nt] = mma(x, y1, acc[1][nt]); }
        }
#pragma unroll
        for (int yt = 0; yt < 2; ++yt) { const int pp = wave * 32 + yt * 16 + fr, h = g * 4 + (pp >> 6), p = pp & 63;
            bf16_t* d = ST + (((size_t)cidx * 16 + h) * 64 + p) * 128 + 4 * fq;
#pragma unroll
            for (int nt = 0; nt < 8; ++nt) { u32x2 w; w.x = pk2(acc[yt][nt][0], acc[yt][nt][1]); w.y = pk2(acc[yt][nt][2], acc[yt][nt][3]); *(u32x2*)(d + nt * 16) = w; } }
        __syncthreads();
    }
}

DEV void phase_ssd_scan(unsigned char* ws, int gtid, int NT) {
    unsigned* ST = (unsigned*)(ws + RB_ST); const float* AC = (const float*)(ws + RB_ACUM);
    for (int e = gtid; e < 2 * 65536; e += NT) {
        const int bl = e >> 16, rem = e & 65535, h = rem >> 12;
        f32x2 carry = {0.f, 0.f};
        for (int c0 = 0; c0 < 64; c0 += 8) {
            unsigned v[8]; float dec[8];
#pragma unroll
            for (int i = 0; i < 8; ++i) { const int cidx = bl * 64 + c0 + i; v[i] = ST[(size_t)cidx * 65536 + rem]; dec[i] = __expf(AC[((size_t)cidx * 128 + 127) * 16 + h]); }
#pragma unroll
            for (int i = 0; i < 8; ++i) { const int cidx = bl * 64 + c0 + i; ST[(size_t)cidx * 65536 + rem] = pk2(carry[0], carry[1]);
                carry[0] = carry[0] * dec[i] + bf_lo(v[i]); carry[1] = carry[1] * dec[i] + bf_hi(v[i]); }
        }
    }
}

DEV void phase_ssd_out(unsigned char* ws, const float* dsk, const float* nw, LAS unsigned char* lds, int tid, int wave, int lane) {
    const bf16_t* XSTC = (const bf16_t*)(ws + RB_XSTC); const bf16_t* BCC = (const bf16_t*)(ws + RB_BCC); const bf16_t* Z = (const bf16_t*)(ws + RB_Z);
    const float* DT = (const float*)(ws + RB_DT); const float* AC = (const float*)(ws + RB_ACUM); const bf16_t* ST = (const bf16_t*)(ws + RB_ST);
    bf16_t* YIN = (bf16_t*)(ws + WS_YIN);
    float* YT = (float*)(ws + RB_XST);
    constexpr int C_OFF = 0, B_OFF = 34816, PV_OFF = 34816, XS_OFF = 34816 + 17408, M_OFF = 69632, TAB_OFF = 104448, RS = 272;
    LAS float* tac = (LAS float*)(lds + TAB_OFF); LAS float* tdt = tac + 512;
    const int fr = lane & 15, fq = lane >> 4;
    LAS unsigned char* Mw = lds + M_OFF + wave * 4352;
    for (int unit = blockIdx.x; unit < (HT / 128) * 4; unit += gridDim.x) {
        const int cidx = unit >> 2, g = unit & 3, t0 = cidx * 128;
        for (int i = tid; i < 2048; i += NTHR) { const int row = i >> 4, ch = i & 15;
            *(LAS u32x4*)(lds + C_OFF + row * RS + ch * 16) = *(const u32x4*)(BCC + (size_t)(t0 + row) * DM + 512 + g * 128 + ch * 8);
            *(LAS u32x4*)(lds + B_OFF + row * RS + ch * 16) = *(const u32x4*)(BCC + (size_t)(t0 + row) * DM + g * 128 + ch * 8); }
        { const int r = tid >> 7, l = tid & 127, h = g * 4 + r; tac[tid] = AC[(size_t)(t0 + l) * 16 + h]; tdt[tid] = DT[(size_t)(t0 + l) * 16 + h]; }
        __syncthreads();
        f32x4 cb[8];
#pragma unroll
        for (int st = 0; st < 8; ++st) cb[st] = (f32x4){0.f, 0.f, 0.f, 0.f};
#pragma unroll
        for (int ks = 0; ks < 4; ++ks) {
            const bf16x8 y = ldsfrag(lds + C_OFF + (wave * 16 + fr) * RS + ks * 64 + fq * 16);
#pragma unroll
            for (int st = 0; st < 8; ++st) cb[st] = mma(ldsfrag(lds + B_OFF + (st * 16 + fr) * RS + ks * 64 + fq * 16), y, cb[st]);
        }
        __syncthreads();
        const int l = wave * 16 + fr;
        const size_t t = (size_t)(t0 + l);
        float ssq = 0.f;
#pragma unroll 1
        for (int r = 0; r < 4; ++r) {
            const int h = g * 4 + r;
            for (int i = tid; i < 1024; i += NTHR) { const int row = i >> 4, ch = i & 15;
                *(LAS u32x4*)(lds + PV_OFF + row * RS + ch * 16) = *(const u32x4*)(ST + (((size_t)cidx * 16 + h) * 64 + row) * 128 + ch * 8); }
            for (int i = tid; i < 1024; i += NTHR) { const int row = i >> 4, ch = i & 15;
                *(LAS u32x4*)(lds + XS_OFF + row * RS + ch * 16) = *(const u32x4*)(XSTC + (size_t)(h * 64 + row) * HT + t0 + ch * 8); }
            const float al = tac[r * 128 + l];
#pragma unroll
            for (int st = 0; st < 8; ++st) { float m[4];
#pragma unroll
                for (int j = 0; j < 4; ++j) { const int s = st * 16 + 4 * fq + j; const float d = fminf(al - tac[r * 128 + s], 0.f); m[j] = (s <= l) ? cb[st][j] * __expf(d) * tdt[r * 128 + s] : 0.f; }
                u32x2 w; w.x = pk2(m[0], m[1]); w.y = pk2(m[2], m[3]); *(LAS u32x2*)(Mw + fr * RS + (st * 16 + 4 * fq) * 2) = w; }
            __syncthreads();
            f32x4 acc[4];
#pragma unroll
            for (int pt = 0; pt < 4; ++pt) acc[pt] = (f32x4){0.f, 0.f, 0.f, 0.f};
#pragma unroll
            for (int ks = 0; ks < 4; ++ks) { const bf16x8 y = ldsfrag(lds + C_OFF + l * RS + ks * 64 + fq * 16);
#pragma unroll
                for (int pt = 0; pt < 4; ++pt) acc[pt] = mma(ldsfrag(lds + PV_OFF + (pt * 16 + fr) * RS + ks * 64 + fq * 16), y, acc[pt]); }
            const float el = __expf(al);
#pragma unroll
            for (int pt = 0; pt < 4; ++pt) acc[pt] *= el;
#pragma unroll
            for (int ks = 0; ks < 4; ++ks) { const bf16x8 y = ldsfrag(Mw + fr * RS + ks * 64 + fq * 16);
#pragma unroll
                for (int pt = 0; pt < 4; ++pt) acc[pt] = mma(ldsfrag(lds + XS_OFF + (pt * 16 + fr) * RS + ks * 64 + fq * 16), y, acc[pt]); }
            const float dh = dsk[h];
#pragma unroll
            for (int pt = 0; pt < 4; ++pt) {
#pragma unroll
                for (int j = 0; j < 4; ++j) { const bf16_t xv = *(const LAS bf16_t*)(lds + XS_OFF + (pt * 16 + 4 * fq + j) * RS + l * 2); acc[pt][j] += dh * bf1(xv); }
                const int c = g * 256 + r * 64 + pt * 16 + 4 * fq;
                const u32x2 zw = *(const u32x2*)(Z + t * DM + c);
                f32x4 v = acc[pt]; v[0] *= bf_lo(zw.x); v[1] *= bf_hi(zw.x); v[2] *= bf_lo(zw.y); v[3] *= bf_hi(zw.y);
                ssq += (v[0] * v[0] + v[1] * v[1]) + (v[2] * v[2] + v[3] * v[3]);
                *(f32x4*)(YT + t * DM + c) = v;
            }
            __syncthreads();
        }
        ssq += __shfl_xor(ssq, 16); ssq += __shfl_xor(ssq, 32);
        const float rstd = rsqrtf(ssq * (1.f / 256.f) + EPS);
#pragma unroll 4
        for (int q = 0; q < 16; ++q) { const int c = g * 256 + q * 16 + 4 * fq;
            const f32x4 w4 = *(const f32x4*)(nw + c); const f32x4 v = *(const f32x4*)(YT + t * DM + c);
            u32x2 o; o.x = pk2(v[0] * rstd * w4[0], v[1] * rstd * w4[1]); o.y = pk2(v[2] * rstd * w4[2], v[3] * rstd * w4[3]);
            *(u32x2*)(YIN + t * DM + c) = o; }
        __syncthreads();
    }
}

DEV float gla_gk(const float* DTGK, size_t t, const float (&w)[16], float b) {
    const f32x4* gl = (const f32x4*)(DTGK + t * 32 + 16);
    const f32x4 g0 = gl[0], g1 = gl[1], g2 = gl[2], g3 = gl[3];
    float z = b;
    z += g0[0] * w[0] + g0[1] * w[1] + g0[2] * w[2] + g0[3] * w[3];
    z += g1[0] * w[4] + g1[1] * w[5] + g1[2] * w[6] + g1[3] * w[7];
    z += g2[0] * w[8] + g2[1] * w[9] + g2[2] * w[10] + g2[3] * w[11];
    z += g3[0] * w[12] + g3[1] * w[13] + g3[2] * w[14] + g3[3] * w[15];
    return logsigf_(z) * (1.f / 16.f);
}
DEV void phase_gla_prep(unsigned char* ws, const float* w2, const float* bg, int gtid, int NT) {
    bf16_t* QK = (bf16_t*)(ws + RC_QK); bf16_t* __restrict__ KT = (bf16_t*)(ws + RC_KT); float* __restrict__ DEC = (float*)(ws + WS_DEC);
    const float* __restrict__ DTGK = (const float*)(ws + WS_DTGK);
    for (int e = gtid; e < (HT / 64) * 512; e += NT) {
        const int d = e & 511, ch = e >> 9, t0 = ch * 64;
        float w[16];
#pragma unroll
        for (int j = 0; j < 16; ++j) w[j] = w2[j * 512 + d];
        const float b = bg[d];
        float glast = 0.f;
#pragma unroll 4
        for (int i = 0; i < 64; ++i) glast += gla_gk(DTGK, (size_t)(t0 + i), w, b);
        float run = 0.f;
        bf16_t* kd = KT + (size_t)d * HT + t0;
#pragma unroll 1
        for (int m = 0; m < 8; ++m) {
            float qv[8], kv[8], gv[8];
#pragma unroll
            for (int ii = 0; ii < 8; ++ii) { const bf16_t* qp = QK + (size_t)(t0 + m * 8 + ii) * DM + d; qv[ii] = bf1(qp[0]); kv[ii] = bf1(qp[512]); gv[ii] = gla_gk(DTGK, (size_t)(t0 + m * 8 + ii), w, b); }
            unsigned tr[4];
#pragma unroll
            for (int ii = 0; ii < 8; ++ii) {
                run += gv[ii];
                bf16_t* qp = QK + (size_t)(t0 + m * 8 + ii) * DM + d;
                qp[0] = (bf16_t)f2bf(qv[ii] * 0.08838834764831845f * __expf(run));
                qp[512] = (bf16_t)f2bf(kv[ii] * __expf(-run));
                const unsigned ke = f2bf(kv[ii] * __expf(glast - run));
                if (ii & 1) tr[ii >> 1] |= ke << 16; else tr[ii >> 1] = ke;
            }
            *(u32x4*)(kd + 8 * m) = (u32x4){tr[0], tr[1], tr[2], tr[3]};
        }
        DEC[(size_t)ch * 512 + d] = __expf(glast);
    }
}

DEV void phase_gla_states(unsigned char* ws, LAS unsigned char* lds, int tid, int wave, int lane) {
    const bf16_t* KT = (const bf16_t*)(ws + RC_KT); const bf16_t* VT = (const bf16_t*)(ws + RC_VT); bf16_t* ST = (bf16_t*)(ws + RC_ST);
    constexpr int V_OFF = 0, K_OFF = 36864, RS = 144;
    const int fr = lane & 15, fq = lane >> 4;
    for (int unit = blockIdx.x; unit < (HT / 64) * 4; unit += gridDim.x) {
        const int cidx = unit >> 2, h = unit & 3, t0 = cidx * 64;
        for (int i = tid; i < 2048; i += NTHR) { const int row = i >> 3, ch = i & 7;
            *(LAS u32x4*)(lds + V_OFF + row * RS + ch * 16) = *(const u32x4*)(VT + (size_t)(h * 256 + row) * HT + t0 + ch * 8); }
        for (int i = tid; i < 1024; i += NTHR) { const int row = i >> 3, ch = i & 7;
            *(LAS u32x4*)(lds + K_OFF + row * RS + ch * 16) = *(const u32x4*)(KT + (size_t)(h * 128 + row) * HT + t0 + ch * 8); }
        __syncthreads();
        f32x4 acc[2][8];
#pragma unroll
        for (int a = 0; a < 2; ++a)
#pragma unroll
            for (int b = 0; b < 8; ++b) acc[a][b] = (f32x4){0.f, 0.f, 0.f, 0.f};
#pragma unroll
        for (int ks = 0; ks < 2; ++ks) {
            const bf16x8 y0 = ldsfrag(lds + V_OFF + (wave * 32 + fr) * RS + ks * 64 + fq * 16), y1 = ldsfrag(lds + V_OFF + (wave * 32 + 16 + fr) * RS + ks * 64 + fq * 16);
#pragma unroll
            for (int dt = 0; dt < 8; ++dt) { const bf16x8 x = ldsfrag(lds + K_OFF + (dt * 16 + fr) * RS + ks * 64 + fq * 16); acc[0][dt] = mma(x, y0, acc[0][dt]); acc[1][dt] = mma(x, y1, acc[1][dt]); }
        }
#pragma unroll
        for (int yt = 0; yt < 2; ++yt) { const int v = wave * 32 + yt * 16 + fr;
            bf16_t* dp = ST + (((size_t)cidx * 4 + h) * 256 + v) * 128 + 4 * fq;
#pragma unroll
            for (int dt = 0; dt < 8; ++dt) { u32x2 w; w.x = pk2(acc[yt][dt][0], acc[yt][dt][1]); w.y = pk2(acc[yt][dt][2], acc[yt][dt][3]); *(u32x2*)(dp + dt * 16) = w; } }
        __syncthreads();
    }
}

DEV void phase_gla_scan(unsigned char* ws, int gtid, int NT) {
    unsigned* ST = (unsigned*)(ws + RC_ST); const float* DEC = (const float*)(ws + WS_DEC);
    for (int e = gtid; e < 2 * 65536; e += NT) {
        const int bl = e >> 16, rem = e & 65535, h = rem >> 14, d = (rem * 2) & 127;
        f32x2 carry = {0.f, 0.f};
        for (int c0 = 0; c0 < 128; c0 += 8) {
            unsigned v[8]; f32x2 dec[8];
#pragma unroll
            for (int i = 0; i < 8; ++i) { const int cidx = bl * 128 + c0 + i; v[i] = ST[(size_t)cidx * 65536 + rem]; dec[i] = *(const f32x2*)(DEC + (size_t)cidx * 512 + h * 128 + d); }
#pragma unroll
            for (int i = 0; i < 8; ++i) { const int cidx = bl * 128 + c0 + i; ST[(size_t)cidx * 65536 + rem] = pk2(carry[0], carry[1]);
                carry[0] = carry[0] * dec[i][0] + bf_lo(v[i]); carry[1] = carry[1] * dec[i][1] + bf_hi(v[i]); }
        }
    }
}

DEV void phase_gla_out(unsigned char* ws, const float* nw, LAS unsigned char* lds, int tid, int wave, int lane) {
    const bf16_t* QK = (const bf16_t*)(ws + RC_QK); const bf16_t* VT = (const bf16_t*)(ws + RC_VT); const bf16_t* GS = (const bf16_t*)(ws + RC_GS);
    const bf16_t* ST = (const bf16_t*)(ws + RC_ST); bf16_t* YIN = (bf16_t*)(ws + WS_YIN);
    constexpr int Q_OFF = 0, K_OFF = 17408, V_OFF = 34816, P_OFF = 71680, S_OFF = 80896, RSD = 272, RST = 144;
    LAS float* ssqt = (LAS float*)(lds + S_OFF);
    const int fr = lane & 15, fq = lane >> 4, lt = wave >> 1, vh = wave & 1;
    for (int unit = blockIdx.x; unit < (HT / 64) * 4; unit += gridDim.x) {
        const int cidx = unit >> 2, h = unit & 3, t0 = cidx * 64;
        for (int i = tid; i < 1024; i += NTHR) { const int row = i >> 4, ch = i & 15;
            *(LAS u32x4*)(lds + Q_OFF + row * RSD + ch * 16) = *(const u32x4*)(QK + (size_t)(t0 + row) * DM + h * 128 + ch * 8);
            *(LAS u32x4*)(lds + K_OFF + row * RSD + ch * 16) = *(const u32x4*)(QK + (size_t)(t0 + row) * DM + 512 + h * 128 + ch * 8); }
        for (int i = tid; i < 2048; i += NTHR) { const int row = i >> 3, ch = i & 7;
            *(LAS u32x4*)(lds + V_OFF + row * RST + ch * 16) = *(const u32x4*)(VT + (size_t)(h * 256 + row) * HT + t0 + ch * 8); }
        __syncthreads();
        const int l = lt * 16 + fr;
        {
            f32x4 sc[2] = {(f32x4){0.f, 0.f, 0.f, 0.f}, (f32x4){0.f, 0.f, 0.f, 0.f}};
#pragma unroll
            for (int ks = 0; ks < 4; ++ks) { const bf16x8 y = ldsfrag(lds + Q_OFF + l * RSD + ks * 64 + fq * 16);
#pragma unroll
                for (int i = 0; i < 2; ++i) sc[i] = mma(ldsfrag(lds + K_OFF + ((2 * vh + i) * 16 + fr) * RSD + ks * 64 + fq * 16), y, sc[i]); }
#pragma unroll
            for (int i = 0; i < 2; ++i) { const int s0 = (2 * vh + i) * 16 + 4 * fq; float m[4];
#pragma unroll
                for (int j = 0; j < 4; ++j) m[j] = (s0 + j <= l) ? sc[i][j] : 0.f;
                u32x2 w; w.x = pk2(m[0], m[1]); w.y = pk2(m[2], m[3]); *(LAS u32x2*)(lds + P_OFF + l * RST + s0 * 2) = w; }
        }
        __syncthreads();
        f32x4 acc[8];
#pragma unroll
        for (int i = 0; i < 8; ++i) acc[i] = (f32x4){0.f, 0.f, 0.f, 0.f};
#pragma unroll
        for (int ks = 0; ks < 2; ++ks) { const bf16x8 y = ldsfrag(lds + P_OFF + l * RST + ks * 64 + fq * 16);
#pragma unroll
            for (int i = 0; i < 8; ++i) acc[i] = mma(ldsfrag(lds + V_OFF + ((vh * 8 + i) * 16 + fr) * RST + ks * 64 + fq * 16), y, acc[i]); }
        const bf16_t* sp = ST + (((size_t)cidx * 4 + h) * 256 + vh * 128 + fr) * 128 + fq * 8;
#pragma unroll
        for (int ks = 0; ks < (GLA_NO_INTER ? 0 : 4); ++ks) { const bf16x8 y = ldsfrag(lds + Q_OFF + l * RSD + ks * 64 + fq * 16);
#pragma unroll
            for (int i = 0; i < 8; ++i) acc[i] = mma(*(const bf16x8*)(sp + (size_t)i * 16 * 128 + ks * 32), y, acc[i]); }
        float ssq = 0.f;
#pragma unroll
        for (int i = 0; i < 8; ++i) ssq += (acc[i][0] * acc[i][0] + acc[i][1] * acc[i][1]) + (acc[i][2] * acc[i][2] + acc[i][3] * acc[i][3]);
        ssq += __shfl_xor(ssq, 16); ssq += __shfl_xor(ssq, 32);
        if (fq == 0) ssqt[l * 2 + vh] = ssq;
        __syncthreads();
        const float rstd = rsqrtf((ssqt[l * 2] + ssqt[l * 2 + 1]) * (1.f / 256.f) + EPS);
        const size_t t = (size_t)(t0 + l);
#pragma unroll
        for (int i = 0; i < 8; ++i) { const int v = (vh * 8 + i) * 16 + 4 * fq, c = h * 256 + v;
            const u32x2 gw = *(const u32x2*)(GS + t * DM + c); const f32x4 w4 = *(const f32x4*)(nw + v);
            u32x2 o; o.x = pk2(acc[i][0] * rstd * w4[0] * bf_lo(gw.x), acc[i][1] * rstd * w4[1] * bf_hi(gw.x));
            o.y = pk2(acc[i][2] * rstd * w4[2] * bf_lo(gw.y), acc[i][3] * rstd * w4[3] * bf_hi(gw.y));
            *(u32x2*)(YIN + t * DM + c) = o; }
        __syncthreads();
    }
}


#define XB_TMO      128
#define XB_XCNT(j)  (256  + 64 * (j))
#define XB_XSUB(j)  (1280 + 64 * (j))
#define XB_XGEN(j)  (2304 + 64 * (j))
#define XB_TOP      3328
#define XB_TOPGEN   3392
#define XCD_BAR_WORDS 3456
#define XB_SPIN_CAP (1u << 22)
DEV unsigned xb_ld(unsigned* p)              { return __hip_atomic_load(p, __ATOMIC_RELAXED, __HIP_MEMORY_SCOPE_AGENT); }
DEV unsigned xb_add(unsigned* p, unsigned v) { return __hip_atomic_fetch_add(p, v, __ATOMIC_RELAXED, __HIP_MEMORY_SCOPE_AGENT); }
DEV unsigned xb_xcc_id() { return (unsigned)__builtin_amdgcn_s_getreg((3 << 11) | 20) & 0xFu; }
#define XB_SPIN(cond, bar) do { unsigned _sp = 0; while (cond) { __builtin_amdgcn_s_sleep(1); \
    if ((++_sp & 255u) == 0u) { if (xb_ld(&(bar)[XB_TMO])) break; if (_sp > XB_SPIN_CAP) { atomicAdd(&(bar)[XB_TMO], 1u); break; } } } } while (0)
DEV void xcd_barrier_complete(unsigned* bar, unsigned x, unsigned Gn, unsigned& nloc, unsigned& nx) {
    unsigned sum, cnt, mine, sp = 0u;
    for (;;) {
        sum = 0u; cnt = 0u; mine = 0u;
#pragma unroll
        for (unsigned j = 0; j < 16; ++j) { const unsigned c = xb_ld(&bar[XB_XCNT(j)]); sum += c; cnt += (c > 0u) ? 1u : 0u; mine = (j == x) ? c : mine; }
        if (sum == Gn) break;
        __builtin_amdgcn_s_sleep(1);
        if ((++sp & 255u) == 0u) { if (xb_ld(&bar[XB_TMO])) break; if (sp > XB_SPIN_CAP) { atomicAdd(&bar[XB_TMO], 1u); break; } }
    }
    nloc = mine > 0u ? mine : 1u; nx = cnt > 0u ? cnt : 1u;
}
DEV void xcd_barrier(unsigned* bar, unsigned x, volatile LAS unsigned* st, int tid, unsigned Gn) {
    asm volatile("s_waitcnt vmcnt(0)" ::: "memory");
    __syncthreads();
    if (tid == 0) {
        __builtin_amdgcn_s_waitcnt(0);
        unsigned nloc = st[0], nx = st[1];
        if (nloc == 0u) { xcd_barrier_complete(bar, x, Gn, nloc, nx); st[0] = nloc; st[1] = nx; }
        const unsigned old = xb_add(&bar[XB_XSUB(x)], 1u);
        const unsigned gen = old / nloc;
        if (old + 1u == (gen + 1u) * nloc) {
            __builtin_amdgcn_fence(__ATOMIC_RELEASE, "agent");
            asm volatile("s_waitcnt vmcnt(0)" ::: "memory");
            const unsigned og = xb_add(&bar[XB_TOP], 1u);
            const unsigned tg = og / nx;
            if (og + 1u == (tg + 1u) * nx) xb_add(&bar[XB_TOPGEN], 1u);
            else XB_SPIN(xb_ld(&bar[XB_TOPGEN]) == tg, bar);
            __builtin_amdgcn_fence(__ATOMIC_ACQUIRE, "agent");
            xb_add(&bar[XB_XGEN(x)], 1u);
            asm volatile("s_waitcnt vmcnt(0)" ::: "memory");
        } else {
            XB_SPIN(xb_ld(&bar[XB_XGEN(x)]) == gen, bar);
            __builtin_amdgcn_fence(__ATOMIC_ACQUIRE, "agent");
            asm volatile("s_waitcnt vmcnt(0)" ::: "memory");
        }
    }
    __syncthreads();
}

typedef const __attribute__((address_space(4))) Params* KParams;
DEV KParams kargs() { unsigned long long kp = (unsigned long long)__builtin_amdgcn_kernarg_segment_ptr(); asm volatile("" : "+s"(kp)); return (KParams)kp; }

__global__ void __launch_bounds__(NTHR, 2) mega_fwd(Params Parg, int pc_lo, int pc_hi, int coop, int pad_) {
    extern __shared__ __attribute__((aligned(16))) unsigned char smem[];
    cg::grid_group grid = cg::this_grid();
    if (coop) grid.sync();
    volatile LAS unsigned* xst = (volatile LAS unsigned*)((LAS unsigned char*)smem + 139264 - 16);
    const unsigned xcc = xb_xcc_id();
    if (threadIdx.x == 0) { xst[0] = 0u; xst[1] = 0u; (void)xb_add((unsigned*)(asglobal(kargs()->ws) + WS_BAR) + XB_XCNT(xcc), 1u); }
    __syncthreads();
    using pg8::Sched; using pg8::job_put;
    constexpr int PER_LAYER = 1 + 34 + 3, NPC = 2 * PER_LAYER + 1;
#pragma unroll 1
    for (int pc0 = pc_lo; pc0 < pc_hi; ++pc0) {
        int pc = pc0; asm volatile("" : "+s"(pc));
        int tid = threadIdx.x; asm volatile("" : "+v"(tid));
        const int lane = tid & 63, wave = __builtin_amdgcn_readfirstlane(tid >> 6);
        unsigned ldso = 0; asm volatile("" : "+s"(ldso));
        LAS unsigned char* lds = (LAS unsigned char*)smem + ldso;
        int bxv = blockIdx.x, gdv = gridDim.x; asm volatile("" : "+s"(bxv), "+s"(gdv));
        const int layer = pc / PER_LAYER; const int r = pc - layer * PER_LAYER;
        int ph, hf = 0;
        if (pc == NPC - 1) ph = 21; else if (r == 0) ph = 0; else if (r <= 34) { hf = (r - 1) / 17; ph = (r - 1) - hf * 17 + 1; } else ph = 18 + (r - 35);
        asm volatile("" : "+s"(ph), "+s"(hf));
#define P kargs()
#define ws asglobal(kargs()->ws)
#define INP(i) asglobal(kargs()->in[i])
#define OUTP asglobal(kargs()->out)
#define G gdv
#define bx bxv
#define gw (bx * NWAVES + wave)
#define NGW (G * NWAVES)
#define gtid (bx * NTHR + tid)
#define NT (G * NTHR)
#define WIN ((bf16_t*)(ws + WS_WIN))
#define HB ((bf16_t*)(ws + WS_HB))
#define MERGED ((float*)(ws + WS_MERGED))
#define GB ((bf16_t*)(ws + WS_G))
#define YIN ((bf16_t*)(ws + WS_YIN))
#define xsrc (((layer == 0) ? INP(0) : (const float*)OUTP) + (size_t)hf * HT * DM)
#define xdst (OUTP + (size_t)hf * HT * DM)

#define PROBE11 0
#define NOMIX 0
#define NOMLP 0
#ifndef SKIPMASK

#define SKIPMASK 0u
#endif
        if ((SKIPMASK >> ph) & 1u) ph = 99;
#ifdef DELAY_PROBE
        if (bxv == 3) { const unsigned long long t0 = __builtin_amdgcn_s_memrealtime(); while (__builtin_amdgcn_s_memrealtime() - t0 < 30000ull) __builtin_amdgcn_s_sleep(64); }
#endif
        int nobar = 0;
        switch (ph) {
        case 0:
            phase_weights(ws, INP(2) + (size_t)layer * 1024 * INW, INP(4) + (size_t)layer * 1048576, INP(11) + (size_t)layer * 1048576, INP(15) + (size_t)layer * 1048576,
                          INP(16) + (size_t)layer * 1048576, INP(18) + (size_t)layer * 4194304, INP(19) + (size_t)layer * 4194304, lds, gw, NGW, wave, lane);
            break;
        case 1:
            phase_rmsnorm_bf16(xsrc, INP(1) + layer * DM, HB, HT, gw, NGW, lane);
            if (DUP2) phase_rmsnorm_bf16(xsrc, INP(1) + layer * DM, HB, HT, gw, NGW, lane);
            break;
        case 2: {
            if (tid == 0) { job_put(lds, 0, HB, WIN, ws + RA_UA, nullptr, 64, 12, 3072, 0); job_put(lds, 1, HB, WIN + (size_t)9248 * DM, GB, nullptr, 64, 4, 1024, 1); }
            Sched S; S.init(lds, 2, G, bx, DM, tid);
            pg8::GEMM_BODY<3>(lds, DM, S, tid);
            phase_narrow(HB, WIN + (size_t)6144 * DM, WIN + (size_t)9232 * DM, (float*)(ws + WS_DTGK), gw, NGW, lane);
            break; }
        case 3:
            phase_conv_a((const bf16_t*)(ws + RA_UA), INP(3) + (size_t)layer * 3 * 1024, YIN, gtid, NT);
            if (DUP2) phase_conv_a((const bf16_t*)(ws + RA_UA), INP(3) + (size_t)layer * 3 * 1024, YIN, gtid, NT);
            break;
        case 4: nobar = 1; break;
        case 5: {
            if (tid == 0) { job_put(lds, 0, YIN, ws + WS_WOA, MERGED, GB, 64, 4, 1024, 4);
                            job_put(lds, 1, HB, WIN + (size_t)3072 * DM, ws + RB_Z, nullptr, 64, 4, 1024, 2); job_put(lds, 2, WIN + (size_t)4096 * DM, HB, ws + RB_XST, nullptr, 4, 64, HT, 0);
                            job_put(lds, 3, HB, WIN + (size_t)5120 * DM, ws + RB_BC, nullptr, 64, 4, 1024, 0); job_put(lds, 4, HB, WIN + (size_t)10272 * DM, ws + WS_MSUM, nullptr, 64, 4, 1024, 1); }
            Sched S; S.init(lds, 5, G, bx, DM, tid); pg8::GEMM_BODY<23>(lds, DM, S, tid);
            break; }
        case 6:
            phase_ssd_prep(ws, INP(5) + (size_t)layer * 4 * 2048, INP(6) + (size_t)layer * 2048, INP(7) + layer * 16, INP(8) + layer * 16, gtid, NT, tid, G, bx);
            if (DUP2) phase_ssd_prep(ws, INP(5) + (size_t)layer * 4 * 2048, INP(6) + (size_t)layer * 2048, INP(7) + layer * 16, INP(8) + layer * 16, gtid, NT, tid, G, bx);
            break;
        case 7: phase_ssd_states(ws, lds, tid, wave, lane); if (DUP) { __syncthreads(); phase_ssd_states(ws, lds, tid, wave, lane); } break;
        case 8: phase_ssd_scan(ws, gtid, NT); break;
        case 9: phase_ssd_out(ws, INP(9) + layer * 16, INP(10) + layer * 1024, lds, tid, wave, lane); if (DUP) { __syncthreads(); phase_ssd_out(ws, INP(9) + layer * 16, INP(10) + layer * 1024, lds, tid, wave, lane); } break;
        case 10: nobar = 1; break;
        case 11: {
            if (tid == 0) { job_put(lds, 0, YIN, ws + WS_WOS, MERGED, ws + WS_MSUM, 64, 4, 1024, 5);
                            job_put(lds, 1, HB, WIN + (size_t)6160 * DM, ws + RC_QK, nullptr, 64, 4, 1024, 0); job_put(lds, 2, WIN + (size_t)7184 * DM, HB, ws + RC_VT, nullptr, 4, 64, HT, 0);
                            job_put(lds, 3, HB, WIN + (size_t)8208 * DM, ws + RC_GS, nullptr, 64, 4, 1024, 2); job_put(lds, 4, HB, WIN + (size_t)11296 * DM, GB, nullptr, 64, 4, 1024, 1); }
            Sched S; S.init(lds, 5, G, bx, DM, tid); pg8::GEMM_BODY<39>(lds, DM, S, tid);
            break; }
        case 12: phase_gla_prep(ws, INP(12) + (size_t)layer * 16 * 512, INP(13) + layer * 512, gtid, NT); break;
        case 13: phase_gla_states(ws, lds, tid, wave, lane); if (DUP) { __syncthreads(); phase_gla_states(ws, lds, tid, wave, lane); } break;
        case 14: phase_gla_scan(ws, gtid, NT); break;
        case 15: phase_gla_out(ws, INP(14) + layer * 256, lds, tid, wave, lane); if (DUP) { __syncthreads(); phase_gla_out(ws, INP(14) + layer * 256, lds, tid, wave, lane); } break;
        case 16: {
            if (tid == 0) job_put(lds, 0, YIN, ws + WS_WOG, ws + WS_MSUM, GB, 64, 4, 1024, 6);
            Sched S; S.init(lds, 1, G, bx, DM, tid); pg8::GEMM_BODY<64>(lds, DM, S, tid);
            break; }
        case 17: {
            if (tid == 0) job_put(lds, 0, GB, ws + WS_WO, xdst, xsrc, 64, 4, NOMIX ? 0 : 1024, 7);
            Sched S; S.init(lds, 1, G, bx, DM, tid); pg8::GEMM_BODY<128>(lds, DM, S, tid);
            break; }
        case 18:
            phase_rmsnorm_bf16(OUTP, INP(17) + layer * DM, (bf16_t*)(ws + WS_MERGED), T_ALL, gw, NGW, lane);
            break;
        case 19: {
            if (tid == 0) job_put(lds, 0, ws + WS_MERGED, ws + WS_WUP, ws + WS_R, nullptr, 128, 16, DFF, 3);
            Sched S; S.init(lds, 1, G, bx, DM, tid); pg8::GEMM_BODY<8>(lds, DM, S, tid);
            break; }
        case 20: {
            if (tid == 0) job_put(lds, 0, ws + WS_R, ws + WS_WDN, OUTP, OUTP, 128, 4, NOMLP ? 0 : 1024, 7);
            Sched S; S.init(lds, 1, G, bx, DFF, tid); pg8::GEMM_BODY<128>(lds, DFF, S, tid);
            break; }
        case 99: {
#ifdef SPIN_PROBE
            if (pc == 6 || pc == 23) { const unsigned long long t0 = __builtin_amdgcn_s_memrealtime(); while (__builtin_amdgcn_s_memrealtime() - t0 < 500000ull) __builtin_amdgcn_s_sleep(64); }
#endif
            break; }
        default:
            phase_rmsnorm_f32(OUTP, INP(20), T_ALL, gw, NGW, lane);
            break;
        }
        if (pc0 != pc_hi - 1 && !nobar) {
            xcd_barrier((unsigned*)(ws + WS_BAR), xcc, xst, tid, (unsigned)gdv);
            if (BAR2) xcd_barrier((unsigned*)(ws + WS_BAR), xcc, xst, tid, (unsigned)gdv);
        }
    }
#undef P
#undef ws
#undef INP
#undef OUTP
#undef G
#undef bx
#undef gw
#undef NGW
#undef gtid
#undef NT
#undef WIN
#undef HB
#undef MERGED
#undef GB
#undef YIN
#undef xsrc
#undef xdst
}

extern "C" void kernel_launch(void* const* d_in, const int* in_sizes, int n_in, void* d_out, int out_size, void* d_ws, size_t ws_size, hipStream_t stream) {
    static int grid = 0;
    if (grid == 0) {
        if (n_in != 21 || out_size != T_ALL * DM || ws_size < WS_TOTAL) { fprintf(stderr, "kernel_launch: unexpected shapes (n_in %d out %d ws %zu need %zu)\n", n_in, out_size, ws_size, (size_t)WS_TOTAL); grid = -1; return; }
        int dev = 0, cus = 0, per_cu = 0;
        hipGetDevice(&dev);
        hipDeviceGetAttribute(&cus, hipDeviceAttributeMultiprocessorCount, dev);
        if (hipFuncSetAttribute((const void*)mega_fwd, hipFuncAttributeMaxDynamicSharedMemorySize, LDS_BYTES) != hipSuccess) { fprintf(stderr, "kernel_launch: hipFuncSetAttribute failed\n"); }
        if (hipOccupancyMaxActiveBlocksPerMultiprocessor(&per_cu, (const void*)mega_fwd, NTHR, LDS_BYTES) != hipSuccess || per_cu < 1) { fprintf(stderr, "kernel_launch: occupancy query says %d\n", per_cu); per_cu = 1; }
        (void)hipGetLastError();
        grid = cus > 0 ? cus : 256;
    }
    if (grid < 0) return;
    if (hipMemsetAsync((char*)d_ws + WS_BAR, 0, 16384, stream) != hipSuccess) { fprintf(stderr, "kernel_launch: memset failed\n"); return; }
    Params p{};
    for (int i = 0; i < 21; ++i) p.in[i] = (const float*)d_in[i];
    p.out = (float*)d_out; p.ws = (unsigned char*)d_ws;
#ifndef N_LAUNCH_SPLIT
#define N_LAUNCH_SPLIT 0
#endif
    constexpr int NPC_H = 2 * 38 + 1;
    if (N_LAUNCH_SPLIT) {
        for (int pc = 0; pc < NPC_H; ++pc) {
            hipLaunchKernelGGL(mega_fwd, dim3(grid), dim3(NTHR), LDS_BYTES, stream, p, pc, pc + 1, 0, 0);
        }
        hipError_t e = hipPeekAtLastError();
        if (e != hipSuccess) fprintf(stderr, "launch failed: %s (grid %d)\n", hipGetErrorString(e), grid);
    } else {
        int lo = 0, hi = NPC_H, coop = 1, pad = 0;
        void* args[] = {&p, &lo, &hi, &coop, &pad};
        hipError_t e = hipLaunchCooperativeKernel((const void*)mega_fwd, dim3(grid), dim3(NTHR), args, LDS_BYTES, stream);
        if (e != hipSuccess) fprintf(stderr, "cooperative launch failed: %s (grid %d)\n", hipGetErrorString(e), grid);
    }
}
```

```cpp
#include <hip/hip_runtime.h>
#include <hip/hip_cooperative_groups.h>
#include <cstdio>
namespace cg = cooperative_groups;

#define LAS __attribute__((address_space(3)))
#define DEV __device__ __forceinline__
typedef unsigned short bf16_t;
typedef short bf16x8 __attribute__((ext_vector_type(8)));
typedef float f32x4 __attribute__((ext_vector_type(4)));
typedef float f32x2 __attribute__((ext_vector_type(2)));
typedef unsigned u32x4 __attribute__((ext_vector_type(4)));
typedef unsigned u32x2 __attribute__((ext_vector_type(2)));

constexpr int T_ALL = 32768, HT = 16384, DM = 1024, SEQ = 8192, INW = 12320, DFF = 4096;
constexpr int NTHR = 512, NWAVES = 8;
constexpr int LDS_BYTES = 136 * 1024;
constexpr float EPS = 1e-6f;

constexpr size_t WS_WIN = 1048576;
constexpr size_t WS_WOA = WS_WIN + (size_t)INW * 1024 * 2 + 1048576;
constexpr size_t WS_WOS = WS_WOA + 2097152;
constexpr size_t WS_WOG = WS_WOS + 2097152;
constexpr size_t WS_WO = WS_WOG + 2097152;
constexpr size_t WS_WUP = WS_WO + 2097152;
constexpr size_t WS_WDN = WS_WUP + 8388608;
constexpr size_t WS_HB = WS_WDN + 8388608;
constexpr size_t WS_MERGED = WS_HB + (size_t)HT * 1024 * 2;
constexpr size_t WS_G = WS_MERGED + (size_t)HT * 1024 * 4;
constexpr size_t WS_YIN = WS_G + (size_t)HT * 1024 * 2;
constexpr size_t WS_DTGK = WS_YIN + (size_t)HT * 1024 * 2;
constexpr size_t WS_R = WS_DTGK + (size_t)HT * 32 * 4;
constexpr size_t RA_UA = WS_R;
constexpr size_t RB_Z = WS_R;
constexpr size_t RB_XST = RB_Z + 33554432;
constexpr size_t RB_BC = RB_XST + 33554432;
constexpr size_t RB_XSTC = RB_BC + 33554432;
constexpr size_t RB_BCC = RB_XSTC + 33554432;
constexpr size_t RB_BTC = RB_BCC + 33554432;
constexpr size_t RB_DT = RB_BTC + 16777216;
constexpr size_t RB_ACUM = RB_DT + 1048576;
constexpr size_t RB_ST = RB_ACUM + 1048576;
constexpr size_t RB_END = RB_ST + 67108864;
constexpr size_t RC_QK = WS_R;
constexpr size_t RC_KT = RC_QK + 33554432;
constexpr size_t RC_VT = RC_KT + 16777216;
constexpr size_t RC_GS = RC_VT + 33554432;
constexpr size_t RC_DEC = RC_GS + 33554432;
constexpr size_t RC_ST = RC_DEC + 524288;
constexpr size_t RC_END = RC_ST + 134217728;
constexpr size_t R_HID_END = WS_R + (size_t)T_ALL * DFF * 2;
constexpr size_t WS_END = (RB_END > RC_END ? (RB_END > R_HID_END ? RB_END : R_HID_END) : (RC_END > R_HID_END ? RC_END : R_HID_END));

constexpr size_t WS_MSUM = (WS_END + 255) & ~(size_t)255;
constexpr size_t WS_BAR = WS_MSUM + (size_t)HT * 1024 * 2;
constexpr size_t WS_DEC = WS_BAR + 16384;
constexpr size_t WS_TOTAL = WS_DEC + 524288;
struct Params { const float* in[21]; float* out; unsigned char* ws; };

DEV unsigned f2bf(float f) { unsigned u = __float_as_uint(f); return (u + 0x7fffu + ((u >> 16) & 1u)) >> 16; }
typedef __bf16 bf16x2_t __attribute__((ext_vector_type(2)));
DEV unsigned pk2(float lo, float hi) { const f32x2 v = {lo, hi}; const bf16x2_t r = __builtin_convertvector(v, bf16x2_t); return __builtin_bit_cast(unsigned, r); }
DEV float bf_lo(unsigned w) { return __uint_as_float(w << 16); }
DEV float bf_hi(unsigned w) { return __uint_as_float(w & 0xffff0000u); }
DEV float bf1(bf16_t h) { return __uint_as_float(((unsigned)h) << 16); }
DEV void unpack8(const u32x4 w, float (&f)[8]) {
    f[0] = bf_lo(w.x); f[1] = bf_hi(w.x); f[2] = bf_lo(w.y); f[3] = bf_hi(w.y);
    f[4] = bf_lo(w.z); f[5] = bf_hi(w.z); f[6] = bf_lo(w.w); f[7] = bf_hi(w.w);
}
DEV u32x4 pack8(const float (&f)[8]) { u32x4 w; w.x = pk2(f[0], f[1]); w.y = pk2(f[2], f[3]); w.z = pk2(f[4], f[5]); w.w = pk2(f[6], f[7]); return w; }
DEV float sigmoidf_(float x) { return __builtin_amdgcn_rcpf(1.0f + __expf(-x)); }
DEV float siluf_(float x) { return x * sigmoidf_(x); }
DEV float softplusf_(float x) { return x > 20.f ? x : (x < -15.f ? __expf(x) : __logf(1.0f + __expf(x))); }
DEV float logsigf_(float x) { const float e = __expf(-fabsf(x)); return fminf(x, 0.f) - (e < 1e-4f ? e : __logf(1.0f + e)); }
DEV float wave_sum(float v) {
#pragma unroll
    for (int o = 1; o < 64; o <<= 1) v += __shfl_xor(v, o);
    return v;
}
DEV f32x4 mma(bf16x8 x, bf16x8 y, f32x4 acc) { return __builtin_amdgcn_mfma_f32_16x16x32_bf16(x, y, acc, 0, 0, 0); }
DEV bf16x8 ldsfrag(const LAS unsigned char* p) { return *(const LAS bf16x8*)p; }
#define SCALE_A 1.f
#define SCALE_B 1.f
#define SCALE_C 1.f
#define DUP 0
#define DUP2 0
#define BAR2 0
#define GLA_NO_INTER 0
#define GLA_ZERO_DEC 0
#ifndef GEMM_BODY
#define GEMM_BODY gemm_phase
#endif
#define LDS_WAIT() asm volatile("s_waitcnt lgkmcnt(0)" ::: "memory")
#define GAS __attribute__((address_space(1)))
template <class T> DEV T* asglobal(T* p) { return (T*)(GAS T*)p; }

namespace pg8 {
constexpr int BM = 256, BK = 64, HALF = 128, HTB = HALF * BK * 2, STAGE_BYTES = 8 * HTB, NXCD = 8, WGM = 8;
DEV int lds_byte(int r, int c) { const int st = (r >> 4) * 2 + (c >> 5), rr = r & 15, cc = c & 31, ob = rr * 64 + cc * 2; return st * 1024 + (ob ^ (((ob >> 9) & 1) << 5)); }
DEV void stage_rc(int b, int& R, int& C) { const int st = b / 1024, sb = b % 1024, swz = sb ^ (((sb >> 9) & 1) << 5); R = (st >> 1) * 16 + swz / 64; C = (st & 1) * 32 + (swz % 64) / 2; }
DEV int perm32(int rho) { const int n = rho >> 4, i = rho & 15; return 8 * (i >> 2) + 4 * n + (i & 3); }

struct Job { const bf16_t* A; const bf16_t* B; void* out; const void* aux; int nM, nN, ldc, kind; };
struct Unit { const char* A; const char* B; int jid, pm, pn; };
constexpr int JT_OFF = 131072;
DEV int rfl(int v) { return __builtin_amdgcn_readfirstlane(v); }
DEV const char* rflp(const LAS int* p) { const unsigned lo = (unsigned)rfl(p[0]), hi = (unsigned)rfl(p[1]); return asglobal((const char*)(((unsigned long long)hi << 32) | lo)); }
DEV void job_put(LAS unsigned char* lds, int q, const void* A, const void* B, void* out, const void* aux, int nM, int nN, int ldc, int kind) {
    LAS int* jt = (LAS int*)(lds + JT_OFF) + q * 12;
    const unsigned long long a = (unsigned long long)A, b = (unsigned long long)B, o = (unsigned long long)out, x = (unsigned long long)aux;
    jt[0] = (int)(unsigned)a; jt[1] = (int)(unsigned)(a >> 32); jt[2] = (int)(unsigned)b; jt[3] = (int)(unsigned)(b >> 32);
    jt[4] = (int)(unsigned)o; jt[5] = (int)(unsigned)(o >> 32); jt[6] = (int)(unsigned)x; jt[7] = (int)(unsigned)(x >> 32);
    jt[8] = nM; jt[9] = nN; jt[10] = ldc; jt[11] = kind;
}
struct Sched {
    LAS unsigned char* lds; int nj, total, G, c; size_t tstep;
    DEV void init(LAS unsigned char* lds_, int nj_, int G_, int c_, int K, int tid_) {
        lds = lds_; nj = nj_; G = G_; c = c_; tstep = (size_t)BM * K * 2;
        __syncthreads();
        LAS int* jt = (LAS int*)(lds + JT_OFF);
        if (tid_ == 0) { int s = 0; for (int q = 0; q < nj; ++q) { jt[72 + q] = s; s += jt[q * 12 + 8] * jt[q * 12 + 9]; } for (int q = nj; q < 7; ++q) jt[72 + q] = s; }
        __syncthreads();
        total = rfl(jt[72 + 6]);
    }
    DEV bool next(int i, Unit& u) const {
        const int L = i * G + c; if (L >= total) return false;
        const LAS int* jt = (const LAS int*)(lds + JT_OFF);
        int jid = 0;
        for (int q = 1; q < nj; ++q) if (L >= rfl(jt[72 + q])) jid = q;
        const LAS int* J = jt + jid * 12;
        const int base = rfl(jt[72 + jid]), nM = rfl(J[8]), nN = rfl(J[9]);
        int wgid = L - base; const int nwg = nM * nN;
        { const int q = nwg / NXCD, r = nwg % NXCD, xcd = wgid % NXCD, off = wgid / NXCD; wgid = (xcd < r ? xcd * (q + 1) : r * (q + 1) + (xcd - r) * q) + off; }
        const int nig = WGM * nN, gid = wgid / nig, fm = gid * WGM, gsz = (nM - fm) < WGM ? (nM - fm) : WGM;
        u.pm = fm + ((wgid % nig) % gsz); u.pn = (wgid % nig) / gsz; u.jid = jid;
        u.A = rflp(J) + (size_t)u.pm * tstep; u.B = rflp(J + 2) + (size_t)u.pn * tstep;
        return true;
    }
};

DEV void st16_wt(GAS u32x4* p, u32x4 v) { asm volatile("global_store_dwordx4 %0, %1, off sc1" :: "v"(p), "v"(v) : "memory"); }
DEV void st16f_wt(GAS f32x4* p, f32x4 v) { asm volatile("global_store_dwordx4 %0, %1, off sc1" :: "v"(p), "v"(v) : "memory"); }
DEV unsigned cvt_pk_bf16(float lo, float hi) { return pk2(lo, hi); }

template <int KIND> DEV void epi_loop(const f32x4 (&acc)[2][2][4][2], const Job& J, const Unit& u, int wr, int wc, int fr, int fq) {
    const int row0 = u.pm * BM + wr * 64 + fr, col0 = u.pn * BM + wc * 32 + 8 * fq;
    GAS bf16_t* const outb = (GAS bf16_t*)J.out; GAS float* const outf = (GAS float*)J.out;
    const GAS float* const auxf = (const GAS float*)J.aux; GAS bf16_t* const auxb = (GAS bf16_t*)const_cast<void*>(J.aux);
#pragma unroll
    for (int ai = 0; ai < 2; ++ai)
#pragma unroll
        for (int m = 0; m < 4; ++m) {
            const size_t row = (size_t)(row0 + ai * HALF + m * 16);
#pragma unroll
            for (int bj = 0; bj < 2; ++bj) {
                const int col = col0 + bj * HALF;
                f32x4 v0 = acc[ai][bj][m][0], v1 = acc[ai][bj][m][1];
                if (KIND <= 3) {
                    if (KIND == 1) {
#pragma unroll
                        for (int e = 0; e < 4; ++e) { v0[e] = sigmoidf_(v0[e]); v1[e] = sigmoidf_(v1[e]); } }
                    if (KIND == 2) {
#pragma unroll
                        for (int e = 0; e < 4; ++e) { v0[e] = siluf_(v0[e]); v1[e] = siluf_(v1[e]); } }
                    if (KIND == 3) {
#pragma unroll
                        for (int e = 0; e < 4; ++e) { float a = fmaxf(v0[e], 0.f), b = fmaxf(v1[e], 0.f); v0[e] = a * a; v1[e] = b * b; } }
                    u32x4 w; w.x = cvt_pk_bf16(v0[0], v0[1]); w.y = cvt_pk_bf16(v0[2], v0[3]); w.z = cvt_pk_bf16(v1[0], v1[1]); w.w = cvt_pk_bf16(v1[2], v1[3]);
                    *(GAS u32x4*)(outb + row * J.ldc + col) = w;
                } else if (KIND == 7) {
                    const GAS float* xin = auxf + row * DM + col; GAS float* xo = outf + row * DM + col;
                    const f32x4 a = *(const GAS f32x4*)xin, b = *(const GAS f32x4*)(xin + 4);
                    const float sc = (J.ldc == 0) ? 0.f : 1.f; *(GAS f32x4*)xo = a + v0 * sc; *(GAS f32x4*)(xo + 4) = b + v1 * sc;
                } else if (KIND == 4) {
                    const u32x4 gw = *(const GAS u32x4*)(auxb + row * DM + col); float g[8]; unpack8(gw, g);
                    f32x4 r0, r1;
#pragma unroll
                    for (int e = 0; e < 4; ++e) { r0[e] = g[e] * v0[e] * SCALE_A; r1[e] = g[4 + e] * v1[e] * SCALE_A; }
                    GAS float* mo = outf + row * DM + col; *(GAS f32x4*)mo = r0; *(GAS f32x4*)(mo + 4) = r1;
                } else if (KIND == 5) {
                    GAS bf16_t* gp = auxb + row * DM + col;
                    const u32x4 gw = *(const GAS u32x4*)gp; float g[8]; unpack8(gw, g);
#pragma unroll
                    for (int e = 0; e < 8; ++e) g[e] *= SCALE_B;
                    const GAS float* mo = outf + row * DM + col; const f32x4 m0 = *(const GAS f32x4*)mo, m1 = *(const GAS f32x4*)(mo + 4);
                    u32x4 w; w.x = cvt_pk_bf16(m0[0] + g[0] * v0[0], m0[1] + g[1] * v0[1]); w.y = cvt_pk_bf16(m0[2] + g[2] * v0[2], m0[3] + g[3] * v0[3]);
                    w.z = cvt_pk_bf16(m1[0] + g[4] * v1[0], m1[1] + g[5] * v1[1]); w.w = cvt_pk_bf16(m1[2] + g[6] * v1[2], m1[3] + g[7] * v1[3]);
                    *(GAS u32x4*)gp = w;
                } else {
                    GAS bf16_t* gp = auxb + row * DM + col;
                    const u32x4 gw = *(const GAS u32x4*)gp, aw = *(const GAS u32x4*)(outb + row * DM + col);
                    float g[8], a[8]; unpack8(gw, g); unpack8(aw, a);
#pragma unroll
                    for (int e = 0; e < 8; ++e) g[e] *= SCALE_C;
                    u32x4 w; w.x = cvt_pk_bf16(a[0] + g[0] * v0[0], a[1] + g[1] * v0[1]); w.y = cvt_pk_bf16(a[2] + g[2] * v0[2], a[3] + g[3] * v0[3]);
                    w.z = cvt_pk_bf16(a[4] + g[4] * v1[0], a[5] + g[5] * v1[1]); w.w = cvt_pk_bf16(a[6] + g[6] * v1[2], a[7] + g[7] * v1[3]);
                    *(GAS u32x4*)gp = w;
                }
            }
        }
}

template <int MASK> DEV void run_epi(const Sched& S, const Unit& u, const f32x4 (&acc)[2][2][4][2], int wr, int wc, int fr, int fq) {
    const LAS int* Jp = (const LAS int*)(S.lds + JT_OFF) + u.jid * 12;
    Job J; J.A = nullptr; J.B = nullptr; J.out = (void*)rflp(Jp + 4); J.aux = (const void*)rflp(Jp + 6); J.nM = 0; J.nN = 0; J.ldc = rfl(Jp[10]); J.kind = rfl(Jp[11]);
    const int k = J.kind;
    if ((MASK & 1) && k == 0) epi_loop<0>(acc, J, u, wr, wc, fr, fq);
    else if ((MASK & 2) && k == 1) epi_loop<1>(acc, J, u, wr, wc, fr, fq);
    else if ((MASK & 4) && k == 2) epi_loop<2>(acc, J, u, wr, wc, fr, fq);
    else if ((MASK & 8) && k == 3) epi_loop<3>(acc, J, u, wr, wc, fr, fq);
    else if ((MASK & 16) && k == 4) epi_loop<4>(acc, J, u, wr, wc, fr, fq);
    else if ((MASK & 32) && k == 5) epi_loop<5>(acc, J, u, wr, wc, fr, fq);
    else if ((MASK & 64) && k == 6) epi_loop<6>(acc, J, u, wr, wc, fr, fq);
    else if ((MASK & 128) && k == 7) epi_loop<7>(acc, J, u, wr, wc, fr, fq);
}

template <int MASK>
DEV void gemm_phase(LAS unsigned char* lds, const int K, const Sched& S, const int tid) {
    const int wid = __builtin_amdgcn_readfirstlane(tid >> 6), lane = tid & 63, wr = wid >> 2, wc = wid & 3, fr = lane & 15, fq = lane >> 4;
    const int nt = K / BK;
    unsigned voffA[2], voffB[2];
#pragma unroll
    for (int i = 0; i < 2; ++i) { int R, C; stage_rc(tid * 16 + i * 8192, R, C); const int Rb = (R & ~31) + perm32(R & 31);
        voffA[i] = (unsigned)(R * K + C) * 2u; voffB[i] = (unsigned)(Rb * K + C) * 2u; }
    const size_t kstep = (size_t)(BK * 2);
    const size_t hstep = (size_t)HALF * K * 2;
    const unsigned ldsw = (unsigned)wid * 1024u;
    const int aoff = lds_byte(wr * 64 + fr, fq * 8), boff = lds_byte(wc * 32 + fr, fq * 8);
#define PG8_SA(b, h) (((b) * 2 + (h)) * HTB)
#define PG8_SB(b, h) ((4 + (b) * 2 + (h)) * HTB)
#define PG8_STAGE(bufoff, gbase, voff) do { _Pragma("unroll") for (int _i = 0; _i < 2; ++_i) \
        __builtin_amdgcn_global_load_lds((const unsigned*)((const char*)(gbase) + (voff)[_i]), (LAS unsigned*)(lds + (bufoff) + ldsw + _i * 8192), 16, 0, 0); } while (0)
#define PG8_LDA(dst, b, h) do { _Pragma("unroll") for (int m = 0; m < 4; ++m) _Pragma("unroll") for (int k = 0; k < 2; ++k) dst[m][k] = *(const LAS bf16x8*)(lds + PG8_SA(b, h) + aoff + m * 2048 + k * 1024); } while (0)
#define PG8_LDB(dst, b, h) do { _Pragma("unroll") for (int n = 0; n < 2; ++n) _Pragma("unroll") for (int k = 0; k < 2; ++k) dst[n][k] = *(const LAS bf16x8*)(lds + PG8_SB(b, h) + boff + n * 2048 + k * 1024); } while (0)
#define PG8_MMA(ai, bj, At, Bt) do { __builtin_amdgcn_s_setprio(1); _Pragma("unroll") for (int m = 0; m < 4; ++m) _Pragma("unroll") for (int n = 0; n < 2; ++n) _Pragma("unroll") for (int k = 0; k < 2; ++k) \
        acc[ai][bj][m][n] = __builtin_amdgcn_mfma_f32_16x16x32_bf16(Bt[n][k], At[m][k], acc[ai][bj][m][n], 0, 0, 0); __builtin_amdgcn_s_setprio(0); } while (0)
#define PG8_WAIT_V(n) asm volatile("s_waitcnt vmcnt(" #n ")" ::: "memory")
#define PG8_WAIT_L(n) asm volatile("s_waitcnt lgkmcnt(" #n ")" ::: "memory")
#define PG8_BAR __builtin_amdgcn_s_barrier()
#define PG8_SCHED __builtin_amdgcn_sched_barrier(0)
    Unit cur, nxt; int ui = 0;
    if (!S.next(0, cur)) return;
    f32x4 acc[2][2][4][2];
#pragma unroll
    for (int a = 0; a < 2; ++a)
#pragma unroll
        for (int b = 0; b < 2; ++b)
#pragma unroll
            for (int m = 0; m < 4; ++m)
#pragma unroll
                for (int n = 0; n < 2; ++n) acc[a][b][m][n] = (f32x4){0.f, 0.f, 0.f, 0.f};
    bf16x8 At[4][2], B0[2][2], B1[2][2];
    const char* cA = cur.A; const char* cB = cur.B;
    PG8_STAGE(PG8_SB(0, 0), cB, voffB); PG8_STAGE(PG8_SA(0, 0), cA, voffA); PG8_STAGE(PG8_SB(0, 1), cB + hstep, voffB); PG8_STAGE(PG8_SA(0, 1), cA + hstep, voffA);
    if (wr == 1) PG8_BAR;
    PG8_WAIT_V(4); PG8_BAR;
    PG8_STAGE(PG8_SB(1, 0), cB + kstep, voffB); PG8_STAGE(PG8_SA(1, 0), cA + kstep, voffA); PG8_STAGE(PG8_SB(1, 1), cB + hstep + kstep, voffB);
    PG8_WAIT_V(6); PG8_BAR;
    for (;;) {
        const bool has_next = S.next(ui + 1, nxt);
        const char* nA = has_next ? nxt.A : cA; const char* nB = has_next ? nxt.B : cB;
        for (int t = 0; t < nt; t += 2) {
            const bool last = (t == nt - 2);
            const char* a1 = cA + (size_t)(t + 1) * kstep;
            const char* a2 = last ? nA : cA + (size_t)(t + 2) * kstep; const char* b2 = last ? nB : cB + (size_t)(t + 2) * kstep;
            const char* a3 = a2 + kstep; const char* b3 = b2 + kstep;
            PG8_LDB(B0, 0, 0); PG8_SCHED; PG8_LDA(At, 0, 0); PG8_STAGE(PG8_SA(1, 1), a1 + hstep, voffA);
            PG8_WAIT_L(8); PG8_BAR; PG8_WAIT_L(0); PG8_MMA(0, 0, At, B0); PG8_BAR; PG8_SCHED;
            PG8_LDB(B1, 0, 1); PG8_STAGE(PG8_SB(0, 0), b2, voffB);
            PG8_BAR; PG8_WAIT_L(0); PG8_MMA(0, 1, At, B1); PG8_BAR;
            PG8_LDA(At, 0, 1); PG8_STAGE(PG8_SA(0, 0), a2, voffA);
            PG8_BAR; PG8_WAIT_L(0); PG8_MMA(1, 0, At, B0); PG8_BAR; PG8_SCHED;
            PG8_STAGE(PG8_SB(0, 1), b2 + hstep, voffB);
            PG8_WAIT_V(6); PG8_BAR; PG8_MMA(1, 1, At, B1); PG8_BAR;
            PG8_LDB(B0, 1, 0); PG8_SCHED; PG8_LDA(At, 1, 0); PG8_STAGE(PG8_SA(0, 1), a2 + hstep, voffA);
            PG8_WAIT_L(8); PG8_BAR; PG8_WAIT_L(0); PG8_MMA(0, 0, At, B0); PG8_BAR; PG8_SCHED;
            PG8_LDB(B1, 1, 1); PG8_STAGE(PG8_SB(1, 0), b3, voffB);
            PG8_BAR; PG8_WAIT_L(0); PG8_MMA(0, 1, At, B1); PG8_BAR;
            PG8_LDA(At, 1, 1); PG8_STAGE(PG8_SA(1, 0), a3, voffA);
            PG8_BAR; PG8_WAIT_L(0); PG8_MMA(1, 0, At, B0); PG8_BAR; PG8_SCHED;
            PG8_STAGE(PG8_SB(1, 1), b3 + hstep, voffB);
            PG8_WAIT_V(6); PG8_BAR; PG8_MMA(1, 1, At, B1); PG8_BAR;
        }
        run_epi<MASK>(S, cur, acc, wr, wc, fr, fq);
        if (!has_next) break;
#pragma unroll
        for (int a = 0; a < 2; ++a)
#pragma unroll
            for (int b = 0; b < 2; ++b)
#pragma unroll
                for (int m = 0; m < 4; ++m)
#pragma unroll
                    for (int n = 0; n < 2; ++n) acc[a][b][m][n] = (f32x4){0.f, 0.f, 0.f, 0.f};
        cur = nxt; cA = nA; cB = nB; ++ui;
    }
    PG8_WAIT_V(0);
    if (wr == 0) PG8_BAR;
    PG8_BAR;
#undef PG8_SA
#undef PG8_SB
#undef PG8_STAGE
#undef PG8_LDA
#undef PG8_LDB
#undef PG8_MMA
#undef PG8_WAIT_V
#undef PG8_WAIT_L
#undef PG8_BAR
#undef PG8_SCHED
}

template <int MASK>
DEV void gemm_simple(LAS unsigned char* lds, const int K, const Sched& S, const int tid) {
    const int wid = __builtin_amdgcn_readfirstlane(tid >> 6), lane = tid & 63, wr = wid >> 2, wc = wid & 3, fr = lane & 15, fq = lane >> 4;
    const int nt = K / BK;
    unsigned voffA[2], voffB[2];
#pragma unroll
    for (int i = 0; i < 2; ++i) { int R, C; stage_rc(tid * 16 + i * 8192, R, C); const int Rb = (R & ~31) + perm32(R & 31);
        voffA[i] = (unsigned)(R * K + C) * 2u; voffB[i] = (unsigned)(Rb * K + C) * 2u; }
    const size_t kstep = (size_t)(BK * 2), hstep = (size_t)HALF * K * 2;
    const unsigned ldsl = (unsigned)wid * 1024u + (unsigned)lane * 16u;
    const int aoff = lds_byte(wr * 64 + fr, fq * 8), boff = lds_byte(wc * 32 + fr, fq * 8);
#define GS_SA(b, h) (((b) * 2 + (h)) * HTB)
#define GS_SB(b, h) ((4 + (b) * 2 + (h)) * HTB)
#define GS_LOAD(dst, pa, pb) do { _Pragma("unroll") for (int _i = 0; _i < 2; ++_i) { \
        dst[0][_i] = *(const GAS u32x4*)((const GAS char*)(pa) + voffA[_i]); dst[1][_i] = *(const GAS u32x4*)((const GAS char*)(pa) + hstep + voffA[_i]); \
        dst[2][_i] = *(const GAS u32x4*)((const GAS char*)(pb) + voffB[_i]); dst[3][_i] = *(const GAS u32x4*)((const GAS char*)(pb) + hstep + voffB[_i]); } } while (0)
#define GS_WRITE(b, src) do { _Pragma("unroll") for (int _i = 0; _i < 2; ++_i) { \
        *(LAS u32x4*)(lds + GS_SA(b, 0) + ldsl + _i * 8192) = src[0][_i]; *(LAS u32x4*)(lds + GS_SA(b, 1) + ldsl + _i * 8192) = src[1][_i]; \
        *(LAS u32x4*)(lds + GS_SB(b, 0) + ldsl + _i * 8192) = src[2][_i]; *(LAS u32x4*)(lds + GS_SB(b, 1) + ldsl + _i * 8192) = src[3][_i]; } } while (0)
    Unit cur; int ui = 0;
    while (S.next(ui, cur)) {
        f32x4 acc[2][2][4][2];
#pragma unroll
        for (int a = 0; a < 2; ++a)
#pragma unroll
            for (int b = 0; b < 2; ++b)
#pragma unroll
                for (int m = 0; m < 4; ++m)
#pragma unroll
                    for (int n = 0; n < 2; ++n) acc[a][b][m][n] = (f32x4){0.f, 0.f, 0.f, 0.f};
        const char* cA = cur.A; const char* cB = cur.B;
        u32x4 st[4][2];
        GS_LOAD(st, cA, cB);
        GS_WRITE(0, st);
        __syncthreads();
        for (int t = 0; t < nt; ++t) {
            const int b = t & 1;
            if (t + 1 < nt) GS_LOAD(st, cA + (size_t)(t + 1) * kstep, cB + (size_t)(t + 1) * kstep);
#pragma unroll
            for (int ai = 0; ai < 2; ++ai) {
                bf16x8 At[4][2];
#pragma unroll
                for (int m = 0; m < 4; ++m)
#pragma unroll
                    for (int k = 0; k < 2; ++k) At[m][k] = *(const LAS bf16x8*)(lds + (b ? GS_SA(1, 0) : GS_SA(0, 0)) + ai * HTB + aoff + m * 2048 + k * 1024);
#pragma unroll
                for (int bj = 0; bj < 2; ++bj) {
                    bf16x8 Bt[2][2];
#pragma unroll
                    for (int n = 0; n < 2; ++n)
#pragma unroll
                        for (int k = 0; k < 2; ++k) Bt[n][k] = *(const LAS bf16x8*)(lds + (b ? GS_SB(1, 0) : GS_SB(0, 0)) + bj * HTB + boff + n * 2048 + k * 1024);
#pragma unroll
                    for (int m = 0; m < 4; ++m)
#pragma unroll
                        for (int n = 0; n < 2; ++n)
#pragma unroll
                            for (int k = 0; k < 2; ++k) acc[ai][bj][m][n] = __builtin_amdgcn_mfma_f32_16x16x32_bf16(Bt[n][k], At[m][k], acc[ai][bj][m][n], 0, 0, 0);
                }
            }
            if (t + 1 < nt) { if (b) GS_WRITE(0, st); else GS_WRITE(1, st); }
            __syncthreads();
        }
        run_epi<MASK>(S, cur, acc, wr, wc, fr, fq);
        ++ui;
    }
    __syncthreads();
#undef GS_SA
#undef GS_SB
#undef GS_LOAD
#undef GS_WRITE
}
}

DEV void transpose_item(const float* W, int K, int N, bf16_t* WT, LAS float* scr, int item, int lane) {
    const int nblk = N / 32, kb = item / nblk, nb = item % nblk, k0 = 64 * kb, n0 = 32 * nb;
#pragma unroll 8
    for (int i = 0; i < 32; ++i) { const int kk = 2 * i + (lane >> 5); scr[kk * 33 + (lane & 31)] = W[(size_t)(k0 + kk) * N + n0 + (lane & 31)]; }
    LDS_WAIT();
    const int c = lane & 7;
#pragma unroll
    for (int jj = 0; jj < 4; ++jj) { const int n = (lane >> 3) + 8 * jj; const LAS float* s = scr + (8 * c) * 33 + n;
        u32x4 o; o.x = pk2(s[0 * 33], s[1 * 33]); o.y = pk2(s[2 * 33], s[3 * 33]); o.z = pk2(s[4 * 33], s[5 * 33]); o.w = pk2(s[6 * 33], s[7 * 33]);
        *(u32x4*)(WT + (size_t)(n0 + n) * K + k0 + 8 * c) = o; }
    LDS_WAIT();
}

DEV void phase_weights(unsigned char* ws, const float* w_in, const float* w_oa, const float* w_os, const float* w_og, const float* w_o, const float* w_up, const float* w_dn, LAS unsigned char* lds, int gw, int NGW, int wave, int lane) {
    LAS float* scr = (LAS float*)(lds + wave * 8704);
    constexpr int I_IN = 16 * (INW / 32), I_SQ = 16 * 32, I_UP = 16 * 128, I_DN = 64 * 32;
    constexpr int NIT = I_IN + 4 * I_SQ + I_UP + I_DN;
    for (int it = gw; it < NIT; it += NGW) {
        int r = it;
        if (r < I_IN) { transpose_item(w_in, 1024, INW, (bf16_t*)(ws + WS_WIN), scr, r, lane); continue; } r -= I_IN;
        if (r < I_SQ) { transpose_item(w_oa, 1024, 1024, (bf16_t*)(ws + WS_WOA), scr, r, lane); continue; } r -= I_SQ;
        if (r < I_SQ) { transpose_item(w_os, 1024, 1024, (bf16_t*)(ws + WS_WOS), scr, r, lane); continue; } r -= I_SQ;
        if (r < I_SQ) { transpose_item(w_og, 1024, 1024, (bf16_t*)(ws + WS_WOG), scr, r, lane); continue; } r -= I_SQ;
        if (r < I_SQ) { transpose_item(w_o, 1024, 1024, (bf16_t*)(ws + WS_WO), scr, r, lane); continue; } r -= I_SQ;
        if (r < I_UP) { transpose_item(w_up, 1024, 4096, (bf16_t*)(ws + WS_WUP), scr, r, lane); continue; } r -= I_UP;
        transpose_item(w_dn, 4096, 1024, (bf16_t*)(ws + WS_WDN), scr, r, lane);
    }
}

DEV void phase_rmsnorm_bf16(const float* x, const float* w, bf16_t* o, int nrows, int gw, int NGW, int lane) {
    for (int m = gw; m < nrows; m += NGW) {
        const f32x4* xr = (const f32x4*)(x + (size_t)m * DM) + lane;
        f32x4 v[4]; float s = 0.f;
#pragma unroll
        for (int j = 0; j < 4; ++j) { v[j] = xr[64 * j]; s += (v[j].x * v[j].x + v[j].y * v[j].y) + (v[j].z * v[j].z + v[j].w * v[j].w); }
        const float rstd = rsqrtf(wave_sum(s) * (1.f / DM) + EPS);
        u32x2* o8 = (u32x2*)(o + (size_t)m * DM) + lane;
#pragma unroll
        for (int j = 0; j < 4; ++j) { const f32x4 ww = ((const f32x4*)w)[lane + 64 * j]; u32x2 r; r.x = pk2(v[j].x * rstd * ww.x, v[j].y * rstd * ww.y); r.y = pk2(v[j].z * rstd * ww.z, v[j].w * rstd * ww.w); o8[64 * j] = r; }
    }
}
DEV void phase_rmsnorm_f32(float* x, const float* w, int nrows, int gw, int NGW, int lane) {
    for (int m = gw; m < nrows; m += NGW) {
        f32x4* xr = (f32x4*)(x + (size_t)m * DM) + lane;
        f32x4 v[4]; float s = 0.f;
#pragma unroll
        for (int j = 0; j < 4; ++j) { v[j] = xr[64 * j]; s += (v[j].x * v[j].x + v[j].y * v[j].y) + (v[j].z * v[j].z + v[j].w * v[j].w); }
        const float rstd = rsqrtf(wave_sum(s) * (1.f / DM) + EPS);
#pragma unroll
        for (int j = 0; j < 4; ++j) { const f32x4 ww = ((const f32x4*)w)[lane + 64 * j]; xr[64 * j] = v[j] * rstd * ww; }
    }
}

DEV void phase_narrow(const bf16_t* HB, const bf16_t* Wdt, const bf16_t* Wgk, float* DTGK, int gw, int NGW, int lane) {
    const int fr = lane & 15, fq = lane >> 4;
    for (int u = gw; u < HT / 16; u += NGW) {
        const int t0 = u * 16;
        f32x4 a0 = {0.f, 0.f, 0.f, 0.f}, a1 = {0.f, 0.f, 0.f, 0.f};
        const bf16_t* ap = HB + (size_t)(t0 + fr) * DM + fq * 8;
        const bf16_t* b0p = Wdt + (size_t)fr * DM + fq * 8;
        const bf16_t* b1p = Wgk + (size_t)fr * DM + fq * 8;
#pragma unroll 4
        for (int k = 0; k < DM; k += 32) {
            const bf16x8 a = *(const bf16x8*)(ap + k), b0 = *(const bf16x8*)(b0p + k), b1 = *(const bf16x8*)(b1p + k);
            a0 = mma(a, b0, a0); a1 = mma(a, b1, a1);
        }
#pragma unroll
        for (int j = 0; j < 4; ++j) { float* d = DTGK + (size_t)(t0 + 4 * fq + j) * 32; d[fr] = a0[j]; d[16 + fr] = a1[j]; }
    }
}

DEV void phase_conv_a(const bf16_t* __restrict__ UA, const float* __restrict__ cw, bf16_t* __restrict__ YIN, int gtid, int NT) {
    for (int u = gtid; u < (HT / 16) * 128; u += NT) {
        const int c0 = (u & 127) * 8, t0 = (u >> 7) * 16;
        float w0[8], w1[8], w2[8], p1[8], p2[8];
#pragma unroll
        for (int j = 0; j < 8; ++j) { w0[j] = cw[c0 + j]; w1[j] = cw[1024 + c0 + j]; w2[j] = cw[2048 + c0 + j]; p1[j] = 0.f; p2[j] = 0.f; }
        if ((t0 & (SEQ - 1)) != 0) {
            float ax[8], ac[8];
            unpack8(*(const u32x4*)(UA + (size_t)(t0 - 2) * 3072 + c0), ax); unpack8(*(const u32x4*)(UA + (size_t)(t0 - 2) * 3072 + 2048 + c0), ac);
#pragma unroll
            for (int j = 0; j < 8; ++j) p2[j] = ax[j] * ac[j];
            unpack8(*(const u32x4*)(UA + (size_t)(t0 - 1) * 3072 + c0), ax); unpack8(*(const u32x4*)(UA + (size_t)(t0 - 1) * 3072 + 2048 + c0), ac);
#pragma unroll
            for (int j = 0; j < 8; ++j) p1[j] = ax[j] * ac[j];
        }
#pragma unroll 4
        for (int i = 0; i < 16; ++i) {
            const bf16_t* rp = UA + (size_t)(t0 + i) * 3072 + c0;
            float ax[8], ab[8], ac[8], o[8];
            unpack8(*(const u32x4*)rp, ax); unpack8(*(const u32x4*)(rp + 1024), ab); unpack8(*(const u32x4*)(rp + 2048), ac);
#pragma unroll
            for (int j = 0; j < 8; ++j) { const float p0 = ax[j] * ac[j]; o[j] = ab[j] * (w0[j] * p2[j] + w1[j] * p1[j] + w2[j] * p0); p2[j] = p1[j]; p1[j] = p0; }
            *(u32x4*)(YIN + (size_t)(t0 + i) * DM + c0) = pack8(o);
        }
    }
}

DEV void phase_ssd_prep(unsigned char* ws, const float* cw, const float* cb, const float* dtb, const float* alog, int gtid, int NT, int tid, int nblk, int blk) {
    const bf16_t* __restrict__ XST = (const bf16_t*)(ws + RB_XST); bf16_t* __restrict__ XSTC = (bf16_t*)(ws + RB_XSTC);
    for (int u = gtid; u < 1024 * (HT / 8); u += NT) {
        const int tb = u & (HT / 8 - 1), c = u >> 11, t0 = tb * 8;
        float x[11], cur[8];
        unpack8(*(const u32x4*)(XST + (size_t)c * HT + t0), cur);
        if ((t0 & (SEQ - 1)) != 0) { float pv[8]; unpack8(*(const u32x4*)(XST + (size_t)c * HT + t0 - 8), pv); x[0] = pv[5]; x[1] = pv[6]; x[2] = pv[7]; }
        else { x[0] = 0.f; x[1] = 0.f; x[2] = 0.f; }
#pragma unroll
        for (int i = 0; i < 8; ++i) x[3 + i] = cur[i];
        const float w0 = cw[c], w1 = cw[2048 + c], w2 = cw[4096 + c], w3 = cw[6144 + c], b = cb[c];
        float y[8];
#pragma unroll
        for (int i = 0; i < 8; ++i) y[i] = siluf_(b + w0 * x[i] + w1 * x[i + 1] + w2 * x[i + 2] + w3 * x[i + 3]);
        *(u32x4*)(XSTC + (size_t)c * HT + t0) = pack8(y);
    }
    const bf16_t* __restrict__ BC = (const bf16_t*)(ws + RB_BC); bf16_t* __restrict__ BCC = (bf16_t*)(ws + RB_BCC); bf16_t* __restrict__ BTC = (bf16_t*)(ws + RB_BTC);
    for (int u = gtid; u < (HT / 8) * 128; u += NT) {
        const int cg8 = u & 127, c0 = cg8 * 8, t0 = (u >> 7) * 8, cc = 1024 + c0;
        float w0[8], w1[8], w2[8], w3[8], bb[8], x1[8], x2[8], x3[8];
#pragma unroll
        for (int j = 0; j < 8; ++j) { w0[j] = cw[cc + j]; w1[j] = cw[2048 + cc + j]; w2[j] = cw[4096 + cc + j]; w3[j] = cw[6144 + cc + j]; bb[j] = cb[cc + j]; x1[j] = 0.f; x2[j] = 0.f; x3[j] = 0.f; }
        if ((t0 & (SEQ - 1)) != 0) {
            unpack8(*(const u32x4*)(BC + (size_t)(t0 - 1) * DM + c0), x1); unpack8(*(const u32x4*)(BC + (size_t)(t0 - 2) * DM + c0), x2); unpack8(*(const u32x4*)(BC + (size_t)(t0 - 3) * DM + c0), x3);
        }
        unsigned tr[8][4];
#pragma unroll
        for (int i = 0; i < 8; ++i) {
            float x0[8], y[8];
            unpack8(*(const u32x4*)(BC + (size_t)(t0 + i) * DM + c0), x0);
#pragma unroll
            for (int j = 0; j < 8; ++j) { y[j] = siluf_(bb[j] + w3[j] * x0[j] + w2[j] * x1[j] + w1[j] * x2[j] + w0[j] * x3[j]); x3[j] = x2[j]; x2[j] = x1[j]; x1[j] = x0[j]; }
            *(u32x4*)(BCC + (size_t)(t0 + i) * DM + c0) = pack8(y);
#pragma unroll
            for (int j = 0; j < 8; ++j) { if (i & 1) tr[j][i >> 1] |= f2bf(y[j]) << 16; else tr[j][i >> 1] = f2bf(y[j]); }
        }
        if (cg8 < 64) {
#pragma unroll
            for (int j = 0; j < 8; ++j) *(u32x4*)(BTC + (size_t)(c0 + j) * HT + t0) = (u32x4){tr[j][0], tr[j][1], tr[j][2], tr[j][3]};
        }
    }
    const float* __restrict__ DTGK = (const float*)(ws + WS_DTGK); float* __restrict__ DT = (float*)(ws + RB_DT); float* __restrict__ AC = (float*)(ws + RB_ACUM);
    {
        const int lane_ = tid & 63, gw_ = blk * NWAVES + (tid >> 6), ngw_ = nblk * NWAVES;
        for (int ch = gw_; ch < HT / 128; ch += ngw_) {
            const size_t tA = (size_t)ch * 128 + 2 * lane_;
            float d0[16], d1[16];
#pragma unroll
            for (int q = 0; q < 4; ++q) { const f32x4 a = *(const f32x4*)(DTGK + tA * 32 + 4 * q), b = *(const f32x4*)(DTGK + (tA + 1) * 32 + 4 * q);
#pragma unroll
                for (int e = 0; e < 4; ++e) { d0[4 * q + e] = a[e]; d1[4 * q + e] = b[e]; } }
            float c0[16], c1[16];
#pragma unroll
            for (int h = 0; h < 16; ++h) {
                const float av = -__expf(alog[h]), bias = dtb[h];
                d0[h] = softplusf_(d0[h] + bias); d1[h] = softplusf_(d1[h] + bias);
                const float x0 = d0[h] * av, x1 = x0 + d1[h] * av;
                float s = x1;
#pragma unroll
                for (int off = 1; off < 64; off <<= 1) { const float y = __shfl_up(s, off); if (lane_ >= off) s += y; }
                const float pre = s - x1; c0[h] = pre + x0; c1[h] = pre + x1;
            }
#pragma unroll
            for (int q = 0; q < 4; ++q) {
                *(f32x4*)(DT + tA * 16 + 4 * q) = (f32x4){d0[4 * q], d0[4 * q + 1], d0[4 * q + 2], d0[4 * q + 3]};
                *(f32x4*)(DT + (tA + 1) * 16 + 4 * q) = (f32x4){d1[4 * q], d1[4 * q + 1], d1[4 * q + 2], d1[4 * q + 3]};
                *(f32x4*)(AC + tA * 16 + 4 * q) = (f32x4){c0[4 * q], c0[4 * q + 1], c0[4 * q + 2], c0[4 * q + 3]};
                *(f32x4*)(AC + (tA + 1) * 16 + 4 * q) = (f32x4){c1[4 * q], c1[4 * q + 1], c1[4 * q + 2], c1[4 * q + 3]};
            }
        }
    }
}

DEV void phase_ssd_states(unsigned char* ws, LAS unsigned char* lds, int tid, int wave, int lane) {
    const bf16_t* XSTC = (const bf16_t*)(ws + RB_XSTC); const bf16_t* BTC = (const bf16_t*)(ws + RB_BTC);
    const float* DT = (const float*)(ws + RB_DT); const float* AC = (const float*)(ws + RB_ACUM); bf16_t* ST = (bf16_t*)(ws + RB_ST);
    constexpr int BT_OFF = 0, XW_OFF = 34816, TAB_OFF = 34816 + 69632, RS = 272;
    LAS float* wt = (LAS float*)(lds + TAB_OFF);
    const int fr = lane & 15, fq = lane >> 4;
    for (int unit = blockIdx.x; unit < (HT / 128) * 4; unit += gridDim.x) {
        const int cidx = unit >> 2, g = unit & 3, t0 = cidx * 128;
        { const int r = tid >> 7, l = tid & 127, h = g * 4 + r;
          const float al = AC[(size_t)(t0 + 127) * 16 + h], a = AC[(size_t)(t0 + l) * 16 + h];
          wt[r * 128 + l] = DT[(size_t)(t0 + l) * 16 + h] * __expf(al - a); }
        for (int i = tid; i < 2048; i += NTHR) { const int row = i >> 4, ch = i & 15;
            *(LAS u32x4*)(lds + BT_OFF + row * RS + ch * 16) = *(const u32x4*)(BTC + (size_t)(g * 128 + row) * HT + t0 + ch * 8); }
        __syncthreads();
        for (int i = tid; i < 4096; i += NTHR) { const int row = i >> 4, ch = i & 15; float f[8];
            unpack8(*(const u32x4*)(XSTC + (size_t)(g * 256 + row) * HT + t0 + ch * 8), f);
            const LAS float* wp = wt + (row >> 6) * 128 + ch * 8;
#pragma unroll
            for (int e = 0; e < 8; ++e) f[e] *= wp[e];
            *(LAS u32x4*)(lds + XW_OFF + row * RS + ch * 16) = pack8(f); }
        __syncthreads();
        f32x4 acc[2][8];
#pragma unroll
        for (int a = 0; a < 2; ++a)
#pragma unroll
            for (int b = 0; b < 8; ++b) acc[a][b] = (f32x4){0.f, 0.f, 0.f, 0.f};
#pragma unroll
        for (int ks = 0; ks < 4; ++ks) {
            const bf16x8 y0 = ldsfrag(lds + XW_OFF + (wave * 32 + fr) * RS + ks * 64 + fq * 16), y1 = ldsfrag(lds + XW_OFF + (wave * 32 + 16 + fr) * RS + ks * 64 + fq * 16);
#pragma unroll
            for (int nt = 0; nt < 8; ++nt) { const bf16x8 x = ldsfrag(lds + BT_OFF + (nt * 16 + fr) * RS + ks * 64 + fq * 16); acc[0][nt] = mma(x, y0, acc[0][nt]); acc[1][nt] = mma(x, y1, acc[1][nt]); }
        }
#pragma unroll
        for (int yt = 0; yt < 2; ++yt) { const int pp = wave * 32 + yt * 16 + fr, h = g * 4 + (pp >> 6), p = pp & 63;
            bf16_t* d = ST + (((size_t)cidx * 16 + h) * 64 + p) * 128 + 4 * fq;
#pragma unroll
            for (int nt = 0; nt < 8; ++nt) { u32x2 w; w.x = pk2(acc[yt][nt][0], acc[yt][nt][1]); w.y = pk2(acc[yt][nt][2], acc[yt][nt][3]); *(u32x2*)(d + nt * 16) = w; } }
        __syncthreads();
    }
}

DEV void phase_ssd_scan(unsigned char* ws, int gtid, int NT) {
    unsigned* ST = (unsigned*)(ws + RB_ST); const float* AC = (const float*)(ws + RB_ACUM);
    for (int e = gtid; e < 2 * 65536; e += NT) {
        const int bl = e >> 16, rem = e & 65535, h = rem >> 12;
        f32x2 carry = {0.f, 0.f};
        for (int c0 = 0; c0 < 64; c0 += 8) {
            unsigned v[8]; float dec[8];
#pragma unroll
            for (int i = 0; i < 8; ++i) { const int cidx = bl * 64 + c0 + i; v[i] = ST[(size_t)cidx * 65536 + rem]; dec[i] = __expf(AC[((size_t)cidx * 128 + 127) * 16 + h]); }
#pragma unroll
            for (int i = 0; i < 8; ++i) { const int cidx = bl * 64 + c0 + i; ST[(size_t)cidx * 65536 + rem] = pk2(carry[0], carry[1]);
                carry[0] = carry[0] * dec[i] + bf_lo(v[i]); carry[1] = carry[1] * dec[i] + bf_hi(v[i]); }
        }
    }
}

DEV void phase_ssd_out(unsigned char* ws, const float* dsk, const float* nw, LAS unsigned char* lds, int tid, int wave, int lane) {
    const bf16_t* XSTC = (const bf16_t*)(ws + RB_XSTC); const bf16_t* BCC = (const bf16_t*)(ws + RB_BCC); const bf16_t* Z = (const bf16_t*)(ws + RB_Z);
    const float* DT = (const float*)(ws + RB_DT); const float* AC = (const float*)(ws + RB_ACUM); const bf16_t* ST = (const bf16_t*)(ws + RB_ST);
    bf16_t* YIN = (bf16_t*)(ws + WS_YIN);
    float* YT = (float*)(ws + RB_XST);
    constexpr int C_OFF = 0, B_OFF = 34816, PV_OFF = 34816, XS_OFF = 34816 + 17408, M_OFF = 69632, TAB_OFF = 104448, RS = 272;
    LAS float* tac = (LAS float*)(lds + TAB_OFF); LAS float* tdt = tac + 512;
    const int fr = lane & 15, fq = lane >> 4;
    LAS unsigned char* Mw = lds + M_OFF + wave * 4352;
    for (int unit = blockIdx.x; unit < (HT / 128) * 4; unit += gridDim.x) {
        const int cidx = unit >> 2, g = unit & 3, t0 = cidx * 128;
        for (int i = tid; i < 2048; i += NTHR) { const int row = i >> 4, ch = i & 15;
            *(LAS u32x4*)(lds + C_OFF + row * RS + ch * 16) = *(const u32x4*)(BCC + (size_t)(t0 + row) * DM + 512 + g * 128 + ch * 8);
            *(LAS u32x4*)(lds + B_OFF + row * RS + ch * 16) = *(const u32x4*)(BCC + (size_t)(t0 + row) * DM + g * 128 + ch * 8); }
        { const int r = tid >> 7, l = tid & 127, h = g * 4 + r; tac[tid] = AC[(size_t)(t0 + l) * 16 + h]; tdt[tid] = DT[(size_t)(t0 + l) * 16 + h]; }
        __syncthreads();
        f32x4 cb[8];
#pragma unroll
        for (int st = 0; st < 8; ++st) cb[st] = (f32x4){0.f, 0.f, 0.f, 0.f};
#pragma unroll
        for (int ks = 0; ks < 4; ++ks) {
            const bf16x8 y = ldsfrag(lds + C_OFF + (wave * 16 + fr) * RS + ks * 64 + fq * 16);
#pragma unroll
            for (int st = 0; st < 8; ++st) cb[st] = mma(ldsfrag(lds + B_OFF + (st * 16 + fr) * RS + ks * 64 + fq * 16), y, cb[st]);
        }
        __syncthreads();
        const int l = wave * 16 + fr;
        const size_t t = (size_t)(t0 + l);
        float ssq = 0.f;
#pragma unroll 1
        for (int r = 0; r < 4; ++r) {
            const int h = g * 4 + r;
            for (int i = tid; i < 1024; i += NTHR) { const int row = i >> 4, ch = i & 15;
                *(LAS u32x4*)(lds + PV_OFF + row * RS + ch * 16) = *(const u32x4*)(ST + (((size_t)cidx * 16 + h) * 64 + row) * 128 + ch * 8); }
            for (int i = tid; i < 1024; i += NTHR) { const int row = i >> 4, ch = i & 15;
                *(LAS u32x4*)(lds + XS_OFF + row * RS + ch * 16) = *(const u32x4*)(XSTC + (size_t)(h * 64 + row) * HT + t0 + ch * 8); }
            const float al = tac[r * 128 + l];
#pragma unroll
            for (int st = 0; st < 8; ++st) { float m[4];
#pragma unroll
                for (int j = 0; j < 4; ++j) { const int s = st * 16 + 4 * fq + j; const float d = fminf(al - tac[r * 128 + s], 0.f); m[j] = (s <= l) ? cb[st][j] * __expf(d) * tdt[r * 128 + s] : 0.f; }
                u32x2 w; w.x = pk2(m[0], m[1]); w.y = pk2(m[2], m[3]); *(LAS u32x2*)(Mw + fr * RS + (st * 16 + 4 * fq) * 2) = w; }
            __syncthreads();
            f32x4 acc[4];
#pragma unroll
            for (int pt = 0; pt < 4; ++pt) acc[pt] = (f32x4){0.f, 0.f, 0.f, 0.f};
#pragma unroll
            for (int ks = 0; ks < 4; ++ks) { const bf16x8 y = ldsfrag(lds + C_OFF + l * RS + ks * 64 + fq * 16);
#pragma unroll
                for (int pt = 0; pt < 4; ++pt) acc[pt] = mma(ldsfrag(lds + PV_OFF + (pt * 16 + fr) * RS + ks * 64 + fq * 16), y, acc[pt]); }
            const float el = __expf(al);
#pragma unroll
            for (int pt = 0; pt < 4; ++pt) acc[pt] *= el;
#pragma unroll
            for (int ks = 0; ks < 4; ++ks) { const bf16x8 y = ldsfrag(Mw + fr * RS + ks * 64 + fq * 16);
#pragma unroll
                for (int pt = 0; pt < 4; ++pt) acc[pt] = mma(ldsfrag(lds + XS_OFF + (pt * 16 + fr) * RS + ks * 64 + fq * 16), y, acc[pt]); }
            const float dh = dsk[h];
#pragma unroll
            for (int pt = 0; pt < 4; ++pt) {
#pragma unroll
                for (int j = 0; j < 4; ++j) { const bf16_t xv = *(const LAS bf16_t*)(lds + XS_OFF + (pt * 16 + 4 * fq + j) * RS + l * 2); acc[pt][j] += dh * bf1(xv); }
                const int c = g * 256 + r * 64 + pt * 16 + 4 * fq;
                const u32x2 zw = *(const u32x2*)(Z + t * DM + c);
                f32x4 v = acc[pt]; v[0] *= bf_lo(zw.x); v[1] *= bf_hi(zw.x); v[2] *= bf_lo(zw.y); v[3] *= bf_hi(zw.y);
                ssq += (v[0] * v[0] + v[1] * v[1]) + (v[2] * v[2] + v[3] * v[3]);
                *(f32x4*)(YT + t * DM + c) = v;
            }
            __syncthreads();
        }
        ssq += __shfl_xor(ssq, 16); ssq += __shfl_xor(ssq, 32);
        const float rstd = rsqrtf(ssq * (1.f / 256.f) + EPS);
#pragma unroll 4
        for (int q = 0; q < 16; ++q) { const int c = g * 256 + q * 16 + 4 * fq;
            const f32x4 w4 = *(const f32x4*)(nw + c); const f32x4 v = *(const f32x4*)(YT + t * DM + c);
            u32x2 o; o.x = pk2(v[0] * rstd * w4[0], v[1] * rstd * w4[1]); o.y = pk2(v[2] * rstd * w4[2], v[3] * rstd * w4[3]);
            *(u32x2*)(YIN + t * DM + c) = o; }
        __syncthreads();
    }
}

DEV float gla_gk(const float* DTGK, size_t t, const float (&w)[16], float b) {
    const f32x4* gl = (const f32x4*)(DTGK + t * 32 + 16);
    const f32x4 g0 = gl[0], g1 = gl[1], g2 = gl[2], g3 = gl[3];
    float z = b;
    z += g0[0] * w[0] + g0[1] * w[1] + g0[2] * w[2] + g0[3] * w[3];
    z += g1[0] * w[4] + g1[1] * w[5] + g1[2] * w[6] + g1[3] * w[7];
    z += g2[0] * w[8] + g2[1] * w[9] + g2[2] * w[10] + g2[3] * w[11];
    z += g3[0] * w[12] + g3[1] * w[13] + g3[2] * w[14] + g3[3] * w[15];
    return logsigf_(z) * (1.f / 16.f);
}
DEV void phase_gla_prep(unsigned char* ws, const float* __restrict__ w2, const float* __restrict__ bg, int gtid, int NT) {
    bf16_t* QK = (bf16_t*)(ws + RC_QK); bf16_t* __restrict__ KT = (bf16_t*)(ws + RC_KT); float* __restrict__ DEC = (float*)(ws + WS_DEC);
    const float* __restrict__ DTGK = (const float*)(ws + WS_DTGK);
    const int lane = gtid & 63, gwv = gtid >> 6, nwv = NT >> 6;
    for (int u = gwv; u < (HT / 64) * 64; u += nwv) {
        const int cg = u & 63, ch = u >> 6, d0 = cg * 8; const size_t t = (size_t)ch * 64 + lane;
        const f32x4* gl = (const f32x4*)(DTGK + t * 32 + 16);
        const f32x4 g0 = gl[0], g1 = gl[1], g2 = gl[2], g3 = gl[3];
        const float glv[16] = {g0[0], g0[1], g0[2], g0[3], g1[0], g1[1], g1[2], g1[3], g2[0], g2[1], g2[2], g2[3], g3[0], g3[1], g3[2], g3[3]};
        bf16_t* qp = QK + t * DM + d0;
        float q[8], k[8]; unpack8(*(const u32x4*)qp, q); unpack8(*(const u32x4*)(qp + 512), k);
        float z[8];
        { const f32x4 b0 = *(const f32x4*)(bg + d0), b1 = *(const f32x4*)(bg + d0 + 4);
#pragma unroll
          for (int c = 0; c < 4; ++c) { z[c] = b0[c]; z[4 + c] = b1[c]; } }
#pragma unroll
        for (int j = 0; j < 16; ++j) { const f32x4 wa = *(const f32x4*)(w2 + j * 512 + d0), wb = *(const f32x4*)(w2 + j * 512 + d0 + 4);
#pragma unroll
            for (int c = 0; c < 4; ++c) { z[c] += glv[j] * wa[c]; z[4 + c] += glv[j] * wb[c]; } }
        float qo[8], ko[8], dec8[8];
#pragma unroll
        for (int c = 0; c < 8; ++c) {
            float s = logsigf_(z[c]) * (1.f / 16.f);
#pragma unroll
            for (int off = 1; off < 64; off <<= 1) { const float y = __shfl_up(s, off); if (lane >= off) s += y; }
            const float glast = __shfl(s, 63);
            qo[c] = q[c] * 0.08838834764831845f * __expf(s);
            ko[c] = k[c] * __expf(-s);
            KT[(size_t)(d0 + c) * HT + t] = (bf16_t)f2bf(k[c] * __expf(glast - s));
            dec8[c] = __expf(glast);
        }
        *(u32x4*)qp = pack8(qo); *(u32x4*)(qp + 512) = pack8(ko);
        if (lane == 63) { float* dp = DEC + (size_t)ch * 512 + d0; *(f32x4*)dp = (f32x4){dec8[0], dec8[1], dec8[2], dec8[3]}; *(f32x4*)(dp + 4) = (f32x4){dec8[4], dec8[5], dec8[6], dec8[7]}; }
    }
}

DEV void phase_gla_states(unsigned char* ws, LAS unsigned char* lds, int tid, int wave, int lane) {
    const bf16_t* KT = (const bf16_t*)(ws + RC_KT); const bf16_t* VT = (const bf16_t*)(ws + RC_VT); bf16_t* ST = (bf16_t*)(ws + RC_ST);
    constexpr int V_OFF = 0, K_OFF = 36864, RS = 144;
    const int fr = lane & 15, fq = lane >> 4;
    for (int unit = blockIdx.x; unit < (HT / 64) * 4; unit += gridDim.x) {
        const int cidx = unit >> 2, h = unit & 3, t0 = cidx * 64;
        for (int i = tid; i < 2048; i += NTHR) { const int row = i >> 3, ch = i & 7;
            *(LAS u32x4*)(lds + V_OFF + row * RS + ch * 16) = *(const u32x4*)(VT + (size_t)(h * 256 + row) * HT + t0 + ch * 8); }
        for (int i = tid; i < 1024; i += NTHR) { const int row = i >> 3, ch = i & 7;
            *(LAS u32x4*)(lds + K_OFF + row * RS + ch * 16) = *(const u32x4*)(KT + (size_t)(h * 128 + row) * HT + t0 + ch * 8); }
        __syncthreads();
        f32x4 acc[2][8];
#pragma unroll
        for (int a = 0; a < 2; ++a)
#pragma unroll
            for (int b = 0; b < 8; ++b) acc[a][b] = (f32x4){0.f, 0.f, 0.f, 0.f};
#pragma unroll
        for (int ks = 0; ks < 2; ++ks) {
            const bf16x8 y0 = ldsfrag(lds + V_OFF + (wave * 32 + fr) * RS + ks * 64 + fq * 16), y1 = ldsfrag(lds + V_OFF + (wave * 32 + 16 + fr) * RS + ks * 64 + fq * 16);
#pragma unroll
            for (int dt = 0; dt < 8; ++dt) { const bf16x8 x = ldsfrag(lds + K_OFF + (dt * 16 + fr) * RS + ks * 64 + fq * 16); acc[0][dt] = mma(x, y0, acc[0][dt]); acc[1][dt] = mma(x, y1, acc[1][dt]); }
        }
#pragma unroll
        for (int yt = 0; yt < 2; ++yt) { const int v = wave * 32 + yt * 16 + fr;
            bf16_t* dp = ST + (((size_t)cidx * 4 + h) * 256 + v) * 128 + 4 * fq;
#pragma unroll
            for (int dt = 0; dt < 8; ++dt) { u32x2 w; w.x = pk2(acc[yt][dt][0], acc[yt][dt][1]); w.y = pk2(acc[yt][dt][2], acc[yt][dt][3]); *(u32x2*)(dp + dt * 16) = w; } }
        __syncthreads();
    }
}

DEV void phase_gla_scan(unsigned char* ws, int gtid, int NT) {
    unsigned* ST = (unsigned*)(ws + RC_ST); const float* DEC = (const float*)(ws + WS_DEC);
    for (int e = gtid; e < 2 * 65536; e += NT) {
        const int bl = e >> 16, rem = e & 65535, h = rem >> 14, d = (rem * 2) & 127;
        f32x2 carry = {0.f, 0.f};
        for (int c0 = 0; c0 < 128; c0 += 8) {
            unsigned v[8]; f32x2 dec[8];
#pragma unroll
            for (int i = 0; i < 8; ++i) { const int cidx = bl * 128 + c0 + i; v[i] = ST[(size_t)cidx * 65536 + rem]; dec[i] = *(const f32x2*)(DEC + (size_t)cidx * 512 + h * 128 + d); }
#pragma unroll
            for (int i = 0; i < 8; ++i) { const int cidx = bl * 128 + c0 + i; ST[(size_t)cidx * 65536 + rem] = pk2(carry[0], carry[1]);
                carry[0] = carry[0] * dec[i][0] + bf_lo(v[i]); carry[1] = carry[1] * dec[i][1] + bf_hi(v[i]); }
        }
    }
}

DEV void phase_gla_out(unsigned char* ws, const float* nw, LAS unsigned char* lds, int tid, int wave, int lane) {
    const bf16_t* QK = (const bf16_t*)(ws + RC_QK); const bf16_t* VT = (const bf16_t*)(ws + RC_VT); const bf16_t* GS = (const bf16_t*)(ws + RC_GS);
    const bf16_t* ST = (const bf16_t*)(ws + RC_ST); bf16_t* YIN = (bf16_t*)(ws + WS_YIN);
    constexpr int Q_OFF = 0, K_OFF = 17408, V_OFF = 34816, P_OFF = 71680, S_OFF = 80896, RSD = 272, RST = 144;
    LAS float* ssqt = (LAS float*)(lds + S_OFF);
    const int fr = lane & 15, fq = lane >> 4, lt = wave >> 1, vh = wave & 1;
    for (int unit = blockIdx.x; unit < (HT / 64) * 4; unit += gridDim.x) {
        const int cidx = unit >> 2, h = unit & 3, t0 = cidx * 64;
        for (int i = tid; i < 1024; i += NTHR) { const int row = i >> 4, ch = i & 15;
            *(LAS u32x4*)(lds + Q_OFF + row * RSD + ch * 16) = *(const u32x4*)(QK + (size_t)(t0 + row) * DM + h * 128 + ch * 8);
            *(LAS u32x4*)(lds + K_OFF + row * RSD + ch * 16) = *(const u32x4*)(QK + (size_t)(t0 + row) * DM + 512 + h * 128 + ch * 8); }
        for (int i = tid; i < 2048; i += NTHR) { const int row = i >> 3, ch = i & 7;
            *(LAS u32x4*)(lds + V_OFF + row * RST + ch * 16) = *(const u32x4*)(VT + (size_t)(h * 256 + row) * HT + t0 + ch * 8); }
        __syncthreads();
        const int l = lt * 16 + fr;
        {
            f32x4 sc[2] = {(f32x4){0.f, 0.f, 0.f, 0.f}, (f32x4){0.f, 0.f, 0.f, 0.f}};
#pragma unroll
            for (int ks = 0; ks < 4; ++ks) { const bf16x8 y = ldsfrag(lds + Q_OFF + l * RSD + ks * 64 + fq * 16);
#pragma unroll
                for (int i = 0; i < 2; ++i) sc[i] = mma(ldsfrag(lds + K_OFF + ((2 * vh + i) * 16 + fr) * RSD + ks * 64 + fq * 16), y, sc[i]); }
#pragma unroll
            for (int i = 0; i < 2; ++i) { const int s0 = (2 * vh + i) * 16 + 4 * fq; float m[4];
#pragma unroll
                for (int j = 0; j < 4; ++j) m[j] = (s0 + j <= l) ? sc[i][j] : 0.f;
                u32x2 w; w.x = pk2(m[0], m[1]); w.y = pk2(m[2], m[3]); *(LAS u32x2*)(lds + P_OFF + l * RST + s0 * 2) = w; }
        }
        __syncthreads();
        f32x4 acc[8];
#pragma unroll
        for (int i = 0; i < 8; ++i) acc[i] = (f32x4){0.f, 0.f, 0.f, 0.f};
#pragma unroll
        for (int ks = 0; ks < 2; ++ks) { const bf16x8 y = ldsfrag(lds + P_OFF + l * RST + ks * 64 + fq * 16);
#pragma unroll
            for (int i = 0; i < 8; ++i) acc[i] = mma(ldsfrag(lds + V_OFF + ((vh * 8 + i) * 16 + fr) * RST + ks * 64 + fq * 16), y, acc[i]); }
        const bf16_t* sp = ST + (((size_t)cidx * 4 + h) * 256 + vh * 128 + fr) * 128 + fq * 8;
#pragma unroll
        for (int ks = 0; ks < (GLA_NO_INTER ? 0 : 4); ++ks) { const bf16x8 y = ldsfrag(lds + Q_OFF + l * RSD + ks * 64 + fq * 16);
#pragma unroll
            for (int i = 0; i < 8; ++i) acc[i] = mma(*(const bf16x8*)(sp + (size_t)i * 16 * 128 + ks * 32), y, acc[i]); }
        float ssq = 0.f;
#pragma unroll
        for (int i = 0; i < 8; ++i) ssq += (acc[i][0] * acc[i][0] + acc[i][1] * acc[i][1]) + (acc[i][2] * acc[i][2] + acc[i][3] * acc[i][3]);
        ssq += __shfl_xor(ssq, 16); ssq += __shfl_xor(ssq, 32);
        if (fq == 0) ssqt[l * 2 + vh] = ssq;
        __syncthreads();
        const float rstd = rsqrtf((ssqt[l * 2] + ssqt[l * 2 + 1]) * (1.f / 256.f) + EPS);
        const size_t t = (size_t)(t0 + l);
#pragma unroll
        for (int i = 0; i < 8; ++i) { const int v = (vh * 8 + i) * 16 + 4 * fq, c = h * 256 + v;
            const u32x2 gw = *(const u32x2*)(GS + t * DM + c); const f32x4 w4 = *(const f32x4*)(nw + v);
            u32x2 o; o.x = pk2(acc[i][0] * rstd * w4[0] * bf_lo(gw.x), acc[i][1] * rstd * w4[1] * bf_hi(gw.x));
            o.y = pk2(acc[i][2] * rstd * w4[2] * bf_lo(gw.y), acc[i][3] * rstd * w4[3] * bf_hi(gw.y));
            *(u32x2*)(YIN + t * DM + c) = o; }
        __syncthreads();
    }
}


#define XB_TMO      128
#define XB_XCNT(j)  (256  + 64 * (j))
#define XB_XSUB(j)  (1280 + 64 * (j))
#define XB_XGEN(j)  (2304 + 64 * (j))
#define XB_TOP      3328
#define XB_TOPGEN   3392
#define XCD_BAR_WORDS 3456
#define XB_SPIN_CAP (1u << 22)
DEV unsigned xb_ld(unsigned* p)              { return __hip_atomic_load(p, __ATOMIC_RELAXED, __HIP_MEMORY_SCOPE_AGENT); }
DEV unsigned xb_add(unsigned* p, unsigned v) { return __hip_atomic_fetch_add(p, v, __ATOMIC_RELAXED, __HIP_MEMORY_SCOPE_AGENT); }
DEV unsigned xb_xcc_id() { return (unsigned)__builtin_amdgcn_s_getreg((3 << 11) | 20) & 0xFu; }
#define XB_SPIN(cond, bar) do { unsigned _sp = 0; while (cond) { __builtin_amdgcn_s_sleep(1); \
    if ((++_sp & 255u) == 0u) { if (xb_ld(&(bar)[XB_TMO])) break; if (_sp > XB_SPIN_CAP) { atomicAdd(&(bar)[XB_TMO], 1u); break; } } } } while (0)
DEV void xcd_barrier_complete(unsigned* bar, unsigned x, unsigned Gn, unsigned& nloc, unsigned& nx) {
    unsigned sum, cnt, mine, sp = 0u;
    for (;;) {
        sum = 0u; cnt = 0u; mine = 0u;
#pragma unroll
        for (unsigned j = 0; j < 16; ++j) { const unsigned c = xb_ld(&bar[XB_XCNT(j)]); sum += c; cnt += (c > 0u) ? 1u : 0u; mine = (j == x) ? c : mine; }
        if (sum == Gn) break;
        __builtin_amdgcn_s_sleep(1);
        if ((++sp & 255u) == 0u) { if (xb_ld(&bar[XB_TMO])) break; if (sp > XB_SPIN_CAP) { atomicAdd(&bar[XB_TMO], 1u); break; } }
    }
    nloc = mine > 0u ? mine : 1u; nx = cnt > 0u ? cnt : 1u;
}
DEV void xcd_barrier(unsigned* bar, unsigned x, volatile LAS unsigned* st, int tid, unsigned Gn) {
    asm volatile("s_waitcnt vmcnt(0)" ::: "memory");
    __syncthreads();
    if (tid == 0) {
        __builtin_amdgcn_s_waitcnt(0);
        unsigned nloc = st[0], nx = st[1];
        if (nloc == 0u) { xcd_barrier_complete(bar, x, Gn, nloc, nx); st[0] = nloc; st[1] = nx; }
        const unsigned old = xb_add(&bar[XB_XSUB(x)], 1u);
        const unsigned gen = old / nloc;
        if (old + 1u == (gen + 1u) * nloc) {
            __builtin_amdgcn_fence(__ATOMIC_RELEASE, "agent");
            asm volatile("s_waitcnt vmcnt(0)" ::: "memory");
            const unsigned og = xb_add(&bar[XB_TOP], 1u);
            const unsigned tg = og / nx;
            if (og + 1u == (tg + 1u) * nx) xb_add(&bar[XB_TOPGEN], 1u);
            else XB_SPIN(xb_ld(&bar[XB_TOPGEN]) == tg, bar);
            __builtin_amdgcn_fence(__ATOMIC_ACQUIRE, "agent");
            xb_add(&bar[XB_XGEN(x)], 1u);
            asm volatile("s_waitcnt vmcnt(0)" ::: "memory");
        } else {
            XB_SPIN(xb_ld(&bar[XB_XGEN(x)]) == gen, bar);
            __builtin_amdgcn_fence(__ATOMIC_ACQUIRE, "agent");
            asm volatile("s_waitcnt vmcnt(0)" ::: "memory");
        }
    }
    __syncthreads();
}

typedef const __attribute__((address_space(4))) Params* KParams;
DEV KParams kargs() { unsigned long long kp = (unsigned long long)__builtin_amdgcn_kernarg_segment_ptr(); asm volatile("" : "+s"(kp)); return (KParams)kp; }

__global__ void __launch_bounds__(NTHR, 2) mega_fwd(Params Parg, int pc_lo, int pc_hi, int coop, int pad_) {
    extern __shared__ __attribute__((aligned(16))) unsigned char smem[];
    cg::grid_group grid = cg::this_grid();
    if (coop) grid.sync();
    volatile LAS unsigned* xst = (volatile LAS unsigned*)((LAS unsigned char*)smem + 139264 - 16);
    const unsigned xcc = xb_xcc_id();
    if (threadIdx.x == 0) { xst[0] = 0u; xst[1] = 0u; (void)xb_add((unsigned*)(asglobal(kargs()->ws) + WS_BAR) + XB_XCNT(xcc), 1u); }
    __syncthreads();
    using pg8::Sched; using pg8::job_put;
    constexpr int PER_LAYER = 1 + 34 + 3, NPC = 2 * PER_LAYER + 1;
#pragma unroll 1
    for (int pc0 = pc_lo; pc0 < pc_hi; ++pc0) {
        int pc = pc0; asm volatile("" : "+s"(pc));
        int tid = threadIdx.x; asm volatile("" : "+v"(tid));
        const int lane = tid & 63, wave = __builtin_amdgcn_readfirstlane(tid >> 6);
        unsigned ldso = 0; asm volatile("" : "+s"(ldso));
        LAS unsigned char* lds = (LAS unsigned char*)smem + ldso;
        int bxv = blockIdx.x, gdv = gridDim.x; asm volatile("" : "+s"(bxv), "+s"(gdv));
        const int layer = pc / PER_LAYER; const int r = pc - layer * PER_LAYER;
        int ph, hf = 0;
        if (pc == NPC - 1) ph = 21; else if (r == 0) ph = 0; else if (r <= 34) { hf = (r - 1) / 17; ph = (r - 1) - hf * 17 + 1; } else ph = 18 + (r - 35);
        asm volatile("" : "+s"(ph), "+s"(hf));
#define P kargs()
#define ws asglobal(kargs()->ws)
#define INP(i) asglobal(kargs()->in[i])
#define OUTP asglobal(kargs()->out)
#define G gdv
#define bx bxv
#define gw (bx * NWAVES + wave)
#define NGW (G * NWAVES)
#define gtid (bx * NTHR + tid)
#define NT (G * NTHR)
#define WIN ((bf16_t*)(ws + WS_WIN))
#define HB ((bf16_t*)(ws + WS_HB))
#define MERGED ((float*)(ws + WS_MERGED))
#define GB ((bf16_t*)(ws + WS_G))
#define YIN ((bf16_t*)(ws + WS_YIN))
#define xsrc (((layer == 0) ? INP(0) : (const float*)OUTP) + (size_t)hf * HT * DM)
#define xdst (OUTP + (size_t)hf * HT * DM)

#define PROBE11 0
#define NOMIX 0
#define NOMLP 0
#ifndef SKIPMASK

#define SKIPMASK 0u
#endif
        if ((SKIPMASK >> ph) & 1u) ph = 99;
#ifdef DELAY_PROBE
        if (bxv == 3) { const unsigned long long t0 = __builtin_amdgcn_s_memrealtime(); while (__builtin_amdgcn_s_memrealtime() - t0 < 30000ull) __builtin_amdgcn_s_sleep(64); }
#endif
        int nobar = 0;
        switch (ph) {
        case 0:
            phase_weights(ws, INP(2) + (size_t)layer * 1024 * INW, INP(4) + (size_t)layer * 1048576, INP(11) + (size_t)layer * 1048576, INP(15) + (size_t)layer * 1048576,
                          INP(16) + (size_t)layer * 1048576, INP(18) + (size_t)layer * 4194304, INP(19) + (size_t)layer * 4194304, lds, gw, NGW, wave, lane);
            break;
        case 1:
            phase_rmsnorm_bf16(xsrc, INP(1) + layer * DM, HB, HT, gw, NGW, lane);
            if (DUP2) phase_rmsnorm_bf16(xsrc, INP(1) + layer * DM, HB, HT, gw, NGW, lane);
            break;
        case 2: {
            if (tid == 0) { job_put(lds, 0, HB, WIN, ws + RA_UA, nullptr, 64, 12, 3072, 0); job_put(lds, 1, HB, WIN + (size_t)9248 * DM, GB, nullptr, 64, 4, 1024, 1); }
            Sched S; S.init(lds, 2, G, bx, DM, tid);
            pg8::GEMM_BODY<3>(lds, DM, S, tid);
            phase_narrow(HB, WIN + (size_t)6144 * DM, WIN + (size_t)9232 * DM, (float*)(ws + WS_DTGK), gw, NGW, lane);
            break; }
        case 3:
            phase_conv_a((const bf16_t*)(ws + RA_UA), INP(3) + (size_t)layer * 3 * 1024, YIN, gtid, NT);
            if (DUP2) phase_conv_a((const bf16_t*)(ws + RA_UA), INP(3) + (size_t)layer * 3 * 1024, YIN, gtid, NT);
            break;
        case 4: nobar = 1; break;
        case 5: {
            if (tid == 0) { job_put(lds, 0, YIN, ws + WS_WOA, MERGED, GB, 64, 4, 1024, 4);
                            job_put(lds, 1, HB, WIN + (size_t)3072 * DM, ws + RB_Z, nullptr, 64, 4, 1024, 2); job_put(lds, 2, WIN + (size_t)4096 * DM, HB, ws + RB_XST, nullptr, 4, 64, HT, 0);
                            job_put(lds, 3, HB, WIN + (size_t)5120 * DM, ws + RB_BC, nullptr, 64, 4, 1024, 0); job_put(lds, 4, HB, WIN + (size_t)10272 * DM, ws + WS_MSUM, nullptr, 64, 4, 1024, 1); }
            Sched S; S.init(lds, 5, G, bx, DM, tid); pg8::GEMM_BODY<23>(lds, DM, S, tid);
            break; }
        case 6:
            phase_ssd_prep(ws, INP(5) + (size_t)layer * 4 * 2048, INP(6) + (size_t)layer * 2048, INP(7) + layer * 16, INP(8) + layer * 16, gtid, NT, tid, G, bx);
            if (DUP2) phase_ssd_prep(ws, INP(5) + (size_t)layer * 4 * 2048, INP(6) + (size_t)layer * 2048, INP(7) + layer * 16, INP(8) + layer * 16, gtid, NT, tid, G, bx);
            break;
        case 7: phase_ssd_states(ws, lds, tid, wave, lane); if (DUP) { __syncthreads(); phase_ssd_states(ws, lds, tid, wave, lane); } break;
        case 8: phase_ssd_scan(ws, gtid, NT); break;
        case 9: phase_ssd_out(ws, INP(9) + layer * 16, INP(10) + layer * 1024, lds, tid, wave, lane); if (DUP) { __syncthreads(); phase_ssd_out(ws, INP(9) + layer * 16, INP(10) + layer * 1024, lds, tid, wave, lane); } break;
        case 10: nobar = 1; break;
        case 11: {
            if (tid == 0) { job_put(lds, 0, YIN, ws + WS_WOS, MERGED, ws + WS_MSUM, 64, 4, 1024, 5);
                            job_put(lds, 1, HB, WIN + (size_t)6160 * DM, ws + RC_QK, nullptr, 64, 4, 1024, 0); job_put(lds, 2, WIN + (size_t)7184 * DM, HB, ws + RC_VT, nullptr, 4, 64, HT, 0);
                            job_put(lds, 3, HB, WIN + (size_t)8208 * DM, ws + RC_GS, nullptr, 64, 4, 1024, 2); job_put(lds, 4, HB, WIN + (size_t)11296 * DM, GB, nullptr, 64, 4, 1024, 1); }
            Sched S; S.init(lds, 5, G, bx, DM, tid); pg8::GEMM_BODY<39>(lds, DM, S, tid);
            break; }
        case 12: phase_gla_prep(ws, INP(12) + (size_t)layer * 16 * 512, INP(13) + layer * 512, gtid, NT); break;
        case 13: phase_gla_states(ws, lds, tid, wave, lane); if (DUP) { __syncthreads(); phase_gla_states(ws, lds, tid, wave, lane); } break;
        case 14: phase_gla_scan(ws, gtid, NT); break;
        case 15: phase_gla_out(ws, INP(14) + layer * 256, lds, tid, wave, lane); if (DUP) { __syncthreads(); phase_gla_out(ws, INP(14) + layer * 256, lds, tid, wave, lane); } break;
        case 16: {
            if (tid == 0) job_put(lds, 0, YIN, ws + WS_WOG, ws + WS_MSUM, GB, 64, 4, 1024, 6);
            Sched S; S.init(lds, 1, G, bx, DM, tid); pg8::GEMM_BODY<64>(lds, DM, S, tid);
            break; }
        case 17: {
            if (tid == 0) job_put(lds, 0, GB, ws + WS_WO, xdst, xsrc, 64, 4, NOMIX ? 0 : 1024, 7);
            Sched S; S.init(lds, 1, G, bx, DM, tid); pg8::GEMM_BODY<128>(lds, DM, S, tid);
            break; }
        case 18:
            phase_rmsnorm_bf16(OUTP, INP(17) + layer * DM, (bf16_t*)(ws + WS_MERGED), T_ALL, gw, NGW, lane);
            break;
        case 19: {
            if (tid == 0) job_put(lds, 0, ws + WS_MERGED, ws + WS_WUP, ws + WS_R, nullptr, 128, 16, DFF, 3);
            Sched S; S.init(lds, 1, G, bx, DM, tid); pg8::GEMM_BODY<8>(lds, DM, S, tid);
            break; }
        case 20: {
            if (tid == 0) job_put(lds, 0, ws + WS_R, ws + WS_WDN, OUTP, OUTP, 128, 4, NOMLP ? 0 : 1024, 7);
            Sched S; S.init(lds, 1, G, bx, DFF, tid); pg8::GEMM_BODY<128>(lds, DFF, S, tid);
            break; }
        case 99: {
#ifdef SPIN_PROBE
            if (pc == 6 || pc == 23) { const unsigned long long t0 = __builtin_amdgcn_s_memrealtime(); while (__builtin_amdgcn_s_memrealtime() - t0 < 500000ull) __builtin_amdgcn_s_sleep(64); }
#endif
            break; }
        default:
            phase_rmsnorm_f32(OUTP, INP(20), T_ALL, gw, NGW, lane);
            break;
        }
        if (pc0 != pc_hi - 1 && !nobar) {
            xcd_barrier((unsigned*)(ws + WS_BAR), xcc, xst, tid, (unsigned)gdv);
            if (BAR2) xcd_barrier((unsigned*)(ws + WS_BAR), xcc, xst, tid, (unsigned)gdv);
        }
    }
#undef P
#undef ws
#undef INP
#undef OUTP
#undef G
#undef bx
#undef gw
#undef NGW
#undef gtid
#undef NT
#undef WIN
#undef HB
#undef MERGED
#undef GB
#undef YIN
#undef xsrc
#undef xdst
}

extern "C" void kernel_launch(void* const* d_in, const int* in_sizes, int n_in, void* d_out, int out_size, void* d_ws, size_t ws_size, hipStream_t stream) {
    static int grid = 0;
    if (grid == 0) {
        if (n_in != 21 || out_size != T_ALL * DM || ws_size < WS_TOTAL) { fprintf(stderr, "kernel_launch: unexpected shapes (n_in %d out %d ws %zu need %zu)\n", n_in, out_size, ws_size, (size_t)WS_TOTAL); grid = -1; return; }
        int dev = 0, cus = 0, per_cu = 0;
        hipGetDevice(&dev);
        hipDeviceGetAttribute(&cus, hipDeviceAttributeMultiprocessorCount, dev);
        if (hipFuncSetAttribute((const void*)mega_fwd, hipFuncAttributeMaxDynamicSharedMemorySize, LDS_BYTES) != hipSuccess) { fprintf(stderr, "kernel_launch: hipFuncSetAttribute failed\n"); }
        if (hipOccupancyMaxActiveBlocksPerMultiprocessor(&per_cu, (const void*)mega_fwd, NTHR, LDS_BYTES) != hipSuccess || per_cu < 1) { fprintf(stderr, "kernel_launch: occupancy query says %d\n", per_cu); per_cu = 1; }
        (void)hipGetLastError();
        grid = cus > 0 ? cus : 256;
    }
    if (grid < 0) return;
    if (hipMemsetAsync((char*)d_ws + WS_BAR, 0, 16384, stream) != hipSuccess) { fprintf(stderr, "kernel_launch: memset failed\n"); return; }
    Params p{};
    for (int i = 0; i < 21; ++i) p.in[i] = (const float*)d_in[i];
    p.out = (float*)d_out; p.ws = (unsigned char*)d_ws;
#ifndef N_LAUNCH_SPLIT
#define N_LAUNCH_SPLIT 0
#endif
    constexpr int NPC_H = 2 * 38 + 1;
    if (N_LAUNCH_SPLIT) {
        for (int pc = 0; pc < NPC_H; ++pc) {
            hipLaunchKernelGGL(mega_fwd, dim3(grid), dim3(NTHR), LDS_BYTES, stream, p, pc, pc + 1, 0, 0);
        }
        hipError_t e = hipPeekAtLastError();
        if (e != hipSuccess) fprintf(stderr, "launch failed: %s (grid %d)\n", hipGetErrorString(e), grid);
    } else {
        int lo = 0, hi = NPC_H, coop = 1, pad = 0;
        void* args[] = {&p, &lo, &hi, &coop, &pad};
        hipError_t e = hipLaunchCooperativeKernel((const void*)mega_fwd, dim3(grid), dim3(NTHR), args, LDS_BYTES, stream);
        if (e != hipSuccess) fprintf(stderr, "cooperative launch failed: %s (grid %d)\n", hipGetErrorString(e), grid);
    }
}
```

```cpp
#include <hip/hip_runtime.h>
#include <hip/hip_cooperative_groups.h>
#include <cstdio>
namespace cg = cooperative_groups;

#define LAS __attribute__((address_space(3)))
#define DEV __device__ __forceinline__
typedef unsigned short bf16_t;
typedef short bf16x8 __attribute__((ext_vector_type(8)));
typedef float f32x4 __attribute__((ext_vector_type(4)));
typedef float f32x2 __attribute__((ext_vector_type(2)));
typedef unsigned u32x4 __attribute__((ext_vector_type(4)));
typedef unsigned u32x2 __attribute__((ext_vector_type(2)));

constexpr int T_ALL = 32768, HT = 16384, DM = 1024, SEQ = 8192, INW = 12320, DFF = 4096;
constexpr int NTHR = 512, NWAVES = 8;
constexpr int LDS_BYTES = 136 * 1024;
constexpr float EPS = 1e-6f;

constexpr size_t WS_WIN = 1048576;
constexpr size_t WS_WOA = WS_WIN + (size_t)INW * 1024 * 2 + 1048576;
constexpr size_t WS_WOS = WS_WOA + 2097152;
constexpr size_t WS_WOG = WS_WOS + 2097152;
constexpr size_t WS_WO = WS_WOG + 2097152;
constexpr size_t WS_WUP = WS_WO + 2097152;
constexpr size_t WS_WDN = WS_WUP + 8388608;
constexpr size_t WS_HB = WS_WDN + 8388608;
constexpr size_t WS_MERGED = WS_HB + (size_t)HT * 1024 * 2;
constexpr size_t WS_G = WS_MERGED + (size_t)HT * 1024 * 4;
constexpr size_t WS_YIN = WS_G + (size_t)HT * 1024 * 2;
constexpr size_t WS_DTGK = WS_YIN + (size_t)HT * 1024 * 2;
constexpr size_t WS_R = WS_DTGK + (size_t)HT * 32 * 4;
constexpr size_t RA_UA = WS_R;
constexpr size_t RB_Z = WS_R;
constexpr size_t RB_XST = RB_Z + 33554432;
constexpr size_t RB_BC = RB_XST + 33554432;
constexpr size_t RB_XSTC = RB_BC + 33554432;
constexpr size_t RB_BCC = RB_XSTC + 33554432;
constexpr size_t RB_BTC = RB_BCC + 33554432;
constexpr size_t RB_DT = RB_BTC + 16777216;
constexpr size_t RB_ACUM = RB_DT + 1048576;
constexpr size_t RB_ST = RB_ACUM + 1048576;
constexpr size_t RB_END = RB_ST + 67108864;
constexpr size_t RC_QK = WS_R;
constexpr size_t RC_KT = RC_QK + 33554432;
constexpr size_t RC_VT = RC_KT + 16777216;
constexpr size_t RC_GS = RC_VT + 33554432;
constexpr size_t RC_DEC = RC_GS + 33554432;
constexpr size_t RC_ST = RC_DEC + 524288;
constexpr size_t RC_END = RC_ST + 134217728;
constexpr size_t R_HID_END = WS_R + (size_t)T_ALL * DFF * 2;
constexpr size_t WS_END = (RB_END > RC_END ? (RB_END > R_HID_END ? RB_END : R_HID_END) : (RC_END > R_HID_END ? RC_END : R_HID_END));

constexpr size_t WS_MSUM = (WS_END + 255) & ~(size_t)255;
constexpr size_t WS_BAR = WS_MSUM + (size_t)HT * 1024 * 2;
constexpr size_t WS_DEC = WS_BAR + 16384;
constexpr size_t WS_TOTAL = WS_DEC + 524288;
struct Params { const float* in[21]; float* out; unsigned char* ws; };

DEV unsigned f2bf(float f) { unsigned u = __float_as_uint(f); return (u + 0x7fffu + ((u >> 16) & 1u)) >> 16; }
typedef __bf16 bf16x2_t __attribute__((ext_vector_type(2)));
DEV unsigned pk2(float lo, float hi) { const f32x2 v = {lo, hi}; const bf16x2_t r = __builtin_convertvector(v, bf16x2_t); return __builtin_bit_cast(unsigned, r); }
DEV float bf_lo(unsigned w) { return __uint_as_float(w << 16); }
DEV float bf_hi(unsigned w) { return __uint_as_float(w & 0xffff0000u); }
DEV float bf1(bf16_t h) { return __uint_as_float(((unsigned)h) << 16); }
DEV void unpack8(const u32x4 w, float (&f)[8]) {
    f[0] = bf_lo(w.x); f[1] = bf_hi(w.x); f[2] = bf_lo(w.y); f[3] = bf_hi(w.y);
    f[4] = bf_lo(w.z); f[5] = bf_hi(w.z); f[6] = bf_lo(w.w); f[7] = bf_hi(w.w);
}
DEV u32x4 pack8(const float (&f)[8]) { u32x4 w; w.x = pk2(f[0], f[1]); w.y = pk2(f[2], f[3]); w.z = pk2(f[4], f[5]); w.w = pk2(f[6], f[7]); return w; }
DEV float sigmoidf_(float x) { return __builtin_amdgcn_rcpf(1.0f + __expf(-x)); }
DEV float siluf_(float x) { return x * sigmoidf_(x); }
DEV float softplusf_(float x) { return x > 20.f ? x : (x < -15.f ? __expf(x) : __logf(1.0f + __expf(x))); }
DEV float logsigf_(float x) { const float e = __expf(-fabsf(x)); return fminf(x, 0.f) - (e < 1e-4f ? e : __logf(1.0f + e)); }
DEV float wave_sum(float v) {
#pragma unroll
    for (int o = 1; o < 64; o <<= 1) v += __shfl_xor(v, o);
    return v;
}
DEV f32x4 mma(bf16x8 x, bf16x8 y, f32x4 acc) { return __builtin_amdgcn_mfma_f32_16x16x32_bf16(x, y, acc, 0, 0, 0); }
DEV bf16x8 ldsfrag(const LAS unsigned char* p) { return *(const LAS bf16x8*)p; }
#define SCALE_A 1.f
#define SCALE_B 1.f
#define SCALE_C 1.f
#define DUP 0
#define DUP2 0
#define BAR2 0
#define GLA_NO_INTER 0
#define GLA_ZERO_DEC 0
#ifndef GEMM_BODY
#define GEMM_BODY gemm_phase
#endif
#define LDS_WAIT() asm volatile("s_waitcnt lgkmcnt(0)" ::: "memory")
#define GAS __attribute__((address_space(1)))
template <class T> DEV T* asglobal(T* p) { return (T*)(GAS T*)p; }

namespace pg8 {
constexpr int BM = 256, BK = 64, HALF = 128, HTB = HALF * BK * 2, STAGE_BYTES = 8 * HTB, NXCD = 8, WGM = 8;
DEV int lds_byte(int r, int c) { const int st = (r >> 4) * 2 + (c >> 5), rr = r & 15, cc = c & 31, ob = rr * 64 + cc * 2; return st * 1024 + (ob ^ (((ob >> 9) & 1) << 5)); }
DEV void stage_rc(int b, int& R, int& C) { const int st = b / 1024, sb = b % 1024, swz = sb ^ (((sb >> 9) & 1) << 5); R = (st >> 1) * 16 + swz / 64; C = (st & 1) * 32 + (swz % 64) / 2; }
DEV int perm32(int rho) { const int n = rho >> 4, i = rho & 15; return 8 * (i >> 2) + 4 * n + (i & 3); }

struct Job { const bf16_t* A; const bf16_t* B; void* out; const void* aux; int nM, nN, ldc, kind; };
struct Unit { const char* A; const char* B; int jid, pm, pn; };
constexpr int JT_OFF = 131072;
DEV int rfl(int v) { return __builtin_amdgcn_readfirstlane(v); }
DEV const char* rflp(const LAS int* p) { const unsigned lo = (unsigned)rfl(p[0]), hi = (unsigned)rfl(p[1]); return asglobal((const char*)(((unsigned long long)hi << 32) | lo)); }
DEV void job_put(LAS unsigned char* lds, int q, const void* A, const void* B, void* out, const void* aux, int nM, int nN, int ldc, int kind) {
    LAS int* jt = (LAS int*)(lds + JT_OFF) + q * 12;
    const unsigned long long a = (unsigned long long)A, b = (unsigned long long)B, o = (unsigned long long)out, x = (unsigned long long)aux;
    jt[0] = (int)(unsigned)a; jt[1] = (int)(unsigned)(a >> 32); jt[2] = (int)(unsigned)b; jt[3] = (int)(unsigned)(b >> 32);
    jt[4] = (int)(unsigned)o; jt[5] = (int)(unsigned)(o >> 32); jt[6] = (int)(unsigned)x; jt[7] = (int)(unsigned)(x >> 32);
    jt[8] = nM; jt[9] = nN; jt[10] = ldc; jt[11] = kind;
}
struct Sched {
    LAS unsigned char* lds; int nj, total, G, c; size_t tstep;
    DEV void init(LAS unsigned char* lds_, int nj_, int G_, int c_, int K, int tid_) {
        lds = lds_; nj = nj_; G = G_; c = c_; tstep = (size_t)BM * K * 2;
        __syncthreads();
        LAS int* jt = (LAS int*)(lds + JT_OFF);
        if (tid_ == 0) { int s = 0; for (int q = 0; q < nj; ++q) { jt[72 + q] = s; s += jt[q * 12 + 8] * jt[q * 12 + 9]; } for (int q = nj; q < 7; ++q) jt[72 + q] = s; }
        __syncthreads();
        total = rfl(jt[72 + 6]);
    }
    DEV bool next(int i, Unit& u) const {
        const int L = i * G + c; if (L >= total) return false;
        const LAS int* jt = (const LAS int*)(lds + JT_OFF);
        int jid = 0;
        for (int q = 1; q < nj; ++q) if (L >= rfl(jt[72 + q])) jid = q;
        const LAS int* J = jt + jid * 12;
        const int base = rfl(jt[72 + jid]), nM = rfl(J[8]), nN = rfl(J[9]);
        int wgid = L - base; const int nwg = nM * nN;
        { const int q = nwg / NXCD, r = nwg % NXCD, xcd = wgid % NXCD, off = wgid / NXCD; wgid = (xcd < r ? xcd * (q + 1) : r * (q + 1) + (xcd - r) * q) + off; }
        const int nig = WGM * nN, gid = wgid / nig, fm = gid * WGM, gsz = (nM - fm) < WGM ? (nM - fm) : WGM;
        u.pm = fm + ((wgid % nig) % gsz); u.pn = (wgid % nig) / gsz; u.jid = jid;
        u.A = rflp(J) + (size_t)u.pm * tstep; u.B = rflp(J + 2) + (size_t)u.pn * tstep;
        return true;
    }
};

DEV void st16_wt(GAS u32x4* p, u32x4 v) { asm volatile("global_store_dwordx4 %0, %1, off sc1" :: "v"(p), "v"(v) : "memory"); }
DEV void st16f_wt(GAS f32x4* p, f32x4 v) { asm volatile("global_store_dwordx4 %0, %1, off sc1" :: "v"(p), "v"(v) : "memory"); }
DEV unsigned cvt_pk_bf16(float lo, float hi) { return pk2(lo, hi); }

template <int KIND> DEV void epi_loop(const f32x4 (&acc)[2][2][4][2], const Job& J, const Unit& u, int wr, int wc, int fr, int fq) {
    const int row0 = u.pm * BM + wr * 64 + fr, col0 = u.pn * BM + wc * 32 + 8 * fq;
    GAS bf16_t* const outb = (GAS bf16_t*)J.out; GAS float* const outf = (GAS float*)J.out;
    const GAS float* const auxf = (const GAS float*)J.aux; GAS bf16_t* const auxb = (GAS bf16_t*)const_cast<void*>(J.aux);
#pragma unroll
    for (int ai = 0; ai < 2; ++ai)
#pragma unroll
        for (int m = 0; m < 4; ++m) {
            const size_t row = (size_t)(row0 + ai * HALF + m * 16);
#pragma unroll
            for (int bj = 0; bj < 2; ++bj) {
                const int col = col0 + bj * HALF;
                f32x4 v0 = acc[ai][bj][m][0], v1 = acc[ai][bj][m][1];
                if (KIND <= 3) {
                    if (KIND == 1) {
#pragma unroll
                        for (int e = 0; e < 4; ++e) { v0[e] = sigmoidf_(v0[e]); v1[e] = sigmoidf_(v1[e]); } }
                    if (KIND == 2) {
#pragma unroll
                        for (int e = 0; e < 4; ++e) { v0[e] = siluf_(v0[e]); v1[e] = siluf_(v1[e]); } }
                    if (KIND == 3) {
#pragma unroll
                        for (int e = 0; e < 4; ++e) { float a = fmaxf(v0[e], 0.f), b = fmaxf(v1[e], 0.f); v0[e] = a * a; v1[e] = b * b; } }
                    u32x4 w; w.x = cvt_pk_bf16(v0[0], v0[1]); w.y = cvt_pk_bf16(v0[2], v0[3]); w.z = cvt_pk_bf16(v1[0], v1[1]); w.w = cvt_pk_bf16(v1[2], v1[3]);
                    *(GAS u32x4*)(outb + row * J.ldc + col) = w;
                } else if (KIND == 7) {
                    const GAS float* xin = auxf + row * DM + col; GAS float* xo = outf + row * DM + col;
                    const f32x4 a = *(const GAS f32x4*)xin, b = *(const GAS f32x4*)(xin + 4);
                    const float sc = (J.ldc == 0) ? 0.f : 1.f; *(GAS f32x4*)xo = a + v0 * sc; *(GAS f32x4*)(xo + 4) = b + v1 * sc;
                } else if (KIND == 4) {
                    const u32x4 gw = *(const GAS u32x4*)(auxb + row * DM + col); float g[8]; unpack8(gw, g);
                    f32x4 r0, r1;
#pragma unroll
                    for (int e = 0; e < 4; ++e) { r0[e] = g[e] * v0[e] * SCALE_A; r1[e] = g[4 + e] * v1[e] * SCALE_A; }
                    GAS float* mo = outf + row * DM + col; *(GAS f32x4*)mo = r0; *(GAS f32x4*)(mo + 4) = r1;
                } else if (KIND == 5) {
                    GAS bf16_t* gp = auxb + row * DM + col;
                    const u32x4 gw = *(const GAS u32x4*)gp; float g[8]; unpack8(gw, g);
#pragma unroll
                    for (int e = 0; e < 8; ++e) g[e] *= SCALE_B;
                    const GAS float* mo = outf + row * DM + col; const f32x4 m0 = *(const GAS f32x4*)mo, m1 = *(const GAS f32x4*)(mo + 4);
                    u32x4 w; w.x = cvt_pk_bf16(m0[0] + g[0] * v0[0], m0[1] + g[1] * v0[1]); w.y = cvt_pk_bf16(m0[2] + g[2] * v0[2], m0[3] + g[3] * v0[3]);
                    w.z = cvt_pk_bf16(m1[0] + g[4] * v1[0], m1[1] + g[5] * v1[1]); w.w = cvt_pk_bf16(m1[2] + g[6] * v1[2], m1[3] + g[7] * v1[3]);
                    *(GAS u32x4*)gp = w;
                } else {
                    GAS bf16_t* gp = auxb + row * DM + col;
                    const u32x4 gw = *(const GAS u32x4*)gp, aw = *(const GAS u32x4*)(outb + row * DM + col);
                    float g[8], a[8]; unpack8(gw, g); unpack8(aw, a);
#pragma unroll
                    for (int e = 0; e < 8; ++e) g[e] *= SCALE_C;
                    u32x4 w; w.x = cvt_pk_bf16(a[0] + g[0] * v0[0], a[1] + g[1] * v0[1]); w.y = cvt_pk_bf16(a[2] + g[2] * v0[2], a[3] + g[3] * v0[3]);
                    w.z = cvt_pk_bf16(a[4] + g[4] * v1[0], a[5] + g[5] * v1[1]); w.w = cvt_pk_bf16(a[6] + g[6] * v1[2], a[7] + g[7] * v1[3]);
                    *(GAS u32x4*)gp = w;
                }
            }
        }
}

template <int MASK> DEV void run_epi(const Sched& S, const Unit& u, const f32x4 (&acc)[2][2][4][2], int wr, int wc, int fr, int fq) {
    const LAS int* Jp = (const LAS int*)(S.lds + JT_OFF) + u.jid * 12;
    Job J; J.A = nullptr; J.B = nullptr; J.out = (void*)rflp(Jp + 4); J.aux = (const void*)rflp(Jp + 6); J.nM = 0; J.nN = 0; J.ldc = rfl(Jp[10]); J.kind = rfl(Jp[11]);
    const int k = J.kind;
    if ((MASK & 1) && k == 0) epi_loop<0>(acc, J, u, wr, wc, fr, fq);
    else if ((MASK & 2) && k == 1) epi_loop<1>(acc, J, u, wr, wc, fr, fq);
    else if ((MASK & 4) && k == 2) epi_loop<2>(acc, J, u, wr, wc, fr, fq);
    else if ((MASK & 8) && k == 3) epi_loop<3>(acc, J, u, wr, wc, fr, fq);
    else if ((MASK & 16) && k == 4) epi_loop<4>(acc, J, u, wr, wc, fr, fq);
    else if ((MASK & 32) && k == 5) epi_loop<5>(acc, J, u, wr, wc, fr, fq);
    else if ((MASK & 64) && k == 6) epi_loop<6>(acc, J, u, wr, wc, fr, fq);
    else if ((MASK & 128) && k == 7) epi_loop<7>(acc, J, u, wr, wc, fr, fq);
}

template <int MASK>
DEV void gemm_phase(LAS unsigned char* lds, const int K, const Sched& S, const int tid) {
    const int wid = __builtin_amdgcn_readfirstlane(tid >> 6), lane = tid & 63, wr = wid >> 2, wc = wid & 3, fr = lane & 15, fq = lane >> 4;
    const int nt = K / BK;
    unsigned voffA[2], voffB[2];
#pragma unroll
    for (int i = 0; i < 2; ++i) { int R, C; stage_rc(tid * 16 + i * 8192, R, C); const int Rb = (R & ~31) + perm32(R & 31);
        voffA[i] = (unsigned)(R * K + C) * 2u; voffB[i] = (unsigned)(Rb * K + C) * 2u; }
    const size_t kstep = (size_t)(BK * 2);
    const size_t hstep = (size_t)HALF * K * 2;
    const unsigned ldsw = (unsigned)wid * 1024u;
    const int aoff = lds_byte(wr * 64 + fr, fq * 8), boff = lds_byte(wc * 32 + fr, fq * 8);
#define PG8_SA(b, h) (((b) * 2 + (h)) * HTB)
#define PG8_SB(b, h) ((4 + (b) * 2 + (h)) * HTB)
#define PG8_STAGE(bufoff, gbase, voff) do { _Pragma("unroll") for (int _i = 0; _i < 2; ++_i) \
        __builtin_amdgcn_global_load_lds((const unsigned*)((const char*)(gbase) + (voff)[_i]), (LAS unsigned*)(lds + (bufoff) + ldsw + _i * 8192), 16, 0, 0); } while (0)
#define PG8_LDA(dst, b, h) do { _Pragma("unroll") for (int m = 0; m < 4; ++m) _Pragma("unroll") for (int k = 0; k < 2; ++k) dst[m][k] = *(const LAS bf16x8*)(lds + PG8_SA(b, h) + aoff + m * 2048 + k * 1024); } while (0)
#define PG8_LDB(dst, b, h) do { _Pragma("unroll") for (int n = 0; n < 2; ++n) _Pragma("unroll") for (int k = 0; k < 2; ++k) dst[n][k] = *(const LAS bf16x8*)(lds + PG8_SB(b, h) + boff + n * 2048 + k * 1024); } while (0)
#define PG8_MMA(ai, bj, At, Bt) do { __builtin_amdgcn_s_setprio(1); _Pragma("unroll") for (int m = 0; m < 4; ++m) _Pragma("unroll") for (int n = 0; n < 2; ++n) _Pragma("unroll") for (int k = 0; k < 2; ++k) \
        acc[ai][bj][m][n] = __builtin_amdgcn_mfma_f32_16x16x32_bf16(Bt[n][k], At[m][k], acc[ai][bj][m][n], 0, 0, 0); __builtin_amdgcn_s_setprio(0); } while (0)
#define PG8_WAIT_V(n) asm volatile("s_waitcnt vmcnt(" #n ")" ::: "memory")
#define PG8_WAIT_L(n) asm volatile("s_waitcnt lgkmcnt(" #n ")" ::: "memory")
#define PG8_BAR __builtin_amdgcn_s_barrier()
#define PG8_SCHED __builtin_amdgcn_sched_barrier(0)
    Unit cur, nxt; int ui = 0;
    if (!S.next(0, cur)) return;
    f32x4 acc[2][2][4][2];
#pragma unroll
    for (int a = 0; a < 2; ++a)
#pragma unroll
        for (int b = 0; b < 2; ++b)
#pragma unroll
            for (int m = 0; m < 4; ++m)
#pragma unroll
                for (int n = 0; n < 2; ++n) acc[a][b][m][n] = (f32x4){0.f, 0.f, 0.f, 0.f};
    bf16x8 At[4][2], B0[2][2], B1[2][2];
    const char* cA = cur.A; const char* cB = cur.B;
    PG8_STAGE(PG8_SB(0, 0), cB, voffB); PG8_STAGE(PG8_SA(0, 0), cA, voffA); PG8_STAGE(PG8_SB(0, 1), cB + hstep, voffB); PG8_STAGE(PG8_SA(0, 1), cA + hstep, voffA);
    if (wr == 1) PG8_BAR;
    PG8_WAIT_V(4); PG8_BAR;
    PG8_STAGE(PG8_SB(1, 0), cB + kstep, voffB); PG8_STAGE(PG8_SA(1, 0), cA + kstep, voffA); PG8_STAGE(PG8_SB(1, 1), cB + hstep + kstep, voffB);
    PG8_WAIT_V(6); PG8_BAR;
    for (;;) {
        const bool has_next = S.next(ui + 1, nxt);
        const char* nA = has_next ? nxt.A : cA; const char* nB = has_next ? nxt.B : cB;
        for (int t = 0; t < nt; t += 2) {
            const bool last = (t == nt - 2);
            const char* a1 = cA + (size_t)(t + 1) * kstep;
            const char* a2 = last ? nA : cA + (size_t)(t + 2) * kstep; const char* b2 = last ? nB : cB + (size_t)(t + 2) * kstep;
            const char* a3 = a2 + kstep; const char* b3 = b2 + kstep;
            PG8_LDB(B0, 0, 0); PG8_SCHED; PG8_LDA(At, 0, 0); PG8_STAGE(PG8_SA(1, 1), a1 + hstep, voffA);
            PG8_WAIT_L(8); PG8_BAR; PG8_WAIT_L(0); PG8_MMA(0, 0, At, B0); PG8_BAR; PG8_SCHED;
            PG8_LDB(B1, 0, 1); PG8_STAGE(PG8_SB(0, 0), b2, voffB);
            PG8_BAR; PG8_WAIT_L(0); PG8_MMA(0, 1, At, B1); PG8_BAR;
            PG8_LDA(At, 0, 1); PG8_STAGE(PG8_SA(0, 0), a2, voffA);
            PG8_BAR; PG8_WAIT_L(0); PG8_MMA(1, 0, At, B0); PG8_BAR; PG8_SCHED;
            PG8_STAGE(PG8_SB(0, 1), b2 + hstep, voffB);
            PG8_WAIT_V(6); PG8_BAR; PG8_MMA(1, 1, At, B1); PG8_BAR;
            PG8_LDB(B0, 1, 0); PG8_SCHED; PG8_LDA(At, 1, 0); PG8_STAGE(PG8_SA(0, 1), a2 + hstep, voffA);
            PG8_WAIT_L(8); PG8_BAR; PG8_WAIT_L(0); PG8_MMA(0, 0, At, B0); PG8_BAR; PG8_SCHED;
            PG8_LDB(B1, 1, 1); PG8_STAGE(PG8_SB(1, 0), b3, voffB);
            PG8_BAR; PG8_WAIT_L(0); PG8_MMA(0, 1, At, B1); PG8_BAR;
            PG8_LDA(At, 1, 1); PG8_STAGE(PG8_SA(1, 0), a3, voffA);
            PG8_BAR; PG8_WAIT_L(0); PG8_MMA(1, 0, At, B0); PG8_BAR; PG8_SCHED;
            PG8_STAGE(PG8_SB(1, 1), b3 + hstep, voffB);
            PG8_WAIT_V(6); PG8_BAR; PG8_MMA(1, 1, At, B1); PG8_BAR;
        }
        run_epi<MASK>(S, cur, acc, wr, wc, fr, fq);
        if (!has_next) break;
#pragma unroll
        for (int a = 0; a < 2; ++a)
#pragma unroll
            for (int b = 0; b < 2; ++b)
#pragma unroll
                for (int m = 0; m < 4; ++m)
#pragma unroll
                    for (int n = 0; n < 2; ++n) acc[a][b][m][n] = (f32x4){0.f, 0.f, 0.f, 0.f};
        cur = nxt; cA = nA; cB = nB; ++ui;
    }
    PG8_WAIT_V(0);
    if (wr == 0) PG8_BAR;
    PG8_BAR;
#undef PG8_SA
#undef PG8_SB
#undef PG8_STAGE
#undef PG8_LDA
#undef PG8_LDB
#undef PG8_MMA
#undef PG8_WAIT_V
#undef PG8_WAIT_L
#undef PG8_BAR
#undef PG8_SCHED
}

template <int MASK>
DEV void gemm_simple(LAS unsigned char* lds, const int K, const Sched& S, const int tid) {
    const int wid = __builtin_amdgcn_readfirstlane(tid >> 6), lane = tid & 63, wr = wid >> 2, wc = wid & 3, fr = lane & 15, fq = lane >> 4;
    const int nt = K / BK;
    unsigned voffA[2], voffB[2];
#pragma unroll
    for (int i = 0; i < 2; ++i) { int R, C; stage_rc(tid * 16 + i * 8192, R, C); const int Rb = (R & ~31) + perm32(R & 31);
        voffA[i] = (unsigned)(R * K + C) * 2u; voffB[i] = (unsigned)(Rb * K + C) * 2u; }
    const size_t kstep = (size_t)(BK * 2), hstep = (size_t)HALF * K * 2;
    const unsigned ldsl = (unsigned)wid * 1024u + (unsigned)lane * 16u;
    const int aoff = lds_byte(wr * 64 + fr, fq * 8), boff = lds_byte(wc * 32 + fr, fq * 8);
#define GS_SA(b, h) (((b) * 2 + (h)) * HTB)
#define GS_SB(b, h) ((4 + (b) * 2 + (h)) * HTB)
#define GS_LOAD(dst, pa, pb) do { _Pragma("unroll") for (int _i = 0; _i < 2; ++_i) { \
        dst[0][_i] = *(const GAS u32x4*)((const GAS char*)(pa) + voffA[_i]); dst[1][_i] = *(const GAS u32x4*)((const GAS char*)(pa) + hstep + voffA[_i]); \
        dst[2][_i] = *(const GAS u32x4*)((const GAS char*)(pb) + voffB[_i]); dst[3][_i] = *(const GAS u32x4*)((const GAS char*)(pb) + hstep + voffB[_i]); } } while (0)
#define GS_WRITE(b, src) do { _Pragma("unroll") for (int _i = 0; _i < 2; ++_i) { \
        *(LAS u32x4*)(lds + GS_SA(b, 0) + ldsl + _i * 8192) = src[0][_i]; *(LAS u32x4*)(lds + GS_SA(b, 1) + ldsl + _i * 8192) = src[1][_i]; \
        *(LAS u32x4*)(lds + GS_SB(b, 0) + ldsl + _i * 8192) = src[2][_i]; *(LAS u32x4*)(lds + GS_SB(b, 1) + ldsl + _i * 8192) = src[3][_i]; } } while (0)
    Unit cur; int ui = 0;
    while (S.next(ui, cur)) {
        f32x4 acc[2][2][4][2];
#pragma unroll
        for (int a = 0; a < 2; ++a)
#pragma unroll
            for (int b = 0; b < 2; ++b)
#pragma unroll
                for (int m = 0; m < 4; ++m)
#pragma unroll
                    for (int n = 0; n < 2; ++n) acc[a][b][m][n] = (f32x4){0.f, 0.f, 0.f, 0.f};
        const char* cA = cur.A; const char* cB = cur.B;
        u32x4 st[4][2];
        GS_LOAD(st, cA, cB);
        GS_WRITE(0, st);
        __syncthreads();
        for (int t = 0; t < nt; ++t) {
            const int b = t & 1;
            if (t + 1 < nt) GS_LOAD(st, cA + (size_t)(t + 1) * kstep, cB + (size_t)(t + 1) * kstep);
#pragma unroll
            for (int ai = 0; ai < 2; ++ai) {
                bf16x8 At[4][2];
#pragma unroll
                for (int m = 0; m < 4; ++m)
#pragma unroll
                    for (int k = 0; k < 2; ++k) At[m][k] = *(const LAS bf16x8*)(lds + (b ? GS_SA(1, 0) : GS_SA(0, 0)) + ai * HTB + aoff + m * 2048 + k * 1024);
#pragma unroll
                for (int bj = 0; bj < 2; ++bj) {
                    bf16x8 Bt[2][2];
#pragma unroll
                    for (int n = 0; n < 2; ++n)
#pragma unroll
                        for (int k = 0; k < 2; ++k) Bt[n][k] = *(const LAS bf16x8*)(lds + (b ? GS_SB(1, 0) : GS_SB(0, 0)) + bj * HTB + boff + n * 2048 + k * 1024);
#pragma unroll
                    for (int m = 0; m < 4; ++m)
#pragma unroll
                        for (int n = 0; n < 2; ++n)
#pragma unroll
                            for (int k = 0; k < 2; ++k) acc[ai][bj][m][n] = __builtin_amdgcn_mfma_f32_16x16x32_bf16(Bt[n][k], At[m][k], acc[ai][bj][m][n], 0, 0, 0);
                }
            }
            if (t + 1 < nt) { if (b) GS_WRITE(0, st); else GS_WRITE(1, st); }
            __syncthreads();
        }
        run_epi<MASK>(S, cur, acc, wr, wc, fr, fq);
        ++ui;
    }
    __syncthreads();
#undef GS_SA
#undef GS_SB
#undef GS_LOAD
#undef GS_WRITE
}
}

DEV void transpose_item(const float* W, int K, int N, bf16_t* WT, LAS float* scr, int item, int lane) {
    const int nblk = N / 32, kb = item / nblk, nb = item % nblk, k0 = 64 * kb, n0 = 32 * nb;
#pragma unroll 8
    for (int i = 0; i < 32; ++i) { const int kk = 2 * i + (lane >> 5); scr[kk * 33 + (lane & 31)] = W[(size_t)(k0 + kk) * N + n0 + (lane & 31)]; }
    LDS_WAIT();
    const int c = lane & 7;
#pragma unroll
    for (int jj = 0; jj < 4; ++jj) { const int n = (lane >> 3) + 8 * jj; const LAS float* s = scr + (8 * c) * 33 + n;
        u32x4 o; o.x = pk2(s[0 * 33], s[1 * 33]); o.y = pk2(s[2 * 33], s[3 * 33]); o.z = pk2(s[4 * 33], s[5 * 33]); o.w = pk2(s[6 * 33], s[7 * 33]);
        *(u32x4*)(WT + (size_t)(n0 + n) * K + k0 + 8 * c) = o; }
    LDS_WAIT();
}

DEV void phase_weights(unsigned char* ws, const float* w_in, const float* w_oa, const float* w_os, const float* w_og, const float* w_o, const float* w_up, const float* w_dn, LAS unsigned char* lds, int gw, int NGW, int wave, int lane) {
    LAS float* scr = (LAS float*)(lds + wave * 8704);
    constexpr int I_IN = 16 * (INW / 32), I_SQ = 16 * 32, I_UP = 16 * 128, I_DN = 64 * 32;
    constexpr int NIT = I_IN + 4 * I_SQ + I_UP + I_DN;
    for (int it = gw; it < NIT; it += NGW) {
        int r = it;
        if (r < I_IN) { transpose_item(w_in, 1024, INW, (bf16_t*)(ws + WS_WIN), scr, r, lane); continue; } r -= I_IN;
        if (r < I_SQ) { transpose_item(w_oa, 1024, 1024, (bf16_t*)(ws + WS_WOA), scr, r, lane); continue; } r -= I_SQ;
        if (r < I_SQ) { transpose_item(w_os, 1024, 1024, (bf16_t*)(ws + WS_WOS), scr, r, lane); continue; } r -= I_SQ;
        if (r < I_SQ) { transpose_item(w_og, 1024, 1024, (bf16_t*)(ws + WS_WOG), scr, r, lane); continue; } r -= I_SQ;
        if (r < I_SQ) { transpose_item(w_o, 1024, 1024, (bf16_t*)(ws + WS_WO), scr, r, lane); continue; } r -= I_SQ;
        if (r < I_UP) { transpose_item(w_up, 1024, 4096, (bf16_t*)(ws + WS_WUP), scr, r, lane); continue; } r -= I_UP;
        transpose_item(w_dn, 4096, 1024, (bf16_t*)(ws + WS_WDN), scr, r, lane);
    }
}

DEV void phase_rmsnorm_bf16(const float* x, const float* w, bf16_t* o, int nrows, int gw, int NGW, int lane) {
    for (int m = gw; m < nrows; m += NGW) {
        const f32x4* xr = (const f32x4*)(x + (size_t)m * DM) + lane;
        f32x4 v[4]; float s = 0.f;
#pragma unroll
        for (int j = 0; j < 4; ++j) { v[j] = xr[64 * j]; s += (v[j].x * v[j].x + v[j].y * v[j].y) + (v[j].z * v[j].z + v[j].w * v[j].w); }
        const float rstd = rsqrtf(wave_sum(s) * (1.f / DM) + EPS);
        u32x2* o8 = (u32x2*)(o + (size_t)m * DM) + lane;
#pragma unroll
        for (int j = 0; j < 4; ++j) { const f32x4 ww = ((const f32x4*)w)[lane + 64 * j]; u32x2 r; r.x = pk2(v[j].x * rstd * ww.x, v[j].y * rstd * ww.y); r.y = pk2(v[j].z * rstd * ww.z, v[j].w * rstd * ww.w); o8[64 * j] = r; }
    }
}
DEV void phase_rmsnorm_f32(float* x, const float* w, int nrows, int gw, int NGW, int lane) {
    for (int m = gw; m < nrows; m += NGW) {
        f32x4* xr = (f32x4*)(x + (size_t)m * DM) + lane;
        f32x4 v[4]; float s = 0.f;
#pragma unroll
        for (int j = 0; j < 4; ++j) { v[j] = xr[64 * j]; s += (v[j].x * v[j].x + v[j].y * v[j].y) + (v[j].z * v[j].z + v[j].w * v[j].w); }
        const float rstd = rsqrtf(wave_sum(s) * (1.f / DM) + EPS);
#pragma unroll
        for (int j = 0; j < 4; ++j) { const f32x4 ww = ((const f32x4*)w)[lane + 64 * j]; xr[64 * j] = v[j] * rstd * ww; }
    }
}

DEV void phase_narrow(const bf16_t* HB, const bf16_t* Wdt, const bf16_t* Wgk, float* DTGK, int gw, int NGW, int lane) {
    const int fr = lane & 15, fq = lane >> 4;
    for (int u = gw; u < HT / 16; u += NGW) {
        const int t0 = u * 16;
        f32x4 a0 = {0.f, 0.f, 0.f, 0.f}, a1 = {0.f, 0.f, 0.f, 0.f};
        const bf16_t* ap = HB + (size_t)(t0 + fr) * DM + fq * 8;
        const bf16_t* b0p = Wdt + (size_t)fr * DM + fq * 8;
        const bf16_t* b1p = Wgk + (size_t)fr * DM + fq * 8;
#pragma unroll 8
        for (int k = 0; k < DM; k += 32) {
            const bf16x8 a = *(const bf16x8*)(ap + k), b0 = *(const bf16x8*)(b0p + k), b1 = *(const bf16x8*)(b1p + k);
            a0 = mma(a, b0, a0); a1 = mma(a, b1, a1);
        }
#pragma unroll
        for (int j = 0; j < 4; ++j) { float* d = DTGK + (size_t)(t0 + 4 * fq + j) * 32; d[fr] = a0[j]; d[16 + fr] = a1[j]; }
    }
}

DEV void phase_conv_a(const bf16_t* __restrict__ UA, const float* __restrict__ cw, bf16_t* __restrict__ YIN, int gtid, int NT) {
    for (int u = gtid; u < (HT / 16) * 128; u += NT) {
        const int c0 = (u & 127) * 8, t0 = (u >> 7) * 16;
        float w0[8], w1[8], w2[8], p1[8], p2[8];
#pragma unroll
        for (int j = 0; j < 8; ++j) { w0[j] = cw[c0 + j]; w1[j] = cw[1024 + c0 + j]; w2[j] = cw[2048 + c0 + j]; p1[j] = 0.f; p2[j] = 0.f; }
        if ((t0 & (SEQ - 1)) != 0) {
            float ax[8], ac[8];
            unpack8(*(const u32x4*)(UA + (size_t)(t0 - 2) * 3072 + c0), ax); unpack8(*(const u32x4*)(UA + (size_t)(t0 - 2) * 3072 + 2048 + c0), ac);
#pragma unroll
            for (int j = 0; j < 8; ++j) p2[j] = ax[j] * ac[j];
            unpack8(*(const u32x4*)(UA + (size_t)(t0 - 1) * 3072 + c0), ax); unpack8(*(const u32x4*)(UA + (size_t)(t0 - 1) * 3072 + 2048 + c0), ac);
#pragma unroll
            for (int j = 0; j < 8; ++j) p1[j] = ax[j] * ac[j];
        }
#pragma unroll 4
        for (int i = 0; i < 16; ++i) {
            const bf16_t* rp = UA + (size_t)(t0 + i) * 3072 + c0;
            float ax[8], ab[8], ac[8], o[8];
            unpack8(*(const u32x4*)rp, ax); unpack8(*(const u32x4*)(rp + 1024), ab); unpack8(*(const u32x4*)(rp + 2048), ac);
#pragma unroll
            for (int j = 0; j < 8; ++j) { const float p0 = ax[j] * ac[j]; o[j] = ab[j] * (w0[j] * p2[j] + w1[j] * p1[j] + w2[j] * p0); p2[j] = p1[j]; p1[j] = p0; }
            *(u32x4*)(YIN + (size_t)(t0 + i) * DM + c0) = pack8(o);
        }
    }
}

DEV void phase_ssd_prep(unsigned char* ws, const float* cw, const float* cb, const float* dtb, const float* alog, int gtid, int NT, int tid, int nblk, int blk) {
    const bf16_t* __restrict__ XST = (const bf16_t*)(ws + RB_XST); bf16_t* __restrict__ XSTC = (bf16_t*)(ws + RB_XSTC);
    for (int u = gtid; u < 1024 * (HT / 8); u += NT) {
        const int tb = u & (HT / 8 - 1), c = u >> 11, t0 = tb * 8;
        float x[11], cur[8];
        unpack8(*(const u32x4*)(XST + (size_t)c * HT + t0), cur);
        if ((t0 & (SEQ - 1)) != 0) { float pv[8]; unpack8(*(const u32x4*)(XST + (size_t)c * HT + t0 - 8), pv); x[0] = pv[5]; x[1] = pv[6]; x[2] = pv[7]; }
        else { x[0] = 0.f; x[1] = 0.f; x[2] = 0.f; }
#pragma unroll
        for (int i = 0; i < 8; ++i) x[3 + i] = cur[i];
        const float w0 = cw[c], w1 = cw[2048 + c], w2 = cw[4096 + c], w3 = cw[6144 + c], b = cb[c];
        float y[8];
#pragma unroll
        for (int i = 0; i < 8; ++i) y[i] = siluf_(b + w0 * x[i] + w1 * x[i + 1] + w2 * x[i + 2] + w3 * x[i + 3]);
        *(u32x4*)(XSTC + (size_t)c * HT + t0) = pack8(y);
    }
    const bf16_t* __restrict__ BC = (const bf16_t*)(ws + RB_BC); bf16_t* __restrict__ BCC = (bf16_t*)(ws + RB_BCC); bf16_t* __restrict__ BTC = (bf16_t*)(ws + RB_BTC);
    for (int u = gtid; u < (HT / 8) * 128; u += NT) {
        const int cg8 = u & 127, c0 = cg8 * 8, t0 = (u >> 7) * 8, cc = 1024 + c0;
        float w0[8], w1[8], w2[8], w3[8], bb[8], x1[8], x2[8], x3[8];
#pragma unroll
        for (int j = 0; j < 8; ++j) { w0[j] = cw[cc + j]; w1[j] = cw[2048 + cc + j]; w2[j] = cw[4096 + cc + j]; w3[j] = cw[6144 + cc + j]; bb[j] = cb[cc + j]; x1[j] = 0.f; x2[j] = 0.f; x3[j] = 0.f; }
        if ((t0 & (SEQ - 1)) != 0) {
            unpack8(*(const u32x4*)(BC + (size_t)(t0 - 1) * DM + c0), x1); unpack8(*(const u32x4*)(BC + (size_t)(t0 - 2) * DM + c0), x2); unpack8(*(const u32x4*)(BC + (size_t)(t0 - 3) * DM + c0), x3);
        }
        unsigned tr[8][4];
#pragma unroll
        for (int i = 0; i < 8; ++i) {
            float x0[8], y[8];
            unpack8(*(const u32x4*)(BC + (size_t)(t0 + i) * DM + c0), x0);
#pragma unroll
            for (int j = 0; j < 8; ++j) { y[j] = siluf_(bb[j] + w3[j] * x0[j] + w2[j] * x1[j] + w1[j] * x2[j] + w0[j] * x3[j]); x3[j] = x2[j]; x2[j] = x1[j]; x1[j] = x0[j]; }
            *(u32x4*)(BCC + (size_t)(t0 + i) * DM + c0) = pack8(y);
#pragma unroll
            for (int j = 0; j < 8; ++j) { if (i & 1) tr[j][i >> 1] |= f2bf(y[j]) << 16; else tr[j][i >> 1] = f2bf(y[j]); }
        }
        if (cg8 < 64) {
#pragma unroll
            for (int j = 0; j < 8; ++j) *(u32x4*)(BTC + (size_t)(c0 + j) * HT + t0) = (u32x4){tr[j][0], tr[j][1], tr[j][2], tr[j][3]};
        }
    }
    const float* __restrict__ DTGK = (const float*)(ws + WS_DTGK); float* __restrict__ DT = (float*)(ws + RB_DT); float* __restrict__ AC = (float*)(ws + RB_ACUM);
    {
        const int lane_ = tid & 63, gw_ = blk * NWAVES + (tid >> 6), ngw_ = nblk * NWAVES;
        for (int ch = gw_; ch < HT / 128; ch += ngw_) {
            const size_t tA = (size_t)ch * 128 + 2 * lane_;
            float d0[16], d1[16];
#pragma unroll
            for (int q = 0; q < 4; ++q) { const f32x4 a = *(const f32x4*)(DTGK + tA * 32 + 4 * q), b = *(const f32x4*)(DTGK + (tA + 1) * 32 + 4 * q);
#pragma unroll
                for (int e = 0; e < 4; ++e) { d0[4 * q + e] = a[e]; d1[4 * q + e] = b[e]; } }
            float c0[16], c1[16];
#pragma unroll
            for (int h = 0; h < 16; ++h) {
                const float av = -__expf(alog[h]), bias = dtb[h];
                d0[h] = softplusf_(d0[h] + bias); d1[h] = softplusf_(d1[h] + bias);
                const float x0 = d0[h] * av, x1 = x0 + d1[h] * av;
                float s = x1;
#pragma unroll
                for (int off = 1; off < 64; off <<= 1) { const float y = __shfl_up(s, off); if (lane_ >= off) s += y; }
                const float pre = s - x1; c0[h] = pre + x0; c1[h] = pre + x1;
            }
#pragma unroll
            for (int q = 0; q < 4; ++q) {
                *(f32x4*)(DT + tA * 16 + 4 * q) = (f32x4){d0[4 * q], d0[4 * q + 1], d0[4 * q + 2], d0[4 * q + 3]};
                *(f32x4*)(DT + (tA + 1) * 16 + 4 * q) = (f32x4){d1[4 * q], d1[4 * q + 1], d1[4 * q + 2], d1[4 * q + 3]};
                *(f32x4*)(AC + tA * 16 + 4 * q) = (f32x4){c0[4 * q], c0[4 * q + 1], c0[4 * q + 2], c0[4 * q + 3]};
                *(f32x4*)(AC + (tA + 1) * 16 + 4 * q) = (f32x4){c1[4 * q], c1[4 * q + 1], c1[4 * q + 2], c1[4 * q + 3]};
            }
        }
    }
}

DEV void phase_ssd_states(unsigned char* ws, LAS unsigned char* lds, int tid, int wave, int lane) {
    const bf16_t* XSTC = (const bf16_t*)(ws + RB_XSTC); const bf16_t* BTC = (const bf16_t*)(ws + RB_BTC);
    const float* DT = (const float*)(ws + RB_DT); const float* AC = (const float*)(ws + RB_ACUM); bf16_t* ST = (bf16_t*)(ws + RB_ST);
    constexpr int BT_OFF = 0, XW_OFF = 34816, TAB_OFF = 34816 + 69632, RS = 272;
    LAS float* wt = (LAS float*)(lds + TAB_OFF);
    const int fr = lane & 15, fq = lane >> 4;
    for (int unit = blockIdx.x; unit < (HT / 128) * 4; unit += gridDim.x) {
        const int cidx = unit >> 2, g = unit & 3, t0 = cidx * 128;
        { const int r = tid >> 7, l = tid & 127, h = g * 4 + r;
          const float al = AC[(size_t)(t0 + 127) * 16 + h], a = AC[(size_t)(t0 + l) * 16 + h];
          wt[r * 128 + l] = DT[(size_t)(t0 + l) * 16 + h] * __expf(al - a); }
        for (int i = tid; i < 2048; i += NTHR) { const int row = i >> 4, ch = i & 15;
            *(LAS u32x4*)(lds + BT_OFF + row * RS + ch * 16) = *(const u32x4*)(BTC + (size_t)(g * 128 + row) * HT + t0 + ch * 8); }
        __syncthreads();
        for (int i = tid; i < 4096; i += NTHR) { const int row = i >> 4, ch = i & 15; float f[8];
            unpack8(*(const u32x4*)(XSTC + (size_t)(g * 256 + row) * HT + t0 + ch * 8), f);
            const LAS float* wp = wt + (row >> 6) * 128 + ch * 8;
#pragma unroll
            for (int e = 0; e < 8; ++e) f[e] *= wp[e];
            *(LAS u32x4*)(lds + XW_OFF + row * RS + ch * 16) = pack8(f); }
        __syncthreads();
        f32x4 acc[2][8];
#pragma unroll
        for (int a = 0; a < 2; ++a)
#pragma unroll
            for (int b = 0; b < 8; ++b) acc[a][b] = (f32x4){0.f, 0.f, 0.f, 0.f};
#pragma unroll
        for (int ks = 0; ks < 4; ++ks) {
            const bf16x8 y0 = ldsfrag(lds + XW_OFF + (wave * 32 + fr) * RS + ks * 64 + fq * 16), y1 = ldsfrag(lds + XW_OFF + (wave * 32 + 16 + fr) * RS + ks * 64 + fq * 16);
#pragma unroll
            for (int nt = 0; nt < 8; ++nt) { const bf16x8 x = ldsfrag(lds + BT_OFF + (nt * 16 + fr) * RS + ks * 64 + fq * 16); acc[0][nt] = mma(x, y0, acc[0][nt]); acc[1][nt] = mma(x, y1, acc[1][nt]); }
        }
#pragma unroll
        for (int yt = 0; yt < 2; ++yt) { const int pp = wave * 32 + yt * 16 + fr, h = g * 4 + (pp >> 6), p = pp & 63;
            bf16_t* d = ST + (((size_t)cidx * 16 + h) * 64 + p) * 128 + 4 * fq;
#pragma unroll
            for (int nt = 0; nt < 8; ++nt) { u32x2 w; w.x = pk2(acc[yt][nt][0], acc[yt][nt][1]); w.y = pk2(acc[yt][nt][2], acc[yt][nt][3]); *(u32x2*)(d + nt * 16) = w; } }
        __syncthreads();
    }
}

DEV void phase_ssd_scan(unsigned char* ws, int gtid, int NT) {
    unsigned* ST = (unsigned*)(ws + RB_ST); const float* AC = (const float*)(ws + RB_ACUM);
    for (int e = gtid; e < 2 * 65536; e += NT) {
        const int bl = e >> 16, rem = e & 65535, h = rem >> 12;
        f32x2 carry = {0.f, 0.f};
        for (int c0 = 0; c0 < 64; c0 += 8) {
            unsigned v[8]; float dec[8];
#pragma unroll
            for (int i = 0; i < 8; ++i) { const int cidx = bl * 64 + c0 + i; v[i] = ST[(size_t)cidx * 65536 + rem]; dec[i] = __expf(AC[((size_t)cidx * 128 + 127) * 16 + h]); }
#pragma unroll
            for (int i = 0; i < 8; ++i) { const int cidx = bl * 64 + c0 + i; ST[(size_t)cidx * 65536 + rem] = pk2(carry[0], carry[1]);
                carry[0] = carry[0] * dec[i] + bf_lo(v[i]); carry[1] = carry[1] * dec[i] + bf_hi(v[i]); }
        }
    }
}

DEV void phase_ssd_out(unsigned char* ws, const float* dsk, const float* nw, LAS unsigned char* lds, int tid, int wave, int lane) {
    const bf16_t* XSTC = (const bf16_t*)(ws + RB_XSTC); const bf16_t* BCC = (const bf16_t*)(ws + RB_BCC); const bf16_t* Z = (const bf16_t*)(ws + RB_Z);
    const float* DT = (const float*)(ws + RB_DT); const float* AC = (const float*)(ws + RB_ACUM); const bf16_t* ST = (const bf16_t*)(ws + RB_ST);
    bf16_t* YIN = (bf16_t*)(ws + WS_YIN);
    float* YT = (float*)(ws + RB_XST);
    constexpr int C_OFF = 0, B_OFF = 34816, PV_OFF = 34816, XS_OFF = 34816 + 17408, M_OFF = 69632, TAB_OFF = 104448, RS = 272;
    LAS float* tac = (LAS float*)(lds + TAB_OFF); LAS float* tdt = tac + 512;
    const int fr = lane & 15, fq = lane >> 4;
    LAS unsigned char* Mw = lds + M_OFF + wave * 4352;
    for (int unit = blockIdx.x; unit < (HT / 128) * 4; unit += gridDim.x) {
        const int cidx = unit >> 2, g = unit & 3, t0 = cidx * 128;
        for (int i = tid; i < 2048; i += NTHR) { const int row = i >> 4, ch = i & 15;
            *(LAS u32x4*)(lds + C_OFF + row * RS + ch * 16) = *(const u32x4*)(BCC + (size_t)(t0 + row) * DM + 512 + g * 128 + ch * 8);
            *(LAS u32x4*)(lds + B_OFF + row * RS + ch * 16) = *(const u32x4*)(BCC + (size_t)(t0 + row) * DM + g * 128 + ch * 8); }
        { const int r = tid >> 7, l = tid & 127, h = g * 4 + r; tac[tid] = AC[(size_t)(t0 + l) * 16 + h]; tdt[tid] = DT[(size_t)(t0 + l) * 16 + h]; }
        __syncthreads();
        f32x4 cb[8];
#pragma unroll
        for (int st = 0; st < 8; ++st) cb[st] = (f32x4){0.f, 0.f, 0.f, 0.f};
#pragma unroll
        for (int ks = 0; ks < 4; ++ks) {
            const bf16x8 y = ldsfrag(lds + C_OFF + (wave * 16 + fr) * RS + ks * 64 + fq * 16);
#pragma unroll
            for (int st = 0; st < 8; ++st) cb[st] = mma(ldsfrag(lds + B_OFF + (st * 16 + fr) * RS + ks * 64 + fq * 16), y, cb[st]);
        }
        __syncthreads();
        const int l = wave * 16 + fr;
        const size_t t = (size_t)(t0 + l);
        float ssq = 0.f;
        u32x4 pvr0, pvr1, xsr0, xsr1; u32x2 zr[4];
#define SSD_LOADH(RR) do { const int h_ = g * 4 + (RR); const int row_ = tid >> 4, ch_ = tid & 15; \
            pvr0 = *(const u32x4*)(ST + (((size_t)cidx * 16 + h_) * 64 + row_) * 128 + ch_ * 8); pvr1 = *(const u32x4*)(ST + (((size_t)cidx * 16 + h_) * 64 + row_ + 32) * 128 + ch_ * 8); \
            xsr0 = *(const u32x4*)(XSTC + (size_t)(h_ * 64 + row_) * HT + t0 + ch_ * 8); xsr1 = *(const u32x4*)(XSTC + (size_t)(h_ * 64 + row_ + 32) * HT + t0 + ch_ * 8); \
            _Pragma("unroll") for (int pt_ = 0; pt_ < 4; ++pt_) zr[pt_] = *(const u32x2*)(Z + t * DM + g * 256 + (RR) * 64 + pt_ * 16 + 4 * fq); } while (0)
        SSD_LOADH(0);
#pragma unroll 1
        for (int r = 0; r < 4; ++r) {
            const int h = g * 4 + r;
            { const int row_ = tid >> 4, ch_ = tid & 15;
              *(LAS u32x4*)(lds + PV_OFF + row_ * RS + ch_ * 16) = pvr0; *(LAS u32x4*)(lds + PV_OFF + (row_ + 32) * RS + ch_ * 16) = pvr1;
              *(LAS u32x4*)(lds + XS_OFF + row_ * RS + ch_ * 16) = xsr0; *(LAS u32x4*)(lds + XS_OFF + (row_ + 32) * RS + ch_ * 16) = xsr1; }
            u32x2 zc[4];
#pragma unroll
            for (int pt = 0; pt < 4; ++pt) zc[pt] = zr[pt];
            const float al = tac[r * 128 + l];
#pragma unroll
            for (int st = 0; st < 8; ++st) { float m[4];
#pragma unroll
                for (int j = 0; j < 4; ++j) { const int s = st * 16 + 4 * fq + j; const float d = fminf(al - tac[r * 128 + s], 0.f); m[j] = (s <= l) ? cb[st][j] * __expf(d) * tdt[r * 128 + s] : 0.f; }
                u32x2 w; w.x = pk2(m[0], m[1]); w.y = pk2(m[2], m[3]); *(LAS u32x2*)(Mw + fr * RS + (st * 16 + 4 * fq) * 2) = w; }
            __syncthreads();
            if (r < 3) SSD_LOADH(r + 1);
            f32x4 acc[4];
#pragma unroll
            for (int pt = 0; pt < 4; ++pt) acc[pt] = (f32x4){0.f, 0.f, 0.f, 0.f};
#pragma unroll
            for (int ks = 0; ks < 4; ++ks) { const bf16x8 y = ldsfrag(lds + C_OFF + l * RS + ks * 64 + fq * 16);
#pragma unroll
                for (int pt = 0; pt < 4; ++pt) acc[pt] = mma(ldsfrag(lds + PV_OFF + (pt * 16 + fr) * RS + ks * 64 + fq * 16), y, acc[pt]); }
            const float el = __expf(al);
#pragma unroll
            for (int pt = 0; pt < 4; ++pt) acc[pt] *= el;
#pragma unroll
            for (int ks = 0; ks < 4; ++ks) { const bf16x8 y = ldsfrag(Mw + fr * RS + ks * 64 + fq * 16);
#pragma unroll
                for (int pt = 0; pt < 4; ++pt) acc[pt] = mma(ldsfrag(lds + XS_OFF + (pt * 16 + fr) * RS + ks * 64 + fq * 16), y, acc[pt]); }
            const float dh = dsk[h];
#pragma unroll
            for (int pt = 0; pt < 4; ++pt) {
#pragma unroll
                for (int j = 0; j < 4; ++j) { const bf16_t xv = *(const LAS bf16_t*)(lds + XS_OFF + (pt * 16 + 4 * fq + j) * RS + l * 2); acc[pt][j] += dh * bf1(xv); }
                const int c = g * 256 + r * 64 + pt * 16 + 4 * fq;
                const u32x2 zw = zc[pt];
                f32x4 v = acc[pt]; v[0] *= bf_lo(zw.x); v[1] *= bf_hi(zw.x); v[2] *= bf_lo(zw.y); v[3] *= bf_hi(zw.y);
                ssq += (v[0] * v[0] + v[1] * v[1]) + (v[2] * v[2] + v[3] * v[3]);
                *(f32x4*)(YT + t * DM + c) = v;
            }
            __syncthreads();
        }
        ssq += __shfl_xor(ssq, 16); ssq += __shfl_xor(ssq, 32);
        const float rstd = rsqrtf(ssq * (1.f / 256.f) + EPS);
#pragma unroll 4
        for (int q = 0; q < 16; ++q) { const int c = g * 256 + q * 16 + 4 * fq;
            const f32x4 w4 = *(const f32x4*)(nw + c); const f32x4 v = *(const f32x4*)(YT + t * DM + c);
            u32x2 o; o.x = pk2(v[0] * rstd * w4[0], v[1] * rstd * w4[1]); o.y = pk2(v[2] * rstd * w4[2], v[3] * rstd * w4[3]);
            *(u32x2*)(YIN + t * DM + c) = o; }
        __syncthreads();
    }
}

DEV float gla_gk(const float* DTGK, size_t t, const float (&w)[16], float b) {
    const f32x4* gl = (const f32x4*)(DTGK + t * 32 + 16);
    const f32x4 g0 = gl[0], g1 = gl[1], g2 = gl[2], g3 = gl[3];
    float z = b;
    z += g0[0] * w[0] + g0[1] * w[1] + g0[2] * w[2] + g0[3] * w[3];
    z += g1[0] * w[4] + g1[1] * w[5] + g1[2] * w[6] + g1[3] * w[7];
    z += g2[0] * w[8] + g2[1] * w[9] + g2[2] * w[10] + g2[3] * w[11];
    z += g3[0] * w[12] + g3[1] * w[13] + g3[2] * w[14] + g3[3] * w[15];
    return logsigf_(z) * (1.f / 16.f);
}
DEV void phase_gla_prep(unsigned char* ws, const float* __restrict__ w2, const float* __restrict__ bg, int gtid, int NT) {
    bf16_t* QK = (bf16_t*)(ws + RC_QK); bf16_t* __restrict__ KT = (bf16_t*)(ws + RC_KT); float* __restrict__ DEC = (float*)(ws + WS_DEC);
    const float* __restrict__ DTGK = (const float*)(ws + WS_DTGK);
    const int lane = gtid & 63, gwv = gtid >> 6, nwv = NT >> 6;
    for (int u = gwv; u < (HT / 64) * 64; u += nwv) {
        const int cg = u & 63, ch = u >> 6, d0 = cg * 8; const size_t t = (size_t)ch * 64 + lane;
        const f32x4* gl = (const f32x4*)(DTGK + t * 32 + 16);
        const f32x4 g0 = gl[0], g1 = gl[1], g2 = gl[2], g3 = gl[3];
        const float glv[16] = {g0[0], g0[1], g0[2], g0[3], g1[0], g1[1], g1[2], g1[3], g2[0], g2[1], g2[2], g2[3], g3[0], g3[1], g3[2], g3[3]};
        bf16_t* qp = QK + t * DM + d0;
        float q[8], k[8]; unpack8(*(const u32x4*)qp, q); unpack8(*(const u32x4*)(qp + 512), k);
        float z[8];
        { const f32x4 b0 = *(const f32x4*)(bg + d0), b1 = *(const f32x4*)(bg + d0 + 4);
#pragma unroll
          for (int c = 0; c < 4; ++c) { z[c] = b0[c]; z[4 + c] = b1[c]; } }
#pragma unroll
        for (int j = 0; j < 16; ++j) { const f32x4 wa = *(const f32x4*)(w2 + j * 512 + d0), wb = *(const f32x4*)(w2 + j * 512 + d0 + 4);
#pragma unroll
            for (int c = 0; c < 4; ++c) { z[c] += glv[j] * wa[c]; z[4 + c] += glv[j] * wb[c]; } }
        float qo[8], ko[8], dec8[8];
#pragma unroll
        for (int c = 0; c < 8; ++c) {
            float s = logsigf_(z[c]) * (1.f / 16.f);
#pragma unroll
            for (int off = 1; off < 64; off <<= 1) { const float y = __shfl_up(s, off); if (lane >= off) s += y; }
            const float glast = __shfl(s, 63);
            qo[c] = q[c] * 0.08838834764831845f * __expf(s);
            ko[c] = k[c] * __expf(-s);
            KT[(size_t)(d0 + c) * HT + t] = (bf16_t)f2bf(k[c] * __expf(glast - s));
            dec8[c] = __expf(glast);
        }
        *(u32x4*)qp = pack8(qo); *(u32x4*)(qp + 512) = pack8(ko);
        if (lane == 63) { float* dp = DEC + (size_t)ch * 512 + d0; *(f32x4*)dp = (f32x4){dec8[0], dec8[1], dec8[2], dec8[3]}; *(f32x4*)(dp + 4) = (f32x4){dec8[4], dec8[5], dec8[6], dec8[7]}; }
    }
}

DEV void phase_gla_states(unsigned char* ws, LAS unsigned char* lds, int tid, int wave, int lane) {
    const bf16_t* KT = (const bf16_t*)(ws + RC_KT); const bf16_t* VT = (const bf16_t*)(ws + RC_VT); bf16_t* ST = (bf16_t*)(ws + RC_ST);
    constexpr int V_OFF = 0, K_OFF = 36864, RS = 144;
    const int fr = lane & 15, fq = lane >> 4;
    for (int unit = blockIdx.x; unit < (HT / 64) * 4; unit += gridDim.x) {
        const int cidx = unit >> 2, h = unit & 3, t0 = cidx * 64;
        for (int i = tid; i < 2048; i += NTHR) { const int row = i >> 3, ch = i & 7;
            *(LAS u32x4*)(lds + V_OFF + row * RS + ch * 16) = *(const u32x4*)(VT + (size_t)(h * 256 + row) * HT + t0 + ch * 8); }
        for (int i = tid; i < 1024; i += NTHR) { const int row = i >> 3, ch = i & 7;
            *(LAS u32x4*)(lds + K_OFF + row * RS + ch * 16) = *(const u32x4*)(KT + (size_t)(h * 128 + row) * HT + t0 + ch * 8); }
        __syncthreads();
        f32x4 acc[2][8];
#pragma unroll
        for (int a = 0; a < 2; ++a)
#pragma unroll
            for (int b = 0; b < 8; ++b) acc[a][b] = (f32x4){0.f, 0.f, 0.f, 0.f};
#pragma unroll
        for (int ks = 0; ks < 2; ++ks) {
            const bf16x8 y0 = ldsfrag(lds + V_OFF + (wave * 32 + fr) * RS + ks * 64 + fq * 16), y1 = ldsfrag(lds + V_OFF + (wave * 32 + 16 + fr) * RS + ks * 64 + fq * 16);
#pragma unroll
            for (int dt = 0; dt < 8; ++dt) { const bf16x8 x = ldsfrag(lds + K_OFF + (dt * 16 + fr) * RS + ks * 64 + fq * 16); acc[0][dt] = mma(x, y0, acc[0][dt]); acc[1][dt] = mma(x, y1, acc[1][dt]); }
        }
#pragma unroll
        for (int yt = 0; yt < 2; ++yt) { const int v = wave * 32 + yt * 16 + fr;
            bf16_t* dp = ST + (((size_t)cidx * 4 + h) * 256 + v) * 128 + 4 * fq;
#pragma unroll
            for (int dt = 0; dt < 8; ++dt) { u32x2 w; w.x = pk2(acc[yt][dt][0], acc[yt][dt][1]); w.y = pk2(acc[yt][dt][2], acc[yt][dt][3]); *(u32x2*)(dp + dt * 16) = w; } }
        __syncthreads();
    }
}

DEV void phase_gla_scan(unsigned char* ws, int gtid, int NT) {
    unsigned* ST = (unsigned*)(ws + RC_ST); const float* DEC = (const float*)(ws + WS_DEC);
    for (int e = gtid; e < 2 * 65536; e += NT) {
        const int bl = e >> 16, rem = e & 65535, h = rem >> 14, d = (rem * 2) & 127;
        f32x2 carry = {0.f, 0.f};
        for (int c0 = 0; c0 < 128; c0 += 8) {
            unsigned v[8]; f32x2 dec[8];
#pragma unroll
            for (int i = 0; i < 8; ++i) { const int cidx = bl * 128 + c0 + i; v[i] = ST[(size_t)cidx * 65536 + rem]; dec[i] = *(const f32x2*)(DEC + (size_t)cidx * 512 + h * 128 + d); }
#pragma unroll
            for (int i = 0; i < 8; ++i) { const int cidx = bl * 128 + c0 + i; ST[(size_t)cidx * 65536 + rem] = pk2(carry[0], carry[1]);
                carry[0] = carry[0] * dec[i][0] + bf_lo(v[i]); carry[1] = carry[1] * dec[i][1] + bf_hi(v[i]); }
        }
    }
}

DEV void phase_gla_out(unsigned char* ws, const float* nw, LAS unsigned char* lds, int tid, int wave, int lane) {
    const bf16_t* QK = (const bf16_t*)(ws + RC_QK); const bf16_t* VT = (const bf16_t*)(ws + RC_VT); const bf16_t* GS = (const bf16_t*)(ws + RC_GS);
    const bf16_t* ST = (const bf16_t*)(ws + RC_ST); bf16_t* YIN = (bf16_t*)(ws + WS_YIN);
    constexpr int Q_OFF = 0, K_OFF = 17408, V_OFF = 34816, P_OFF = 71680, S_OFF = 80896, RSD = 272, RST = 144;
    LAS float* ssqt = (LAS float*)(lds + S_OFF);
    const int fr = lane & 15, fq = lane >> 4, lt = wave >> 1, vh = wave & 1;
    for (int unit = blockIdx.x; unit < (HT / 64) * 4; unit += gridDim.x) {
        const int cidx = unit >> 2, h = unit & 3, t0 = cidx * 64;
        for (int i = tid; i < 1024; i += NTHR) { const int row = i >> 4, ch = i & 15;
            *(LAS u32x4*)(lds + Q_OFF + row * RSD + ch * 16) = *(const u32x4*)(QK + (size_t)(t0 + row) * DM + h * 128 + ch * 8);
            *(LAS u32x4*)(lds + K_OFF + row * RSD + ch * 16) = *(const u32x4*)(QK + (size_t)(t0 + row) * DM + 512 + h * 128 + ch * 8); }
        for (int i = tid; i < 2048; i += NTHR) { const int row = i >> 3, ch = i & 7;
            *(LAS u32x4*)(lds + V_OFF + row * RST + ch * 16) = *(const u32x4*)(VT + (size_t)(h * 256 + row) * HT + t0 + ch * 8); }
        __syncthreads();
        const int l = lt * 16 + fr;
        {
            f32x4 sc[2] = {(f32x4){0.f, 0.f, 0.f, 0.f}, (f32x4){0.f, 0.f, 0.f, 0.f}};
#pragma unroll
            for (int ks = 0; ks < 4; ++ks) { const bf16x8 y = ldsfrag(lds + Q_OFF + l * RSD + ks * 64 + fq * 16);
#pragma unroll
                for (int i = 0; i < 2; ++i) sc[i] = mma(ldsfrag(lds + K_OFF + ((2 * vh + i) * 16 + fr) * RSD + ks * 64 + fq * 16), y, sc[i]); }
#pragma unroll
            for (int i = 0; i < 2; ++i) { const int s0 = (2 * vh + i) * 16 + 4 * fq; float m[4];
#pragma unroll
                for (int j = 0; j < 4; ++j) m[j] = (s0 + j <= l) ? sc[i][j] : 0.f;
                u32x2 w; w.x = pk2(m[0], m[1]); w.y = pk2(m[2], m[3]); *(LAS u32x2*)(lds + P_OFF + l * RST + s0 * 2) = w; }
        }
        __syncthreads();
        f32x4 acc[8];
#pragma unroll
        for (int i = 0; i < 8; ++i) acc[i] = (f32x4){0.f, 0.f, 0.f, 0.f};
#pragma unroll
        for (int ks = 0; ks < 2; ++ks) { const bf16x8 y = ldsfrag(lds + P_OFF + l * RST + ks * 64 + fq * 16);
#pragma unroll
            for (int i = 0; i < 8; ++i) acc[i] = mma(ldsfrag(lds + V_OFF + ((vh * 8 + i) * 16 + fr) * RST + ks * 64 + fq * 16), y, acc[i]); }
        const bf16_t* sp = ST + (((size_t)cidx * 4 + h) * 256 + vh * 128 + fr) * 128 + fq * 8;
#pragma unroll
        for (int ks = 0; ks < (GLA_NO_INTER ? 0 : 4); ++ks) { const bf16x8 y = ldsfrag(lds + Q_OFF + l * RSD + ks * 64 + fq * 16);
#pragma unroll
            for (int i = 0; i < 8; ++i) acc[i] = mma(*(const bf16x8*)(sp + (size_t)i * 16 * 128 + ks * 32), y, acc[i]); }
        float ssq = 0.f;
#pragma unroll
        for (int i = 0; i < 8; ++i) ssq += (acc[i][0] * acc[i][0] + acc[i][1] * acc[i][1]) + (acc[i][2] * acc[i][2] + acc[i][3] * acc[i][3]);
        ssq += __shfl_xor(ssq, 16); ssq += __shfl_xor(ssq, 32);
        if (fq == 0) ssqt[l * 2 + vh] = ssq;
        __syncthreads();
        const float rstd = rsqrtf((ssqt[l * 2] + ssqt[l * 2 + 1]) * (1.f / 256.f) + EPS);
        const size_t t = (size_t)(t0 + l);
#pragma unroll
        for (int i = 0; i < 8; ++i) { const int v = (vh * 8 + i) * 16 + 4 * fq, c = h * 256 + v;
            const u32x2 gw = *(const u32x2*)(GS + t * DM + c); const f32x4 w4 = *(const f32x4*)(nw + v);
            u32x2 o; o.x = pk2(acc[i][0] * rstd * w4[0] * bf_lo(gw.x), acc[i][1] * rstd * w4[1] * bf_hi(gw.x));
            o.y = pk2(acc[i][2] * rstd * w4[2] * bf_lo(gw.y), acc[i][3] * rstd * w4[3] * bf_hi(gw.y));
            *(u32x2*)(YIN + t * DM + c) = o; }
        __syncthreads();
    }
}


#define XB_TMO      128
#define XB_XCNT(j)  (256  + 64 * (j))
#define XB_XSUB(j)  (1280 + 64 * (j))
#define XB_XGEN(j)  (2304 + 64 * (j))
#define XB_TOP      3328
#define XB_TOPGEN   3392
#define XCD_BAR_WORDS 3456
#define XB_SPIN_CAP (1u << 22)
DEV unsigned xb_ld(unsigned* p)              { return __hip_atomic_load(p, __ATOMIC_RELAXED, __HIP_MEMORY_SCOPE_AGENT); }
DEV unsigned xb_add(unsigned* p, unsigned v) { return __hip_atomic_fetch_add(p, v, __ATOMIC_RELAXED, __HIP_MEMORY_SCOPE_AGENT); }
DEV unsigned xb_xcc_id() { return (unsigned)__builtin_amdgcn_s_getreg((3 << 11) | 20) & 0xFu; }
#define XB_SPIN(cond, bar) do { unsigned _sp = 0; while (cond) { __builtin_amdgcn_s_sleep(1); \
    if ((++_sp & 255u) == 0u) { if (xb_ld(&(bar)[XB_TMO])) break; if (_sp > XB_SPIN_CAP) { atomicAdd(&(bar)[XB_TMO], 1u); break; } } } } while (0)
DEV void xcd_barrier_complete(unsigned* bar, unsigned x, unsigned Gn, unsigned& nloc, unsigned& nx) {
    unsigned sum, cnt, mine, sp = 0u;
    for (;;) {
        sum = 0u; cnt = 0u; mine = 0u;
#pragma unroll
        for (unsigned j = 0; j < 16; ++j) { const unsigned c = xb_ld(&bar[XB_XCNT(j)]); sum += c; cnt += (c > 0u) ? 1u : 0u; mine = (j == x) ? c : mine; }
        if (sum == Gn) break;
        __builtin_amdgcn_s_sleep(1);
        if ((++sp & 255u) == 0u) { if (xb_ld(&bar[XB_TMO])) break; if (sp > XB_SPIN_CAP) { atomicAdd(&bar[XB_TMO], 1u); break; } }
    }
    nloc = mine > 0u ? mine : 1u; nx = cnt > 0u ? cnt : 1u;
}
DEV void xcd_barrier(unsigned* bar, unsigned x, volatile LAS unsigned* st, int tid, unsigned Gn) {
    asm volatile("s_waitcnt vmcnt(0)" ::: "memory");
    __syncthreads();
    if (tid == 0) {
        __builtin_amdgcn_s_waitcnt(0);
        unsigned nloc = st[0], nx = st[1];
        if (nloc == 0u) { xcd_barrier_complete(bar, x, Gn, nloc, nx); st[0] = nloc; st[1] = nx; }
        const unsigned old = xb_add(&bar[XB_XSUB(x)], 1u);
        const unsigned gen = old / nloc;
        if (old + 1u == (gen + 1u) * nloc) {
            __builtin_amdgcn_fence(__ATOMIC_RELEASE, "agent");
            asm volatile("s_waitcnt vmcnt(0)" ::: "memory");
            const unsigned og = xb_add(&bar[XB_TOP], 1u);
            const unsigned tg = og / nx;
            if (og + 1u == (tg + 1u) * nx) xb_add(&bar[XB_TOPGEN], 1u);
            else XB_SPIN(xb_ld(&bar[XB_TOPGEN]) == tg, bar);
            __builtin_amdgcn_fence(__ATOMIC_ACQUIRE, "agent");
            xb_add(&bar[XB_XGEN(x)], 1u);
            asm volatile("s_waitcnt vmcnt(0)" ::: "memory");
        } else {
            XB_SPIN(xb_ld(&bar[XB_XGEN(x)]) == gen, bar);
            __builtin_amdgcn_fence(__ATOMIC_ACQUIRE, "agent");
            asm volatile("s_waitcnt vmcnt(0)" ::: "memory");
        }
    }
    __syncthreads();
}

typedef const __attribute__((address_space(4))) Params* KParams;
DEV KParams kargs() { unsigned long long kp = (unsigned long long)__builtin_amdgcn_kernarg_segment_ptr(); asm volatile("" : "+s"(kp)); return (KParams)kp; }

__global__ void __launch_bounds__(NTHR, 2) mega_fwd(Params Parg, int pc_lo, int pc_hi, int coop, int pad_) {
    extern __shared__ __attribute__((aligned(16))) unsigned char smem[];
    cg::grid_group grid = cg::this_grid();
    if (coop) grid.sync();
    volatile LAS unsigned* xst = (volatile LAS unsigned*)((LAS unsigned char*)smem + 139264 - 16);
    const unsigned xcc = xb_xcc_id();
    if (threadIdx.x == 0) { xst[0] = 0u; xst[1] = 0u; (void)xb_add((unsigned*)(asglobal(kargs()->ws) + WS_BAR) + XB_XCNT(xcc), 1u); }
    __syncthreads();
    using pg8::Sched; using pg8::job_put;
    constexpr int PER_LAYER = 1 + 34 + 3, NPC = 2 * PER_LAYER + 1;
#pragma unroll 1
    for (int pc0 = pc_lo; pc0 < pc_hi; ++pc0) {
        int pc = pc0; asm volatile("" : "+s"(pc));
        int tid = threadIdx.x; asm volatile("" : "+v"(tid));
        const int lane = tid & 63, wave = __builtin_amdgcn_readfirstlane(tid >> 6);
        unsigned ldso = 0; asm volatile("" : "+s"(ldso));
        LAS unsigned char* lds = (LAS unsigned char*)smem + ldso;
        int bxv = blockIdx.x, gdv = gridDim.x; asm volatile("" : "+s"(bxv), "+s"(gdv));
        const int layer = pc / PER_LAYER; const int r = pc - layer * PER_LAYER;
        int ph, hf = 0;
        if (pc == NPC - 1) ph = 21; else if (r == 0) ph = 0; else if (r <= 34) { hf = (r - 1) / 17; ph = (r - 1) - hf * 17 + 1; } else ph = 18 + (r - 35);
        asm volatile("" : "+s"(ph), "+s"(hf));
#define P kargs()
#define ws asglobal(kargs()->ws)
#define INP(i) asglobal(kargs()->in[i])
#define OUTP asglobal(kargs()->out)
#define G gdv
#define bx bxv
#define gw (bx * NWAVES + wave)
#define NGW (G * NWAVES)
#define gtid (bx * NTHR + tid)
#define NT (G * NTHR)
#define WIN ((bf16_t*)(ws + WS_WIN))
#define HB ((bf16_t*)(ws + WS_HB))
#define MERGED ((float*)(ws + WS_MERGED))
#define GB ((bf16_t*)(ws + WS_G))
#define YIN ((bf16_t*)(ws + WS_YIN))
#define xsrc (((layer == 0) ? INP(0) : (const float*)OUTP) + (size_t)hf * HT * DM)
#define xdst (OUTP + (size_t)hf * HT * DM)

#define PROBE11 0
#define NOMIX 0
#define NOMLP 0
#ifndef SKIPMASK

#define SKIPMASK 0u
#endif
        if ((SKIPMASK >> ph) & 1u) ph = 99;
#ifdef DELAY_PROBE
        if (bxv == 3) { const unsigned long long t0 = __builtin_amdgcn_s_memrealtime(); while (__builtin_amdgcn_s_memrealtime() - t0 < 30000ull) __builtin_amdgcn_s_sleep(64); }
#endif
        int nobar = 0;
        switch (ph) {
        case 0:
            phase_weights(ws, INP(2) + (size_t)layer * 1024 * INW, INP(4) + (size_t)layer * 1048576, INP(11) + (size_t)layer * 1048576, INP(15) + (size_t)layer * 1048576,
                          INP(16) + (size_t)layer * 1048576, INP(18) + (size_t)layer * 4194304, INP(19) + (size_t)layer * 4194304, lds, gw, NGW, wave, lane);
            phase_rmsnorm_bf16(xsrc, INP(1) + layer * DM, HB, HT, gw, NGW, lane);
            break;
        case 1:
            if (hf == 0) { nobar = 1; break; }
            phase_rmsnorm_bf16(xsrc, INP(1) + layer * DM, HB, HT, gw, NGW, lane);
            if (DUP2) phase_rmsnorm_bf16(xsrc, INP(1) + layer * DM, HB, HT, gw, NGW, lane);
            break;
        case 2: {
            if (tid == 0) { job_put(lds, 0, HB, WIN, ws + RA_UA, nullptr, 64, 12, 3072, 0); job_put(lds, 1, HB, WIN + (size_t)9248 * DM, GB, nullptr, 64, 4, 1024, 1); }
            Sched S; S.init(lds, 2, G, bx, DM, tid);
            pg8::GEMM_BODY<3>(lds, DM, S, tid);
            phase_narrow(HB, WIN + (size_t)6144 * DM, WIN + (size_t)9232 * DM, (float*)(ws + WS_DTGK), gw, NGW, lane);
            break; }
        case 3:
            phase_conv_a((const bf16_t*)(ws + RA_UA), INP(3) + (size_t)layer * 3 * 1024, YIN, gtid, NT);
            if (DUP2) phase_conv_a((const bf16_t*)(ws + RA_UA), INP(3) + (size_t)layer * 3 * 1024, YIN, gtid, NT);
            break;
        case 4: nobar = 1; break;
        case 5: {
            if (tid == 0) { job_put(lds, 0, YIN, ws + WS_WOA, MERGED, GB, 64, 4, 1024, 4);
                            job_put(lds, 1, HB, WIN + (size_t)3072 * DM, ws + RB_Z, nullptr, 64, 4, 1024, 2); job_put(lds, 2, WIN + (size_t)4096 * DM, HB, ws + RB_XST, nullptr, 4, 64, HT, 0);
                            job_put(lds, 3, HB, WIN + (size_t)5120 * DM, ws + RB_BC, nullptr, 64, 4, 1024, 0); job_put(lds, 4, HB, WIN + (size_t)10272 * DM, ws + WS_MSUM, nullptr, 64, 4, 1024, 1); }
            Sched S; S.init(lds, 5, G, bx, DM, tid); pg8::GEMM_BODY<23>(lds, DM, S, tid);
            break; }
        case 6:
            phase_ssd_prep(ws, INP(5) + (size_t)layer * 4 * 2048, INP(6) + (size_t)layer * 2048, INP(7) + layer * 16, INP(8) + layer * 16, gtid, NT, tid, G, bx);
            if (DUP2) phase_ssd_prep(ws, INP(5) + (size_t)layer * 4 * 2048, INP(6) + (size_t)layer * 2048, INP(7) + layer * 16, INP(8) + layer * 16, gtid, NT, tid, G, bx);
            break;
        case 7: phase_ssd_states(ws, lds, tid, wave, lane); if (DUP) { __syncthreads(); phase_ssd_states(ws, lds, tid, wave, lane); } break;
        case 8: phase_ssd_scan(ws, gtid, NT); break;
        case 9: phase_ssd_out(ws, INP(9) + layer * 16, INP(10) + layer * 1024, lds, tid, wave, lane); if (DUP) { __syncthreads(); phase_ssd_out(ws, INP(9) + layer * 16, INP(10) + layer * 1024, lds, tid, wave, lane); } break;
        case 10: nobar = 1; break;
        case 11: {
            if (tid == 0) { job_put(lds, 0, YIN, ws + WS_WOS, MERGED, ws + WS_MSUM, 64, 4, 1024, 5);
                            job_put(lds, 1, HB, WIN + (size_t)6160 * DM, ws + RC_QK, nullptr, 64, 4, 1024, 0); job_put(lds, 2, WIN + (size_t)7184 * DM, HB, ws + RC_VT, nullptr, 4, 64, HT, 0);
                            job_put(lds, 3, HB, WIN + (size_t)8208 * DM, ws + RC_GS, nullptr, 64, 4, 1024, 2); job_put(lds, 4, HB, WIN + (size_t)11296 * DM, GB, nullptr, 64, 4, 1024, 1); }
            Sched S; S.init(lds, 5, G, bx, DM, tid); pg8::GEMM_BODY<39>(lds, DM, S, tid);
            break; }
        case 12: phase_gla_prep(ws, INP(12) + (size_t)layer * 16 * 512, INP(13) + layer * 512, gtid, NT); break;
        case 13: phase_gla_states(ws, lds, tid, wave, lane); if (DUP) { __syncthreads(); phase_gla_states(ws, lds, tid, wave, lane); } break;
        case 14: phase_gla_scan(ws, gtid, NT); break;
        case 15: phase_gla_out(ws, INP(14) + layer * 256, lds, tid, wave, lane); if (DUP) { __syncthreads(); phase_gla_out(ws, INP(14) + layer * 256, lds, tid, wave, lane); } break;
        case 16: {
            if (tid == 0) job_put(lds, 0, YIN, ws + WS_WOG, ws + WS_MSUM, GB, 64, 4, 1024, 6);
            Sched S; S.init(lds, 1, G, bx, DM, tid); pg8::GEMM_BODY<64>(lds, DM, S, tid);
            break; }
        case 17: {
            if (tid == 0) job_put(lds, 0, GB, ws + WS_WO, xdst, xsrc, 64, 4, NOMIX ? 0 : 1024, 7);
            Sched S; S.init(lds, 1, G, bx, DM, tid); pg8::GEMM_BODY<128>(lds, DM, S, tid);
            break; }
        case 18:
            phase_rmsnorm_bf16(OUTP, INP(17) + layer * DM, (bf16_t*)(ws + WS_MERGED), T_ALL, gw, NGW, lane);
            break;
        case 19: {
            if (tid == 0) job_put(lds, 0, ws + WS_MERGED, ws + WS_WUP, ws + WS_R, nullptr, 128, 16, DFF, 3);
            Sched S; S.init(lds, 1, G, bx, DM, tid); pg8::GEMM_BODY<8>(lds, DM, S, tid);
            break; }
        case 20: {
            if (tid == 0) job_put(lds, 0, ws + WS_R, ws + WS_WDN, OUTP, OUTP, 128, 4, NOMLP ? 0 : 1024, 7);
            Sched S; S.init(lds, 1, G, bx, DFF, tid); pg8::GEMM_BODY<128>(lds, DFF, S, tid);
            break; }
        case 99: {
#ifdef SPIN_PROBE
            if (pc == 6 || pc == 23) { const unsigned long long t0 = __builtin_amdgcn_s_memrealtime(); while (__builtin_amdgcn_s_memrealtime() - t0 < 500000ull) __builtin_amdgcn_s_sleep(64); }
#endif
            break; }
        default:
            phase_rmsnorm_f32(OUTP, INP(20), T_ALL, gw, NGW, lane);
            break;
        }
        if (pc0 != pc_hi - 1 && !nobar) {
            xcd_barrier((unsigned*)(ws + WS_BAR), xcc, xst, tid, (unsigned)gdv);
            if (BAR2) xcd_barrier((unsigned*)(ws + WS_BAR), xcc, xst, tid, (unsigned)gdv);
        }
    }
#undef P
#undef ws
#undef INP
#undef OUTP
#undef G
#undef bx
#undef gw
#undef NGW
#undef gtid
#undef NT
#undef WIN
#undef HB
#undef MERGED
#undef GB
#undef YIN
#undef xsrc
#undef xdst
}

extern "C" void kernel_launch(void* const* d_in, const int* in_sizes, int n_in, void* d_out, int out_size, void* d_ws, size_t ws_size, hipStream_t stream) {
    static int grid = 0;
    if (grid == 0) {
        if (n_in != 21 || out_size != T_ALL * DM || ws_size < WS_TOTAL) { fprintf(stderr, "kernel_launch: unexpected shapes (n_in %d out %d ws %zu need %zu)\n", n_in, out_size, ws_size, (size_t)WS_TOTAL); grid = -1; return; }
        int dev = 0, cus = 0, per_cu = 0;
        hipGetDevice(&dev);
        hipDeviceGetAttribute(&cus, hipDeviceAttributeMultiprocessorCount, dev);
        if (hipFuncSetAttribute((const void*)mega_fwd, hipFuncAttributeMaxDynamicSharedMemorySize, LDS_BYTES) != hipSuccess) { fprintf(stderr, "kernel_launch: hipFuncSetAttribute failed\n"); }
        if (hipOccupancyMaxActiveBlocksPerMultiprocessor(&per_cu, (const void*)mega_fwd, NTHR, LDS_BYTES) != hipSuccess || per_cu < 1) { fprintf(stderr, "kernel_launch: occupancy query says %d\n", per_cu); per_cu = 1; }
        (void)hipGetLastError();
        grid = cus > 0 ? cus : 256;
    }
    if (grid < 0) return;
    if (hipMemsetAsync((char*)d_ws + WS_BAR, 0, 16384, stream) != hipSuccess) { fprintf(stderr, "kernel_launch: memset failed\n"); return; }
    Params p{};
    for (int i = 0; i < 21; ++i) p.in[i] = (const float*)d_in[i];
    p.out = (float*)d_out; p.ws = (unsigned char*)d_ws;
#ifndef N_LAUNCH_SPLIT
#define N_LAUNCH_SPLIT 0
#endif
    constexpr int NPC_H = 2 * 38 + 1;
    if (N_LAUNCH_SPLIT) {
        for (int pc = 0; pc < NPC_H; ++pc) {
            hipLaunchKernelGGL(mega_fwd, dim3(grid), dim3(NTHR), LDS_BYTES, stream, p, pc, pc + 1, 0, 0);
        }
        hipError_t e = hipPeekAtLastError();
        if (e != hipSuccess) fprintf(stderr, "launch failed: %s (grid %d)\n", hipGetErrorString(e), grid);
    } else {
        int lo = 0, hi = NPC_H, coop = 1, pad = 0;
        void* args[] = {&p, &lo, &hi, &coop, &pad};
        hipError_t e = hipLaunchCooperativeKernel((const void*)mega_fwd, dim3(grid), dim3(NTHR), args, LDS_BYTES, stream);
        if (e != hipSuccess) fprintf(stderr, "cooperative launch failed: %s (grid %d)\n", hipGetErrorString(e), grid);
    }
}
```

```cpp
#include <hip/hip_runtime.h>
#include <hip/hip_cooperative_groups.h>
#include <cstdio>
namespace cg = cooperative_groups;

#define LAS __attribute__((address_space(3)))
#define DEV __device__ __forceinline__
typedef unsigned short bf16_t;
typedef short bf16x8 __attribute__((ext_vector_type(8)));
typedef float f32x4 __attribute__((ext_vector_type(4)));
typedef float f32x2 __attribute__((ext_vector_type(2)));
typedef unsigned u32x4 __attribute__((ext_vector_type(4)));
typedef unsigned u32x2 __attribute__((ext_vector_type(2)));

constexpr int T_ALL = 32768, HT = 16384, DM = 1024, SEQ = 8192, INW = 12320, DFF = 4096;
constexpr int NTHR = 512, NWAVES = 8;
constexpr int LDS_BYTES = 136 * 1024;
constexpr float EPS = 1e-6f;

constexpr size_t WS_WIN = 1048576;
constexpr size_t WS_WOA = WS_WIN + (size_t)INW * 1024 * 2 + 1048576;
constexpr size_t WS_WOS = WS_WOA + 2097152;
constexpr size_t WS_WOG = WS_WOS + 2097152;
constexpr size_t WS_WO = WS_WOG + 2097152;
constexpr size_t WS_WUP = WS_WO + 2097152;
constexpr size_t WS_WDN = WS_WUP + 8388608;
constexpr size_t WS_HB = WS_WDN + 8388608;
constexpr size_t WS_MERGED = WS_HB + (size_t)HT * 1024 * 2;
constexpr size_t WS_G = WS_MERGED + (size_t)HT * 1024 * 4;
constexpr size_t WS_YIN = WS_G + (size_t)HT * 1024 * 2;
constexpr size_t WS_DTGK = WS_YIN + (size_t)HT * 1024 * 2;
constexpr size_t WS_R = WS_DTGK + (size_t)HT * 32 * 4;
constexpr size_t RA_UA = WS_R;
constexpr size_t RB_Z = WS_R;
constexpr size_t RB_XST = RB_Z + 33554432;
constexpr size_t RB_BC = RB_XST + 33554432;
constexpr size_t RB_XSTC = RB_BC + 33554432;
constexpr size_t RB_BCC = RB_XSTC + 33554432;
constexpr size_t RB_BTC = RB_BCC + 33554432;
constexpr size_t RB_DT = RB_BTC + 16777216;
constexpr size_t RB_ACUM = RB_DT + 1048576;
constexpr size_t RB_ST = RB_ACUM + 1048576;
constexpr size_t RB_END = RB_ST + 67108864;
constexpr size_t RC_QK = WS_R;
constexpr size_t RC_KT = RC_QK + 33554432;
constexpr size_t RC_VT = RC_KT + 16777216;
constexpr size_t RC_GS = RC_VT + 33554432;
constexpr size_t RC_DEC = RC_GS + 33554432;
constexpr size_t RC_ST = RC_DEC + 524288;
constexpr size_t RC_END = RC_ST + 134217728;
constexpr size_t R_HID_END = WS_R + (size_t)T_ALL * DFF * 2;
constexpr size_t WS_END = (RB_END > RC_END ? (RB_END > R_HID_END ? RB_END : R_HID_END) : (RC_END > R_HID_END ? RC_END : R_HID_END));

constexpr size_t WS_MSUM = (WS_END + 255) & ~(size_t)255;
constexpr size_t WS_BAR = WS_MSUM + (size_t)HT * 1024 * 2;
constexpr size_t WS_DEC = WS_BAR + 16384;
constexpr size_t WS_TOTAL = WS_DEC + 524288;
struct Params { const float* in[21]; float* out; unsigned char* ws; };

DEV unsigned f2bf(float f) { unsigned u = __float_as_uint(f); return (u + 0x7fffu + ((u >> 16) & 1u)) >> 16; }
typedef __bf16 bf16x2_t __attribute__((ext_vector_type(2)));
DEV unsigned pk2(float lo, float hi) { const f32x2 v = {lo, hi}; const bf16x2_t r = __builtin_convertvector(v, bf16x2_t); return __builtin_bit_cast(unsigned, r); }
DEV float bf_lo(unsigned w) { return __uint_as_float(w << 16); }
DEV float bf_hi(unsigned w) { return __uint_as_float(w & 0xffff0000u); }
DEV float bf1(bf16_t h) { return __uint_as_float(((unsigned)h) << 16); }
DEV void unpack8(const u32x4 w, float (&f)[8]) {
    f[0] = bf_lo(w.x); f[1] = bf_hi(w.x); f[2] = bf_lo(w.y); f[3] = bf_hi(w.y);
    f[4] = bf_lo(w.z); f[5] = bf_hi(w.z); f[6] = bf_lo(w.w); f[7] = bf_hi(w.w);
}
DEV u32x4 pack8(const float (&f)[8]) { u32x4 w; w.x = pk2(f[0], f[1]); w.y = pk2(f[2], f[3]); w.z = pk2(f[4], f[5]); w.w = pk2(f[6], f[7]); return w; }
DEV float sigmoidf_(float x) { return __builtin_amdgcn_rcpf(1.0f + __expf(-x)); }
DEV float siluf_(float x) { return x * sigmoidf_(x); }
DEV float softplusf_(float x) { return x > 20.f ? x : (x < -15.f ? __expf(x) : __logf(1.0f + __expf(x))); }
DEV float logsigf_(float x) { const float e = __expf(-fabsf(x)); return fminf(x, 0.f) - (e < 1e-4f ? e : __logf(1.0f + e)); }
DEV float wave_sum(float v) {
#pragma unroll
    for (int o = 1; o < 64; o <<= 1) v += __shfl_xor(v, o);
    return v;
}
DEV f32x4 mma(bf16x8 x, bf16x8 y, f32x4 acc) { return __builtin_amdgcn_mfma_f32_16x16x32_bf16(x, y, acc, 0, 0, 0); }
DEV bf16x8 ldsfrag(const LAS unsigned char* p) { return *(const LAS bf16x8*)p; }
#define SCALE_A 1.f
#define SCALE_B 1.f
#define SCALE_C 1.f
#define DUP 0
#define DUP2 0
#define BAR2 0
#define GLA_NO_INTER 0
#define GLA_ZERO_DEC 0
#ifndef GEMM_BODY
#define GEMM_BODY gemm_phase
#endif
#define LDS_WAIT() asm volatile("s_waitcnt lgkmcnt(0)" ::: "memory")
#define GAS __attribute__((address_space(1)))
template <class T> DEV T* asglobal(T* p) { return (T*)(GAS T*)p; }

namespace pg8 {
constexpr int BM = 256, BK = 64, HALF = 128, HTB = HALF * BK * 2, STAGE_BYTES = 8 * HTB, NXCD = 8, WGM = 8;
DEV int lds_byte(int r, int c) { const int st = (r >> 4) * 2 + (c >> 5), rr = r & 15, cc = c & 31, ob = rr * 64 + cc * 2; return st * 1024 + (ob ^ (((ob >> 9) & 1) << 5)); }
DEV void stage_rc(int b, int& R, int& C) { const int st = b / 1024, sb = b % 1024, swz = sb ^ (((sb >> 9) & 1) << 5); R = (st >> 1) * 16 + swz / 64; C = (st & 1) * 32 + (swz % 64) / 2; }
DEV int perm32(int rho) { const int n = rho >> 4, i = rho & 15; return 8 * (i >> 2) + 4 * n + (i & 3); }

struct Job { const bf16_t* A; const bf16_t* B; void* out; const void* aux; int nM, nN, ldc, kind; };
struct Unit { const char* A; const char* B; int jid, pm, pn; };
constexpr int JT_OFF = 131072;
DEV int rfl(int v) { return __builtin_amdgcn_readfirstlane(v); }
DEV const char* rflp(const LAS int* p) { const unsigned lo = (unsigned)rfl(p[0]), hi = (unsigned)rfl(p[1]); return asglobal((const char*)(((unsigned long long)hi << 32) | lo)); }
DEV void job_put(LAS unsigned char* lds, int q, const void* A, const void* B, void* out, const void* aux, int nM, int nN, int ldc, int kind) {
    LAS int* jt = (LAS int*)(lds + JT_OFF) + q * 12;
    const unsigned long long a = (unsigned long long)A, b = (unsigned long long)B, o = (unsigned long long)out, x = (unsigned long long)aux;
    jt[0] = (int)(unsigned)a; jt[1] = (int)(unsigned)(a >> 32); jt[2] = (int)(unsigned)b; jt[3] = (int)(unsigned)(b >> 32);
    jt[4] = (int)(unsigned)o; jt[5] = (int)(unsigned)(o >> 32); jt[6] = (int)(unsigned)x; jt[7] = (int)(unsigned)(x >> 32);
    jt[8] = nM; jt[9] = nN; jt[10] = ldc; jt[11] = kind;
}
struct Sched {
    LAS unsigned char* lds; int nj, total, G, c; size_t tstep;
    DEV void init(LAS unsigned char* lds_, int nj_, int G_, int c_, int K, int tid_) {
        lds = lds_; nj = nj_; G = G_; c = c_; tstep = (size_t)BM * K * 2;
        __syncthreads();
        LAS int* jt = (LAS int*)(lds + JT_OFF);
        if (tid_ == 0) { int s = 0; for (int q = 0; q < nj; ++q) { jt[72 + q] = s; s += jt[q * 12 + 8] * jt[q * 12 + 9]; } for (int q = nj; q < 7; ++q) jt[72 + q] = s; }
        __syncthreads();
        total = rfl(jt[72 + 6]);
    }
    DEV bool next(int i, Unit& u) const {
        const int L = i * G + c; if (L >= total) return false;
        const LAS int* jt = (const LAS int*)(lds + JT_OFF);
        int jid = 0;
        for (int q = 1; q < nj; ++q) if (L >= rfl(jt[72 + q])) jid = q;
        const LAS int* J = jt + jid * 12;
        const int base = rfl(jt[72 + jid]), nM = rfl(J[8]), nN = rfl(J[9]);
        int wgid = L - base; const int nwg = nM * nN;
        { const int q = nwg / NXCD, r = nwg % NXCD, xcd = wgid % NXCD, off = wgid / NXCD; wgid = (xcd < r ? xcd * (q + 1) : r * (q + 1) + (xcd - r) * q) + off; }
        const int nig = WGM * nN, gid = wgid / nig, fm = gid * WGM, gsz = (nM - fm) < WGM ? (nM - fm) : WGM;
        u.pm = fm + ((wgid % nig) % gsz); u.pn = (wgid % nig) / gsz; u.jid = jid;
        u.A = rflp(J) + (size_t)u.pm * tstep; u.B = rflp(J + 2) + (size_t)u.pn * tstep;
        return true;
    }
};

DEV void st16_wt(GAS u32x4* p, u32x4 v) { asm volatile("global_store_dwordx4 %0, %1, off sc1" :: "v"(p), "v"(v) : "memory"); }
DEV void st16f_wt(GAS f32x4* p, f32x4 v) { asm volatile("global_store_dwordx4 %0, %1, off sc1" :: "v"(p), "v"(v) : "memory"); }
DEV unsigned cvt_pk_bf16(float lo, float hi) { return pk2(lo, hi); }

template <int KIND> DEV void epi_loop(const f32x4 (&acc)[2][2][4][2], const Job& J, const Unit& u, int wr, int wc, int fr, int fq) {
    const int row0 = u.pm * BM + wr * 64 + fr, col0 = u.pn * BM + wc * 32 + 8 * fq;
    GAS bf16_t* const outb = (GAS bf16_t*)J.out; GAS float* const outf = (GAS float*)J.out;
    const GAS float* const auxf = (const GAS float*)J.aux; GAS bf16_t* const auxb = (GAS bf16_t*)const_cast<void*>(J.aux);
#pragma unroll
    for (int ai = 0; ai < 2; ++ai)
#pragma unroll
        for (int m = 0; m < 4; ++m) {
            const size_t row = (size_t)(row0 + ai * HALF + m * 16);
#pragma unroll
            for (int bj = 0; bj < 2; ++bj) {
                const int col = col0 + bj * HALF;
                f32x4 v0 = acc[ai][bj][m][0], v1 = acc[ai][bj][m][1];
                if (KIND <= 3) {
                    if (KIND == 1) {
#pragma unroll
                        for (int e = 0; e < 4; ++e) { v0[e] = sigmoidf_(v0[e]); v1[e] = sigmoidf_(v1[e]); } }
                    if (KIND == 2) {
#pragma unroll
                        for (int e = 0; e < 4; ++e) { v0[e] = siluf_(v0[e]); v1[e] = siluf_(v1[e]); } }
                    if (KIND == 3) {
#pragma unroll
                        for (int e = 0; e < 4; ++e) { float a = fmaxf(v0[e], 0.f), b = fmaxf(v1[e], 0.f); v0[e] = a * a; v1[e] = b * b; } }
                    u32x4 w; w.x = cvt_pk_bf16(v0[0], v0[1]); w.y = cvt_pk_bf16(v0[2], v0[3]); w.z = cvt_pk_bf16(v1[0], v1[1]); w.w = cvt_pk_bf16(v1[2], v1[3]);
                    *(GAS u32x4*)(outb + row * J.ldc + col) = w;
                } else if (KIND == 7) {
                    const GAS float* xin = auxf + row * DM + col; GAS float* xo = outf + row * DM + col;
                    const f32x4 a = *(const GAS f32x4*)xin, b = *(const GAS f32x4*)(xin + 4);
                    const float sc = (J.ldc == 0) ? 0.f : 1.f; *(GAS f32x4*)xo = a + v0 * sc; *(GAS f32x4*)(xo + 4) = b + v1 * sc;
                } else if (KIND == 4) {
                    const u32x4 gw = *(const GAS u32x4*)(auxb + row * DM + col); float g[8]; unpack8(gw, g);
                    f32x4 r0, r1;
#pragma unroll
                    for (int e = 0; e < 4; ++e) { r0[e] = g[e] * v0[e] * SCALE_A; r1[e] = g[4 + e] * v1[e] * SCALE_A; }
                    GAS float* mo = outf + row * DM + col; *(GAS f32x4*)mo = r0; *(GAS f32x4*)(mo + 4) = r1;
                } else if (KIND == 5) {
                    GAS bf16_t* gp = auxb + row * DM + col;
                    const u32x4 gw = *(const GAS u32x4*)gp; float g[8]; unpack8(gw, g);
#pragma unroll
                    for (int e = 0; e < 8; ++e) g[e] *= SCALE_B;
                    const GAS float* mo = outf + row * DM + col; const f32x4 m0 = *(const GAS f32x4*)mo, m1 = *(const GAS f32x4*)(mo + 4);
                    u32x4 w; w.x = cvt_pk_bf16(m0[0] + g[0] * v0[0], m0[1] + g[1] * v0[1]); w.y = cvt_pk_bf16(m0[2] + g[2] * v0[2], m0[3] + g[3] * v0[3]);
                    w.z = cvt_pk_bf16(m1[0] + g[4] * v1[0], m1[1] + g[5] * v1[1]); w.w = cvt_pk_bf16(m1[2] + g[6] * v1[2], m1[3] + g[7] * v1[3]);
                    *(GAS u32x4*)gp = w;
                } else {
                    GAS bf16_t* gp = auxb + row * DM + col;
                    const u32x4 gw = *(const GAS u32x4*)gp, aw = *(const GAS u32x4*)(outb + row * DM + col);
                    float g[8], a[8]; unpack8(gw, g); unpack8(aw, a);
#pragma unroll
                    for (int e = 0; e < 8; ++e) g[e] *= SCALE_C;
                    u32x4 w; w.x = cvt_pk_bf16(a[0] + g[0] * v0[0], a[1] + g[1] * v0[1]); w.y = cvt_pk_bf16(a[2] + g[2] * v0[2], a[3] + g[3] * v0[3]);
                    w.z = cvt_pk_bf16(a[4] + g[4] * v1[0], a[5] + g[5] * v1[1]); w.w = cvt_pk_bf16(a[6] + g[6] * v1[2], a[7] + g[7] * v1[3]);
                    *(GAS u32x4*)gp = w;
                }
            }
        }
}

template <int MASK> DEV void run_epi(const Sched& S, const Unit& u, const f32x4 (&acc)[2][2][4][2], int wr, int wc, int fr, int fq) {
    const LAS int* Jp = (const LAS int*)(S.lds + JT_OFF) + u.jid * 12;
    Job J; J.A = nullptr; J.B = nullptr; J.out = (void*)rflp(Jp + 4); J.aux = (const void*)rflp(Jp + 6); J.nM = 0; J.nN = 0; J.ldc = rfl(Jp[10]); J.kind = rfl(Jp[11]);
    const int k = J.kind;
    if ((MASK & 1) && k == 0) epi_loop<0>(acc, J, u, wr, wc, fr, fq);
    else if ((MASK & 2) && k == 1) epi_loop<1>(acc, J, u, wr, wc, fr, fq);
    else if ((MASK & 4) && k == 2) epi_loop<2>(acc, J, u, wr, wc, fr, fq);
    else if ((MASK & 8) && k == 3) epi_loop<3>(acc, J, u, wr, wc, fr, fq);
    else if ((MASK & 16) && k == 4) epi_loop<4>(acc, J, u, wr, wc, fr, fq);
    else if ((MASK & 32) && k == 5) epi_loop<5>(acc, J, u, wr, wc, fr, fq);
    else if ((MASK & 64) && k == 6) epi_loop<6>(acc, J, u, wr, wc, fr, fq);
    else if ((MASK & 128) && k == 7) epi_loop<7>(acc, J, u, wr, wc, fr, fq);
}

template <int MASK>
DEV void gemm_phase(LAS unsigned char* lds, const int K, const Sched& S, const int tid) {
    const int wid = __builtin_amdgcn_readfirstlane(tid >> 6), lane = tid & 63, wr = wid >> 2, wc = wid & 3, fr = lane & 15, fq = lane >> 4;
    const int nt = K / BK;
    unsigned voffA[2], voffB[2];
#pragma unroll
    for (int i = 0; i < 2; ++i) { int R, C; stage_rc(tid * 16 + i * 8192, R, C); const int Rb = (R & ~31) + perm32(R & 31);
        voffA[i] = (unsigned)(R * K + C) * 2u; voffB[i] = (unsigned)(Rb * K + C) * 2u; }
    const size_t kstep = (size_t)(BK * 2);
    const size_t hstep = (size_t)HALF * K * 2;
    const unsigned ldsw = (unsigned)wid * 1024u;
    const int aoff = lds_byte(wr * 64 + fr, fq * 8), boff = lds_byte(wc * 32 + fr, fq * 8);
#define PG8_SA(b, h) (((b) * 2 + (h)) * HTB)
#define PG8_SB(b, h) ((4 + (b) * 2 + (h)) * HTB)
#define PG8_STAGE(bufoff, gbase, voff) do { _Pragma("unroll") for (int _i = 0; _i < 2; ++_i) \
        __builtin_amdgcn_global_load_lds((const unsigned*)((const char*)(gbase) + (voff)[_i]), (LAS unsigned*)(lds + (bufoff) + ldsw + _i * 8192), 16, 0, 0); } while (0)
#define PG8_LDA(dst, b, h) do { _Pragma("unroll") for (int m = 0; m < 4; ++m) _Pragma("unroll") for (int k = 0; k < 2; ++k) dst[m][k] = *(const LAS bf16x8*)(lds + PG8_SA(b, h) + aoff + m * 2048 + k * 1024); } while (0)
#define PG8_LDB(dst, b, h) do { _Pragma("unroll") for (int n = 0; n < 2; ++n) _Pragma("unroll") for (int k = 0; k < 2; ++k) dst[n][k] = *(const LAS bf16x8*)(lds + PG8_SB(b, h) + boff + n * 2048 + k * 1024); } while (0)
#define PG8_MMA(ai, bj, At, Bt) do { __builtin_amdgcn_s_setprio(1); _Pragma("unroll") for (int m = 0; m < 4; ++m) _Pragma("unroll") for (int n = 0; n < 2; ++n) _Pragma("unroll") for (int k = 0; k < 2; ++k) \
        acc[ai][bj][m][n] = __builtin_amdgcn_mfma_f32_16x16x32_bf16(Bt[n][k], At[m][k], acc[ai][bj][m][n], 0, 0, 0); __builtin_amdgcn_s_setprio(0); } while (0)
#define PG8_WAIT_V(n) asm volatile("s_waitcnt vmcnt(" #n ")" ::: "memory")
#define PG8_WAIT_L(n) asm volatile("s_waitcnt lgkmcnt(" #n ")" ::: "memory")
#define PG8_BAR __builtin_amdgcn_s_barrier()
#define PG8_SCHED __builtin_amdgcn_sched_barrier(0)
    Unit cur, nxt; int ui = 0;
    if (!S.next(0, cur)) return;
    f32x4 acc[2][2][4][2];
#pragma unroll
    for (int a = 0; a < 2; ++a)
#pragma unroll
        for (int b = 0; b < 2; ++b)
#pragma unroll
            for (int m = 0; m < 4; ++m)
#pragma unroll
                for (int n = 0; n < 2; ++n) acc[a][b][m][n] = (f32x4){0.f, 0.f, 0.f, 0.f};
    bf16x8 At[4][2], B0[2][2], B1[2][2];
    const char* cA = cur.A; const char* cB = cur.B;
    PG8_STAGE(PG8_SB(0, 0), cB, voffB); PG8_STAGE(PG8_SA(0, 0), cA, voffA); PG8_STAGE(PG8_SB(0, 1), cB + hstep, voffB); PG8_STAGE(PG8_SA(0, 1), cA + hstep, voffA);
    if (wr == 1) PG8_BAR;
    PG8_WAIT_V(4); PG8_BAR;
    PG8_STAGE(PG8_SB(1, 0), cB + kstep, voffB); PG8_STAGE(PG8_SA(1, 0), cA + kstep, voffA); PG8_STAGE(PG8_SB(1, 1), cB + hstep + kstep, voffB);
    PG8_WAIT_V(6); PG8_BAR;
    for (;;) {
        const bool has_next = S.next(ui + 1, nxt);
        const char* nA = has_next ? nxt.A : cA; const char* nB = has_next ? nxt.B : cB;
        for (int t = 0; t < nt; t += 2) {
            const bool last = (t == nt - 2);
            const char* a1 = cA + (size_t)(t + 1) * kstep;
            const char* a2 = last ? nA : cA + (size_t)(t + 2) * kstep; const char* b2 = last ? nB : cB + (size_t)(t + 2) * kstep;
            const char* a3 = a2 + kstep; const char* b3 = b2 + kstep;
            PG8_LDB(B0, 0, 0); PG8_SCHED; PG8_LDA(At, 0, 0); PG8_STAGE(PG8_SA(1, 1), a1 + hstep, voffA);
            PG8_WAIT_L(8); PG8_BAR; PG8_WAIT_L(0); PG8_MMA(0, 0, At, B0); PG8_BAR; PG8_SCHED;
            PG8_LDB(B1, 0, 1); PG8_STAGE(PG8_SB(0, 0), b2, voffB);
            PG8_BAR; PG8_WAIT_L(0); PG8_MMA(0, 1, At, B1); PG8_BAR;
            PG8_LDA(At, 0, 1); PG8_STAGE(PG8_SA(0, 0), a2, voffA);
            PG8_BAR; PG8_WAIT_L(0); PG8_MMA(1, 0, At, B0); PG8_BAR; PG8_SCHED;
            PG8_STAGE(PG8_SB(0, 1), b2 + hstep, voffB);
            PG8_WAIT_V(6); PG8_BAR; PG8_MMA(1, 1, At, B1); PG8_BAR;
            PG8_LDB(B0, 1, 0); PG8_SCHED; PG8_LDA(At, 1, 0); PG8_STAGE(PG8_SA(0, 1), a2 + hstep, voffA);
            PG8_WAIT_L(8); PG8_BAR; PG8_WAIT_L(0); PG8_MMA(0, 0, At, B0); PG8_BAR; PG8_SCHED;
            PG8_LDB(B1, 1, 1); PG8_STAGE(PG8_SB(1, 0), b3, voffB);
            PG8_BAR; PG8_WAIT_L(0); PG8_MMA(0, 1, At, B1); PG8_BAR;
            PG8_LDA(At, 1, 1); PG8_STAGE(PG8_SA(1, 0), a3, voffA);
            PG8_BAR; PG8_WAIT_L(0); PG8_MMA(1, 0, At, B0); PG8_BAR; PG8_SCHED;
            PG8_STAGE(PG8_SB(1, 1), b3 + hstep, voffB);
            PG8_WAIT_V(6); PG8_BAR; PG8_MMA(1, 1, At, B1); PG8_BAR;
        }
        run_epi<MASK>(S, cur, acc, wr, wc, fr, fq);
        if (!has_next) break;
#pragma unroll
        for (int a = 0; a < 2; ++a)
#pragma unroll
            for (int b = 0; b < 2; ++b)
#pragma unroll
                for (int m = 0; m < 4; ++m)
#pragma unroll
                    for (int n = 0; n < 2; ++n) acc[a][b][m][n] = (f32x4){0.f, 0.f, 0.f, 0.f};
        cur = nxt; cA = nA; cB = nB; ++ui;
    }
    PG8_WAIT_V(0);
    if (wr == 0) PG8_BAR;
    PG8_BAR;
#undef PG8_SA
#undef PG8_SB
#undef PG8_STAGE
#undef PG8_LDA
#undef PG8_LDB
#undef PG8_MMA
#undef PG8_WAIT_V
#undef PG8_WAIT_L
#undef PG8_BAR
#undef PG8_SCHED
}

template <int MASK>
DEV void gemm_simple(LAS unsigned char* lds, const int K, const Sched& S, const int tid) {
    const int wid = __builtin_amdgcn_readfirstlane(tid >> 6), lane = tid & 63, wr = wid >> 2, wc = wid & 3, fr = lane & 15, fq = lane >> 4;
    const int nt = K / BK;
    unsigned voffA[2], voffB[2];
#pragma unroll
    for (int i = 0; i < 2; ++i) { int R, C; stage_rc(tid * 16 + i * 8192, R, C); const int Rb = (R & ~31) + perm32(R & 31);
        voffA[i] = (unsigned)(R * K + C) * 2u; voffB[i] = (unsigned)(Rb * K + C) * 2u; }
    const size_t kstep = (size_t)(BK * 2), hstep = (size_t)HALF * K * 2;
    const unsigned ldsl = (unsigned)wid * 1024u + (unsigned)lane * 16u;
    const int aoff = lds_byte(wr * 64 + fr, fq * 8), boff = lds_byte(wc * 32 + fr, fq * 8);
#define GS_SA(b, h) (((b) * 2 + (h)) * HTB)
#define GS_SB(b, h) ((4 + (b) * 2 + (h)) * HTB)
#define GS_LOAD(dst, pa, pb) do { _Pragma("unroll") for (int _i = 0; _i < 2; ++_i) { \
        dst[0][_i] = *(const GAS u32x4*)((const GAS char*)(pa) + voffA[_i]); dst[1][_i] = *(const GAS u32x4*)((const GAS char*)(pa) + hstep + voffA[_i]); \
        dst[2][_i] = *(const GAS u32x4*)((const GAS char*)(pb) + voffB[_i]); dst[3][_i] = *(const GAS u32x4*)((const GAS char*)(pb) + hstep + voffB[_i]); } } while (0)
#define GS_WRITE(b, src) do { _Pragma("unroll") for (int _i = 0; _i < 2; ++_i) { \
        *(LAS u32x4*)(lds + GS_SA(b, 0) + ldsl + _i * 8192) = src[0][_i]; *(LAS u32x4*)(lds + GS_SA(b, 1) + ldsl + _i * 8192) = src[1][_i]; \
        *(LAS u32x4*)(lds + GS_SB(b, 0) + ldsl + _i * 8192) = src[2][_i]; *(LAS u32x4*)(lds + GS_SB(b, 1) + ldsl + _i * 8192) = src[3][_i]; } } while (0)
    Unit cur; int ui = 0;
    while (S.next(ui, cur)) {
        f32x4 acc[2][2][4][2];
#pragma unroll
        for (int a = 0; a < 2; ++a)
#pragma unroll
            for (int b = 0; b < 2; ++b)
#pragma unroll
                for (int m = 0; m < 4; ++m)
#pragma unroll
                    for (int n = 0; n < 2; ++n) acc[a][b][m][n] = (f32x4){0.f, 0.f, 0.f, 0.f};
        const char* cA = cur.A; const char* cB = cur.B;
        u32x4 st[4][2];
        GS_LOAD(st, cA, cB);
        GS_WRITE(0, st);
        __syncthreads();
        for (int t = 0; t < nt; ++t) {
            const int b = t & 1;
            if (t + 1 < nt) GS_LOAD(st, cA + (size_t)(t + 1) * kstep, cB + (size_t)(t + 1) * kstep);
#pragma unroll
            for (int ai = 0; ai < 2; ++ai) {
                bf16x8 At[4][2];
#pragma unroll
                for (int m = 0; m < 4; ++m)
#pragma unroll
                    for (int k = 0; k < 2; ++k) At[m][k] = *(const LAS bf16x8*)(lds + (b ? GS_SA(1, 0) : GS_SA(0, 0)) + ai * HTB + aoff + m * 2048 + k * 1024);
#pragma unroll
                for (int bj = 0; bj < 2; ++bj) {
                    bf16x8 Bt[2][2];
#pragma unroll
                    for (int n = 0; n < 2; ++n)
#pragma unroll
                        for (int k = 0; k < 2; ++k) Bt[n][k] = *(const LAS bf16x8*)(lds + (b ? GS_SB(1, 0) : GS_SB(0, 0)) + bj * HTB + boff + n * 2048 + k * 1024);
#pragma unroll
                    for (int m = 0; m < 4; ++m)
#pragma unroll
                        for (int n = 0; n < 2; ++n)
#pragma unroll
                            for (int k = 0; k < 2; ++k) acc[ai][bj][m][n] = __builtin_amdgcn_mfma_f32_16x16x32_bf16(Bt[n][k], At[m][k], acc[ai][bj][m][n], 0, 0, 0);
                }
            }
            if (t + 1 < nt) { if (b) GS_WRITE(0, st); else GS_WRITE(1, st); }
            __syncthreads();
        }
        run_epi<MASK>(S, cur, acc, wr, wc, fr, fq);
        ++ui;
    }
    __syncthreads();
#undef GS_SA
#undef GS_SB
#undef GS_LOAD
#undef GS_WRITE
}
}

DEV void transpose_item(const float* W, int K, int N, bf16_t* WT, LAS float* scr, int item, int lane) {
    const int nblk = N / 32, kb = item / nblk, nb = item % nblk, k0 = 64 * kb, n0 = 32 * nb;
#pragma unroll 8
    for (int i = 0; i < 32; ++i) { const int kk = 2 * i + (lane >> 5); scr[kk * 33 + (lane & 31)] = W[(size_t)(k0 + kk) * N + n0 + (lane & 31)]; }
    LDS_WAIT();
    const int c = lane & 7;
#pragma unroll
    for (int jj = 0; jj < 4; ++jj) { const int n = (lane >> 3) + 8 * jj; const LAS float* s = scr + (8 * c) * 33 + n;
        u32x4 o; o.x = pk2(s[0 * 33], s[1 * 33]); o.y = pk2(s[2 * 33], s[3 * 33]); o.z = pk2(s[4 * 33], s[5 * 33]); o.w = pk2(s[6 * 33], s[7 * 33]);
        *(u32x4*)(WT + (size_t)(n0 + n) * K + k0 + 8 * c) = o; }
    LDS_WAIT();
}

DEV void phase_weights(unsigned char* ws, const float* w_in, const float* w_oa, const float* w_os, const float* w_og, const float* w_o, const float* w_up, const float* w_dn, LAS unsigned char* lds, int gw, int NGW, int wave, int lane) {
    LAS float* scr = (LAS float*)(lds + wave * 8704);
    constexpr int I_IN = 16 * (INW / 32), I_SQ = 16 * 32, I_UP = 16 * 128, I_DN = 64 * 32;
    constexpr int NIT = I_IN + 4 * I_SQ + I_UP + I_DN;
    for (int it = gw; it < NIT; it += NGW) {
        int r = it;
        if (r < I_IN) { transpose_item(w_in, 1024, INW, (bf16_t*)(ws + WS_WIN), scr, r, lane); continue; } r -= I_IN;
        if (r < I_SQ) { transpose_item(w_oa, 1024, 1024, (bf16_t*)(ws + WS_WOA), scr, r, lane); continue; } r -= I_SQ;
        if (r < I_SQ) { transpose_item(w_os, 1024, 1024, (bf16_t*)(ws + WS_WOS), scr, r, lane); continue; } r -= I_SQ;
        if (r < I_SQ) { transpose_item(w_og, 1024, 1024, (bf16_t*)(ws + WS_WOG), scr, r, lane); continue; } r -= I_SQ;
        if (r < I_SQ) { transpose_item(w_o, 1024, 1024, (bf16_t*)(ws + WS_WO), scr, r, lane); continue; } r -= I_SQ;
        if (r < I_UP) { transpose_item(w_up, 1024, 4096, (bf16_t*)(ws + WS_WUP), scr, r, lane); continue; } r -= I_UP;
        transpose_item(w_dn, 4096, 1024, (bf16_t*)(ws + WS_WDN), scr, r, lane);
    }
}

DEV void phase_rmsnorm_bf16(const float* __restrict__ x, const float* __restrict__ w, bf16_t* __restrict__ o, int nrows, int gw, int NGW, int lane) {
    for (int m = gw; m < nrows; m += 2 * NGW) {
        const int m2 = m + NGW; const bool has2 = m2 < nrows;
        const f32x4* xa = (const f32x4*)(x + (size_t)m * DM) + lane; const f32x4* xb = (const f32x4*)(x + (size_t)(has2 ? m2 : m) * DM) + lane;
        f32x4 va[4], vb[4]; float sa = 0.f, sb = 0.f;
#pragma unroll
        for (int j = 0; j < 4; ++j) { va[j] = xa[64 * j]; vb[j] = xb[64 * j]; }
#pragma unroll
        for (int j = 0; j < 4; ++j) { sa += (va[j].x * va[j].x + va[j].y * va[j].y) + (va[j].z * va[j].z + va[j].w * va[j].w); sb += (vb[j].x * vb[j].x + vb[j].y * vb[j].y) + (vb[j].z * vb[j].z + vb[j].w * vb[j].w); }
        const float ra = rsqrtf(wave_sum(sa) * (1.f / DM) + EPS), rb = rsqrtf(wave_sum(sb) * (1.f / DM) + EPS);
        u32x2* oa = (u32x2*)(o + (size_t)m * DM) + lane; u32x2* ob = (u32x2*)(o + (size_t)m2 * DM) + lane;
#pragma unroll
        for (int j = 0; j < 4; ++j) { const f32x4 ww = ((const f32x4*)w)[lane + 64 * j];
            u32x2 r; r.x = pk2(va[j].x * ra * ww.x, va[j].y * ra * ww.y); r.y = pk2(va[j].z * ra * ww.z, va[j].w * ra * ww.w); oa[64 * j] = r;
            if (has2) { u32x2 q; q.x = pk2(vb[j].x * rb * ww.x, vb[j].y * rb * ww.y); q.y = pk2(vb[j].z * rb * ww.z, vb[j].w * rb * ww.w); ob[64 * j] = q; } }
    }
}
DEV void phase_rmsnorm_f32(float* x, const float* __restrict__ w, int nrows, int gw, int NGW, int lane) {
    for (int m = gw; m < nrows; m += 2 * NGW) {
        const int m2 = m + NGW; const bool has2 = m2 < nrows;
        f32x4* xa = (f32x4*)(x + (size_t)m * DM) + lane; f32x4* xb = (f32x4*)(x + (size_t)(has2 ? m2 : m) * DM) + lane;
        f32x4 va[4], vb[4]; float sa = 0.f, sb = 0.f;
#pragma unroll
        for (int j = 0; j < 4; ++j) { va[j] = xa[64 * j]; vb[j] = xb[64 * j]; }
#pragma unroll
        for (int j = 0; j < 4; ++j) { sa += (va[j].x * va[j].x + va[j].y * va[j].y) + (va[j].z * va[j].z + va[j].w * va[j].w); sb += (vb[j].x * vb[j].x + vb[j].y * vb[j].y) + (vb[j].z * vb[j].z + vb[j].w * vb[j].w); }
        const float ra = rsqrtf(wave_sum(sa) * (1.f / DM) + EPS), rb = rsqrtf(wave_sum(sb) * (1.f / DM) + EPS);
#pragma unroll
        for (int j = 0; j < 4; ++j) { const f32x4 ww = ((const f32x4*)w)[lane + 64 * j]; xa[64 * j] = va[j] * ra * ww; if (has2) xb[64 * j] = vb[j] * rb * ww; }
    }
}

DEV void phase_narrow(const bf16_t* HB, const bf16_t* Wdt, const bf16_t* Wgk, float* DTGK, int gw, int NGW, int lane) {
    const int fr = lane & 15, fq = lane >> 4;
    for (int u = gw; u < HT / 16; u += NGW) {
        const int t0 = u * 16;
        f32x4 a0 = {0.f, 0.f, 0.f, 0.f}, a1 = {0.f, 0.f, 0.f, 0.f};
        const bf16_t* ap = HB + (size_t)(t0 + fr) * DM + fq * 8;
        const bf16_t* b0p = Wdt + (size_t)fr * DM + fq * 8;
        const bf16_t* b1p = Wgk + (size_t)fr * DM + fq * 8;
#pragma unroll 8
        for (int k = 0; k < DM; k += 32) {
            const bf16x8 a = *(const bf16x8*)(ap + k), b0 = *(const bf16x8*)(b0p + k), b1 = *(const bf16x8*)(b1p + k);
            a0 = mma(a, b0, a0); a1 = mma(a, b1, a1);
        }
#pragma unroll
        for (int j = 0; j < 4; ++j) { float* d = DTGK + (size_t)(t0 + 4 * fq + j) * 32; d[fr] = a0[j]; d[16 + fr] = a1[j]; }
    }
}

DEV void phase_conv_a(const bf16_t* __restrict__ UA, const float* __restrict__ cw, bf16_t* __restrict__ YIN, int gtid, int NT) {
    for (int u = gtid; u < (HT / 16) * 128; u += NT) {
        const int c0 = (u & 127) * 8, t0 = (u >> 7) * 16;
        float w0[8], w1[8], w2[8], p1[8], p2[8];
#pragma unroll
        for (int j = 0; j < 8; ++j) { w0[j] = cw[c0 + j]; w1[j] = cw[1024 + c0 + j]; w2[j] = cw[2048 + c0 + j]; p1[j] = 0.f; p2[j] = 0.f; }
        if ((t0 & (SEQ - 1)) != 0) {
            float ax[8], ac[8];
            unpack8(*(const u32x4*)(UA + (size_t)(t0 - 2) * 3072 + c0), ax); unpack8(*(const u32x4*)(UA + (size_t)(t0 - 2) * 3072 + 2048 + c0), ac);
#pragma unroll
            for (int j = 0; j < 8; ++j) p2[j] = ax[j] * ac[j];
            unpack8(*(const u32x4*)(UA + (size_t)(t0 - 1) * 3072 + c0), ax); unpack8(*(const u32x4*)(UA + (size_t)(t0 - 1) * 3072 + 2048 + c0), ac);
#pragma unroll
            for (int j = 0; j < 8; ++j) p1[j] = ax[j] * ac[j];
        }
#pragma unroll 4
        for (int i = 0; i < 16; ++i) {
            const bf16_t* rp = UA + (size_t)(t0 + i) * 3072 + c0;
            float ax[8], ab[8], ac[8], o[8];
            unpack8(*(const u32x4*)rp, ax); unpack8(*(const u32x4*)(rp + 1024), ab); unpack8(*(const u32x4*)(rp + 2048), ac);
#pragma unroll
            for (int j = 0; j < 8; ++j) { const float p0 = ax[j] * ac[j]; o[j] = ab[j] * (w0[j] * p2[j] + w1[j] * p1[j] + w2[j] * p0); p2[j] = p1[j]; p1[j] = p0; }
            *(u32x4*)(YIN + (size_t)(t0 + i) * DM + c0) = pack8(o);
        }
    }
}

DEV void phase_ssd_prep(unsigned char* ws, const float* cw, const float* cb, const float* dtb, const float* alog, int gtid, int NT, int tid, int nblk, int blk) {
    const bf16_t* __restrict__ XST = (const bf16_t*)(ws + RB_XST); bf16_t* __restrict__ XSTC = (bf16_t*)(ws + RB_XSTC);
    for (int u = gtid; u < 1024 * (HT / 8); u += NT) {
        const int tb = u & (HT / 8 - 1), c = u >> 11, t0 = tb * 8;
        float x[11], cur[8];
        unpack8(*(const u32x4*)(XST + (size_t)c * HT + t0), cur);
        if ((t0 & (SEQ - 1)) != 0) { float pv[8]; unpack8(*(const u32x4*)(XST + (size_t)c * HT + t0 - 8), pv); x[0] = pv[5]; x[1] = pv[6]; x[2] = pv[7]; }
        else { x[0] = 0.f; x[1] = 0.f; x[2] = 0.f; }
#pragma unroll
        for (int i = 0; i < 8; ++i) x[3 + i] = cur[i];
        const float w0 = cw[c], w1 = cw[2048 + c], w2 = cw[4096 + c], w3 = cw[6144 + c], b = cb[c];
        float y[8];
#pragma unroll
        for (int i = 0; i < 8; ++i) y[i] = siluf_(b + w0 * x[i] + w1 * x[i + 1] + w2 * x[i + 2] + w3 * x[i + 3]);
        *(u32x4*)(XSTC + (size_t)c * HT + t0) = pack8(y);
    }
    const bf16_t* __restrict__ BC = (const bf16_t*)(ws + RB_BC); bf16_t* __restrict__ BCC = (bf16_t*)(ws + RB_BCC); bf16_t* __restrict__ BTC = (bf16_t*)(ws + RB_BTC);
    for (int u = gtid; u < (HT / 8) * 128; u += NT) {
        const int cg8 = u & 127, c0 = cg8 * 8, t0 = (u >> 7) * 8, cc = 1024 + c0;
        float w0[8], w1[8], w2[8], w3[8], bb[8], x1[8], x2[8], x3[8];
#pragma unroll
        for (int j = 0; j < 8; ++j) { w0[j] = cw[cc + j]; w1[j] = cw[2048 + cc + j]; w2[j] = cw[4096 + cc + j]; w3[j] = cw[6144 + cc + j]; bb[j] = cb[cc + j]; x1[j] = 0.f; x2[j] = 0.f; x3[j] = 0.f; }
        if ((t0 & (SEQ - 1)) != 0) {
            unpack8(*(const u32x4*)(BC + (size_t)(t0 - 1) * DM + c0), x1); unpack8(*(const u32x4*)(BC + (size_t)(t0 - 2) * DM + c0), x2); unpack8(*(const u32x4*)(BC + (size_t)(t0 - 3) * DM + c0), x3);
        }
        unsigned tr[8][4];
#pragma unroll
        for (int i = 0; i < 8; ++i) {
            float x0[8], y[8];
            unpack8(*(const u32x4*)(BC + (size_t)(t0 + i) * DM + c0), x0);
#pragma unroll
            for (int j = 0; j < 8; ++j) { y[j] = siluf_(bb[j] + w3[j] * x0[j] + w2[j] * x1[j] + w1[j] * x2[j] + w0[j] * x3[j]); x3[j] = x2[j]; x2[j] = x1[j]; x1[j] = x0[j]; }
            *(u32x4*)(BCC + (size_t)(t0 + i) * DM + c0) = pack8(y);
#pragma unroll
            for (int j = 0; j < 8; ++j) { if (i & 1) tr[j][i >> 1] |= f2bf(y[j]) << 16; else tr[j][i >> 1] = f2bf(y[j]); }
        }
        if (cg8 < 64) {
#pragma unroll
            for (int j = 0; j < 8; ++j) *(u32x4*)(BTC + (size_t)(c0 + j) * HT + t0) = (u32x4){tr[j][0], tr[j][1], tr[j][2], tr[j][3]};
        }
    }
    const float* __restrict__ DTGK = (const float*)(ws + WS_DTGK); float* __restrict__ DT = (float*)(ws + RB_DT); float* __restrict__ AC = (float*)(ws + RB_ACUM);
    {
        const int lane_ = tid & 63, gw_ = blk * NWAVES + (tid >> 6), ngw_ = nblk * NWAVES;
        for (int ch = gw_; ch < HT / 128; ch += ngw_) {
            const size_t tA = (size_t)ch * 128 + 2 * lane_;
            float d0[16], d1[16];
#pragma unroll
            for (int q = 0; q < 4; ++q) { const f32x4 a = *(const f32x4*)(DTGK + tA * 32 + 4 * q), b = *(const f32x4*)(DTGK + (tA + 1) * 32 + 4 * q);
#pragma unroll
                for (int e = 0; e < 4; ++e) { d0[4 * q + e] = a[e]; d1[4 * q + e] = b[e]; } }
            float c0[16], c1[16];
#pragma unroll
            for (int h = 0; h < 16; ++h) {
                const float av = -__expf(alog[h]), bias = dtb[h];
                d0[h] = softplusf_(d0[h] + bias); d1[h] = softplusf_(d1[h] + bias);
                const float x0 = d0[h] * av, x1 = x0 + d1[h] * av;
                float s = x1;
#pragma unroll
                for (int off = 1; off < 64; off <<= 1) { const float y = __shfl_up(s, off); if (lane_ >= off) s += y; }
                const float pre = s - x1; c0[h] = pre + x0; c1[h] = pre + x1;
            }
#pragma unroll
            for (int q = 0; q < 4; ++q) {
                *(f32x4*)(DT + tA * 16 + 4 * q) = (f32x4){d0[4 * q], d0[4 * q + 1], d0[4 * q + 2], d0[4 * q + 3]};
                *(f32x4*)(DT + (tA + 1) * 16 + 4 * q) = (f32x4){d1[4 * q], d1[4 * q + 1], d1[4 * q + 2], d1[4 * q + 3]};
                *(f32x4*)(AC + tA * 16 + 4 * q) = (f32x4){c0[4 * q], c0[4 * q + 1], c0[4 * q + 2], c0[4 * q + 3]};
                *(f32x4*)(AC + (tA + 1) * 16 + 4 * q) = (f32x4){c1[4 * q], c1[4 * q + 1], c1[4 * q + 2], c1[4 * q + 3]};
            }
        }
    }
}

DEV void phase_ssd_states(unsigned char* ws, LAS unsigned char* lds, int tid, int wave, int lane) {
    const bf16_t* XSTC = (const bf16_t*)(ws + RB_XSTC); const bf16_t* BTC = (const bf16_t*)(ws + RB_BTC);
    const float* DT = (const float*)(ws + RB_DT); const float* AC = (const float*)(ws + RB_ACUM); bf16_t* ST = (bf16_t*)(ws + RB_ST);
    constexpr int BT_OFF = 0, XW_OFF = 34816, TAB_OFF = 34816 + 69632, RS = 272;
    LAS float* wt = (LAS float*)(lds + TAB_OFF);
    const int fr = lane & 15, fq = lane >> 4;
    for (int unit = blockIdx.x; unit < (HT / 128) * 4; unit += gridDim.x) {
        const int cidx = unit >> 2, g = unit & 3, t0 = cidx * 128;
        { const int r = tid >> 7, l = tid & 127, h = g * 4 + r;
          const float al = AC[(size_t)(t0 + 127) * 16 + h], a = AC[(size_t)(t0 + l) * 16 + h];
          wt[r * 128 + l] = DT[(size_t)(t0 + l) * 16 + h] * __expf(al - a); }
        for (int i = tid; i < 2048; i += NTHR) { const int row = i >> 4, ch = i & 15;
            *(LAS u32x4*)(lds + BT_OFF + row * RS + ch * 16) = *(const u32x4*)(BTC + (size_t)(g * 128 + row) * HT + t0 + ch * 8); }
        __syncthreads();
        for (int i = tid; i < 4096; i += NTHR) { const int row = i >> 4, ch = i & 15; float f[8];
            unpack8(*(const u32x4*)(XSTC + (size_t)(g * 256 + row) * HT + t0 + ch * 8), f);
            const LAS float* wp = wt + (row >> 6) * 128 + ch * 8;
#pragma unroll
            for (int e = 0; e < 8; ++e) f[e] *= wp[e];
            *(LAS u32x4*)(lds + XW_OFF + row * RS + ch * 16) = pack8(f); }
        __syncthreads();
        f32x4 acc[2][8];
#pragma unroll
        for (int a = 0; a < 2; ++a)
#pragma unroll
            for (int b = 0; b < 8; ++b) acc[a][b] = (f32x4){0.f, 0.f, 0.f, 0.f};
#pragma unroll
        for (int ks = 0; ks < 4; ++ks) {
            const bf16x8 y0 = ldsfrag(lds + XW_OFF + (wave * 32 + fr) * RS + ks * 64 + fq * 16), y1 = ldsfrag(lds + XW_OFF + (wave * 32 + 16 + fr) * RS + ks * 64 + fq * 16);
#pragma unroll
            for (int nt = 0; nt < 8; ++nt) { const bf16x8 x = ldsfrag(lds + BT_OFF + (nt * 16 + fr) * RS + ks * 64 + fq * 16); acc[0][nt] = mma(x, y0, acc[0][nt]); acc[1][nt] = mma(x, y1, acc[1][nt]); }
        }
#pragma unroll
        for (int yt = 0; yt < 2; ++yt) { const int pp = wave * 32 + yt * 16 + fr, h = g * 4 + (pp >> 6), p = pp & 63;
            bf16_t* d = ST + (((size_t)cidx * 16 + h) * 64 + p) * 128 + 4 * fq;
#pragma unroll
            for (int nt = 0; nt < 8; ++nt) { u32x2 w; w.x = pk2(acc[yt][nt][0], acc[yt][nt][1]); w.y = pk2(acc[yt][nt][2], acc[yt][nt][3]); *(u32x2*)(d + nt * 16) = w; } }
        __syncthreads();
    }
}

DEV void phase_ssd_scan(unsigned char* ws, int gtid, int NT) {
    unsigned* ST = (unsigned*)(ws + RB_ST); const float* AC = (const float*)(ws + RB_ACUM);
    for (int e = gtid; e < 2 * 65536; e += NT) {
        const int bl = e >> 16, rem = e & 65535, h = rem >> 12;
        f32x2 carry = {0.f, 0.f};
        for (int c0 = 0; c0 < 64; c0 += 8) {
            unsigned v[8]; float dec[8];
#pragma unroll
            for (int i = 0; i < 8; ++i) { const int cidx = bl * 64 + c0 + i; v[i] = ST[(size_t)cidx * 65536 + rem]; dec[i] = __expf(AC[((size_t)cidx * 128 + 127) * 16 + h]); }
#pragma unroll
            for (int i = 0; i < 8; ++i) { const int cidx = bl * 64 + c0 + i; ST[(size_t)cidx * 65536 + rem] = pk2(carry[0], carry[1]);
                carry[0] = carry[0] * dec[i] + bf_lo(v[i]); carry[1] = carry[1] * dec[i] + bf_hi(v[i]); }
        }
    }
}

DEV void phase_ssd_out(unsigned char* ws, const float* dsk, const float* nw, LAS unsigned char* lds, int tid, int wave, int lane) {
    const bf16_t* XSTC = (const bf16_t*)(ws + RB_XSTC); const bf16_t* BCC = (const bf16_t*)(ws + RB_BCC); const bf16_t* Z = (const bf16_t*)(ws + RB_Z);
    const float* DT = (const float*)(ws + RB_DT); const float* AC = (const float*)(ws + RB_ACUM); const bf16_t* ST = (const bf16_t*)(ws + RB_ST);
    bf16_t* YIN = (bf16_t*)(ws + WS_YIN);
    float* YT = (float*)(ws + RB_XST);
    constexpr int C_OFF = 0, B_OFF = 34816, PV_OFF = 34816, XS_OFF = 34816 + 17408, M_OFF = 69632, TAB_OFF = 104448, RS = 272;
    LAS float* tac = (LAS float*)(lds + TAB_OFF); LAS float* tdt = tac + 512;
    const int fr = lane & 15, fq = lane >> 4;
    LAS unsigned char* Mw = lds + M_OFF + wave * 4352;
    for (int unit = blockIdx.x; unit < (HT / 128) * 4; unit += gridDim.x) {
        const int cidx = unit >> 2, g = unit & 3, t0 = cidx * 128;
        for (int i = tid; i < 2048; i += NTHR) { const int row = i >> 4, ch = i & 15;
            *(LAS u32x4*)(lds + C_OFF + row * RS + ch * 16) = *(const u32x4*)(BCC + (size_t)(t0 + row) * DM + 512 + g * 128 + ch * 8);
            *(LAS u32x4*)(lds + B_OFF + row * RS + ch * 16) = *(const u32x4*)(BCC + (size_t)(t0 + row) * DM + g * 128 + ch * 8); }
        { const int r = tid >> 7, l = tid & 127, h = g * 4 + r; tac[tid] = AC[(size_t)(t0 + l) * 16 + h]; tdt[tid] = DT[(size_t)(t0 + l) * 16 + h]; }
        __syncthreads();
        f32x4 cb[8];
#pragma unroll
        for (int st = 0; st < 8; ++st) cb[st] = (f32x4){0.f, 0.f, 0.f, 0.f};
#pragma unroll
        for (int ks = 0; ks < 4; ++ks) {
            const bf16x8 y = ldsfrag(lds + C_OFF + (wave * 16 + fr) * RS + ks * 64 + fq * 16);
#pragma unroll
            for (int st = 0; st < 8; ++st) cb[st] = mma(ldsfrag(lds + B_OFF + (st * 16 + fr) * RS + ks * 64 + fq * 16), y, cb[st]);
        }
        __syncthreads();
        const int l = wave * 16 + fr;
        const size_t t = (size_t)(t0 + l);
        float ssq = 0.f;
        u32x4 pvr0, pvr1, xsr0, xsr1; u32x2 zr[4];
#define SSD_LOADH(RR) do { const int h_ = g * 4 + (RR); const int row_ = tid >> 4, ch_ = tid & 15; \
            pvr0 = *(const u32x4*)(ST + (((size_t)cidx * 16 + h_) * 64 + row_) * 128 + ch_ * 8); pvr1 = *(const u32x4*)(ST + (((size_t)cidx * 16 + h_) * 64 + row_ + 32) * 128 + ch_ * 8); \
            xsr0 = *(const u32x4*)(XSTC + (size_t)(h_ * 64 + row_) * HT + t0 + ch_ * 8); xsr1 = *(const u32x4*)(XSTC + (size_t)(h_ * 64 + row_ + 32) * HT + t0 + ch_ * 8); \
            _Pragma("unroll") for (int pt_ = 0; pt_ < 4; ++pt_) zr[pt_] = *(const u32x2*)(Z + t * DM + g * 256 + (RR) * 64 + pt_ * 16 + 4 * fq); } while (0)
        SSD_LOADH(0);
#pragma unroll 1
        for (int r = 0; r < 4; ++r) {
            const int h = g * 4 + r;
            { const int row_ = tid >> 4, ch_ = tid & 15;
              *(LAS u32x4*)(lds + PV_OFF + row_ * RS + ch_ * 16) = pvr0; *(LAS u32x4*)(lds + PV_OFF + (row_ + 32) * RS + ch_ * 16) = pvr1;
              *(LAS u32x4*)(lds + XS_OFF + row_ * RS + ch_ * 16) = xsr0; *(LAS u32x4*)(lds + XS_OFF + (row_ + 32) * RS + ch_ * 16) = xsr1; }
            u32x2 zc[4];
#pragma unroll
            for (int pt = 0; pt < 4; ++pt) zc[pt] = zr[pt];
            const float al = tac[r * 128 + l];
#pragma unroll
            for (int st = 0; st < 8; ++st) { float m[4];
#pragma unroll
                for (int j = 0; j < 4; ++j) { const int s = st * 16 + 4 * fq + j; const float d = fminf(al - tac[r * 128 + s], 0.f); m[j] = (s <= l) ? cb[st][j] * __expf(d) * tdt[r * 128 + s] : 0.f; }
                u32x2 w; w.x = pk2(m[0], m[1]); w.y = pk2(m[2], m[3]); *(LAS u32x2*)(Mw + fr * RS + (st * 16 + 4 * fq) * 2) = w; }
            __syncthreads();
            if (r < 3) SSD_LOADH(r + 1);
            f32x4 acc[4];
#pragma unroll
            for (int pt = 0; pt < 4; ++pt) acc[pt] = (f32x4){0.f, 0.f, 0.f, 0.f};
#pragma unroll
            for (int ks = 0; ks < 4; ++ks) { const bf16x8 y = ldsfrag(lds + C_OFF + l * RS + ks * 64 + fq * 16);
#pragma unroll
                for (int pt = 0; pt < 4; ++pt) acc[pt] = mma(ldsfrag(lds + PV_OFF + (pt * 16 + fr) * RS + ks * 64 + fq * 16), y, acc[pt]); }
            const float el = __expf(al);
#pragma unroll
            for (int pt = 0; pt < 4; ++pt) acc[pt] *= el;
#pragma unroll
            for (int ks = 0; ks < 4; ++ks) { const bf16x8 y = ldsfrag(Mw + fr * RS + ks * 64 + fq * 16);
#pragma unroll
                for (int pt = 0; pt < 4; ++pt) acc[pt] = mma(ldsfrag(lds + XS_OFF + (pt * 16 + fr) * RS + ks * 64 + fq * 16), y, acc[pt]); }
            const float dh = dsk[h];
#pragma unroll
            for (int pt = 0; pt < 4; ++pt) {
#pragma unroll
                for (int j = 0; j < 4; ++j) { const bf16_t xv = *(const LAS bf16_t*)(lds + XS_OFF + (pt * 16 + 4 * fq + j) * RS + l * 2); acc[pt][j] += dh * bf1(xv); }
                const int c = g * 256 + r * 64 + pt * 16 + 4 * fq;
                const u32x2 zw = zc[pt];
                f32x4 v = acc[pt]; v[0] *= bf_lo(zw.x); v[1] *= bf_hi(zw.x); v[2] *= bf_lo(zw.y); v[3] *= bf_hi(zw.y);
                ssq += (v[0] * v[0] + v[1] * v[1]) + (v[2] * v[2] + v[3] * v[3]);
                *(f32x4*)(YT + t * DM + c) = v;
            }
            __syncthreads();
        }
        ssq += __shfl_xor(ssq, 16); ssq += __shfl_xor(ssq, 32);
        const float rstd = rsqrtf(ssq * (1.f / 256.f) + EPS);
#pragma unroll 4
        for (int q = 0; q < 16; ++q) { const int c = g * 256 + q * 16 + 4 * fq;
            const f32x4 w4 = *(const f32x4*)(nw + c); const f32x4 v = *(const f32x4*)(YT + t * DM + c);
            u32x2 o; o.x = pk2(v[0] * rstd * w4[0], v[1] * rstd * w4[1]); o.y = pk2(v[2] * rstd * w4[2], v[3] * rstd * w4[3]);
            *(u32x2*)(YIN + t * DM + c) = o; }
        __syncthreads();
    }
}

DEV float gla_gk(const float* DTGK, size_t t, const float (&w)[16], float b) {
    const f32x4* gl = (const f32x4*)(DTGK + t * 32 + 16);
    const f32x4 g0 = gl[0], g1 = gl[1], g2 = gl[2], g3 = gl[3];
    float z = b;
    z += g0[0] * w[0] + g0[1] * w[1] + g0[2] * w[2] + g0[3] * w[3];
    z += g1[0] * w[4] + g1[1] * w[5] + g1[2] * w[6] + g1[3] * w[7];
    z += g2[0] * w[8] + g2[1] * w[9] + g2[2] * w[10] + g2[3] * w[11];
    z += g3[0] * w[12] + g3[1] * w[13] + g3[2] * w[14] + g3[3] * w[15];
    return logsigf_(z) * (1.f / 16.f);
}
DEV void phase_gla_prep(unsigned char* ws, const float* __restrict__ w2, const float* __restrict__ bg, int gtid, int NT) {
    bf16_t* QK = (bf16_t*)(ws + RC_QK); bf16_t* __restrict__ KT = (bf16_t*)(ws + RC_KT); float* __restrict__ DEC = (float*)(ws + WS_DEC);
    const float* __restrict__ DTGK = (const float*)(ws + WS_DTGK);
    const int lane = gtid & 63, gwv = gtid >> 6, nwv = NT >> 6;
    for (int u = gwv; u < (HT / 64) * 64; u += nwv) {
        const int cg = u & 63, ch = u >> 6, d0 = cg * 8; const size_t t = (size_t)ch * 64 + lane;
        const f32x4* gl = (const f32x4*)(DTGK + t * 32 + 16);
        const f32x4 g0 = gl[0], g1 = gl[1], g2 = gl[2], g3 = gl[3];
        const float glv[16] = {g0[0], g0[1], g0[2], g0[3], g1[0], g1[1], g1[2], g1[3], g2[0], g2[1], g2[2], g2[3], g3[0], g3[1], g3[2], g3[3]};
        bf16_t* qp = QK + t * DM + d0;
        float q[8], k[8]; unpack8(*(const u32x4*)qp, q); unpack8(*(const u32x4*)(qp + 512), k);
        float z[8];
        { const f32x4 b0 = *(const f32x4*)(bg + d0), b1 = *(const f32x4*)(bg + d0 + 4);
#pragma unroll
          for (int c = 0; c < 4; ++c) { z[c] = b0[c]; z[4 + c] = b1[c]; } }
#pragma unroll
        for (int j = 0; j < 16; ++j) { const f32x4 wa = *(const f32x4*)(w2 + j * 512 + d0), wb = *(const f32x4*)(w2 + j * 512 + d0 + 4);
#pragma unroll
            for (int c = 0; c < 4; ++c) { z[c] += glv[j] * wa[c]; z[4 + c] += glv[j] * wb[c]; } }
        float qo[8], ko[8], dec8[8];
#pragma unroll
        for (int c = 0; c < 8; ++c) {
            float s = logsigf_(z[c]) * (1.f / 16.f);
#pragma unroll
            for (int off = 1; off < 64; off <<= 1) { const float y = __shfl_up(s, off); if (lane >= off) s += y; }
            const float glast = __shfl(s, 63);
            qo[c] = q[c] * 0.08838834764831845f * __expf(s);
            ko[c] = k[c] * __expf(-s);
            KT[(size_t)(d0 + c) * HT + t] = (bf16_t)f2bf(k[c] * __expf(glast - s));
            dec8[c] = __expf(glast);
        }
        *(u32x4*)qp = pack8(qo); *(u32x4*)(qp + 512) = pack8(ko);
        if (lane == 63) { float* dp = DEC + (size_t)ch * 512 + d0; *(f32x4*)dp = (f32x4){dec8[0], dec8[1], dec8[2], dec8[3]}; *(f32x4*)(dp + 4) = (f32x4){dec8[4], dec8[5], dec8[6], dec8[7]}; }
    }
}

DEV void phase_gla_states(unsigned char* ws, LAS unsigned char* lds, int tid, int wave, int lane) {
    const bf16_t* KT = (const bf16_t*)(ws + RC_KT); const bf16_t* VT = (const bf16_t*)(ws + RC_VT); bf16_t* ST = (bf16_t*)(ws + RC_ST);
    constexpr int V_OFF = 0, K_OFF = 36864, RS = 144;
    const int fr = lane & 15, fq = lane >> 4;
    for (int unit = blockIdx.x; unit < (HT / 64) * 4; unit += gridDim.x) {
        const int cidx = unit >> 2, h = unit & 3, t0 = cidx * 64;
        for (int i = tid; i < 2048; i += NTHR) { const int row = i >> 3, ch = i & 7;
            *(LAS u32x4*)(lds + V_OFF + row * RS + ch * 16) = *(const u32x4*)(VT + (size_t)(h * 256 + row) * HT + t0 + ch * 8); }
        for (int i = tid; i < 1024; i += NTHR) { const int row = i >> 3, ch = i & 7;
            *(LAS u32x4*)(lds + K_OFF + row * RS + ch * 16) = *(const u32x4*)(KT + (size_t)(h * 128 + row) * HT + t0 + ch * 8); }
        __syncthreads();
        f32x4 acc[2][8];
#pragma unroll
        for (int a = 0; a < 2; ++a)
#pragma unroll
            for (int b = 0; b < 8; ++b) acc[a][b] = (f32x4){0.f, 0.f, 0.f, 0.f};
#pragma unroll
        for (int ks = 0; ks < 2; ++ks) {
            const bf16x8 y0 = ldsfrag(lds + V_OFF + (wave * 32 + fr) * RS + ks * 64 + fq * 16), y1 = ldsfrag(lds + V_OFF + (wave * 32 + 16 + fr) * RS + ks * 64 + fq * 16);
#pragma unroll
            for (int dt = 0; dt < 8; ++dt) { const bf16x8 x = ldsfrag(lds + K_OFF + (dt * 16 + fr) * RS + ks * 64 + fq * 16); acc[0][dt] = mma(x, y0, acc[0][dt]); acc[1][dt] = mma(x, y1, acc[1][dt]); }
        }
#pragma unroll
        for (int yt = 0; yt < 2; ++yt) { const int v = wave * 32 + yt * 16 + fr;
            bf16_t* dp = ST + (((size_t)cidx * 4 + h) * 256 + v) * 128 + 4 * fq;
#pragma unroll
            for (int dt = 0; dt < 8; ++dt) { u32x2 w; w.x = pk2(acc[yt][dt][0], acc[yt][dt][1]); w.y = pk2(acc[yt][dt][2], acc[yt][dt][3]); *(u32x2*)(dp + dt * 16) = w; } }
        __syncthreads();
    }
}

DEV void phase_gla_scan(unsigned char* ws, int gtid, int NT) {
    unsigned* ST = (unsigned*)(ws + RC_ST); const float* DEC = (const float*)(ws + WS_DEC);
    for (int e = gtid; e < 2 * 65536; e += NT) {
        const int bl = e >> 16, rem = e & 65535, h = rem >> 14, d = (rem * 2) & 127;
        f32x2 carry = {0.f, 0.f};
        for (int c0 = 0; c0 < 128; c0 += 8) {
            unsigned v[8]; f32x2 dec[8];
#pragma unroll
            for (int i = 0; i < 8; ++i) { const int cidx = bl * 128 + c0 + i; v[i] = ST[(size_t)cidx * 65536 + rem]; dec[i] = *(const f32x2*)(DEC + (size_t)cidx * 512 + h * 128 + d); }
#pragma unroll
            for (int i = 0; i < 8; ++i) { const int cidx = bl * 128 + c0 + i; ST[(size_t)cidx * 65536 + rem] = pk2(carry[0], carry[1]);
                carry[0] = carry[0] * dec[i][0] + bf_lo(v[i]); carry[1] = carry[1] * dec[i][1] + bf_hi(v[i]); }
        }
    }
}

DEV void phase_gla_out(unsigned char* ws, const float* nw, LAS unsigned char* lds, int tid, int wave, int lane) {
    const bf16_t* QK = (const bf16_t*)(ws + RC_QK); const bf16_t* VT = (const bf16_t*)(ws + RC_VT); const bf16_t* GS = (const bf16_t*)(ws + RC_GS);
    const bf16_t* ST = (const bf16_t*)(ws + RC_ST); bf16_t* YIN = (bf16_t*)(ws + WS_YIN);
    constexpr int Q_OFF = 0, K_OFF = 17408, V_OFF = 34816, P_OFF = 71680, S_OFF = 80896, RSD = 272, RST = 144;
    LAS float* ssqt = (LAS float*)(lds + S_OFF);
    const int fr = lane & 15, fq = lane >> 4, lt = wave >> 1, vh = wave & 1;
    for (int unit = blockIdx.x; unit < (HT / 64) * 4; unit += gridDim.x) {
        const int cidx = unit >> 2, h = unit & 3, t0 = cidx * 64;
        for (int i = tid; i < 1024; i += NTHR) { const int row = i >> 4, ch = i & 15;
            *(LAS u32x4*)(lds + Q_OFF + row * RSD + ch * 16) = *(const u32x4*)(QK + (size_t)(t0 + row) * DM + h * 128 + ch * 8);
            *(LAS u32x4*)(lds + K_OFF + row * RSD + ch * 16) = *(const u32x4*)(QK + (size_t)(t0 + row) * DM + 512 + h * 128 + ch * 8); }
        for (int i = tid; i < 2048; i += NTHR) { const int row = i >> 3, ch = i & 7;
            *(LAS u32x4*)(lds + V_OFF + row * RST + ch * 16) = *(const u32x4*)(VT + (size_t)(h * 256 + row) * HT + t0 + ch * 8); }
        __syncthreads();
        const int l = lt * 16 + fr;
        {
            f32x4 sc[2] = {(f32x4){0.f, 0.f, 0.f, 0.f}, (f32x4){0.f, 0.f, 0.f, 0.f}};
#pragma unroll
            for (int ks = 0; ks < 4; ++ks) { const bf16x8 y = ldsfrag(lds + Q_OFF + l * RSD + ks * 64 + fq * 16);
#pragma unroll
                for (int i = 0; i < 2; ++i) sc[i] = mma(ldsfrag(lds + K_OFF + ((2 * vh + i) * 16 + fr) * RSD + ks * 64 + fq * 16), y, sc[i]); }
#pragma unroll
            for (int i = 0; i < 2; ++i) { const int s0 = (2 * vh + i) * 16 + 4 * fq; float m[4];
#pragma unroll
                for (int j = 0; j < 4; ++j) m[j] = (s0 + j <= l) ? sc[i][j] : 0.f;
                u32x2 w; w.x = pk2(m[0], m[1]); w.y = pk2(m[2], m[3]); *(LAS u32x2*)(lds + P_OFF + l * RST + s0 * 2) = w; }
        }
        __syncthreads();
        f32x4 acc[8];
#pragma unroll
        for (int i = 0; i < 8; ++i) acc[i] = (f32x4){0.f, 0.f, 0.f, 0.f};
#pragma unroll
        for (int ks = 0; ks < 2; ++ks) { const bf16x8 y = ldsfrag(lds + P_OFF + l * RST + ks * 64 + fq * 16);
#pragma unroll
            for (int i = 0; i < 8; ++i) acc[i] = mma(ldsfrag(lds + V_OFF + ((vh * 8 + i) * 16 + fr) * RST + ks * 64 + fq * 16), y, acc[i]); }
        const bf16_t* sp = ST + (((size_t)cidx * 4 + h) * 256 + vh * 128 + fr) * 128 + fq * 8;
#pragma unroll
        for (int ks = 0; ks < (GLA_NO_INTER ? 0 : 4); ++ks) { const bf16x8 y = ldsfrag(lds + Q_OFF + l * RSD + ks * 64 + fq * 16);
#pragma unroll
            for (int i = 0; i < 8; ++i) acc[i] = mma(*(const bf16x8*)(sp + (size_t)i * 16 * 128 + ks * 32), y, acc[i]); }
        float ssq = 0.f;
#pragma unroll
        for (int i = 0; i < 8; ++i) ssq += (acc[i][0] * acc[i][0] + acc[i][1] * acc[i][1]) + (acc[i][2] * acc[i][2] + acc[i][3] * acc[i][3]);
        ssq += __shfl_xor(ssq, 16); ssq += __shfl_xor(ssq, 32);
        if (fq == 0) ssqt[l * 2 + vh] = ssq;
        __syncthreads();
        const float rstd = rsqrtf((ssqt[l * 2] + ssqt[l * 2 + 1]) * (1.f / 256.f) + EPS);
        const size_t t = (size_t)(t0 + l);
#pragma unroll
        for (int i = 0; i < 8; ++i) { const int v = (vh * 8 + i) * 16 + 4 * fq, c = h * 256 + v;
            const u32x2 gw = *(const u32x2*)(GS + t * DM + c); const f32x4 w4 = *(const f32x4*)(nw + v);
            u32x2 o; o.x = pk2(acc[i][0] * rstd * w4[0] * bf_lo(gw.x), acc[i][1] * rstd * w4[1] * bf_hi(gw.x));
            o.y = pk2(acc[i][2] * rstd * w4[2] * bf_lo(gw.y), acc[i][3] * rstd * w4[3] * bf_hi(gw.y));
            *(u32x2*)(YIN + t * DM + c) = o; }
        __syncthreads();
    }
}


#define XB_TMO      128
#define XB_XCNT(j)  (256  + 64 * (j))
#define XB_XSUB(j)  (1280 + 64 * (j))
#define XB_XGEN(j)  (2304 + 64 * (j))
#define XB_TOP      3328
#define XB_TOPGEN   3392
#define XCD_BAR_WORDS 3456
#define XB_SPIN_CAP (1u << 22)
DEV unsigned xb_ld(unsigned* p)              { return __hip_atomic_load(p, __ATOMIC_RELAXED, __HIP_MEMORY_SCOPE_AGENT); }
DEV unsigned xb_add(unsigned* p, unsigned v) { return __hip_atomic_fetch_add(p, v, __ATOMIC_RELAXED, __HIP_MEMORY_SCOPE_AGENT); }
DEV unsigned xb_xcc_id() { return (unsigned)__builtin_amdgcn_s_getreg((3 << 11) | 20) & 0xFu; }
#define XB_SPIN(cond, bar) do { unsigned _sp = 0; while (cond) { __builtin_amdgcn_s_sleep(1); \
    if ((++_sp & 255u) == 0u) { if (xb_ld(&(bar)[XB_TMO])) break; if (_sp > XB_SPIN_CAP) { atomicAdd(&(bar)[XB_TMO], 1u); break; } } } } while (0)
DEV void xcd_barrier_complete(unsigned* bar, unsigned x, unsigned Gn, unsigned& nloc, unsigned& nx) {
    unsigned sum, cnt, mine, sp = 0u;
    for (;;) {
        sum = 0u; cnt = 0u; mine = 0u;
#pragma unroll
        for (unsigned j = 0; j < 16; ++j) { const unsigned c = xb_ld(&bar[XB_XCNT(j)]); sum += c; cnt += (c > 0u) ? 1u : 0u; mine = (j == x) ? c : mine; }
        if (sum == Gn) break;
        __builtin_amdgcn_s_sleep(1);
        if ((++sp & 255u) == 0u) { if (xb_ld(&bar[XB_TMO])) break; if (sp > XB_SPIN_CAP) { atomicAdd(&bar[XB_TMO], 1u); break; } }
    }
    nloc = mine > 0u ? mine : 1u; nx = cnt > 0u ? cnt : 1u;
}
DEV void xcd_barrier(unsigned* bar, unsigned x, volatile LAS unsigned* st, int tid, unsigned Gn) {
    asm volatile("s_waitcnt vmcnt(0)" ::: "memory");
    __syncthreads();
    if (tid == 0) {
        __builtin_amdgcn_s_waitcnt(0);
        unsigned nloc = st[0], nx = st[1];
        if (nloc == 0u) { xcd_barrier_complete(bar, x, Gn, nloc, nx); st[0] = nloc; st[1] = nx; }
        const unsigned old = xb_add(&bar[XB_XSUB(x)], 1u);
        const unsigned gen = old / nloc;
        if (old + 1u == (gen + 1u) * nloc) {
            __builtin_amdgcn_fence(__ATOMIC_RELEASE, "agent");
            asm volatile("s_waitcnt vmcnt(0)" ::: "memory");
            const unsigned og = xb_add(&bar[XB_TOP], 1u);
            const unsigned tg = og / nx;
            if (og + 1u == (tg + 1u) * nx) xb_add(&bar[XB_TOPGEN], 1u);
            else XB_SPIN(xb_ld(&bar[XB_TOPGEN]) == tg, bar);
            __builtin_amdgcn_fence(__ATOMIC_ACQUIRE, "agent");
            xb_add(&bar[XB_XGEN(x)], 1u);
            asm volatile("s_waitcnt vmcnt(0)" ::: "memory");
        } else {
            XB_SPIN(xb_ld(&bar[XB_XGEN(x)]) == gen, bar);
            __builtin_amdgcn_fence(__ATOMIC_ACQUIRE, "agent");
            asm volatile("s_waitcnt vmcnt(0)" ::: "memory");
        }
    }
    __syncthreads();
}

typedef const __attribute__((address_space(4))) Params* KParams;
DEV KParams kargs() { unsigned long long kp = (unsigned long long)__builtin_amdgcn_kernarg_segment_ptr(); asm volatile("" : "+s"(kp)); return (KParams)kp; }

__global__ void __launch_bounds__(NTHR, 2) mega_fwd(Params Parg, int pc_lo, int pc_hi, int coop, int pad_) {
    extern __shared__ __attribute__((aligned(16))) unsigned char smem[];
    cg::grid_group grid = cg::this_grid();
    if (coop) grid.sync();
    volatile LAS unsigned* xst = (volatile LAS unsigned*)((LAS unsigned char*)smem + 139264 - 16);
    const unsigned xcc = xb_xcc_id();
    if (threadIdx.x == 0) { xst[0] = 0u; xst[1] = 0u; (void)xb_add((unsigned*)(asglobal(kargs()->ws) + WS_BAR) + XB_XCNT(xcc), 1u); }
    __syncthreads();
    using pg8::Sched; using pg8::job_put;
    constexpr int PER_LAYER = 1 + 34 + 3, NPC = 2 * PER_LAYER + 1;
#pragma unroll 1
    for (int pc0 = pc_lo; pc0 < pc_hi; ++pc0) {
        int pc = pc0; asm volatile("" : "+s"(pc));
        int tid = threadIdx.x; asm volatile("" : "+v"(tid));
        const int lane = tid & 63, wave = __builtin_amdgcn_readfirstlane(tid >> 6);
        unsigned ldso = 0; asm volatile("" : "+s"(ldso));
        LAS unsigned char* lds = (LAS unsigned char*)smem + ldso;
        int bxv = blockIdx.x, gdv = gridDim.x; asm volatile("" : "+s"(bxv), "+s"(gdv));
        const int layer = pc / PER_LAYER; const int r = pc - layer * PER_LAYER;
        int ph, hf = 0;
        if (pc == NPC - 1) ph = 21; else if (r == 0) ph = 0; else if (r <= 34) { hf = (r - 1) / 17; ph = (r - 1) - hf * 17 + 1; } else ph = 18 + (r - 35);
        asm volatile("" : "+s"(ph), "+s"(hf));
#define P kargs()
#define ws asglobal(kargs()->ws)
#define INP(i) asglobal(kargs()->in[i])
#define OUTP asglobal(kargs()->out)
#define G gdv
#define bx bxv
#define gw (bx * NWAVES + wave)
#define NGW (G * NWAVES)
#define gtid (bx * NTHR + tid)
#define NT (G * NTHR)
#define WIN ((bf16_t*)(ws + WS_WIN))
#define HB ((bf16_t*)(ws + WS_HB))
#define MERGED ((float*)(ws + WS_MERGED))
#define GB ((bf16_t*)(ws + WS_G))
#define YIN ((bf16_t*)(ws + WS_YIN))
#define xsrc (((layer == 0) ? INP(0) : (const float*)OUTP) + (size_t)hf * HT * DM)
#define xdst (OUTP + (size_t)hf * HT * DM)

#define PROBE11 0
#define NOMIX 0
#define NOMLP 0
#ifndef SKIPMASK

#define SKIPMASK 0u
#endif
        if ((SKIPMASK >> ph) & 1u) ph = 99;
#ifdef DELAY_PROBE
        if (bxv == 3) { const unsigned long long t0 = __builtin_amdgcn_s_memrealtime(); while (__builtin_amdgcn_s_memrealtime() - t0 < 30000ull) __builtin_amdgcn_s_sleep(64); }
#endif
        int nobar = 0;
        switch (ph) {
        case 0:
            phase_weights(ws, INP(2) + (size_t)layer * 1024 * INW, INP(4) + (size_t)layer * 1048576, INP(11) + (size_t)layer * 1048576, INP(15) + (size_t)layer * 1048576,
                          INP(16) + (size_t)layer * 1048576, INP(18) + (size_t)layer * 4194304, INP(19) + (size_t)layer * 4194304, lds, gw, NGW, wave, lane);
            phase_rmsnorm_bf16(xsrc, INP(1) + layer * DM, HB, HT, gw, NGW, lane);
            break;
        case 1:
            if (hf == 0) { nobar = 1; break; }
            phase_rmsnorm_bf16(xsrc, INP(1) + layer * DM, HB, HT, gw, NGW, lane);
            if (DUP2) phase_rmsnorm_bf16(xsrc, INP(1) + layer * DM, HB, HT, gw, NGW, lane);
            break;
        case 2: {
            if (tid == 0) { job_put(lds, 0, HB, WIN, ws + RA_UA, nullptr, 64, 12, 3072, 0); job_put(lds, 1, HB, WIN + (size_t)9248 * DM, GB, nullptr, 64, 4, 1024, 1); }
            Sched S; S.init(lds, 2, G, bx, DM, tid);
            pg8::GEMM_BODY<3>(lds, DM, S, tid);
            phase_narrow(HB, WIN + (size_t)6144 * DM, WIN + (size_t)9232 * DM, (float*)(ws + WS_DTGK), gw, NGW, lane);
            break; }
        case 3:
            phase_conv_a((const bf16_t*)(ws + RA_UA), INP(3) + (size_t)layer * 3 * 1024, YIN, gtid, NT);
            if (DUP2) phase_conv_a((const bf16_t*)(ws + RA_UA), INP(3) + (size_t)layer * 3 * 1024, YIN, gtid, NT);
            break;
        case 4: nobar = 1; break;
        case 5: {
            if (tid == 0) { job_put(lds, 0, YIN, ws + WS_WOA, MERGED, GB, 64, 4, 1024, 4);
                            job_put(lds, 1, HB, WIN + (size_t)3072 * DM, ws + RB_Z, nullptr, 64, 4, 1024, 2); job_put(lds, 2, WIN + (size_t)4096 * DM, HB, ws + RB_XST, nullptr, 4, 64, HT, 0);
                            job_put(lds, 3, HB, WIN + (size_t)5120 * DM, ws + RB_BC, nullptr, 64, 4, 1024, 0); job_put(lds, 4, HB, WIN + (size_t)10272 * DM, ws + WS_MSUM, nullptr, 64, 4, 1024, 1); }
            Sched S; S.init(lds, 5, G, bx, DM, tid); pg8::GEMM_BODY<23>(lds, DM, S, tid);
            break; }
        case 6:
            phase_ssd_prep(ws, INP(5) + (size_t)layer * 4 * 2048, INP(6) + (size_t)layer * 2048, INP(7) + layer * 16, INP(8) + layer * 16, gtid, NT, tid, G, bx);
            if (DUP2) phase_ssd_prep(ws, INP(5) + (size_t)layer * 4 * 2048, INP(6) + (size_t)layer * 2048, INP(7) + layer * 16, INP(8) + layer * 16, gtid, NT, tid, G, bx);
            break;
        case 7: phase_ssd_states(ws, lds, tid, wave, lane); if (DUP) { __syncthreads(); phase_ssd_states(ws, lds, tid, wave, lane); } break;
        case 8: phase_ssd_scan(ws, gtid, NT); break;
        case 9: phase_ssd_out(ws, INP(9) + layer * 16, INP(10) + layer * 1024, lds, tid, wave, lane); if (DUP) { __syncthreads(); phase_ssd_out(ws, INP(9) + layer * 16, INP(10) + layer * 1024, lds, tid, wave, lane); } break;
        case 10: nobar = 1; break;
        case 11: {
            if (tid == 0) { job_put(lds, 0, YIN, ws + WS_WOS, MERGED, ws + WS_MSUM, 64, 4, 1024, 5);
                            job_put(lds, 1, HB, WIN + (size_t)6160 * DM, ws + RC_QK, nullptr, 64, 4, 1024, 0); job_put(lds, 2, WIN + (size_t)7184 * DM, HB, ws + RC_VT, nullptr, 4, 64, HT, 0);
                            job_put(lds, 3, HB, WIN + (size_t)8208 * DM, ws + RC_GS, nullptr, 64, 4, 1024, 2); job_put(lds, 4, HB, WIN + (size_t)11296 * DM, GB, nullptr, 64, 4, 1024, 1); }
            Sched S; S.init(lds, 5, G, bx, DM, tid); pg8::GEMM_BODY<39>(lds, DM, S, tid);
            break; }
        case 12: phase_gla_prep(ws, INP(12) + (size_t)layer * 16 * 512, INP(13) + layer * 512, gtid, NT); break;
        case 13: phase_gla_states(ws, lds, tid, wave, lane); if (DUP) { __syncthreads(); phase_gla_states(ws, lds, tid, wave, lane); } break;
        case 14: phase_gla_scan(ws, gtid, NT); break;
        case 15: phase_gla_out(ws, INP(14) + layer * 256, lds, tid, wave, lane); if (DUP) { __syncthreads(); phase_gla_out(ws, INP(14) + layer * 256, lds, tid, wave, lane); } break;
        case 16: {
            if (tid == 0) job_put(lds, 0, YIN, ws + WS_WOG, ws + WS_MSUM, GB, 64, 4, 1024, 6);
            Sched S; S.init(lds, 1, G, bx, DM, tid); pg8::GEMM_BODY<64>(lds, DM, S, tid);
            break; }
        case 17: {
            if (tid == 0) job_put(lds, 0, GB, ws + WS_WO, xdst, xsrc, 64, 4, NOMIX ? 0 : 1024, 7);
            Sched S; S.init(lds, 1, G, bx, DM, tid); pg8::GEMM_BODY<128>(lds, DM, S, tid);
            break; }
        case 18:
            phase_rmsnorm_bf16(OUTP, INP(17) + layer * DM, (bf16_t*)(ws + WS_MERGED), T_ALL, gw, NGW, lane);
            break;
        case 19: {
            if (tid == 0) job_put(lds, 0, ws + WS_MERGED, ws + WS_WUP, ws + WS_R, nullptr, 128, 16, DFF, 3);
            Sched S; S.init(lds, 1, G, bx, DM, tid); pg8::GEMM_BODY<8>(lds, DM, S, tid);
            break; }
        case 20: {
            if (tid == 0) job_put(lds, 0, ws + WS_R, ws + WS_WDN, OUTP, OUTP, 128, 4, NOMLP ? 0 : 1024, 7);
            Sched S; S.init(lds, 1, G, bx, DFF, tid); pg8::GEMM_BODY<128>(lds, DFF, S, tid);
            break; }
        case 99: {
#ifdef SPIN_PROBE
            if (pc == 6 || pc == 23) { const unsigned long long t0 = __builtin_amdgcn_s_memrealtime(); while (__builtin_amdgcn_s_memrealtime() - t0 < 500000ull) __builtin_amdgcn_s_sleep(64); }
#endif
            break; }
        default:
            phase_rmsnorm_f32(OUTP, INP(20), T_ALL, gw, NGW, lane);
            break;
        }
        if (pc0 != pc_hi - 1 && !nobar) {
            xcd_barrier((unsigned*)(ws + WS_BAR), xcc, xst, tid, (unsigned)gdv);
            if (BAR2) xcd_barrier((unsigned*)(ws + WS_BAR), xcc, xst, tid, (unsigned)gdv);
        }
    }
#undef P
#undef ws
#undef INP
#undef OUTP
#undef G
#undef bx
#undef gw
#undef NGW
#undef gtid
#undef NT
#undef WIN
#undef HB
#undef MERGED
#undef GB
#undef YIN
#undef xsrc
#undef xdst
}

extern "C" void kernel_launch(void* const* d_in, const int* in_sizes, int n_in, void* d_out, int out_size, void* d_ws, size_t ws_size, hipStream_t stream) {
    static int grid = 0;
    if (grid == 0) {
        if (n_in != 21 || out_size != T_ALL * DM || ws_size < WS_TOTAL) { fprintf(stderr, "kernel_launch: unexpected shapes (n_in %d out %d ws %zu need %zu)\n", n_in, out_size, ws_size, (size_t)WS_TOTAL); grid = -1; return; }
        int dev = 0, cus = 0, per_cu = 0;
        hipGetDevice(&dev);
        hipDeviceGetAttribute(&cus, hipDeviceAttributeMultiprocessorCount, dev);
        if (hipFuncSetAttribute((const void*)mega_fwd, hipFuncAttributeMaxDynamicSharedMemorySize, LDS_BYTES) != hipSuccess) { fprintf(stderr, "kernel_launch: hipFuncSetAttribute failed\n"); }
        if (hipOccupancyMaxActiveBlocksPerMultiprocessor(&per_cu, (const void*)mega_fwd, NTHR, LDS_BYTES) != hipSuccess || per_cu < 1) { fprintf(stderr, "kernel_launch: occupancy query says %d\n", per_cu); per_cu = 1; }
        (void)hipGetLastError();
        grid = cus > 0 ? cus : 256;
    }
    if (grid < 0) return;
    if (hipMemsetAsync((char*)d_ws + WS_BAR, 0, 16384, stream) != hipSuccess) { fprintf(stderr, "kernel_launch: memset failed\n"); return; }
    Params p{};
    for (int i = 0; i < 21; ++i) p.in[i] = (const float*)d_in[i];
    p.out = (float*)d_out; p.ws = (unsigned char*)d_ws;
#ifndef N_LAUNCH_SPLIT
#define N_LAUNCH_SPLIT 0
#endif
    constexpr int NPC_H = 2 * 38 + 1;
    if (N_LAUNCH_SPLIT) {
        for (int pc = 0; pc < NPC_H; ++pc) {
            hipLaunchKernelGGL(mega_fwd, dim3(grid), dim3(NTHR), LDS_BYTES, stream, p, pc, pc + 1, 0, 0);
        }
        hipError_t e = hipPeekAtLastError();
        if (e != hipSuccess) fprintf(stderr, "launch failed: %s (grid %d)\n", hipGetErrorString(e), grid);
    } else {
        int lo = 0, hi = NPC_H, coop = 1, pad = 0;
        void* args[] = {&p, &lo, &hi, &coop, &pad};
        hipError_t e = hipLaunchCooperativeKernel((const void*)mega_fwd, dim3(grid), dim3(NTHR), args, LDS_BYTES, stream);
        if (e != hipSuccess) fprintf(stderr, "cooperative launch failed: %s (grid %d)\n", hipGetErrorString(e), grid);
    }
}
```
